# Optimizing an MI355X kernel written in HIP

```python
import math
import jax, jax.numpy as jnp
from jax import lax
import numpy as np

D_MODEL = 1024
BATCH = 32
SEQ = 256
DEPTH = 2
DEC_BATCH = 2
DEC_SEQ = 2048
PAST_LEN = 256

GRID_W = 64
N_EVEN = (DEPTH + 1) // 2
N_ODD = DEPTH // 2
H_A = 4
DK_A = 128
DV_A = 128
W_A = H_A * DK_A
W_B = 512
HY_ORDER = 2
HY_EMB = 33
HY_BANDS = (HY_EMB - 1) // 2
HY_FF = 64
HY_TARGET = 1e-2
HY_FAST = 0.3
HY_SLOW = 1.5
H_C = 4
DH_C = 64
DV_C = 2 * DH_C
W_C = H_C * DV_C
ROPE_BASE = 10000.0
H_D = 4
DK_D = 64
DV_D = 128
W_D = H_D * DV_D
GLA_RANK = 16
GLA_TAU = 16.0
D_FF = 2816
CHUNK = 32
Q_BLOCK = 128
EPS = 1e-6

EVEN_COLS = (W_A, W_A, W_A, W_A, W_A, (1 + HY_ORDER) * W_B)
ODD_COLS = (H_C * 2 * DH_C, H_C * 2 * DH_C, W_C, H_D * DK_D, H_D * DK_D, W_D, W_D, GLA_RANK, GLA_RANK)
D_IN_EVEN = sum(EVEN_COLS)
D_IN_ODD = sum(ODD_COLS)
F32 = jnp.float32

kernel_name = 'hybrid_hgrn2_hyena_diffattn_gla_prefix_step'


def split_cols(x, sizes):
    idx = [int(i) for i in np.cumsum(sizes)[:-1]]
    return jnp.split(x, idx, axis=-1)


def rms_norm(x, g):
    x32 = x.astype(F32)
    y = x32 * lax.rsqrt(jnp.mean(x32 * x32, axis=-1, keepdims=True) + EPS)
    return (y * g.astype(F32)).astype(x.dtype)


def heads(x, n):
    b_, L, w = x.shape
    return x.reshape(b_, L, n, w // n).transpose(0, 2, 1, 3)


def head_rms(o, g):
    b_, h_, L, d = o.shape
    o32 = o.transpose(0, 2, 1, 3).astype(F32)
    y = o32 * lax.rsqrt(jnp.mean(o32 * o32, axis=-1, keepdims=True) + EPS) * g.reshape(h_, d).astype(F32)
    return y.reshape(b_, L, h_ * d).astype(o.dtype)


def dwconv3(x, w, b):
    L = x.shape[1]
    xp = jnp.pad(x, ((0, 0), (1, 1), (0, 0)))
    return xp[:, :L] * w[0] + xp[:, 1:L + 1] * w[1] + xp[:, 2:] * w[2] + b


def chunk_gated_scan(q, k, v, log_f, s0):
    b_, h_, L, dk = q.shape
    dv = v.shape[-1]
    n = L // CHUNK

    def to_chunks(t):
        return jnp.moveaxis(t.astype(F32).reshape(b_, h_, n, CHUNK, t.shape[-1]), 2, 0)

    mask = jnp.tril(jnp.ones((CHUNK, CHUNK), bool))[:, :, None]

    def step(S, inp):
        qc, kc, vc, gc = inp
        cum = jnp.cumsum(gc, axis=2)
        rel = jnp.where(mask, cum[:, :, :, None, :] - cum[:, :, None, :, :], -jnp.inf)
        att = jnp.einsum('bhtk,bhsk,bhtsk->bhts', qc, kc, jnp.exp(rel))
        o = jnp.einsum('bhts,bhsv->bhtv', att, vc) + jnp.einsum('bhtk,bhkv->bhtv', qc * jnp.exp(cum), S)
        last = cum[:, :, -1:, :]
        S = jnp.exp(last[:, :, 0, :, None]) * S + jnp.einsum('bhsk,bhsv->bhkv', kc * jnp.exp(last - cum), vc)
        return S, o

    s_fin, o = lax.scan(step, s0.astype(F32), (to_chunks(q), to_chunks(k), to_chunks(v), to_chunks(log_f)))
    o = jnp.moveaxis(o, 0, 2).reshape(b_, h_, L, dv)
    return o.astype(v.dtype), s_fin.astype(v.dtype)


def bidir_scan(q, k_f, k_b, v, logf_f, logf_b, s0):
    o_f, s_f = chunk_gated_scan(q, k_f, v, logf_f, s0[:, 0])
    flip = lambda t: jnp.flip(t, axis=2)
    o_b, s_b = chunk_gated_scan(flip(q), flip(k_b), flip(v), flip(logf_b), s0[:, 1])
    return o_f + flip(o_b), jnp.stack([s_f, s_b], axis=1)


def hyena_filters(L, w1, b1, w2, b2, w3, freq):
    t = jnp.linspace(0.0, 1.0, L, dtype=F32)[:, None]
    w = 2.0 * math.pi * jnp.arange(L, dtype=F32)[:, None] / L
    fb = jnp.linspace(1e-4, HY_BANDS - 1, HY_BANDS, dtype=F32)[None]
    z = jnp.concatenate([t, jnp.cos(fb * w), -jnp.sin(fb * w)], axis=-1)
    h = jnp.sin(freq.astype(F32) * (z @ w1.astype(F32) + b1.astype(F32)))
    h = jnp.sin(freq.astype(F32) * (h @ w2.astype(F32) + b2.astype(F32)))
    h = (h @ w3.astype(F32)).reshape(L, HY_ORDER, 2, W_B)
    max_decay = math.log(HY_TARGET) / HY_FAST
    min_decay = math.log(HY_TARGET) / HY_SLOW
    deltas = jnp.abs(jnp.linspace(min_decay, max_decay, W_B, dtype=F32))
    window = jnp.exp(-t * deltas[None])
    return (h * window[:, None, None, :]).transpose(1, 2, 0, 3)


def two_sided_fftconv(u, filt):
    L = u.shape[1]
    kern = jnp.concatenate([filt[0], jnp.zeros((1, filt.shape[-1]), F32), jnp.flip(filt[1, 1:], axis=0)], axis=0)
    U = jnp.fft.rfft(u.astype(F32), n=2 * L, axis=1)
    K = jnp.fft.rfft(kern, axis=0)
    return jnp.fft.irfft(U * K[None], n=2 * L, axis=1)[:, :L].astype(u.dtype)


def rope_2d(x):
    L = x.shape[2]
    rows = L // GRID_W
    row = jnp.repeat(jnp.arange(rows), GRID_W).astype(F32)
    col = jnp.tile(jnp.arange(GRID_W), rows).astype(F32)
    half = DH_C // 2
    inv = ROPE_BASE ** (-jnp.arange(0, half, 2, dtype=F32) / half)

    def rot(t, pos):
        ang = pos[:, None] * inv[None]
        cos = jnp.cos(ang)[:, None, :]
        sin = jnp.sin(ang)[:, None, :]
        t1, t2 = jnp.split(t, 2, axis=-1)
        return jnp.concatenate([t1 * cos - t2 * sin, t1 * sin + t2 * cos], axis=-1)

    xr, xc = jnp.split(x.astype(F32), 2, axis=-1)
    return jnp.concatenate([rot(xr, row), rot(xc, col)], axis=-1).astype(x.dtype)


def diff_attention(q, keys, vals, lam):
    b_, h_, Lq = q.shape[:3]
    nb = Lq // Q_BLOCK
    qb = q.reshape(b_, h_, nb, Q_BLOCK, 2, DH_C).transpose(2, 0, 1, 3, 4, 5)
    scale = DH_C ** -0.5

    def block(qi):
        s = jnp.einsum('bhqpd,bhkpd->bhpqk', qi, keys).astype(F32) * scale
        p = jax.nn.softmax(s, axis=-1)
        w = p[:, :, 0] - lam * p[:, :, 1]
        return jnp.einsum('bhqk,bhkv->bhqv', w.astype(vals.dtype), vals)

    o = lax.map(block, qb)
    return o.transpose(1, 2, 0, 3, 4).reshape(b_, h_, Lq, vals.shape[-1])


def even_mixer(h, s0, p):
    L = h.shape[1]
    q, ff, fb, i, g, hy = split_cols(h @ p['w_in'], EVEN_COLS)
    lb = p['lb']
    f_f = lb[0] + (1.0 - lb[0]) * jax.nn.sigmoid(ff.astype(F32))
    f_b = lb[1] + (1.0 - lb[1]) * jax.nn.sigmoid(fb.astype(F32))
    qh = heads(jax.nn.silu(q) * DK_A ** -0.5, H_A)
    o_a, s_new = bidir_scan(qh, heads(1.0 - f_f, H_A), heads(1.0 - f_b, H_A), heads(i, H_A),
                            heads(jnp.log(f_f), H_A), heads(jnp.log(f_b), H_A), s0)
    out_a = head_rms(o_a, p['hgrn_norm']) * jax.nn.silu(g)
    hy = dwconv3(hy, p['hy_conv_w'], p['hy_conv_b'])
    v, x1, x2 = jnp.split(hy, 1 + HY_ORDER, axis=-1)
    filt = hyena_filters(L, p['hy_w1'], p['hy_b1'], p['hy_w2'], p['hy_b2'], p['hy_w3'], p['hy_freq'])
    z = v
    for o_idx, gate in enumerate((x1, x2)):
        z = gate * (two_sided_fftconv(z, filt[o_idx]) + z * p['hy_d'][o_idx])
    return jnp.concatenate([out_a, z], axis=-1) @ p['w_out'], s_new


def odd_mixer(h, s0, ctx_k, ctx_v, l, p):
    b_, L, _ = h.shape
    cq, ck, cv, dq, dk, dv, dg, da_f, da_b = split_cols(h @ p['w_in'], ODD_COLS)
    q = cq.reshape(b_, L, H_C, 2, DH_C).transpose(0, 2, 1, 3, 4)
    k = ck.reshape(b_, L, H_C, 2, DH_C).transpose(0, 2, 1, 3, 4)
    v = heads(cv, H_C)
    if ctx_k is None:
        keys, vals = k, v
        cache = (k.reshape(b_, H_C, L, 2 * DH_C), v)
    else:
        q = rope_2d(q)
        keys = jnp.concatenate([ctx_k.reshape(b_, H_C, -1, 2, DH_C), rope_2d(k)], axis=2)
        vals = jnp.concatenate([ctx_v, v], axis=2)
        cache = None
    lam_init = 0.8 - 0.6 * math.exp(-0.3 * l)
    lp = p['diff_lambda'].astype(F32)
    lam = jnp.exp(jnp.sum(lp[0] * lp[1])) - jnp.exp(jnp.sum(lp[2] * lp[3])) + lam_init
    o_c = diff_attention(q, keys, vals, lam)
    out_c = head_rms(o_c, p['diff_norm']) * (1.0 - lam_init)
    qd = heads(dq, H_D) * DK_D ** -0.5
    kd = heads(dk, H_D)
    vd = heads(dv, H_D)
    la_f = jax.nn.log_sigmoid((da_f @ p['gla_aw'][0] + p['gla_ab'][0]).astype(F32)) / GLA_TAU
    la_b = jax.nn.log_sigmoid((da_b @ p['gla_aw'][1] + p['gla_ab'][1]).astype(F32)) / GLA_TAU
    o_d, s_new = bidir_scan(qd, kd, kd, vd, heads(la_f, H_D), heads(la_b, H_D), s0)
    out_d = head_rms(o_d, p['gla_norm']) * jax.nn.silu(dg)
    return jnp.concatenate([out_c, out_d], axis=-1) @ p['w_out'], cache, s_new


def conv_ffn(h, up, cw, cb, down):
    u = dwconv3(h @ up, cw, cb)
    a, g = jnp.split(u, 2, axis=-1)
    return (jax.nn.silu(g) * a) @ down


def modulate(x, mod, j):
    return x * (1.0 + mod[:, :, 3 * j + 1]) + mod[:, :, 3 * j]


def setup_inputs(seed: int = 0) -> dict:
    key = jax.random.key(seed)
    ks = iter(jax.random.split(key, 40))

    def nrm(shape, scale=1.0):
        return jax.random.normal(next(ks), shape, F32) * scale

    def gain(shape):
        return 1.0 + nrm(shape, 0.05)

    D = D_MODEL
    return {
        'x_prompt': nrm((BATCH, SEQ, D)),
        'x_sample': nrm((DEC_BATCH, DEC_SEQ, D)),
        'state_hgrn': nrm((DEC_BATCH, N_EVEN, 2, H_A, DK_A, DV_A), 0.5),
        'cache_diff_k': nrm((DEC_BATCH, N_ODD, H_C, PAST_LEN, 2 * DH_C)),
        'cache_diff_v': nrm((DEC_BATCH, N_ODD, H_C, PAST_LEN, DV_C)),
        'state_gla': nrm((DEC_BATCH, N_ODD, 2, H_D, DK_D, DV_D), 0.5),
        'c': nrm((DEC_BATCH, D)),
        'c_ctx': nrm((D,)),
        'ada_w': nrm((DEPTH, D, 6 * D), 0.5 * D ** -0.5),
        'ada_b': nrm((DEPTH, 6 * D), 0.01),
        'norm_g': gain((DEPTH, 4, D)),
        'ffn_up': nrm((DEPTH, D, 2 * D_FF), D ** -0.5),
        'ffn_conv_w': nrm((DEPTH, 3, 2 * D_FF), 3 ** -0.5),
        'ffn_conv_b': nrm((DEPTH, 2 * D_FF), 0.01),
        'ffn_down': nrm((DEPTH, D_FF, D), D_FF ** -0.5),
        'w_in_even': nrm((N_EVEN, D, D_IN_EVEN), D ** -0.5),
        'w_out_even': nrm((N_EVEN, W_A + W_B, D), (W_A + W_B) ** -0.5),
        'hgrn_lb': nrm((DEPTH + 1, 2, W_A), 0.5),
        'hgrn_norm': gain((N_EVEN, W_A)),
        'hy_conv_w': nrm((N_EVEN, 3, (1 + HY_ORDER) * W_B), 3 ** -0.5),
        'hy_conv_b': nrm((N_EVEN, (1 + HY_ORDER) * W_B), 0.01),
        'hy_w1': nrm((N_EVEN, HY_EMB, HY_FF), HY_EMB ** -0.5),
        'hy_b1': nrm((N_EVEN, HY_FF), 0.1),
        'hy_w2': nrm((N_EVEN, HY_FF, HY_FF), HY_FF ** -0.5),
        'hy_b2': nrm((N_EVEN, HY_FF), 0.1),
        'hy_w3': nrm((N_EVEN, HY_FF, HY_ORDER * 2 * W_B), 0.1 * HY_FF ** -0.5),
        'hy_freq': 1.0 + nrm((N_EVEN, HY_FF), 0.1),
        'hy_d': nrm((N_EVEN, HY_ORDER, W_B), 0.5),
        'w_in_odd': nrm((N_ODD, D, D_IN_ODD), D ** -0.5),
        'w_out_odd': nrm((N_ODD, W_C + W_D, D), (W_C + W_D) ** -0.5),
        'diff_lambda': nrm((N_ODD, 4, DH_C), 0.1),
        'diff_norm': gain((N_ODD, W_C)),
        'gla_aw': nrm((N_ODD, 2, GLA_RANK, H_D * DK_D), GLA_RANK ** -0.5),
        'gla_ab': nrm((N_ODD, 2, H_D * DK_D), 0.01),
        'gla_norm': gain((N_ODD, W_D)),
    }


def reference(x_prompt, x_sample, state_hgrn, cache_diff_k, cache_diff_v, state_gla, c, c_ctx,
              ada_w, ada_b, norm_g, ffn_up, ffn_conv_w, ffn_conv_b, ffn_down,
              w_in_even, w_out_even, hgrn_lb, hgrn_norm, hy_conv_w, hy_conv_b,
              hy_w1, hy_b1, hy_w2, hy_b2, hy_w3, hy_freq, hy_d,
              w_in_odd, w_out_odd, diff_lambda, diff_norm, gla_aw, gla_ab, gla_norm):
    lb_all = jnp.cumsum(jax.nn.softmax(hgrn_lb.astype(F32), axis=0), axis=0)
    yp, ys = x_prompt, x_sample
    hg_states, cache_ks, cache_vs, gla_states = [], [], [], []
    for l in range(DEPTH):
        mod_p = (jax.nn.silu(c_ctx) @ ada_w[l] + ada_b[l]).reshape(-1, 1, 6, D_MODEL)
        mod_s = (jax.nn.silu(c) @ ada_w[l] + ada_b[l]).reshape(-1, 1, 6, D_MODEL)
        hp = modulate(rms_norm(yp, norm_g[l, 0]), mod_p, 0)
        hs = modulate(rms_norm(ys, norm_g[l, 0]), mod_s, 0)
        if l % 2 == 0:
            e = l // 2
            p = {'w_in': w_in_even[e], 'w_out': w_out_even[e], 'lb': lb_all[l], 'hgrn_norm': hgrn_norm[e],
                 'hy_conv_w': hy_conv_w[e], 'hy_conv_b': hy_conv_b[e], 'hy_w1': hy_w1[e], 'hy_b1': hy_b1[e],
                 'hy_w2': hy_w2[e], 'hy_b2': hy_b2[e], 'hy_w3': hy_w3[e], 'hy_freq': hy_freq[e], 'hy_d': hy_d[e]}
            zero = jnp.zeros((yp.shape[0], 2, H_A, DK_A, DV_A), yp.dtype)
            mp, st = even_mixer(hp, zero, p)
            ms, _ = even_mixer(hs, state_hgrn[:, e], p)
            hg_states.append(st)
        else:
            o = l // 2
            p = {'w_in': w_in_odd[o], 'w_out': w_out_odd[o], 'diff_lambda': diff_lambda[o],
                 'diff_norm': diff_norm[o], 'gla_aw': gla_aw[o], 'gla_ab': gla_ab[o], 'gla_norm': gla_norm[o]}
            zero = jnp.zeros((yp.shape[0], 2, H_D, DK_D, DV_D), yp.dtype)
            mp, (kc, vc), st = odd_mixer(hp, zero, None, None, l, p)
            ms, _, _ = odd_mixer(hs, state_gla[:, o], cache_diff_k[:, o], cache_diff_v[:, o], l, p)
            cache_ks.append(kc)
            cache_vs.append(vc)
            gla_states.append(st)
        yp = yp + mod_p[:, :, 2] * rms_norm(mp, norm_g[l, 1])
        ys = ys + mod_s[:, :, 2] * rms_norm(ms, norm_g[l, 1])
        hp = modulate(rms_norm(yp, norm_g[l, 2]), mod_p, 1)
        hs = modulate(rms_norm(ys, norm_g[l, 2]), mod_s, 1)
        yp = yp + mod_p[:, :, 5] * rms_norm(conv_ffn(hp, ffn_up[l], ffn_conv_w[l], ffn_conv_b[l], ffn_down[l]), norm_g[l, 3])
        ys = ys + mod_s[:, :, 5] * rms_norm(conv_ffn(hs, ffn_up[l], ffn_conv_w[l], ffn_conv_b[l], ffn_down[l]), norm_g[l, 3])
    new_state_hgrn = jnp.stack(hg_states, axis=1)
    new_cache_diff_k = jnp.stack(cache_ks, axis=1)
    new_cache_diff_v = jnp.stack(cache_vs, axis=1)
    new_state_gla = jnp.stack(gla_states, axis=1)
    return (yp, ys, new_state_hgrn, new_cache_diff_k, new_cache_diff_v, new_state_gla)
```

```cpp
#include <hip/hip_runtime.h>
#include <hip/hip_cooperative_groups.h>
#include <stdint.h>
#include <cstdio>
namespace cg = cooperative_groups;

#ifndef MEGA
#define MEGA 1
#endif
#ifndef REP_PH
#define REP_PH -1
#endif

typedef unsigned short bh;
using bf16x8 = __attribute__((ext_vector_type(8))) short;
using f32x4 = __attribute__((ext_vector_type(4))) float;
using u32x4 = __attribute__((ext_vector_type(4))) unsigned int;

#define NT 12288
#define NTP 8192
#define EPSF 1e-6f
#define NPHASE 22

#define OUT_HGRN 12582912
#define OUT_CK 16777216
#define OUT_CV 20971520
#define OUT_GLA 25165824

#define OFF_ODIR 100663296ull
#define OFF_Z1 150994944ull
#define OFF_HYT 150994944ull
#define OFF_ACTF 138412032ull
#define OFF_Q 150994944ull
#define OFF_KB 163577856ull
#define OFF_VT 176685056ull
#define R_BYTES 207618048ull
#define KV_SAMPLE_BASE 4194304

struct Params {
  const float *x_prompt, *x_sample, *state_hgrn, *cache_k, *cache_v, *state_gla, *c, *c_ctx;
  const float *ada_w, *ada_b, *norm_g, *ffn_up, *ffn_conv_w, *ffn_conv_b, *ffn_down;
  const float *w_in_even, *w_out_even, *hgrn_lb, *hgrn_norm, *hy_conv_w, *hy_conv_b;
  const float *hy_w1, *hy_b1, *hy_w2, *hy_b2, *hy_w3, *hy_freq, *hy_d;
  const float *w_in_odd, *w_out_odd, *diff_lambda, *diff_norm, *gla_aw, *gla_ab, *gla_norm;
  float* out;
  bh* act;
  bh* wt;
  bh* wt2;
  char* R;
  float* mod;
  bh* gt256;
  bh* gt2048;
  unsigned* bar;
};

typedef __bf16 bf2_t __attribute__((ext_vector_type(2)));
typedef float f2_t __attribute__((ext_vector_type(2)));
typedef unsigned int u32x2 __attribute__((ext_vector_type(2)));
__device__ __forceinline__ unsigned pk2(float a, float b) {
  f2_t v = {a, b};
  return __builtin_bit_cast(unsigned, __builtin_convertvector(v, bf2_t));
}
__device__ __forceinline__ bh f2bf(float x) { return (bh)(pk2(x, x) & 0xffffu); }
__device__ __forceinline__ float bflo(unsigned w) { return __uint_as_float(w << 16); }
__device__ __forceinline__ float bfhi(unsigned w) { return __uint_as_float(w & 0xffff0000u); }
__device__ __forceinline__ float bf2f(bh h) { return __uint_as_float(((uint32_t)h) << 16); }
__device__ __forceinline__ float sigmoidf_(float x) { return __builtin_amdgcn_rcpf(1.f + __expf(-x)); }
__device__ __forceinline__ float siluf_(float x) { return x * __builtin_amdgcn_rcpf(1.f + __expf(-x)); }
template <int CTRL>
__device__ __forceinline__ float dppf0(float v) {
  return __int_as_float(__builtin_amdgcn_update_dpp(0, __float_as_int(v), CTRL, 0xF, 0xF, true));
}
__device__ __forceinline__ float wave_sum(float v) {
  v += dppf0<0xB1>(v); v += dppf0<0x4E>(v); v += dppf0<0x141>(v); v += dppf0<0x140>(v);
  v += __shfl_xor(v, 16);
  v += __shfl_xor(v, 32);
  return v;
}

template <int OUT_BF16, int BM, int DEPTH>
__device__ __forceinline__ void gemm_phase(const bh* __restrict__ A, int lda, const bh* __restrict__ Bt, int K, void* Cv, int ldc,
                           int N, int ntn, int bid, int nb, char* smem, const float* cw = nullptr, const float* cb = nullptr) {
  constexpr int MT = BM / 32;
  constexpr int NPA = BM / 32;
  bh* As = (bh*)smem;
  bh* Bs = As + BM * 64;
  int tid_l_ = threadIdx.x; asm volatile("" : "+v"(tid_l_)); const int tid = tid_l_, lane = tid & 63, w = tid >> 6, wr = w >> 1, wc = w & 1, r = lane & 15, g = lane >> 4;
  constexpr int MB = (NT / BM) / 8;
  const int xcd = bid & 7, nloc = nb >> 3;
  const int qend = OUT_BF16 == 3 ? MB * ntn + (ntn + 7) / 8 : MB * ntn;
  for (int q = bid >> 3; q < qend; q += nloc) {
    int mt = xcd * MB + (q % MB), nt = q / MB;
    if (OUT_BF16 == 3 && q >= MB * ntn) { mt = 64; nt = (q - MB * ntn) * 8 + xcd; if (nt >= ntn) continue; }
    const int trow0 = OUT_BF16 == 3 ? mt * 190 - 1 : mt * BM;
    const bh* Ag = A;
    const bh* Bg = Bt + (size_t)(nt * 128) * K;
    f32x4 acc[MT][4];
#pragma unroll
    for (int m = 0; m < MT; ++m)
#pragma unroll
      for (int n = 0; n < 4; ++n) acc[m][n] = (f32x4){0.f, 0.f, 0.f, 0.f};
    u32x4 pa0[NPA], pb0[4], pa1[NPA], pb1[4];
    auto gload = [&](u32x4* pa, u32x4* pb, int kofs) {
#pragma unroll
      for (int i = 0; i < NPA; ++i) {
        int pz = tid + i * 256, row = pz >> 3, cp = pz & 7;
        int tr = trow0 + row;
        if (OUT_BF16 == 3) tr = min(max(tr, 0), NT - 1);
        pa[i] = *(const u32x4*)(Ag + (size_t)tr * lda + kofs + cp * 8);
      }
#pragma unroll
      for (int i = 0; i < 4; ++i) {
        int pz = tid + i * 256, row = pz >> 3, cp = pz & 7;
        pb[i] = *(const u32x4*)(Bg + (size_t)row * K + kofs + cp * 8);
      }
    };
    auto kstep = [&](u32x4* pa, u32x4* pb, int knext) {
      __syncthreads();
#pragma unroll
      for (int i = 0; i < NPA; ++i) {
        int pz = tid + i * 256, row = pz >> 3, cp = pz & 7;
        *(u32x4*)(As + row * 64 + ((cp ^ ((row >> 1) & 7)) << 3)) = pa[i];
      }
#pragma unroll
      for (int i = 0; i < 4; ++i) {
        int pz = tid + i * 256, row = pz >> 3, cp = pz & 7;
        *(u32x4*)(Bs + row * 64 + ((cp ^ ((row >> 1) & 7)) << 3)) = pb[i];
      }
      __syncthreads();
      if (knext < K) gload(pa, pb, knext);
#pragma unroll
      for (int kk = 0; kk < 2; ++kk) {
        bf16x8 af[MT], bfr[4];
#pragma unroll
        for (int m = 0; m < MT; ++m) { const int row = wr * (BM / 2) + m * 16 + r; af[m] = *(const bf16x8*)(As + row * 64 + (((kk * 4 + g) ^ ((row >> 1) & 7)) << 3)); }
#pragma unroll
        for (int n = 0; n < 4; ++n) { const int row = wc * 64 + n * 16 + r; bfr[n] = *(const bf16x8*)(Bs + row * 64 + (((kk * 4 + g) ^ ((row >> 1) & 7)) << 3)); }
        __builtin_amdgcn_sched_barrier(0);
#pragma unroll
        for (int m = 0; m < MT; ++m)
#pragma unroll
          for (int n = 0; n < 4; ++n)
            acc[m][n] = (OUT_BF16 == 1 || OUT_BF16 == 3) ? __builtin_amdgcn_mfma_f32_16x16x32_bf16(bfr[n], af[m], acc[m][n], 0, 0, 0)
                                        : __builtin_amdgcn_mfma_f32_16x16x32_bf16(af[m], bfr[n], acc[m][n], 0, 0, 0);
        __builtin_amdgcn_sched_barrier(0);
      }
    };
    if (DEPTH == 3) {
      constexpr int NA3 = BM / 64;
      bh* As3 = (bh*)smem;
      bh* Bs3 = As3 + 2 * BM * 32;
      u32x4 ra0[NA3], rb0[2], ra1[NA3], rb1[2];
      auto ld3 = [&](u32x4* ra, u32x4* rb, int kofs) {
#pragma unroll
        for (int i = 0; i < NA3; ++i) {
          int pz = tid + i * 256, row = pz >> 2, c = pz & 3;
          int tr = trow0 + row;
          if (OUT_BF16 == 3) tr = min(max(tr, 0), NT - 1);
          ra[i] = *(const u32x4*)(Ag + (size_t)tr * lda + kofs + c * 8);
        }
#pragma unroll
        for (int i = 0; i < 2; ++i) {
          int pz = tid + i * 256, row = pz >> 2, c = pz & 3;
          rb[i] = *(const u32x4*)(Bg + (size_t)row * K + kofs + c * 8);
        }
      };
      auto st3 = [&](const u32x4* ra, const u32x4* rb, int stg) {
#pragma unroll
        for (int i = 0; i < NA3; ++i) {
          int pz = tid + i * 256, row = pz >> 2, c = pz & 3;
          *(u32x4*)(As3 + stg * BM * 32 + row * 32 + ((c ^ (((row >> 3) & 1) << 1)) << 3)) = ra[i];
        }
#pragma unroll
        for (int i = 0; i < 2; ++i) {
          int pz = tid + i * 256, row = pz >> 2, c = pz & 3;
          *(u32x4*)(Bs3 + stg * 128 * 32 + row * 32 + ((c ^ (((row >> 3) & 1) << 1)) << 3)) = rb[i];
        }
      };
      auto comp3 = [&](int cur) {
        bf16x8 af[MT], bfr[4];
#pragma unroll
        for (int m = 0; m < MT; ++m) {
          const int row = wr * (BM / 2) + m * 16 + r;
          af[m] = *(const bf16x8*)(As3 + cur * BM * 32 + row * 32 + ((g ^ (((row >> 3) & 1) << 1)) << 3));
        }
#pragma unroll
        for (int n = 0; n < 4; ++n) {
          const int row = wc * 64 + n * 16 + r;
          bfr[n] = *(const bf16x8*)(Bs3 + cur * 128 * 32 + row * 32 + ((g ^ (((row >> 3) & 1) << 1)) << 3));
        }
#pragma unroll
        for (int m = 0; m < MT; ++m)
#pragma unroll
          for (int n = 0; n < 4; ++n)
            acc[m][n] = (OUT_BF16 == 1 || OUT_BF16 == 3) ? __builtin_amdgcn_mfma_f32_16x16x32_bf16(bfr[n], af[m], acc[m][n], 0, 0, 0)
                                        : __builtin_amdgcn_mfma_f32_16x16x32_bf16(af[m], bfr[n], acc[m][n], 0, 0, 0);
      };
      const int nk = K >> 5;
      __syncthreads();
      ld3(ra0, rb0, 0);
      ld3(ra1, rb1, 32);
      st3(ra0, rb0, 0);
      ld3(ra0, rb0, 64);
      __syncthreads();
      for (int ks = 0; ks < nk; ks += 2) {
        comp3(0);
        st3(ra1, rb1, 1);
        if (ks + 3 < nk) ld3(ra1, rb1, (ks + 3) << 5);
        __syncthreads();
        comp3(1);
        if (ks + 2 < nk) st3(ra0, rb0, 0);
        if (ks + 4 < nk) ld3(ra0, rb0, (ks + 4) << 5);
        __syncthreads();
      }
    } else {
    gload(pa0, pb0, 0);
    if (DEPTH == 2) {
      gload(pa1, pb1, 64);
      for (int k0 = 0; k0 < K; k0 += 128) {
        kstep(pa0, pb0, k0 + 128);
        kstep(pa1, pb1, k0 + 192);
      }
    } else {
      for (int k0 = 0; k0 < K; k0 += 64) kstep(pa0, pb0, k0 + 64);
    }
    }
    if (OUT_BF16 == 1 || OUT_BF16 == 3) {
      __syncthreads();
      bh* Ct = (bh*)smem;
#pragma unroll
      for (int m = 0; m < MT; ++m)
#pragma unroll
        for (int n = 0; n < 4; ++n) {
          const int row = wr * (BM / 2) + m * 16 + r;
          const int sl = wc * 16 + n * 4 + g;
          u32x2 pv;
          pv[0] = pk2(acc[m][n][0], acc[m][n][1]);
          pv[1] = pk2(acc[m][n][2], acc[m][n][3]);
          *(u32x2*)(Ct + row * 128 + ((sl ^ ((row & 15) << 1)) << 2)) = pv;
        }
      __syncthreads();
      if (OUT_BF16 == 1) {
#pragma unroll 2
        for (int i = 0; i < BM / 16; ++i) {
          const int pz = tid + i * 256, row = pz >> 4, pc = pz & 15;
          const u32x4 v = *(const u32x4*)(Ct + row * 128 + ((pc ^ (row & 15)) << 3));
          const int col = nt * 128 + pc * 8;
          if (col < N) *(u32x4*)((bh*)Cv + ((size_t)mt * BM + row) * ldc + col) = v;
        }
      } else {
        const int c8 = tid & 7, rs = tid >> 3;
        const int ja = nt * 64 + c8 * 8;
        float wa[3][8], wg[3][8], ba[8], bg[8];
#pragma unroll
        for (int tp = 0; tp < 3; ++tp) {
          const float4 x0 = *(const float4*)(cw + tp * 5632 + ja), x1 = *(const float4*)(cw + tp * 5632 + ja + 4);
          const float4 y0 = *(const float4*)(cw + tp * 5632 + 2816 + ja), y1 = *(const float4*)(cw + tp * 5632 + 2816 + ja + 4);
          wa[tp][0] = x0.x; wa[tp][1] = x0.y; wa[tp][2] = x0.z; wa[tp][3] = x0.w; wa[tp][4] = x1.x; wa[tp][5] = x1.y; wa[tp][6] = x1.z; wa[tp][7] = x1.w;
          wg[tp][0] = y0.x; wg[tp][1] = y0.y; wg[tp][2] = y0.z; wg[tp][3] = y0.w; wg[tp][4] = y1.x; wg[tp][5] = y1.y; wg[tp][6] = y1.z; wg[tp][7] = y1.w;
        }
        {
          const float4 x0 = *(const float4*)(cb + ja), x1 = *(const float4*)(cb + ja + 4);
          const float4 y0 = *(const float4*)(cb + 2816 + ja), y1 = *(const float4*)(cb + 2816 + ja + 4);
          ba[0] = x0.x; ba[1] = x0.y; ba[2] = x0.z; ba[3] = x0.w; ba[4] = x1.x; ba[5] = x1.y; ba[6] = x1.z; ba[7] = x1.w;
          bg[0] = y0.x; bg[1] = y0.y; bg[2] = y0.z; bg[3] = y0.w; bg[4] = y1.x; bg[5] = y1.y; bg[6] = y1.z; bg[7] = y1.w;
        }
#pragma unroll 1
        for (int i = 0; i < 6; ++i) {
          const int rr = 1 + rs + 32 * i;
          const int t = trow0 + rr;
          if (rr <= 190 && t < NT) {
            const bool start = (t < NTP) ? ((t & 255) == 0) : ((t & 2047) == 0);
            const bool endd = (t < NTP) ? ((t & 255) == 255) : ((t & 2047) == 2047);
            u32x4 am = *(const u32x4*)(Ct + (rr - 1) * 128 + ((c8 ^ ((rr - 1) & 15)) << 3));
            u32x4 gm = *(const u32x4*)(Ct + (rr - 1) * 128 + (((8 + c8) ^ ((rr - 1) & 15)) << 3));
            const u32x4 a0 = *(const u32x4*)(Ct + rr * 128 + ((c8 ^ (rr & 15)) << 3));
            const u32x4 g0 = *(const u32x4*)(Ct + rr * 128 + (((8 + c8) ^ (rr & 15)) << 3));
            u32x4 ap = *(const u32x4*)(Ct + (rr + 1) * 128 + ((c8 ^ ((rr + 1) & 15)) << 3));
            u32x4 gp = *(const u32x4*)(Ct + (rr + 1) * 128 + (((8 + c8) ^ ((rr + 1) & 15)) << 3));
            if (start) { am = (u32x4){0, 0, 0, 0}; gm = (u32x4){0, 0, 0, 0}; }
            if (endd) { ap = (u32x4){0, 0, 0, 0}; gp = (u32x4){0, 0, 0, 0}; }
            u32x4 ov;
#pragma unroll
            for (int e2 = 0; e2 < 4; ++e2) {
              float res[2];
#pragma unroll
              for (int hl = 0; hl < 2; ++hl) {
                const int e = e2 * 2 + hl;
                const float av = wa[0][e] * (hl ? bfhi(am[e2]) : bflo(am[e2])) + wa[1][e] * (hl ? bfhi(a0[e2]) : bflo(a0[e2])) +
                                 wa[2][e] * (hl ? bfhi(ap[e2]) : bflo(ap[e2])) + ba[e];
                const float gv = wg[0][e] * (hl ? bfhi(gm[e2]) : bflo(gm[e2])) + wg[1][e] * (hl ? bfhi(g0[e2]) : bflo(g0[e2])) +
                                 wg[2][e] * (hl ? bfhi(gp[e2]) : bflo(gp[e2])) + bg[e];
                res[hl] = siluf_(gv) * av;
              }
              ov[e2] = pk2(res[0], res[1]);
            }
            *(u32x4*)((bh*)Cv + (size_t)t * 2816 + ja) = ov;
          }
        }
      }
    }
#pragma unroll
    for (int m = 0; m < MT; ++m)
#pragma unroll
      for (int n = 0; n < 4; ++n) {
        if (OUT_BF16 == 1 || OUT_BF16 == 3) continue;
        int col = nt * 128 + wc * 64 + n * 16 + r;
        const size_t rowb = (size_t)mt * BM + wr * (BM / 2) + m * 16 + g * 4;
        if (OUT_BF16 == 2 && nt >= 20) {
          bh* hyt = (bh*)((char*)Cv + OFF_HYT) + (size_t)(col - 2560) * NT + rowb;
          u32x2 pv;
          pv[0] = pk2(acc[m][n][0], acc[m][n][1]);
          pv[1] = pk2(acc[m][n][2], acc[m][n][3]);
          *(u32x2*)hyt = pv;
        } else if (col < N) {
#pragma unroll
          for (int j = 0; j < 4; ++j) {
            size_t row = rowb + j;
            if (OUT_BF16) ((bh*)Cv)[row * ldc + col] = f2bf(acc[m][n][j]);
            else ((float*)Cv)[row * ldc + col] = acc[m][n][j];
          }
        }
      }
  }
}

__device__ __forceinline__ void convert_tile(const float* __restrict__ W, int K, int N, bh* __restrict__ WT, int tile, char* smem, bool perm = false) {
  float* tl = (float*)smem;
  int tid_l_ = threadIdx.x; asm volatile("" : "+v"(tid_l_)); const int tid = tid_l_;
  const int ntk = K >> 6;
  const int kt = tile % ntk, ntile = tile / ntk;
  __syncthreads();
#pragma unroll
  for (int i = 0; i < 16; ++i) {
    int e = tid + i * 256, kk = e >> 6, nn = e & 63, n = ntile * 64 + nn;
    tl[kk * 65 + nn] = (n < N) ? W[(size_t)(kt * 64 + kk) * N + n] : 0.f;
  }
  __syncthreads();
#pragma unroll
  for (int i = 0; i < 16; ++i) {
    int e = tid + i * 256, nn = e >> 6, kk = e & 63;
    const int orow = perm ? (ntile % 44) * 128 + (ntile / 44) * 64 + nn : ntile * 64 + nn;
    WT[(size_t)orow * K + kt * 64 + kk] = f2bf(tl[kk * 65 + nn]);
  }
}

__device__ __forceinline__ void gemv_job(const Params& p, int job, char* smem) {
  float* sc = (float*)smem;
  float* rd = sc + 768;
  int tid_l_ = threadIdx.x; asm volatile("" : "+v"(tid_l_)); const int tid = tid_l_;
  const int iq = job & 3, jb = (job >> 2) % 96, l = (job >> 2) / 96;
  __syncthreads();
  for (int i = tid; i < 768; i += 256) {
    int r = i >> 8, idx = iq * 256 + (i & 255);
    float v = (r == 0) ? p.c_ctx[idx] : p.c[(r - 1) * 1024 + idx];
    sc[i] = siluf_(v);
  }
  __syncthreads();
  const int jl = tid & 63, ig = tid >> 6, j = jb * 64 + jl;
  const float* W = p.ada_w + (size_t)l * 1024 * 6144 + (size_t)(iq * 256 + ig * 64) * 6144 + j;
  float a0 = 0.f, a1 = 0.f, a2 = 0.f;
#pragma unroll 16
  for (int i = 0; i < 64; ++i) {
    float wv = W[(size_t)i * 6144];
    a0 += sc[ig * 64 + i] * wv;
    a1 += sc[256 + ig * 64 + i] * wv;
    a2 += sc[512 + ig * 64 + i] * wv;
  }
  rd[(ig * 3 + 0) * 64 + jl] = a0;
  rd[(ig * 3 + 1) * 64 + jl] = a1;
  rd[(ig * 3 + 2) * 64 + jl] = a2;
  __syncthreads();
  if (tid < 192) {
    int r = tid >> 6, jl2 = tid & 63, j2 = jb * 64 + jl2;
    float sacc = (iq == 0) ? p.ada_b[l * 6144 + j2] : 0.f;
    for (int q = 0; q < 4; ++q) sacc += rd[(q * 3 + r) * 64 + jl2];
    atomicAdd(p.mod + (size_t)(l * 3 + r) * 6144 + j2, sacc);
  }
}

__device__ __forceinline__ void filter_job(const Params& p, int job, char* smem) {
  float* sh2 = (float*)smem;
  int tid_l_ = threadIdx.x; asm volatile("" : "+v"(tid_l_)); const int tid = tid_l_, lane = tid & 63, w = tid >> 6;
  int L, pos0;
  bh* gt;
  if (job < 64) { L = 256; pos0 = job * 4; gt = p.gt256; }
  else { L = 2048; pos0 = (job - 64) * 4; gt = p.gt2048; }
  __syncthreads();
  {
    const int pos = pos0 + w;
    const float t = (float)pos / (float)(L - 1);
    const float wv = 2.0f * 3.14159265358979323846f * (float)pos / (float)L;
    float zv = 0.f;
    if (lane == 0) zv = t;
    else if (lane <= 16) { float fb = 1e-4f + (float)(lane - 1) * ((15.0f - 1e-4f) / 15.0f); zv = cosf(fb * wv); }
    else if (lane <= 32) { float fb = 1e-4f + (float)(lane - 17) * ((15.0f - 1e-4f) / 15.0f); zv = -sinf(fb * wv); }
    const float fr = p.hy_freq[lane];
    float a = p.hy_b1[lane];
    for (int i = 0; i < 33; ++i) a += __shfl(zv, i) * p.hy_w1[i * 64 + lane];
    const float h1 = sinf(fr * a);
    a = p.hy_b2[lane];
    for (int i = 0; i < 64; ++i) a += __shfl(h1, i) * p.hy_w2[i * 64 + lane];
    sh2[w * 64 + lane] = sinf(fr * a);
  }
  __syncthreads();
  float acc[8][4];
#pragma unroll
  for (int m = 0; m < 8; ++m)
#pragma unroll
    for (int pp = 0; pp < 4; ++pp) acc[m][pp] = 0.f;
#pragma unroll 8
  for (int i = 0; i < 64; ++i) {
    const float h0 = sh2[i], h1 = sh2[64 + i], h2 = sh2[128 + i], h3 = sh2[192 + i];
#pragma unroll
    for (int m = 0; m < 8; ++m) {
      const float wv = p.hy_w3[i * 2048 + tid + 256 * m];
      acc[m][0] += wv * h0; acc[m][1] += wv * h1; acc[m][2] += wv * h2; acc[m][3] += wv * h3;
    }
  }
  const float min_decay = logf(1e-2f) / 1.5f, max_decay = logf(1e-2f) / 0.3f;
#pragma unroll
  for (int m = 0; m < 8; ++m) {
    const int o = tid + 256 * m;
    const int ord = o >> 10, side = (o >> 9) & 1, c = o & 511;
    const float delta = fabsf(min_decay + (float)c * ((max_decay - min_decay) / 511.0f));
    bh* grow = gt + (size_t)(ord * 512 + c) * (2 * L);
#pragma unroll
    for (int pp = 0; pp < 4; ++pp) {
      const int pos = pos0 + pp;
      const float t = (float)pos / (float)(L - 1);
      const bh val = f2bf(acc[m][pp] * expf(-t * delta));
      if (side == 0) grow[L - 1 - pos] = val;
      else if (pos >= 1) grow[L - 1 + pos] = val;
    }
  }
}

__device__ __forceinline__ void rows_job(const Params& p, int job, bool first, const bh* src, const float* gres, int lgate, int gate_idx,
                         const float* gnext, int lnext, int shift_idx) {
  int tid_l_ = threadIdx.x; asm volatile("" : "+v"(tid_l_)); const int tid = tid_l_, lane = tid & 63, w = tid >> 6;
  const int rowb = job * 8 + w * 2;
  const int r = rowb < NTP ? 0 : 1 + ((rowb - NTP) >> 11);
  float4 y[2][4], m[2][4];
#pragma unroll
  for (int rr = 0; rr < 2; ++rr) {
    const int row = rowb + rr;
    const float* xin = first ? (row < NTP ? p.x_prompt + (size_t)row * 1024 : p.x_sample + (size_t)(row - NTP) * 1024)
                             : p.out + (size_t)row * 1024;
#pragma unroll
    for (int i = 0; i < 4; ++i) y[rr][i] = *(const float4*)(xin + i * 256 + lane * 4);
    if (src) {
#pragma unroll
      for (int i = 0; i < 4; ++i) { const u32x2 mv = *(const u32x2*)(src + (size_t)row * 1024 + i * 256 + lane * 4); m[rr][i] = make_float4(bflo(mv[0]), bfhi(mv[0]), bflo(mv[1]), bfhi(mv[1])); }
    }
  }
  if (src) {
    const float* gate = p.mod + (size_t)(lgate * 3 + r) * 6144 + gate_idx * 1024;
    float4 gg[4], gt[4];
#pragma unroll
    for (int i = 0; i < 4; ++i) {
      gg[i] = *(const float4*)(gres + i * 256 + lane * 4);
      gt[i] = *(const float4*)(gate + i * 256 + lane * 4);
    }
#pragma unroll
    for (int rr = 0; rr < 2; ++rr) {
      float ss = 0.f;
#pragma unroll
      for (int i = 0; i < 4; ++i)
        ss += m[rr][i].x * m[rr][i].x + m[rr][i].y * m[rr][i].y + m[rr][i].z * m[rr][i].z + m[rr][i].w * m[rr][i].w;
      ss = wave_sum(ss);
      const float rs = rsqrtf(ss * (1.f / 1024.f) + EPSF);
#pragma unroll
      for (int i = 0; i < 4; ++i) {
        y[rr][i].x += gt[i].x * (m[rr][i].x * rs * gg[i].x);
        y[rr][i].y += gt[i].y * (m[rr][i].y * rs * gg[i].y);
        y[rr][i].z += gt[i].z * (m[rr][i].z * rs * gg[i].z);
        y[rr][i].w += gt[i].w * (m[rr][i].w * rs * gg[i].w);
      }
    }
  }
  if (src || first) {
#pragma unroll
    for (int rr = 0; rr < 2; ++rr)
#pragma unroll
      for (int i = 0; i < 4; ++i) *(float4*)(p.out + (size_t)(rowb + rr) * 1024 + i * 256 + lane * 4) = y[rr][i];
  }
  if (gnext) {
    const float* sh = p.mod + (size_t)(lnext * 3 + r) * 6144 + shift_idx * 1024;
    const float* scl = sh + 1024;
    float4 gg[4], s4[4], c4[4];
#pragma unroll
    for (int i = 0; i < 4; ++i) {
      gg[i] = *(const float4*)(gnext + i * 256 + lane * 4);
      s4[i] = *(const float4*)(sh + i * 256 + lane * 4);
      c4[i] = *(const float4*)(scl + i * 256 + lane * 4);
    }
#pragma unroll
    for (int rr = 0; rr < 2; ++rr) {
      float ss = 0.f;
#pragma unroll
      for (int i = 0; i < 4; ++i)
        ss += y[rr][i].x * y[rr][i].x + y[rr][i].y * y[rr][i].y + y[rr][i].z * y[rr][i].z + y[rr][i].w * y[rr][i].w;
      ss = wave_sum(ss);
      const float rs = rsqrtf(ss * (1.f / 1024.f) + EPSF);
      bh* arow = p.act + (size_t)(rowb + rr) * 1024;
#pragma unroll
      for (int i = 0; i < 4; ++i) {
        ushort4 o;
        o.x = f2bf(y[rr][i].x * rs * gg[i].x * (1.f + c4[i].x) + s4[i].x);
        o.y = f2bf(y[rr][i].y * rs * gg[i].y * (1.f + c4[i].y) + s4[i].y);
        o.z = f2bf(y[rr][i].z * rs * gg[i].z * (1.f + c4[i].z) + s4[i].z);
        o.w = f2bf(y[rr][i].w * rs * gg[i].w * (1.f + c4[i].w) + s4[i].w);
        *(ushort4*)(arow + i * 256 + lane * 4) = o;
      }
    }
  }
}

template <int CTRL>
__device__ __forceinline__ float dppf(float v) {
  return __int_as_float(__builtin_amdgcn_update_dpp(0, __float_as_int(v), CTRL, 0xF, 0xF, true));
}
__device__ __forceinline__ float sum16(float v) {
  v += dppf<0xB1>(v); v += dppf<0x4E>(v); v += dppf<0x141>(v); v += dppf<0x140>(v);
  return v;
}
__device__ __forceinline__ float max16(float v) {
  v = fmaxf(v, dppf<0xB1>(v)); v = fmaxf(v, dppf<0x4E>(v)); v = fmaxf(v, dppf<0x141>(v)); v = fmaxf(v, dppf<0x140>(v));
  return v;
}

typedef short s16x4 __attribute__((ext_vector_type(4)));

#define OFF_SC_EVEN 188743680ull
#define OFF_SC_ODD 79691776ull
#define SC_SLOC 8388608ull
#define SC_DECT 16777216ull

template <int MODE, int SKIP = 0>
__device__ __forceinline__ void scan2_unit(const Params& p, int unit, char* smem) {
  constexpr int DK = MODE == 0 ? 128 : 64;
  constexpr int LD = MODE == 0 ? 4096 : 3104;
  constexpr int NQ = DK / 32;
  constexpr int NP = 256 / DK;
  constexpr int TPP = 16 / NP;
  constexpr int RS = DK + 8;
  constexpr int TPT = DK / 8;
  float* sq = (float*)smem;
  float* slf = sq + 16 * DK;
  float* skk = slf + 16 * DK;
  bh* QE = (bh*)(skk + 16 * DK);
  bh* KE = QE + 16 * RS;
  bh* KLT = KE + 16 * RS;
  bh* VT = KLT + DK * 24;
  float* dec = (float*)(VT + 128 * 24);
  float* sx = dec + DK;
  int tid_l_ = threadIdx.x; asm volatile("" : "+v"(tid_l_)); const int tid = tid_l_, lane = tid & 63, w = tid >> 6, r = lane & 15, g = lane >> 4;
  const int dir = unit & 1, h = (unit >> 1) & 3, ss = unit >> 3;
  const bool samp = ss >= 32;
  const int sb = (ss - 32) >> 3, seg = (ss - 32) & 7;
  const int rbase = samp ? (NTP + sb * 2048 + (dir ? 2047 - seg * 256 : seg * 256)) : (ss * 256 + (dir ? 255 : 0));
  const int sgn = dir ? -1 : 1;
  const bh* proj = (const bh*)p.R;
  char* scbase = p.R + (MODE == 0 ? OFF_SC_EVEN : OFF_SC_ODD);
  bh* QB = (bh*)scbase;
  float* odir = (float*)(p.R + OFF_ODIR) + (size_t)dir * NT * 512;
  __syncthreads();
  if (MODE == 0) {
    for (int k = tid; k < 128; k += 256) {
      int ci = dir * 512 + h * 128 + k;
      float x0 = p.hgrn_lb[ci], x1 = p.hgrn_lb[1024 + ci], x2 = p.hgrn_lb[2048 + ci];
      float mx = fmaxf(x0, fmaxf(x1, x2));
      float e0 = expf(x0 - mx), e1 = expf(x1 - mx), e2 = expf(x2 - mx);
      sx[k] = e0 / (e0 + e1 + e2);
    }
  } else {
    for (int i = tid; i < 1024; i += 256) {
      int rr = i >> 6, k = i & 63;
      sx[i] = p.gla_aw[(size_t)(dir * 16 + rr) * 256 + h * 64 + k];
    }
    if (tid < 64) sx[1024 + tid] = p.gla_ab[dir * 256 + h * 64 + tid];
  }
  f32x4 S[2 * NQ][2];
#pragma unroll
  for (int a = 0; a < 2 * NQ; ++a) { S[a][0] = (f32x4){0.f, 0.f, 0.f, 0.f}; S[a][1] = (f32x4){0.f, 0.f, 0.f, 0.f}; }
  constexpr int EPT = MODE == 0 ? 8 : 4;
  const int li = tid >> 4, lk8 = (tid & 15) * EPT;
  const int vi = tid >> 4, v8 = (tid & 15) * 8;
  const int pk = tid % DK, ppart = tid / DK;
  float basec = 0.f;
  u32x4 rq = {0, 0, 0, 0}, rf = {0, 0, 0, 0}, rv = {0, 0, 0, 0}, rd0 = {0, 0, 0, 0}, rd1 = {0, 0, 0, 0};
  auto issue = [&](int c) {
    {
      const bh* pr = proj + (size_t)(rbase + sgn * (c * 16 + li)) * LD;
      if (MODE == 0) {
        rq = *(const u32x4*)(pr + h * 128 + lk8);
        rf = *(const u32x4*)(pr + 512 + dir * 512 + h * 128 + lk8);
      } else {
        const u32x2 q2 = *(const u32x2*)(pr + 1536 + h * 64 + lk8);
        const u32x2 k2 = *(const u32x2*)(pr + 1792 + h * 64 + lk8);
        rq[0] = q2[0]; rq[1] = q2[1]; rf[0] = k2[0]; rf[1] = k2[1];
        rd0 = *(const u32x4*)(pr + 3072 + dir * 16);
        rd1 = *(const u32x4*)(pr + 3072 + dir * 16 + 8);
      }
    }
    {
      const bh* pr = proj + (size_t)(rbase + sgn * (c * 16 + vi)) * LD;
      rv = *(const u32x4*)(pr + (MODE == 0 ? 1536 : 2048) + h * 128 + v8);
    }
  };
  issue(0);
#pragma unroll 1
  for (int c = 0; c < 16; ++c) {
    __syncthreads();
    if (SKIP != 3) {
      float oq[EPT], ol[EPT], ok[EPT];
      if (MODE == 0) {
#pragma unroll
        for (int e = 0; e < EPT; ++e) {
          float q = (e & 1) ? bfhi(rq[e >> 1]) : bflo(rq[e >> 1]);
          float ff = (e & 1) ? bfhi(rf[e >> 1]) : bflo(rf[e >> 1]);
          float lb = sx[lk8 + e];
          float f = lb + (1.f - lb) * sigmoidf_(ff);
          oq[e] = siluf_(q) * 0.08838834764831845f;
          ol[e] = __logf(f);
          ok[e] = 1.f - f;
        }
      } else {
        float da[16];
#pragma unroll
        for (int rr = 0; rr < 16; ++rr) {
          unsigned wd = rr < 8 ? rd0[(rr & 7) >> 1] : rd1[(rr & 7) >> 1];
          da[rr] = (rr & 1) ? bfhi(wd) : bflo(wd);
        }
        float xx[4];
        {
          float4 b0_ = *(const float4*)(sx + 1024 + lk8);
          xx[0] = b0_.x; xx[1] = b0_.y; xx[2] = b0_.z; xx[3] = b0_.w;
        }
#pragma unroll
        for (int rr = 0; rr < 16; ++rr) {
          float4 a0_ = *(const float4*)(sx + rr * 64 + lk8);
          xx[0] += da[rr] * a0_.x; xx[1] += da[rr] * a0_.y; xx[2] += da[rr] * a0_.z; xx[3] += da[rr] * a0_.w;
        }
#pragma unroll
        for (int e = 0; e < 4; ++e) {
          float q = (e & 1) ? bfhi(rq[e >> 1]) : bflo(rq[e >> 1]);
          float kk = (e & 1) ? bfhi(rf[e >> 1]) : bflo(rf[e >> 1]);
          float x = xx[e];
          float ls = fminf(x, 0.f) - __logf(1.f + __expf(-fabsf(x)));
          oq[e] = q * 0.125f;
          ol[e] = ls * 0.0625f;
          ok[e] = kk;
        }
      }
      float* dq_ = sq + li * DK + lk8;
      float* dl_ = slf + li * DK + lk8;
      float* dk_ = skk + li * DK + lk8;
#pragma unroll
      for (int e4 = 0; e4 < EPT; e4 += 4) {
        *(float4*)(dq_ + e4) = make_float4(oq[e4], oq[e4 + 1], oq[e4 + 2], oq[e4 + 3]);
        *(float4*)(dl_ + e4) = make_float4(ol[e4], ol[e4 + 1], ol[e4 + 2], ol[e4 + 3]);
        *(float4*)(dk_ + e4) = make_float4(ok[e4], ok[e4 + 1], ok[e4 + 2], ok[e4 + 3]);
      }
    }
#pragma unroll
    for (int e = 0; e < 8; ++e) {
      unsigned wv = rv[e >> 1];
      VT[(v8 + e) * 24 + vi] = (bh)((e & 1) ? (wv >> 16) : (wv & 0xffffu));
    }
    __syncthreads();
    if (c + 1 < 16) issue(c + 1);
    {
      float total = 0.f, pre = 0.f;
#pragma unroll
      for (int i = 0; i < 16; ++i) {
        float l = slf[i * DK + pk];
        if (i < ppart * TPP) pre += l;
        total += l;
      }
      unsigned kw[TPP / 2];
#pragma unroll
      for (int ii = 0; ii < TPP; ii += 2) {
        float klv[2];
#pragma unroll
        for (int u = 0; u < 2; ++u) {
          const int i = ppart * TPP + ii + u;
          pre += slf[i * DK + pk];
          const float qv = sq[i * DK + pk], kv = skk[i * DK + pk];
          QE[i * RS + pk] = f2bf(qv * __expf(pre));
          KE[i * RS + pk] = f2bf(kv * __expf(-pre));
          klv[u] = kv * __expf(total - pre);
          if (samp) {
            const int row = rbase + sgn * (c * 16 + i);
            QB[((size_t)dir * 4096 + (row - NTP)) * (4 * DK) + h * DK + pk] = f2bf(qv * __expf(basec + pre));
          }
        }
        kw[ii >> 1] = pk2(klv[0], klv[1]);
      }
      if (TPP == 8) {
        u32x4 kv4 = {kw[0], kw[1], kw[(TPP / 2) > 2 ? 2 : 0], kw[(TPP / 2) > 3 ? 3 : 0]};
        *(u32x4*)(KLT + pk * 24 + ppart * 8) = kv4;
      } else {
        u32x2 kv2 = {kw[0], kw[1]};
        *(u32x2*)(KLT + pk * 24 + ppart * 4) = kv2;
      }
      if (ppart == 0) dec[pk] = __expf(total);
      basec += total;
    }
    __syncthreads();
    {
      bf16x8 qf[NQ], kf[NQ];
#pragma unroll
      for (int q = 0; q < NQ; ++q) {
        qf[q] = *(const bf16x8*)(QE + r * RS + q * 32 + g * 8);
        kf[q] = *(const bf16x8*)(KE + r * RS + q * 32 + g * 8);
      }
      f32x4 at = (f32x4){0.f, 0.f, 0.f, 0.f};
#pragma unroll
      for (int q = 0; q < NQ; ++q) at = __builtin_amdgcn_mfma_f32_16x16x32_bf16(kf[q], qf[q], at, 0, 0, 0);
      u32x2 paw;
      paw[0] = pk2((g * 4 + 0 <= r) ? at[0] : 0.f, (g * 4 + 1 <= r) ? at[1] : 0.f);
      paw[1] = pk2((g * 4 + 2 <= r) ? at[2] : 0.f, (g * 4 + 3 <= r) ? at[3] : 0.f);
      const s16x4 pa = __builtin_bit_cast(s16x4, paw);
      s16x4 vf[2];
      f32x4 o[2];
#pragma unroll
      for (int nt = 0; nt < 2; ++nt) {
        vf[nt] = *(const s16x4*)(VT + (w * 32 + nt * 16 + r) * 24 + g * 4);
        o[nt] = __builtin_amdgcn_mfma_f32_16x16x16bf16_1k(pa, vf[nt], (f32x4){0.f, 0.f, 0.f, 0.f}, 0, 0, 0);
      }
#pragma unroll
      for (int q = 0; q < NQ; ++q) {
#pragma unroll
        for (int half = 0; half < 2; ++half) {
          const s16x4 qa = half == 0 ? __builtin_shufflevector(qf[q], qf[q], 0, 1, 2, 3)
                                     : __builtin_shufflevector(qf[q], qf[q], 4, 5, 6, 7);
#pragma unroll
          for (int nt = 0; nt < 2; ++nt) {
            const f32x4 sv_ = S[2 * q + half][nt];
            u32x2 sw;
            sw[0] = pk2(sv_[0], sv_[1]);
            sw[1] = pk2(sv_[2], sv_[3]);
            o[nt] = __builtin_amdgcn_mfma_f32_16x16x16bf16_1k(qa, __builtin_bit_cast(s16x4, sw), o[nt], 0, 0, 0);
          }
        }
      }
#pragma unroll
      for (int nt = 0; nt < 2; ++nt)
#pragma unroll
        for (int j = 0; j < 4; ++j) {
          const int row = rbase + sgn * (c * 16 + g * 4 + j);
          odir[(size_t)row * 512 + h * 128 + w * 32 + nt * 16 + r] = o[nt][j];
        }
#pragma unroll
      for (int q = 0; q < NQ; ++q) {
#pragma unroll
        for (int half = 0; half < 2; ++half) {
          const float4 d4 = *(const float4*)(dec + q * 32 + g * 8 + half * 4);
          const int ka = q * 32 + (r >> 2) * 8 + half * 4 + (r & 3);
          const s16x4 ka4 = *(const s16x4*)(KLT + ka * 24 + g * 4);
#pragma unroll
          for (int nt = 0; nt < 2; ++nt) {
            f32x4 sv_ = S[2 * q + half][nt];
            sv_[0] *= d4.x; sv_[1] *= d4.y; sv_[2] *= d4.z; sv_[3] *= d4.w;
            S[2 * q + half][nt] = __builtin_amdgcn_mfma_f32_16x16x16bf16_1k(ka4, vf[nt], sv_, 0, 0, 0);
          }
        }
      }
    }
  }
  {
    float* so;
    if (!samp) so = p.out + (MODE == 0 ? OUT_HGRN : OUT_GLA) + ((size_t)(ss * 2 + dir) * 4 + h) * DK * 128;
    else {
      const int us = ((sb * 4 + h) * 2 + dir) * 8 + seg;
      so = (float*)(scbase + SC_SLOC) + (size_t)us * DK * 128;
      if (ppart == 0) ((float*)(scbase + SC_DECT))[us * DK + pk] = __expf(basec);
    }
#pragma unroll
    for (int q = 0; q < NQ; ++q)
#pragma unroll
      for (int half = 0; half < 2; ++half)
#pragma unroll
        for (int nt = 0; nt < 2; ++nt)
#pragma unroll
          for (int j = 0; j < 4; ++j)
            so[(size_t)(q * 32 + g * 8 + half * 4 + j) * 128 + w * 32 + nt * 16 + r] = S[2 * q + half][nt][j];
  }
}

template <int MODE>
__device__ __forceinline__ void fixup_unit(const Params& p, int unit, char* smem) {
  constexpr int DK = MODE == 0 ? 128 : 64;
  constexpr int NQ = DK / 32;
  constexpr int RS = DK + 8;
  bh* ST = (bh*)smem;
  int tid_l_ = threadIdx.x; asm volatile("" : "+v"(tid_l_)); const int tid = tid_l_, lane = tid & 63, w = tid >> 6, r = lane & 15, g = lane >> 4;
  const int seg = unit & 7, dir = (unit >> 3) & 1, h = (unit >> 4) & 3, sb = unit >> 6;
  const int unit0 = unit & ~7;
  char* scbase = p.R + (MODE == 0 ? OFF_SC_EVEN : OFF_SC_ODD);
  const bh* QB = (const bh*)scbase;
  const float* SLOC = (const float*)(scbase + SC_SLOC);
  const float* DECT = (const float*)(scbase + SC_DECT);
  const float* s0 = (MODE == 0 ? p.state_hgrn : p.state_gla) + ((size_t)(sb * 2 + dir) * 4 + h) * DK * 128;
  float* odir = (float*)(p.R + OFF_ODIR) + (size_t)dir * NT * 512;
  __syncthreads();
  for (int m = 0; m < DK * 128 / 256; ++m) {
    const int e = tid + 256 * m, k = e >> 7, v = e & 127;
    float cur = s0[e];
    for (int jj = 0; jj < seg; ++jj)
      cur = DECT[(unit0 + jj) * DK + k] * cur + SLOC[(size_t)(unit0 + jj) * DK * 128 + e];
    ST[v * RS + k] = f2bf(cur);
  }
  __syncthreads();
  const int rbase = NTP + sb * 2048 + (dir ? 2047 - seg * 256 : seg * 256);
  const int sgn = dir ? -1 : 1;
#pragma unroll 1
  for (int mt = 0; mt < 4; ++mt) {
    f32x4 acc[8];
#pragma unroll
    for (int nt = 0; nt < 8; ++nt) acc[nt] = (f32x4){0.f, 0.f, 0.f, 0.f};
    const int rowa = rbase + sgn * (w * 64 + mt * 16 + r);
    const bh* qrow = QB + ((size_t)dir * 4096 + (rowa - NTP)) * (4 * DK) + h * DK + g * 8;
#pragma unroll
    for (int q = 0; q < NQ; ++q) {
      const bf16x8 a = *(const bf16x8*)(qrow + q * 32);
#pragma unroll
      for (int nt = 0; nt < 8; ++nt) {
        const bf16x8 b = *(const bf16x8*)(ST + (nt * 16 + r) * RS + q * 32 + g * 8);
        acc[nt] = __builtin_amdgcn_mfma_f32_16x16x32_bf16(a, b, acc[nt], 0, 0, 0);
      }
    }
#pragma unroll
    for (int nt = 0; nt < 8; ++nt)
#pragma unroll
      for (int j = 0; j < 4; ++j) {
        const int row = rbase + sgn * (w * 64 + mt * 16 + g * 4 + j);
        float* dst = odir + (size_t)row * 512 + h * 128 + nt * 16 + r;
        *dst += acc[nt][j];
      }
  }
}

__device__ __forceinline__ void scan_final_job(const Params& p, int job, int mode) {
  int tid_l_ = threadIdx.x; asm volatile("" : "+v"(tid_l_)); const int tid = tid_l_, lane = tid & 63, w = tid >> 6;
  const int rowb = job * 8 + w * 2;
  const int ld = mode == 0 ? 4096 : 3104;
  const int gcol = mode == 0 ? 2048 : 2560;
  const float* nrm = mode == 0 ? p.hgrn_norm : p.gla_norm;
  float2 a[2][4], b[2][4];
  unsigned gw[2][4];
#pragma unroll
  for (int rr = 0; rr < 2; ++rr) {
    const int row = rowb + rr;
    const float* o0 = (const float*)(p.R + OFF_ODIR) + (size_t)row * 512;
    const float* o1 = o0 + (size_t)NT * 512;
    const bh* proj = (const bh*)p.R + (size_t)row * ld;
#pragma unroll
    for (int h = 0; h < 4; ++h) {
      const int c = h * 128 + lane * 2;
      a[rr][h] = *(const float2*)(o0 + c);
      b[rr][h] = *(const float2*)(o1 + c);
      gw[rr][h] = *(const unsigned*)(proj + gcol + c);
    }
  }
  float2 nv[4];
#pragma unroll
  for (int h = 0; h < 4; ++h) nv[h] = *(const float2*)(nrm + h * 128 + lane * 2);
#pragma unroll
  for (int rr = 0; rr < 2; ++rr) {
    bh* arow = p.act + (size_t)(rowb + rr) * 1024 + (mode == 0 ? 0 : 512);
#pragma unroll
    for (int h = 0; h < 4; ++h) {
      const int c = h * 128 + lane * 2;
      float v0 = a[rr][h].x + b[rr][h].x, v1 = a[rr][h].y + b[rr][h].y;
      float ss = wave_sum(v0 * v0 + v1 * v1);
      float rs = rsqrtf(ss * (1.f / 128.f) + EPSF);
      float g0 = bflo(gw[rr][h]), g1 = bfhi(gw[rr][h]);
      *(unsigned*)(arow + c) = pk2(v0 * rs * nv[h].x * siluf_(g0), v1 * rs * nv[h].y * siluf_(g1));
    }
  }
}

using f32x16 = __attribute__((ext_vector_type(16))) float;
__device__ __forceinline__ bf16x8 toep_frag(const unsigned* Gd, int m0) {
  const int q = m0 >> 1;
  const unsigned sh = (unsigned)(m0 & 1) * 2u;
  const unsigned D0 = Gd[q], D1 = Gd[q + 1], D2 = Gd[q + 2], D3 = Gd[q + 3], D4 = Gd[q + 4];
  u32x4 f;
  f[0] = __builtin_amdgcn_alignbyte(D1, D0, sh);
  f[1] = __builtin_amdgcn_alignbyte(D2, D1, sh);
  f[2] = __builtin_amdgcn_alignbyte(D3, D2, sh);
  f[3] = __builtin_amdgcn_alignbyte(D4, D3, sh);
  return __builtin_bit_cast(bf16x8, f);
}
__device__ __forceinline__ void conv4(const bh* raw, int t, int L, float w0, float w1, float w2, float bb, float* out) {
  const u32x2 x = *(const u32x2*)(raw + t);
  const float xm = t > 0 ? bf2f(raw[t - 1]) : 0.f;
  const float xp = (t + 4 < L) ? bf2f(raw[t + 4]) : 0.f;
  const float x0 = bflo(x[0]), x1 = bfhi(x[0]), x2 = bflo(x[1]), x3 = bfhi(x[1]);
  out[0] = w0 * xm + w1 * x0 + w2 * x1 + bb;
  out[1] = w0 * x0 + w1 * x1 + w2 * x2 + bb;
  out[2] = w0 * x1 + w1 * x2 + w2 * x3 + bb;
  out[3] = w0 * x2 + w1 * x3 + w2 * xp + bb;
}
__device__ __forceinline__ u32x4 conv8(const bh* raw, int t, int L, float w0, float w1, float w2, float bb) {
  const u32x4 x = *(const u32x4*)(raw + t);
  float v[10];
  v[0] = t > 0 ? bf2f(raw[t - 1]) : 0.f;
  v[9] = (t + 8 < L) ? bf2f(raw[t + 8]) : 0.f;
#pragma unroll
  for (int e = 0; e < 4; ++e) { v[1 + 2 * e] = bflo(x[e]); v[2 + 2 * e] = bfhi(x[e]); }
  u32x4 o;
#pragma unroll
  for (int e = 0; e < 4; ++e)
    o[e] = pk2(w0 * v[2 * e] + w1 * v[2 * e + 1] + w2 * v[2 * e + 2] + bb, w0 * v[2 * e + 1] + w1 * v[2 * e + 2] + w2 * v[2 * e + 3] + bb);
  return o;
}

__device__ __forceinline__ void hyena_sample_job(const Params& p, int job, char* smem) {
  int tid_l_ = threadIdx.x; asm volatile("" : "+v"(tid_l_)); const int tid = tid_l_, lane = tid & 63, w = tid >> 6;
  const int col = lane & 31, kh = lane >> 5;
  const int cc = w >> 1, nh = w & 1;
  const int sb = job & 1, c0 = (job >> 1) * 2, c = c0 + cc;
  bh* G = (bh*)(smem + cc * 12288);
  bh* U = G + 4096;
  const unsigned* Gd = (const unsigned*)G;
  const bh* HYT = (const bh*)(p.R + OFF_HYT);
  const int rowoff = NTP + sb * 2048;
  __syncthreads();
  {
    const float vw0 = p.hy_conv_w[c], vw1 = p.hy_conv_w[1536 + c], vw2 = p.hy_conv_w[3072 + c], vb = p.hy_conv_b[c];
    const bh* raw = HYT + (size_t)c * NT + rowoff;
#pragma unroll
    for (int i = 0; i < 2; ++i) {
      const int t0 = (nh * 128 + lane + 64 * i) * 8;
      *(u32x4*)(U + t0) = conv8(raw, t0, 2048, vw0, vw1, vw2, vb);
    }
  }
#pragma unroll 1
  for (int ord = 0; ord < 2; ++ord) {
    {
      const bh* gsrc = p.gt2048 + (size_t)(ord * 512 + c) * 4096;
#pragma unroll
      for (int i = 0; i < 4; ++i) {
        const int e8 = (nh * 256 + lane + 64 * i) * 8;
        *(u32x4*)(G + e8) = *(const u32x4*)(gsrc + e8);
      }
    }
    __syncthreads();
    f32x16 acc;
#pragma unroll
    for (int i = 0; i < 16; ++i) acc[i] = 0.f;
    const int mbase = 2047 - col + kh * 8;
    const int dlo = nh == 0 ? -63 : -31, dhi = nh == 0 ? 31 : 63;
#pragma unroll 2
    for (int d = dlo; d <= dhi; ++d) {
      const bf16x8 a0 = toep_frag(Gd, mbase - d * 32);
      const bf16x8 a1 = toep_frag(Gd, mbase - d * 32 + 16);
      const int s1 = nh * 32 + col - d;
      const bool ok = (unsigned)s1 < 64u;
      const int s1c = ok ? s1 : 0;
      u32x4 b0 = *(const u32x4*)(U + s1c * 32 + kh * 8);
      u32x4 b1 = *(const u32x4*)(U + s1c * 32 + 16 + kh * 8);
      if (!ok) { b0 = (u32x4){0, 0, 0, 0}; b1 = (u32x4){0, 0, 0, 0}; }
      acc = __builtin_amdgcn_mfma_f32_32x32x16_bf16(a0, __builtin_bit_cast(bf16x8, b0), acc, 0, 0, 0);
      acc = __builtin_amdgcn_mfma_f32_32x32x16_bf16(a1, __builtin_bit_cast(bf16x8, b1), acc, 0, 0, 0);
    }
    __syncthreads();
    const int gi = (ord + 1) * 512 + c;
    const float gw0 = p.hy_conv_w[gi], gw1 = p.hy_conv_w[1536 + gi], gw2 = p.hy_conv_w[3072 + gi], gb = p.hy_conv_b[gi];
    const float dd = p.hy_d[ord * 512 + c];
    const bh* graw = HYT + (size_t)gi * NT + rowoff;
#pragma unroll
    for (int rq = 0; rq < 4; ++rq) {
      const int trun = (nh * 32 + col) * 32 + 8 * rq + 4 * kh;
      float gte[4];
      conv4(graw, trun, 2048, gw0, gw1, gw2, gb, gte);
      const u32x2 uo = *(const u32x2*)(U + trun);
      u32x2 zo;
      zo[0] = pk2(gte[0] * (acc[rq * 4 + 0] + bflo(uo[0]) * dd), gte[1] * (acc[rq * 4 + 1] + bfhi(uo[0]) * dd));
      zo[1] = pk2(gte[2] * (acc[rq * 4 + 2] + bflo(uo[1]) * dd), gte[3] * (acc[rq * 4 + 3] + bfhi(uo[1]) * dd));
      *(u32x2*)(U + trun) = zo;
    }
    __syncthreads();
  }
#pragma unroll
  for (int rr = 0; rr < 8; ++rr) {
    const int t = tid + 256 * rr;
    const unsigned z0 = *(const bh*)(smem + 8192 + t * 2);
    const unsigned z1 = *(const bh*)(smem + 12288 + 8192 + t * 2);
    *(unsigned*)(p.act + (size_t)(rowoff + t) * 1024 + 512 + c0) = z0 | (z1 << 16);
  }
}

__device__ __forceinline__ void hyena_prompt_job(const Params& p, int job, char* smem) {
  int tid_l_ = threadIdx.x; asm volatile("" : "+v"(tid_l_)); const int tid = tid_l_, lane = tid & 63, w = tid >> 6;
  const int col = lane & 31, kh = lane >> 5;
  const int cc = w >> 1, th = w & 1;
  const int c0 = job * 2, c = c0 + cc;
  bh* Uall = (bh*)smem;
  bh* Gall = (bh*)(smem + 2 * 32 * 264 * 2);
  bh* U = Uall + cc * 32 * 264;
  const unsigned* Gd = (const unsigned*)(Gall + cc * 512);
  const bh* HYT = (const bh*)(p.R + OFF_HYT);
  __syncthreads();
#pragma unroll 1
  for (int c2 = 0; c2 < 2; ++c2) {
    const int ch = c0 + c2;
    const float vw0 = p.hy_conv_w[ch], vw1 = p.hy_conv_w[1536 + ch], vw2 = p.hy_conv_w[3072 + ch], vb = p.hy_conv_b[ch];
#pragma unroll
    for (int i = 0; i < 4; ++i) {
      const int tg = (tid + 256 * i) * 8, b = tg >> 8, t = tg & 255;
      *(u32x4*)(Uall + c2 * 32 * 264 + b * 264 + t) = conv8(HYT + (size_t)ch * NT + b * 256, t, 256, vw0, vw1, vw2, vb);
    }
  }
#pragma unroll 1
  for (int ord = 0; ord < 2; ++ord) {
    if (tid < 128) {
      const int c2 = tid >> 6, l2 = tid & 63;
      *(u32x4*)(Gall + c2 * 512 + l2 * 8) = *(const u32x4*)(p.gt256 + (size_t)(ord * 512 + c0 + c2) * 512 + l2 * 8);
    }
    __syncthreads();
    f32x16 acc[4];
#pragma unroll
    for (int q = 0; q < 4; ++q)
#pragma unroll
      for (int i = 0; i < 16; ++i) acc[q][i] = 0.f;
    const int mbase = 255 - col + kh * 8;
#pragma unroll
    for (int q = 0; q < 4; ++q) {
      const int t1 = th * 4 + q;
#pragma unroll 2
      for (int s1 = 0; s1 < 8; ++s1) {
        const int d = t1 - s1;
        const bf16x8 a0 = toep_frag(Gd, mbase - d * 32);
        const bf16x8 a1 = toep_frag(Gd, mbase - d * 32 + 16);
        const bf16x8 b0 = *(const bf16x8*)(U + col * 264 + s1 * 32 + kh * 8);
        const bf16x8 b1 = *(const bf16x8*)(U + col * 264 + s1 * 32 + 16 + kh * 8);
        acc[q] = __builtin_amdgcn_mfma_f32_32x32x16_bf16(a0, b0, acc[q], 0, 0, 0);
        acc[q] = __builtin_amdgcn_mfma_f32_32x32x16_bf16(a1, b1, acc[q], 0, 0, 0);
      }
    }
    __syncthreads();
    const int gi = (ord + 1) * 512 + c;
    const float gw0 = p.hy_conv_w[gi], gw1 = p.hy_conv_w[1536 + gi], gw2 = p.hy_conv_w[3072 + gi], gb = p.hy_conv_b[gi];
    const float dd = p.hy_d[ord * 512 + c];
    const bh* graw = HYT + (size_t)gi * NT + col * 256;
#pragma unroll
    for (int q = 0; q < 4; ++q)
#pragma unroll
      for (int rq = 0; rq < 4; ++rq) {
        const int trun = (th * 4 + q) * 32 + 8 * rq + 4 * kh;
        float gte[4];
        conv4(graw, trun, 256, gw0, gw1, gw2, gb, gte);
        bh* up = U + col * 264 + trun;
        const u32x2 uo = *(const u32x2*)up;
        u32x2 zo;
        zo[0] = pk2(gte[0] * (acc[q][rq * 4 + 0] + bflo(uo[0]) * dd), gte[1] * (acc[q][rq * 4 + 1] + bfhi(uo[0]) * dd));
        zo[1] = pk2(gte[2] * (acc[q][rq * 4 + 2] + bflo(uo[1]) * dd), gte[3] * (acc[q][rq * 4 + 3] + bfhi(uo[1]) * dd));
        *(u32x2*)up = zo;
      }
    __syncthreads();
  }
#pragma unroll 4
  for (int i = 0; i < 32; ++i) {
    const int e = tid + 256 * i, b = e >> 8, t = e & 255;
    const unsigned z0 = Uall[b * 264 + t], z1 = Uall[32 * 264 + b * 264 + t];
    *(unsigned*)(p.act + (size_t)e * 1024 + 512 + c0) = z0 | (z1 << 16);
  }
}

__device__ __forceinline__ void oddrow_job(const Params& p, int job) {
  int tid_l_ = threadIdx.x; asm volatile("" : "+v"(tid_l_)); const int tid = tid_l_, lane = tid & 63, w = tid >> 6;
  const int row = job * 4 + w;
  const bh* pr = (const bh*)p.R + (size_t)row * 3104;
  bh* Q = (bh*)(p.R + OFF_Q) + (size_t)row * 512;
  bh* KB = (bh*)(p.R + OFF_KB);
  if (row < NTP) {
    const int b = row >> 8, t = row & 255;
    const int e0 = lane * 8, h = e0 >> 7, x = e0 & 127;
    const u32x4 qv = *(const u32x4*)(pr + e0);
    const u32x4 kv = *(const u32x4*)(pr + 512 + e0);
    const u32x4 vv = *(const u32x4*)(pr + 1024 + e0);
    const size_t idx = ((size_t)(b * 4 + h) * 256 + t) * 128 + x;
    *(u32x4*)(Q + e0) = qv;
    *(u32x4*)(KB + idx) = kv;
    float4 k0 = make_float4(bflo(kv[0]), bfhi(kv[0]), bflo(kv[1]), bfhi(kv[1]));
    float4 k1 = make_float4(bflo(kv[2]), bfhi(kv[2]), bflo(kv[3]), bfhi(kv[3]));
    float4 v0 = make_float4(bflo(vv[0]), bfhi(vv[0]), bflo(vv[1]), bfhi(vv[1]));
    float4 v1 = make_float4(bflo(vv[2]), bfhi(vv[2]), bflo(vv[3]), bfhi(vv[3]));
    *(float4*)(p.out + OUT_CK + idx) = k0;
    *(float4*)(p.out + OUT_CK + idx + 4) = k1;
    *(float4*)(p.out + OUT_CV + idx) = v0;
    *(float4*)(p.out + OUT_CV + idx + 4) = v1;
  } else {
    const int sb = (row - NTP) >> 11, t = (row - NTP) & 2047;
    const int rpos = t >> 6, cpos = t & 63;
    float q1[4], q2[4], k1[4], k2[4];
#pragma unroll
    for (int m = 0; m < 4; ++m) {
      int pi = lane + 64 * m;
      int h = pi >> 6, rem = pi & 63, pp = rem >> 5, part = (rem >> 4) & 1, i = rem & 15;
      int d1 = h * 128 + pp * 64 + part * 32 + i, d2 = d1 + 16;
      q1[m] = bf2f(pr[d1]); q2[m] = bf2f(pr[d2]);
      k1[m] = bf2f(pr[512 + d1]); k2[m] = bf2f(pr[512 + d2]);
    }
#pragma unroll
    for (int m = 0; m < 4; ++m) {
      int pi = lane + 64 * m;
      int h = pi >> 6, rem = pi & 63, pp = rem >> 5, part = (rem >> 4) & 1, i = rem & 15;
      int d1 = h * 128 + pp * 64 + part * 32 + i, d2 = d1 + 16;
      float pos = (float)(part ? cpos : rpos);
      float inv = expf(-(float)i * (9.210340371976184f / 16.f));
      float ang = pos * inv;
      float cs = cosf(ang), sn = sinf(ang);
      Q[d1] = f2bf(q1[m] * cs - q2[m] * sn);
      Q[d2] = f2bf(q1[m] * sn + q2[m] * cs);
      size_t kb = KV_SAMPLE_BASE + ((size_t)(sb * 4 + h) * 2304 + 256 + t) * 128;
      KB[kb + (d1 - h * 128)] = f2bf(k1[m] * cs - k2[m] * sn);
      KB[kb + (d2 - h * 128)] = f2bf(k1[m] * sn + k2[m] * cs);
    }
  }
}
__device__ __forceinline__ void ctxk_job(const Params& p, int job) {
  bh* KB = (bh*)(p.R + OFF_KB);
  int tidl = threadIdx.x; asm volatile("" : "+v"(tidl));
#pragma unroll
  for (int i = 0; i < 4; ++i) {
    int e = job * 1024 + i * 256 + tidl;
    int x = e & 127, j = (e >> 7) & 255, hh = (e >> 15) & 3, sb = e >> 17;
    KB[KV_SAMPLE_BASE + ((size_t)(sb * 4 + hh) * 2304 + j) * 128 + x] = f2bf(p.cache_k[e]);
  }
}
__device__ __forceinline__ void vt_job(const Params& p, int job, char* smem) {
  bh* tl = (bh*)smem;
  int tid_l_ = threadIdx.x; asm volatile("" : "+v"(tid_l_)); const int tid = tid_l_;
  int seq, h, kt, Lk;
  if (job < 288) { seq = 32 + job / 144; int r = job % 144; h = r / 36; kt = r % 36; Lk = 2304; }
  else { int j = job - 288; seq = j >> 4; h = (j >> 2) & 3; kt = j & 3; Lk = 256; }
  const bh* proj = (const bh*)p.R;
  __syncthreads();
#pragma unroll 16
  for (int i = 0; i < 32; ++i) {
    int e = tid + i * 256, key = e >> 7, dv = e & 127;
    bh val;
    if (seq < 32) val = proj[(size_t)(seq * 256 + kt * 64 + key) * 3104 + 1024 + h * 128 + dv];
    else if (kt < 4) val = f2bf(p.cache_v[((size_t)((seq - 32) * 4 + h) * 256 + kt * 64 + key) * 128 + dv]);
    else val = proj[(size_t)(NTP + (seq - 32) * 2048 + (kt - 4) * 64 + key) * 3104 + 1024 + h * 128 + dv];
    tl[key * 130 + dv] = val;
  }
  __syncthreads();
  bh* VT = (bh*)(p.R + OFF_VT) + (seq < 32 ? (size_t)(seq * 4 + h) * 128 * 256
                                            : (size_t)KV_SAMPLE_BASE + (size_t)((seq - 32) * 4 + h) * 128 * 2304);
#pragma unroll 4
  for (int i = 0; i < 32; ++i) {
    int e = tid + i * 256, dv = e >> 6, key = e & 63;
    VT[(size_t)dv * Lk + kt * 64 + key] = tl[key * 130 + dv];
  }
}

__device__ __forceinline__ void attn_unit(const Params& p, int unit, char* smem) {
  bh* Pl = (bh*)smem;
  float* sred = (float*)(smem + 10240);
  int tid_l_ = threadIdx.x; asm volatile("" : "+v"(tid_l_)); const int tid = tid_l_, lane = tid & 63, w = tid >> 6, r = lane & 15, g = lane >> 4;
  int seq, h, qb, Lk;
  if (unit < 256) { seq = 32 + (unit >> 7); h = (unit >> 5) & 3; qb = unit & 31; Lk = 2304; }
  else { int u = unit - 256; seq = u >> 4; h = (u >> 2) & 3; qb = u & 3; Lk = 256; }
  const int row0 = seq < 32 ? seq * 256 : NTP + (seq - 32) * 2048;
  const bh* Q = (const bh*)(p.R + OFF_Q);
  const bh* KB = (const bh*)(p.R + OFF_KB) + (seq < 32 ? (size_t)(seq * 4 + h) * 256 * 128
                                                       : (size_t)KV_SAMPLE_BASE + (size_t)((seq - 32) * 4 + h) * 2304 * 128);
  const bh* VT = (const bh*)(p.R + OFF_VT) + (seq < 32 ? (size_t)(seq * 4 + h) * 128 * 256
                                                       : (size_t)KV_SAMPLE_BASE + (size_t)((seq - 32) * 4 + h) * 128 * 2304);
  __syncthreads();
  if (tid < 64) {
    float a = p.diff_lambda[tid] * p.diff_lambda[64 + tid];
    float b = p.diff_lambda[128 + tid] * p.diff_lambda[192 + tid];
    a = wave_sum(a); b = wave_sum(b);
    if (tid == 0) sred[0] = expf(a) - expf(b);
  }
  __syncthreads();
  const float lam_init = 0.8f - 0.6f * expf(-0.3f * 1.0f);
  const float lam = sred[0] + lam_init;
  const int qrow = row0 + qb * 64 + w * 16;
  bf16x8 aq[2][2];
#pragma unroll
  for (int pp = 0; pp < 2; ++pp)
#pragma unroll
    for (int kk = 0; kk < 2; ++kk)
      aq[pp][kk] = *(const bf16x8*)(Q + (size_t)(qrow + r) * 512 + h * 128 + pp * 64 + kk * 32 + g * 8);
  float mrun[2][4], lrun[2][4];
  f32x4 O[2][8];
#pragma unroll
  for (int pp = 0; pp < 2; ++pp) {
#pragma unroll
    for (int j = 0; j < 4; ++j) { mrun[pp][j] = -1e30f; lrun[pp][j] = 0.f; }
#pragma unroll
    for (int n = 0; n < 8; ++n) O[pp][n] = (f32x4){0.f, 0.f, 0.f, 0.f};
  }
  bh* Pw = Pl + w * (2 * 16 * 40);
  const float scale = 0.125f;
  bh* Ks = (bh*)(smem + 10752);
  bh* Vs = Ks + 64 * 128;
  u32x4 pk_[4], pv_[4];
  auto tload = [&](int kt) {
#pragma unroll
    for (int i = 0; i < 4; ++i) {
      const int pz = tid + 256 * i;
      pk_[i] = *(const u32x4*)(KB + (size_t)(kt + (pz >> 4)) * 128 + (pz & 15) * 8);
      pv_[i] = *(const u32x4*)(VT + (size_t)(pz >> 3) * Lk + kt + (pz & 7) * 8);
    }
  };
  tload(0);
#pragma unroll 1
  for (int kt = 0; kt < Lk; kt += 64) {
    __syncthreads();
#pragma unroll
    for (int i = 0; i < 4; ++i) {
      const int pz = tid + 256 * i;
      const int key = pz >> 4, ck = pz & 15, dv = pz >> 3, cv = pz & 7;
      *(u32x4*)(Ks + key * 128 + ((ck ^ (key & 15)) << 3)) = pk_[i];
      *(u32x4*)(Vs + dv * 64 + ((cv ^ ((dv >> 1) & 7)) << 3)) = pv_[i];
    }
    __syncthreads();
    if (kt + 64 < Lk) tload(kt + 64);
#pragma unroll
    for (int h2 = 0; h2 < 2; ++h2) {
      f32x4 s[2][2];
#pragma unroll
      for (int sub = 0; sub < 2; ++sub) {
        const int key = h2 * 32 + sub * 16 + r;
#pragma unroll
        for (int pp = 0; pp < 2; ++pp) {
          const bf16x8 b0 = *(const bf16x8*)(Ks + key * 128 + (((pp * 8 + g) ^ (key & 15)) << 3));
          const bf16x8 b1 = *(const bf16x8*)(Ks + key * 128 + (((pp * 8 + 4 + g) ^ (key & 15)) << 3));
          f32x4 z = (f32x4){0.f, 0.f, 0.f, 0.f};
          z = __builtin_amdgcn_mfma_f32_16x16x32_bf16(aq[pp][0], b0, z, 0, 0, 0);
          z = __builtin_amdgcn_mfma_f32_16x16x32_bf16(aq[pp][1], b1, z, 0, 0, 0);
          s[pp][sub] = z;
        }
      }
#pragma unroll
      for (int pp = 0; pp < 2; ++pp) {
#pragma unroll
        for (int j = 0; j < 4; ++j) {
          float s0 = s[pp][0][j] * scale, s1 = s[pp][1][j] * scale;
          float mx = max16(fmaxf(s0, s1));
          float mnew = fmaxf(mrun[pp][j], mx);
          float alpha = __expf(mrun[pp][j] - mnew);
          float p0 = __expf(s0 - mnew), p1 = __expf(s1 - mnew);
          float rs = sum16(p0 + p1);
          lrun[pp][j] = lrun[pp][j] * alpha + rs;
          mrun[pp][j] = mnew;
#pragma unroll
          for (int n = 0; n < 8; ++n) O[pp][n][j] *= alpha;
          Pw[(pp * 16 + g * 4 + j) * 40 + r] = f2bf(p0);
          Pw[(pp * 16 + g * 4 + j) * 40 + 16 + r] = f2bf(p1);
        }
      }
      __builtin_amdgcn_fence(__ATOMIC_RELEASE, "wavefront");
      __builtin_amdgcn_wave_barrier();
      __builtin_amdgcn_fence(__ATOMIC_ACQUIRE, "wavefront");
      bf16x8 pa0 = *(const bf16x8*)(Pw + (0 * 16 + r) * 40 + g * 8);
      bf16x8 pa1 = *(const bf16x8*)(Pw + (1 * 16 + r) * 40 + g * 8);
#pragma unroll
      for (int n = 0; n < 8; ++n) {
        const int dv = n * 16 + r;
        const bf16x8 vb = *(const bf16x8*)(Vs + dv * 64 + (((h2 * 4 + g) ^ ((dv >> 1) & 7)) << 3));
        O[0][n] = __builtin_amdgcn_mfma_f32_16x16x32_bf16(pa0, vb, O[0][n], 0, 0, 0);
        O[1][n] = __builtin_amdgcn_mfma_f32_16x16x32_bf16(pa1, vb, O[1][n], 0, 0, 0);
      }
      __builtin_amdgcn_fence(__ATOMIC_RELEASE, "wavefront");
      __builtin_amdgcn_wave_barrier();
    }
  }
#pragma unroll
  for (int j = 0; j < 4; ++j) {
    float i0 = 1.f / lrun[0][j], i1 = lam / lrun[1][j];
    float o[8];
    float ss = 0.f;
#pragma unroll
    for (int n = 0; n < 8; ++n) { o[n] = O[0][n][j] * i0 - O[1][n][j] * i1; ss += o[n] * o[n]; }
    ss = sum16(ss);
    float rs = rsqrtf(ss * (1.f / 128.f) + EPSF) * (1.f - lam_init);
    bh* arow = p.act + (size_t)(qrow + g * 4 + j) * 1024 + h * 128;
#pragma unroll
    for (int n = 0; n < 8; ++n) arow[n * 16 + r] = f2bf(o[n] * rs * p.diff_norm[h * 128 + n * 16 + r]);
  }
}

__device__ __forceinline__ void ffnact_job(const Params& p, int layer, int job) {
  int tidl = threadIdx.x; asm volatile("" : "+v"(tidl));
  const int item = job * 256 + tidl;
  const int rc = item / 352, j = (item % 352) * 8;
  const int t0 = rc * 8;
  const bh* U = (const bh*)p.R;
  bh* AO = (bh*)(p.R + OFF_ACTF);
  const float* cw = p.ffn_conv_w + (size_t)layer * 3 * 5632;
  const float* cb = p.ffn_conv_b + (size_t)layer * 5632;
  const bool start = (t0 < NTP) ? ((t0 & 255) == 0) : ((t0 & 2047) == 0);
  const bool endd = (t0 < NTP) ? (((t0 + 8) & 255) == 0) : (((t0 + 8) & 2047) == 0);
  u32x4 ua[10], ug[10];
  const u32x4 zz = {0, 0, 0, 0};
#pragma unroll
  for (int i = 0; i < 10; ++i) {
    const int t = t0 - 1 + i;
    const bool ok = (i == 0) ? !start : ((i == 9) ? !endd : true);
    ua[i] = ok ? *(const u32x4*)(U + (size_t)t * 5632 + j) : zz;
    ug[i] = ok ? *(const u32x4*)(U + (size_t)t * 5632 + 2816 + j) : zz;
  }
  float wa[3][8], wg[3][8], ba[8], bg[8];
#pragma unroll
  for (int tp = 0; tp < 3; ++tp) {
    float4 x0 = *(const float4*)(cw + tp * 5632 + j), x1 = *(const float4*)(cw + tp * 5632 + j + 4);
    float4 y0 = *(const float4*)(cw + tp * 5632 + 2816 + j), y1 = *(const float4*)(cw + tp * 5632 + 2816 + j + 4);
    wa[tp][0] = x0.x; wa[tp][1] = x0.y; wa[tp][2] = x0.z; wa[tp][3] = x0.w; wa[tp][4] = x1.x; wa[tp][5] = x1.y; wa[tp][6] = x1.z; wa[tp][7] = x1.w;
    wg[tp][0] = y0.x; wg[tp][1] = y0.y; wg[tp][2] = y0.z; wg[tp][3] = y0.w; wg[tp][4] = y1.x; wg[tp][5] = y1.y; wg[tp][6] = y1.z; wg[tp][7] = y1.w;
  }
  {
    float4 x0 = *(const float4*)(cb + j), x1 = *(const float4*)(cb + j + 4);
    float4 y0 = *(const float4*)(cb + 2816 + j), y1 = *(const float4*)(cb + 2816 + j + 4);
    ba[0] = x0.x; ba[1] = x0.y; ba[2] = x0.z; ba[3] = x0.w; ba[4] = x1.x; ba[5] = x1.y; ba[6] = x1.z; ba[7] = x1.w;
    bg[0] = y0.x; bg[1] = y0.y; bg[2] = y0.z; bg[3] = y0.w; bg[4] = y1.x; bg[5] = y1.y; bg[6] = y1.z; bg[7] = y1.w;
  }
#pragma unroll
  for (int i = 0; i < 8; ++i) {
    u32x4 ov;
#pragma unroll
    for (int e2 = 0; e2 < 4; ++e2) {
      float res[2];
#pragma unroll
      for (int hl = 0; hl < 2; ++hl) {
        const int e = e2 * 2 + hl;
        float am = hl ? bfhi(ua[i][e2]) : bflo(ua[i][e2]);
        float a0 = hl ? bfhi(ua[i + 1][e2]) : bflo(ua[i + 1][e2]);
        float ap = hl ? bfhi(ua[i + 2][e2]) : bflo(ua[i + 2][e2]);
        float gm = hl ? bfhi(ug[i][e2]) : bflo(ug[i][e2]);
        float g0 = hl ? bfhi(ug[i + 1][e2]) : bflo(ug[i + 1][e2]);
        float gp = hl ? bfhi(ug[i + 2][e2]) : bflo(ug[i + 2][e2]);
        float av = wa[0][e] * am + wa[1][e] * a0 + wa[2][e] * ap + ba[e];
        float gv = wg[0][e] * gm + wg[1][e] * g0 + wg[2][e] * gp + bg[e];
        res[hl] = siluf_(gv) * av;
      }
      ov[e2] = pk2(res[0], res[1]);
    }
    *(u32x4*)(AO + (size_t)(t0 + i) * 2816 + j) = ov;
  }
}

#define XB_TMO      128
#define XB_XCNT(j)  (256  + 64 * (j))
#define XB_XSUB(j)  (1280 + 64 * (j))
#define XB_XGEN(j)  (2304 + 64 * (j))
#define XB_TOP      3328
#define XB_TOPGEN   3392
#define XCD_BAR_WORDS 3456
#define XB_SPIN_CAP (1u << 18)
#define LAS __attribute__((address_space(3)))

__device__ __forceinline__ unsigned xb_ld(unsigned* p)              { return __hip_atomic_load(p, __ATOMIC_RELAXED, __HIP_MEMORY_SCOPE_AGENT); }
__device__ __forceinline__ unsigned xb_add(unsigned* p, unsigned v) { return __hip_atomic_fetch_add(p, v, __ATOMIC_RELAXED, __HIP_MEMORY_SCOPE_AGENT); }
__device__ __forceinline__ unsigned xb_xcc_id() { return (unsigned)__builtin_amdgcn_s_getreg((3 << 11) | 20) & 0xFu; }
#define XB_SPIN(cond, bar) do { unsigned _sp = 0; while (cond) { __builtin_amdgcn_s_sleep(1); \
    if ((++_sp & 255u) == 0u) { if (xb_ld(&(bar)[XB_TMO])) break; if (_sp > XB_SPIN_CAP) { atomicAdd(&(bar)[XB_TMO], 1u); break; } } } } while (0)

struct XcdBarrier {
    unsigned* bar; unsigned x;
    volatile LAS unsigned* st;
};

__device__ __forceinline__ XcdBarrier xcd_barrier_post(unsigned* bar, volatile LAS unsigned* st) {
    XcdBarrier b; b.bar = bar; b.x = xb_xcc_id(); b.st = st;
    if (threadIdx.x == 0) (void)xb_add(&bar[XB_XCNT(b.x)], 1u);
    return b;
}
__device__ __forceinline__ void xcd_barrier_complete(unsigned* bar, unsigned x, unsigned& nloc, unsigned& nx) {
    const unsigned G = gridDim.x * gridDim.y * gridDim.z;
    unsigned sum, cnt, mine, sp = 0u;
    for (;;) {
        sum = 0u; cnt = 0u; mine = 0u;
#pragma unroll
        for (unsigned j = 0; j < 16; ++j) { const unsigned c = xb_ld(&bar[XB_XCNT(j)]); sum += c; cnt += (c > 0u) ? 1u : 0u; mine = (j == x) ? c : mine; }
        if (sum == G) break;
        __builtin_amdgcn_s_sleep(1);
        if ((++sp & 255u) == 0u) { if (xb_ld(&bar[XB_TMO])) break; if (sp > XB_SPIN_CAP) { atomicAdd(&bar[XB_TMO], 1u); break; } }
    }
    nloc = mine > 0u ? mine : 1u; nx = cnt > 0u ? cnt : 1u;
}

__device__ __forceinline__ void xcd_barrier(const XcdBarrier& b) {
    asm volatile("s_waitcnt vmcnt(0)" ::: "memory");
    __syncthreads();
    if (threadIdx.x == 0) {
        unsigned* bar = b.bar;
        __builtin_amdgcn_s_waitcnt(0);
        unsigned nloc = b.st[0], nx = b.st[1];
        if (nloc == 0u) { xcd_barrier_complete(bar, b.x, nloc, nx); b.st[0] = nloc; b.st[1] = nx; }
        const unsigned old = xb_add(&bar[XB_XSUB(b.x)], 1u);
        const unsigned gen = old / nloc;
        if (old + 1u == (gen + 1u) * nloc) {
            __builtin_amdgcn_fence(__ATOMIC_RELEASE, "agent");
            asm volatile("s_waitcnt vmcnt(0)" ::: "memory");
            const unsigned og = xb_add(&bar[XB_TOP], 1u);
            const unsigned tg = og / nx;
            if (og + 1u == (tg + 1u) * nx) xb_add(&bar[XB_TOPGEN], 1u);
            else XB_SPIN(xb_ld(&bar[XB_TOPGEN]) == tg, bar);
            __builtin_amdgcn_fence(__ATOMIC_ACQUIRE, "agent");
            xb_add(&bar[XB_XGEN(b.x)], 1u);
            asm volatile("s_waitcnt vmcnt(0)" ::: "memory");
        } else {
            XB_SPIN(xb_ld(&bar[XB_XGEN(b.x)]) == gen, bar);
            __builtin_amdgcn_fence(__ATOMIC_ACQUIRE, "agent");
            asm volatile("s_waitcnt vmcnt(0)" ::: "memory");
        }
    }
    __syncthreads();
}


template <int ph>
__device__ __forceinline__ void run_phase(const Params& p, int bid, int nb, char* smem, bool rep = false) {
  const float* ng = p.norm_g;
  const bh* Rf = (const bh*)p.R;
  if (ph == 0) {
    for (int j = bid + (rep ? 768 : 0); j < 768 + 576 + 1024; j += nb) {
      if (j < 768) gemv_job(p, j, smem);
      else if (j < 1344) filter_job(p, j - 768, smem);
      else convert_tile(p.w_in_even, 1024, 4096, p.wt, j - 1344, smem);
    }
  } else if (ph == 1) {
    for (int j = bid; j < 1536; j += nb) rows_job(p, j, true, nullptr, nullptr, 0, 0, ng + 0 * 1024, 0, 0);
  } else if (ph == 2) {
    gemm_phase<2, 192, 3>(p.act, 1024, p.wt, 1024, p.R, 4096, 4096, 32, bid, nb, smem);
  } else if (ph == 3) {
    for (int j = bid + (rep ? 512 : 0); j < (rep ? 896 : 512 + 384 + 256 + 256); j += nb) {
      if (j < 512) hyena_sample_job(p, j, smem);
      else if (j < 896) scan2_unit<0>(p, j - 512, smem);
      else if (j < 1152) hyena_prompt_job(p, j - 896, smem);
      else convert_tile(p.w_out_even, 1024, 1024, p.wt, j - 1152, smem);
    }
  } else if (ph == 4) {
    for (int j = bid; j < 128 + 1024; j += nb) {
      if (j < 128) fixup_unit<0>(p, j, smem);
      else scan_final_job(p, j - 128, 0);
    }
  } else if (ph == 5) {
    for (int j = bid; j < 512; j += nb) scan_final_job(p, 1024 + j, 0);
  } else if (ph == 6) {
    gemm_phase<1, 192, 3>(p.act, 1024, p.wt, 1024, p.R, 1024, 1024, 8, bid, nb, smem);
  } else if (ph == 7) {
    for (int j = bid; j < 1536 + 1408 + 704; j += nb) {
      if (j < 1536) rows_job(p, j, false, Rf, ng + 1 * 1024, 0, 2, ng + 2 * 1024, 0, 3);
      else if (j < 2944) convert_tile(p.ffn_up, 1024, 5632, p.wt, j - 1536, smem, true);
      else convert_tile(p.ffn_down, 2816, 1024, p.wt2, j - 2944, smem);
    }
  } else if (ph == 8) {
    gemm_phase<3, 192, 3>(p.act, 1024, p.wt, 1024, p.R + OFF_ACTF, 2816, 5632, 44, bid, nb, smem, p.ffn_conv_w, p.ffn_conv_b);
  } else if (ph == 9) {
  } else if (ph == 10) {
    gemm_phase<1, 192, 3>((const bh*)(p.R + OFF_ACTF), 2816, p.wt2, 2816, p.R, 1024, 1024, 8, bid, nb, smem);
  } else if (ph == 11) {
    for (int j = bid; j < 1536 + 800; j += nb) {
      if (j < 1536) rows_job(p, j, false, Rf, ng + 3 * 1024, 0, 5, ng + 4 * 1024, 1, 0);
      else convert_tile(p.w_in_odd, 1024, 3104, p.wt, j - 1536, smem);
    }
  } else if (ph == 12) {
    gemm_phase<1, 128, 3>(p.act, 1024, p.wt, 1024, p.R, 3104, 3104, 25, bid, nb, smem);
  } else if (ph == 13) {
    for (int j = bid; j < (rep ? 384 : 384 + 800 + 3072 + 256 + 256); j += nb) {
      if (j < 384) scan2_unit<1>(p, j, smem);
      else if (j < 1184) vt_job(p, j - 384, smem);
      else if (j < 4256) oddrow_job(p, j - 1184);
      else if (j < 4512) ctxk_job(p, j - 4256);
      else convert_tile(p.w_out_odd, 1024, 1024, p.wt, j - 4512, smem);
    }
  } else if (ph == 14) {
    for (int j = bid; j < (rep ? 768 : 768 + 128 + 1024); j += nb) {
      if (j < 768) attn_unit(p, j, smem);
      else if (j < 896) fixup_unit<1>(p, j - 768, smem);
      else scan_final_job(p, j - 896, 1);
    }
  } else if (ph == 15) {
    for (int j = bid; j < 512; j += nb) scan_final_job(p, 1024 + j, 1);
  } else if (ph == 16) {
    gemm_phase<1, 192, 3>(p.act, 1024, p.wt, 1024, p.R, 1024, 1024, 8, bid, nb, smem);
  } else if (ph == 17) {
    for (int j = bid; j < 1536 + 1408 + 704; j += nb) {
      if (j < 1536) rows_job(p, j, false, Rf, ng + 5 * 1024, 1, 2, ng + 6 * 1024, 1, 3);
      else if (j < 2944) convert_tile(p.ffn_up + (size_t)1024 * 5632, 1024, 5632, p.wt, j - 1536, smem, true);
      else convert_tile(p.ffn_down + (size_t)2816 * 1024, 2816, 1024, p.wt2, j - 2944, smem);
    }
  } else if (ph == 18) {
    gemm_phase<3, 192, 3>(p.act, 1024, p.wt, 1024, p.R + OFF_ACTF, 2816, 5632, 44, bid, nb, smem, p.ffn_conv_w + 3 * 5632, p.ffn_conv_b + 5632);
  } else if (ph == 19) {
  } else if (ph == 20) {
    gemm_phase<1, 192, 3>((const bh*)(p.R + OFF_ACTF), 2816, p.wt2, 2816, p.R, 1024, 1024, 8, bid, nb, smem);
  } else if (ph == 21) {
    for (int j = bid; j < 1536; j += nb) rows_job(p, j, false, Rf, ng + 7 * 1024, 1, 5, nullptr, 0, 0);
  }
}

template <int PH>
__device__ __forceinline__ void phase_step(const Params& p, int ph0, int ph1, char* smem, cg::grid_group& grid, const XcdBarrier& xb) {
  if (PH == 9 || PH == 19) return;
  if (PH >= ph0 && PH < ph1) {
    if (PH == REP_PH) { run_phase<PH>(p, blockIdx.x, gridDim.x, smem, true); xcd_barrier(xb); }
    run_phase<PH>(p, blockIdx.x, gridDim.x, smem);
    if (PH + 1 < ph1) {
      xcd_barrier(xb);
    }
  }
}

__global__ void __launch_bounds__(256, 2) mega_kernel(Params p, int ph0, int ph1) {
  __shared__ __attribute__((aligned(16))) char smem[49152];
  cg::grid_group grid = cg::this_grid();
  __shared__ uint4 xb_words;
  if (threadIdx.x == 0) xb_words = make_uint4(0u, 0u, 0u, 0u);
  __syncthreads();
  XcdBarrier xb = xcd_barrier_post(p.bar, (volatile LAS unsigned*)&xb_words);
#ifdef EXTRA_SYNCS
  for (int i = 0; i < EXTRA_SYNCS; ++i) xcd_barrier(xb);
#endif
  phase_step<0>(p, ph0, ph1, smem, grid, xb);
  phase_step<1>(p, ph0, ph1, smem, grid, xb);
  phase_step<2>(p, ph0, ph1, smem, grid, xb);
  phase_step<3>(p, ph0, ph1, smem, grid, xb);
  phase_step<4>(p, ph0, ph1, smem, grid, xb);
  phase_step<5>(p, ph0, ph1, smem, grid, xb);
  phase_step<6>(p, ph0, ph1, smem, grid, xb);
  phase_step<7>(p, ph0, ph1, smem, grid, xb);
  phase_step<8>(p, ph0, ph1, smem, grid, xb);
  phase_step<9>(p, ph0, ph1, smem, grid, xb);
  phase_step<10>(p, ph0, ph1, smem, grid, xb);
  phase_step<11>(p, ph0, ph1, smem, grid, xb);
  phase_step<12>(p, ph0, ph1, smem, grid, xb);
  phase_step<13>(p, ph0, ph1, smem, grid, xb);
  phase_step<14>(p, ph0, ph1, smem, grid, xb);
  phase_step<15>(p, ph0, ph1, smem, grid, xb);
  phase_step<16>(p, ph0, ph1, smem, grid, xb);
  phase_step<17>(p, ph0, ph1, smem, grid, xb);
  phase_step<18>(p, ph0, ph1, smem, grid, xb);
  phase_step<19>(p, ph0, ph1, smem, grid, xb);
  phase_step<20>(p, ph0, ph1, smem, grid, xb);
  phase_step<21>(p, ph0, ph1, smem, grid, xb);
}

extern "C" void kernel_launch(void* const* d_in, const int* in_sizes, int n_in, void* d_out, int out_size, void* d_ws,
                              size_t ws_size, hipStream_t stream) {
  static int grid_blocks = 0;
  if (!grid_blocks) {
    int dev = 0, cus = 0, per_cu = 0;
    hipGetDevice(&dev);
    hipDeviceGetAttribute(&cus, hipDeviceAttributeMultiprocessorCount, dev);
    hipOccupancyMaxActiveBlocksPerMultiprocessor(&per_cu, mega_kernel, 256, 0);
    if (per_cu > 2) per_cu = 2;
    if (per_cu < 1) per_cu = 1;
    grid_blocks = cus * per_cu;
  }
  Params p{};
  const float** pf = (const float**)&p;
  for (int i = 0; i < 35; ++i) pf[i] = (const float*)d_in[i];
  p.out = (float*)d_out;
  char* ws = (char*)d_ws;
  size_t off = 0;
  p.act = (bh*)(ws + off); off += (size_t)NT * 1024 * 2;
  p.wt = (bh*)(ws + off); off += (size_t)5632 * 1024 * 2;
  p.wt2 = (bh*)(ws + off); off += (size_t)1024 * 2816 * 2;
  p.R = ws + off; off += R_BYTES;
  p.mod = (float*)(ws + off); off += (size_t)2 * 3 * 6144 * 4;
  p.bar = (unsigned*)(ws + off); off += (size_t)XCD_BAR_WORDS * 4;
  p.gt256 = (bh*)(ws + off); off += (size_t)2 * 512 * 512 * 2;
  p.gt2048 = (bh*)(ws + off); off += (size_t)2 * 512 * 4096 * 2;
  if (off > ws_size) { fprintf(stderr, "workspace too small: need %zu have %zu\n", off, ws_size); return; }
  hipMemsetAsync(p.mod, 0, (size_t)2 * 3 * 6144 * 4 + (size_t)XCD_BAR_WORDS * 4, stream);
#if MEGA
  int ph0 = 0, ph1 = NPHASE;
  void* args[] = {&p, &ph0, &ph1};
  hipError_t e = hipLaunchCooperativeKernel((void*)mega_kernel, dim3(grid_blocks), dim3(256), args, 0, stream);
  if (e != hipSuccess) fprintf(stderr, "cooperative launch failed: %s (grid %d)\n", hipGetErrorString(e), grid_blocks);
#else
  for (int ph = 0; ph < NPHASE; ++ph) {
    int ph0 = ph, ph1 = ph + 1;
    void* args[] = {&p, &ph0, &ph1};
    hipError_t e = hipLaunchCooperativeKernel((void*)mega_kernel, dim3(grid_blocks), dim3(256), args, 0, stream);
    if (e != hipSuccess) fprintf(stderr, "launch failed: %s\n", hipGetErrorString(e));
  }
#endif
}
```

```cpp
#include <hip/hip_runtime.h>
#include <hip/hip_cooperative_groups.h>
#include <stdint.h>
#include <cstdio>
namespace cg = cooperative_groups;

#ifndef MEGA
#define MEGA 1
#endif
#ifndef REP_PH
#define REP_PH -1
#endif

typedef unsigned short bh;
using bf16x8 = __attribute__((ext_vector_type(8))) short;
using f32x4 = __attribute__((ext_vector_type(4))) float;
using u32x4 = __attribute__((ext_vector_type(4))) unsigned int;

#define NT 12288
#define NTP 8192
#define EPSF 1e-6f
#define NPHASE 22

#define OUT_HGRN 12582912
#define OUT_CK 16777216
#define OUT_CV 20971520
#define OUT_GLA 25165824

#define OFF_ODIR 100663296ull
#define OFF_Z1 150994944ull
#define OFF_HYT 150994944ull
#define OFF_ACTF 138412032ull
#define OFF_Q 150994944ull
#define OFF_KB 163577856ull
#define OFF_VT 176685056ull
#define R_BYTES 207618048ull
#define KV_SAMPLE_BASE 4194304

struct Params {
  const float *x_prompt, *x_sample, *state_hgrn, *cache_k, *cache_v, *state_gla, *c, *c_ctx;
  const float *ada_w, *ada_b, *norm_g, *ffn_up, *ffn_conv_w, *ffn_conv_b, *ffn_down;
  const float *w_in_even, *w_out_even, *hgrn_lb, *hgrn_norm, *hy_conv_w, *hy_conv_b;
  const float *hy_w1, *hy_b1, *hy_w2, *hy_b2, *hy_w3, *hy_freq, *hy_d;
  const float *w_in_odd, *w_out_odd, *diff_lambda, *diff_norm, *gla_aw, *gla_ab, *gla_norm;
  float* out;
  bh* act;
  bh* wt;
  bh* wt2;
  char* R;
  float* mod;
  bh* gt256;
  bh* gt2048;
  unsigned* bar;
};

typedef __bf16 bf2_t __attribute__((ext_vector_type(2)));
typedef float f2_t __attribute__((ext_vector_type(2)));
typedef unsigned int u32x2 __attribute__((ext_vector_type(2)));
__device__ __forceinline__ unsigned pk2(float a, float b) {
  f2_t v = {a, b};
  return __builtin_bit_cast(unsigned, __builtin_convertvector(v, bf2_t));
}
__device__ __forceinline__ bh f2bf(float x) { return (bh)(pk2(x, x) & 0xffffu); }
__device__ __forceinline__ float bflo(unsigned w) { return __uint_as_float(w << 16); }
__device__ __forceinline__ float bfhi(unsigned w) { return __uint_as_float(w & 0xffff0000u); }
__device__ __forceinline__ float bf2f(bh h) { return __uint_as_float(((uint32_t)h) << 16); }
__device__ __forceinline__ float sigmoidf_(float x) { return __builtin_amdgcn_rcpf(1.f + __expf(-x)); }
__device__ __forceinline__ float siluf_(float x) { return x * __builtin_amdgcn_rcpf(1.f + __expf(-x)); }
template <int CTRL>
__device__ __forceinline__ float dppf0(float v) {
  return __int_as_float(__builtin_amdgcn_update_dpp(0, __float_as_int(v), CTRL, 0xF, 0xF, true));
}
__device__ __forceinline__ float wave_sum(float v) {
  v += dppf0<0xB1>(v); v += dppf0<0x4E>(v); v += dppf0<0x141>(v); v += dppf0<0x140>(v);
  v += __shfl_xor(v, 16);
  v += __shfl_xor(v, 32);
  return v;
}

template <int OUT_BF16, int BM, int DEPTH>
__device__ __forceinline__ void gemm_phase(const bh* __restrict__ A, int lda, const bh* __restrict__ Bt, int K, void* Cv, int ldc,
                           int N, int ntn, int bid, int nb, char* smem, const float* cw = nullptr, const float* cb = nullptr) {
  constexpr int MT = BM / 32;
  constexpr int NPA = BM / 32;
  bh* As = (bh*)smem;
  bh* Bs = As + BM * 64;
  int tid_l_ = threadIdx.x; asm volatile("" : "+v"(tid_l_)); const int tid = tid_l_, lane = tid & 63, w = tid >> 6, wr = w >> 1, wc = w & 1, r = lane & 15, g = lane >> 4;
  constexpr int MB = (NT / BM) / 8;
  const int xcd = bid & 7, nloc = nb >> 3;
  const int qend = OUT_BF16 == 3 ? MB * ntn + (ntn + 7) / 8 : MB * ntn;
  for (int q = bid >> 3; q < qend; q += nloc) {
    int mt = xcd * MB + (q % MB), nt = q / MB;
    if (OUT_BF16 == 3 && q >= MB * ntn) { mt = 64; nt = (q - MB * ntn) * 8 + xcd; if (nt >= ntn) continue; }
    const int trow0 = OUT_BF16 == 3 ? mt * 190 - 1 : mt * BM;
    const bh* Ag = A;
    const bh* Bg = Bt + (size_t)(nt * 128) * K;
    f32x4 acc[MT][4];
#pragma unroll
    for (int m = 0; m < MT; ++m)
#pragma unroll
      for (int n = 0; n < 4; ++n) acc[m][n] = (f32x4){0.f, 0.f, 0.f, 0.f};
    u32x4 pa0[NPA], pb0[4], pa1[NPA], pb1[4];
    auto gload = [&](u32x4* pa, u32x4* pb, int kofs) {
#pragma unroll
      for (int i = 0; i < NPA; ++i) {
        int pz = tid + i * 256, row = pz >> 3, cp = pz & 7;
        int tr = trow0 + row;
        if (OUT_BF16 == 3) tr = min(max(tr, 0), NT - 1);
        pa[i] = *(const u32x4*)(Ag + (size_t)tr * lda + kofs + cp * 8);
      }
#pragma unroll
      for (int i = 0; i < 4; ++i) {
        int pz = tid + i * 256, row = pz >> 3, cp = pz & 7;
        pb[i] = *(const u32x4*)(Bg + (size_t)row * K + kofs + cp * 8);
      }
    };
    auto kstep = [&](u32x4* pa, u32x4* pb, int knext) {
      __syncthreads();
#pragma unroll
      for (int i = 0; i < NPA; ++i) {
        int pz = tid + i * 256, row = pz >> 3, cp = pz & 7;
        *(u32x4*)(As + row * 64 + ((cp ^ ((row >> 1) & 7)) << 3)) = pa[i];
      }
#pragma unroll
      for (int i = 0; i < 4; ++i) {
        int pz = tid + i * 256, row = pz >> 3, cp = pz & 7;
        *(u32x4*)(Bs + row * 64 + ((cp ^ ((row >> 1) & 7)) << 3)) = pb[i];
      }
      __syncthreads();
      if (knext < K) gload(pa, pb, knext);
#pragma unroll
      for (int kk = 0; kk < 2; ++kk) {
        bf16x8 af[MT], bfr[4];
#pragma unroll
        for (int m = 0; m < MT; ++m) { const int row = wr * (BM / 2) + m * 16 + r; af[m] = *(const bf16x8*)(As + row * 64 + (((kk * 4 + g) ^ ((row >> 1) & 7)) << 3)); }
#pragma unroll
        for (int n = 0; n < 4; ++n) { const int row = wc * 64 + n * 16 + r; bfr[n] = *(const bf16x8*)(Bs + row * 64 + (((kk * 4 + g) ^ ((row >> 1) & 7)) << 3)); }
        __builtin_amdgcn_sched_barrier(0);
#pragma unroll
        for (int m = 0; m < MT; ++m)
#pragma unroll
          for (int n = 0; n < 4; ++n)
            acc[m][n] = (OUT_BF16 == 1 || OUT_BF16 == 3) ? __builtin_amdgcn_mfma_f32_16x16x32_bf16(bfr[n], af[m], acc[m][n], 0, 0, 0)
                                        : __builtin_amdgcn_mfma_f32_16x16x32_bf16(af[m], bfr[n], acc[m][n], 0, 0, 0);
        __builtin_amdgcn_sched_barrier(0);
      }
    };
    if (DEPTH == 3) {
      constexpr int NA3 = BM / 64;
      bh* As3 = (bh*)smem;
      bh* Bs3 = As3 + 2 * BM * 32;
      u32x4 ra0[NA3], rb0[2], ra1[NA3], rb1[2];
      auto ld3 = [&](u32x4* ra, u32x4* rb, int kofs) {
#pragma unroll
        for (int i = 0; i < NA3; ++i) {
          int pz = tid + i * 256, row = pz >> 2, c = pz & 3;
          int tr = trow0 + row;
          if (OUT_BF16 == 3) tr = min(max(tr, 0), NT - 1);
          ra[i] = *(const u32x4*)(Ag + (size_t)tr * lda + kofs + c * 8);
        }
#pragma unroll
        for (int i = 0; i < 2; ++i) {
          int pz = tid + i * 256, row = pz >> 2, c = pz & 3;
          rb[i] = *(const u32x4*)(Bg + (size_t)row * K + kofs + c * 8);
        }
      };
      auto st3 = [&](const u32x4* ra, const u32x4* rb, int stg) {
#pragma unroll
        for (int i = 0; i < NA3; ++i) {
          int pz = tid + i * 256, row = pz >> 2, c = pz & 3;
          *(u32x4*)(As3 + stg * BM * 32 + row * 32 + ((c ^ (((row >> 3) & 1) << 1)) << 3)) = ra[i];
        }
#pragma unroll
        for (int i = 0; i < 2; ++i) {
          int pz = tid + i * 256, row = pz >> 2, c = pz & 3;
          *(u32x4*)(Bs3 + stg * 128 * 32 + row * 32 + ((c ^ (((row >> 3) & 1) << 1)) << 3)) = rb[i];
        }
      };
      auto comp3 = [&](int cur) {
        bf16x8 af[MT], bfr[4];
#pragma unroll
        for (int m = 0; m < MT; ++m) {
          const int row = wr * (BM / 2) + m * 16 + r;
          af[m] = *(const bf16x8*)(As3 + cur * BM * 32 + row * 32 + ((g ^ (((row >> 3) & 1) << 1)) << 3));
        }
#pragma unroll
        for (int n = 0; n < 4; ++n) {
          const int row = wc * 64 + n * 16 + r;
          bfr[n] = *(const bf16x8*)(Bs3 + cur * 128 * 32 + row * 32 + ((g ^ (((row >> 3) & 1) << 1)) << 3));
        }
#pragma unroll
        for (int m = 0; m < MT; ++m)
#pragma unroll
          for (int n = 0; n < 4; ++n)
            acc[m][n] = (OUT_BF16 == 1 || OUT_BF16 == 3) ? __builtin_amdgcn_mfma_f32_16x16x32_bf16(bfr[n], af[m], acc[m][n], 0, 0, 0)
                                        : __builtin_amdgcn_mfma_f32_16x16x32_bf16(af[m], bfr[n], acc[m][n], 0, 0, 0);
      };
      const int nk = K >> 5;
      __syncthreads();
      ld3(ra0, rb0, 0);
      ld3(ra1, rb1, 32);
      st3(ra0, rb0, 0);
      ld3(ra0, rb0, 64);
      __syncthreads();
      for (int ks = 0; ks < nk; ks += 2) {
        comp3(0);
        st3(ra1, rb1, 1);
        if (ks + 3 < nk) ld3(ra1, rb1, (ks + 3) << 5);
        __syncthreads();
        comp3(1);
        if (ks + 2 < nk) st3(ra0, rb0, 0);
        if (ks + 4 < nk) ld3(ra0, rb0, (ks + 4) << 5);
        __syncthreads();
      }
    } else {
    gload(pa0, pb0, 0);
    if (DEPTH == 2) {
      gload(pa1, pb1, 64);
      for (int k0 = 0; k0 < K; k0 += 128) {
        kstep(pa0, pb0, k0 + 128);
        kstep(pa1, pb1, k0 + 192);
      }
    } else {
      for (int k0 = 0; k0 < K; k0 += 64) kstep(pa0, pb0, k0 + 64);
    }
    }
    if (OUT_BF16 == 1 || OUT_BF16 == 3) {
      __syncthreads();
      bh* Ct = (bh*)smem;
#pragma unroll
      for (int m = 0; m < MT; ++m)
#pragma unroll
        for (int n = 0; n < 4; ++n) {
          const int row = wr * (BM / 2) + m * 16 + r;
          const int sl = wc * 16 + n * 4 + g;
          u32x2 pv;
          pv[0] = pk2(acc[m][n][0], acc[m][n][1]);
          pv[1] = pk2(acc[m][n][2], acc[m][n][3]);
          *(u32x2*)(Ct + row * 128 + ((sl ^ ((row & 15) << 1)) << 2)) = pv;
        }
      __syncthreads();
      if (OUT_BF16 == 1) {
#pragma unroll 2
        for (int i = 0; i < BM / 16; ++i) {
          const int pz = tid + i * 256, row = pz >> 4, pc = pz & 15;
          const u32x4 v = *(const u32x4*)(Ct + row * 128 + ((pc ^ (row & 15)) << 3));
          const int col = nt * 128 + pc * 8;
          if (col < N) *(u32x4*)((bh*)Cv + ((size_t)mt * BM + row) * ldc + col) = v;
        }
      } else {
        const int c8 = tid & 7, rs = tid >> 3;
        const int ja = nt * 64 + c8 * 8;
        float wa[3][8], wg[3][8], ba[8], bg[8];
#pragma unroll
        for (int tp = 0; tp < 3; ++tp) {
          const float4 x0 = *(const float4*)(cw + tp * 5632 + ja), x1 = *(const float4*)(cw + tp * 5632 + ja + 4);
          const float4 y0 = *(const float4*)(cw + tp * 5632 + 2816 + ja), y1 = *(const float4*)(cw + tp * 5632 + 2816 + ja + 4);
          wa[tp][0] = x0.x; wa[tp][1] = x0.y; wa[tp][2] = x0.z; wa[tp][3] = x0.w; wa[tp][4] = x1.x; wa[tp][5] = x1.y; wa[tp][6] = x1.z; wa[tp][7] = x1.w;
          wg[tp][0] = y0.x; wg[tp][1] = y0.y; wg[tp][2] = y0.z; wg[tp][3] = y0.w; wg[tp][4] = y1.x; wg[tp][5] = y1.y; wg[tp][6] = y1.z; wg[tp][7] = y1.w;
        }
        {
          const float4 x0 = *(const float4*)(cb + ja), x1 = *(const float4*)(cb + ja + 4);
          const float4 y0 = *(const float4*)(cb + 2816 + ja), y1 = *(const float4*)(cb + 2816 + ja + 4);
          ba[0] = x0.x; ba[1] = x0.y; ba[2] = x0.z; ba[3] = x0.w; ba[4] = x1.x; ba[5] = x1.y; ba[6] = x1.z; ba[7] = x1.w;
          bg[0] = y0.x; bg[1] = y0.y; bg[2] = y0.z; bg[3] = y0.w; bg[4] = y1.x; bg[5] = y1.y; bg[6] = y1.z; bg[7] = y1.w;
        }
#pragma unroll 1
        for (int i = 0; i < 6; ++i) {
          const int rr = 1 + rs + 32 * i;
          const int t = trow0 + rr;
          if (rr <= 190 && t < NT) {
            const bool start = (t < NTP) ? ((t & 255) == 0) : ((t & 2047) == 0);
            const bool endd = (t < NTP) ? ((t & 255) == 255) : ((t & 2047) == 2047);
            u32x4 am = *(const u32x4*)(Ct + (rr - 1) * 128 + ((c8 ^ ((rr - 1) & 15)) << 3));
            u32x4 gm = *(const u32x4*)(Ct + (rr - 1) * 128 + (((8 + c8) ^ ((rr - 1) & 15)) << 3));
            const u32x4 a0 = *(const u32x4*)(Ct + rr * 128 + ((c8 ^ (rr & 15)) << 3));
            const u32x4 g0 = *(const u32x4*)(Ct + rr * 128 + (((8 + c8) ^ (rr & 15)) << 3));
            u32x4 ap = *(const u32x4*)(Ct + (rr + 1) * 128 + ((c8 ^ ((rr + 1) & 15)) << 3));
            u32x4 gp = *(const u32x4*)(Ct + (rr + 1) * 128 + (((8 + c8) ^ ((rr + 1) & 15)) << 3));
            if (start) { am = (u32x4){0, 0, 0, 0}; gm = (u32x4){0, 0, 0, 0}; }
            if (endd) { ap = (u32x4){0, 0, 0, 0}; gp = (u32x4){0, 0, 0, 0}; }
            u32x4 ov;
#pragma unroll
            for (int e2 = 0; e2 < 4; ++e2) {
              float res[2];
#pragma unroll
              for (int hl = 0; hl < 2; ++hl) {
                const int e = e2 * 2 + hl;
                const float av = wa[0][e] * (hl ? bfhi(am[e2]) : bflo(am[e2])) + wa[1][e] * (hl ? bfhi(a0[e2]) : bflo(a0[e2])) +
                                 wa[2][e] * (hl ? bfhi(ap[e2]) : bflo(ap[e2])) + ba[e];
                const float gv = wg[0][e] * (hl ? bfhi(gm[e2]) : bflo(gm[e2])) + wg[1][e] * (hl ? bfhi(g0[e2]) : bflo(g0[e2])) +
                                 wg[2][e] * (hl ? bfhi(gp[e2]) : bflo(gp[e2])) + bg[e];
                res[hl] = siluf_(gv) * av;
              }
              ov[e2] = pk2(res[0], res[1]);
            }
            *(u32x4*)((bh*)Cv + (size_t)t * 2816 + ja) = ov;
          }
        }
      }
    }
#pragma unroll
    for (int m = 0; m < MT; ++m)
#pragma unroll
      for (int n = 0; n < 4; ++n) {
        if (OUT_BF16 == 1 || OUT_BF16 == 3) continue;
        int col = nt * 128 + wc * 64 + n * 16 + r;
        const size_t rowb = (size_t)mt * BM + wr * (BM / 2) + m * 16 + g * 4;
        if (OUT_BF16 == 2 && nt >= 20) {
          bh* hyt = (bh*)((char*)Cv + OFF_HYT) + (size_t)(col - 2560) * NT + rowb;
          u32x2 pv;
          pv[0] = pk2(acc[m][n][0], acc[m][n][1]);
          pv[1] = pk2(acc[m][n][2], acc[m][n][3]);
          *(u32x2*)hyt = pv;
        } else if (col < N) {
#pragma unroll
          for (int j = 0; j < 4; ++j) {
            size_t row = rowb + j;
            if (OUT_BF16) ((bh*)Cv)[row * ldc + col] = f2bf(acc[m][n][j]);
            else ((float*)Cv)[row * ldc + col] = acc[m][n][j];
          }
        }
      }
  }
}

__device__ __forceinline__ void convert_tile(const float* __restrict__ W, int K, int N, bh* __restrict__ WT, int tile, char* smem, bool perm = false) {
  float* tl = (float*)smem;
  int tid_l_ = threadIdx.x; asm volatile("" : "+v"(tid_l_)); const int tid = tid_l_;
  const int ntk = K >> 6;
  const int kt = tile % ntk, ntile = tile / ntk;
  __syncthreads();
#pragma unroll
  for (int i = 0; i < 16; ++i) {
    int e = tid + i * 256, kk = e >> 6, nn = e & 63, n = ntile * 64 + nn;
    tl[kk * 65 + nn] = (n < N) ? W[(size_t)(kt * 64 + kk) * N + n] : 0.f;
  }
  __syncthreads();
#pragma unroll
  for (int i = 0; i < 16; ++i) {
    int e = tid + i * 256, nn = e >> 6, kk = e & 63;
    const int orow = perm ? (ntile % 44) * 128 + (ntile / 44) * 64 + nn : ntile * 64 + nn;
    WT[(size_t)orow * K + kt * 64 + kk] = f2bf(tl[kk * 65 + nn]);
  }
}

__device__ __forceinline__ void gemv_job(const Params& p, int job, char* smem) {
  float* sc = (float*)smem;
  float* rd = sc + 768;
  int tid_l_ = threadIdx.x; asm volatile("" : "+v"(tid_l_)); const int tid = tid_l_;
  const int iq = job & 3, jb = (job >> 2) % 96, l = (job >> 2) / 96;
  __syncthreads();
  for (int i = tid; i < 768; i += 256) {
    int r = i >> 8, idx = iq * 256 + (i & 255);
    float v = (r == 0) ? p.c_ctx[idx] : p.c[(r - 1) * 1024 + idx];
    sc[i] = siluf_(v);
  }
  __syncthreads();
  const int jl = tid & 63, ig = tid >> 6, j = jb * 64 + jl;
  const float* W = p.ada_w + (size_t)l * 1024 * 6144 + (size_t)(iq * 256 + ig * 64) * 6144 + j;
  float a0 = 0.f, a1 = 0.f, a2 = 0.f;
#pragma unroll 16
  for (int i = 0; i < 64; ++i) {
    float wv = W[(size_t)i * 6144];
    a0 += sc[ig * 64 + i] * wv;
    a1 += sc[256 + ig * 64 + i] * wv;
    a2 += sc[512 + ig * 64 + i] * wv;
  }
  rd[(ig * 3 + 0) * 64 + jl] = a0;
  rd[(ig * 3 + 1) * 64 + jl] = a1;
  rd[(ig * 3 + 2) * 64 + jl] = a2;
  __syncthreads();
  if (tid < 192) {
    int r = tid >> 6, jl2 = tid & 63, j2 = jb * 64 + jl2;
    float sacc = (iq == 0) ? p.ada_b[l * 6144 + j2] : 0.f;
    for (int q = 0; q < 4; ++q) sacc += rd[(q * 3 + r) * 64 + jl2];
    atomicAdd(p.mod + (size_t)(l * 3 + r) * 6144 + j2, sacc);
  }
}

__device__ __forceinline__ void filter_job(const Params& p, int job, char* smem) {
  float* sh2 = (float*)smem;
  int tid_l_ = threadIdx.x; asm volatile("" : "+v"(tid_l_)); const int tid = tid_l_, lane = tid & 63, w = tid >> 6;
  int L, pos0;
  bh* gt;
  if (job < 64) { L = 256; pos0 = job * 4; gt = p.gt256; }
  else { L = 2048; pos0 = (job - 64) * 4; gt = p.gt2048; }
  __syncthreads();
  {
    const int pos = pos0 + w;
    const float t = (float)pos / (float)(L - 1);
    const float wv = 2.0f * 3.14159265358979323846f * (float)pos / (float)L;
    float zv = 0.f;
    if (lane == 0) zv = t;
    else if (lane <= 16) { float fb = 1e-4f + (float)(lane - 1) * ((15.0f - 1e-4f) / 15.0f); zv = cosf(fb * wv); }
    else if (lane <= 32) { float fb = 1e-4f + (float)(lane - 17) * ((15.0f - 1e-4f) / 15.0f); zv = -sinf(fb * wv); }
    const float fr = p.hy_freq[lane];
    float a = p.hy_b1[lane];
    for (int i = 0; i < 33; ++i) a += __shfl(zv, i) * p.hy_w1[i * 64 + lane];
    const float h1 = sinf(fr * a);
    a = p.hy_b2[lane];
    for (int i = 0; i < 64; ++i) a += __shfl(h1, i) * p.hy_w2[i * 64 + lane];
    sh2[w * 64 + lane] = sinf(fr * a);
  }
  __syncthreads();
  float acc[8][4];
#pragma unroll
  for (int m = 0; m < 8; ++m)
#pragma unroll
    for (int pp = 0; pp < 4; ++pp) acc[m][pp] = 0.f;
#pragma unroll 8
  for (int i = 0; i < 64; ++i) {
    const float h0 = sh2[i], h1 = sh2[64 + i], h2 = sh2[128 + i], h3 = sh2[192 + i];
#pragma unroll
    for (int m = 0; m < 8; ++m) {
      const float wv = p.hy_w3[i * 2048 + tid + 256 * m];
      acc[m][0] += wv * h0; acc[m][1] += wv * h1; acc[m][2] += wv * h2; acc[m][3] += wv * h3;
    }
  }
  const float min_decay = logf(1e-2f) / 1.5f, max_decay = logf(1e-2f) / 0.3f;
#pragma unroll
  for (int m = 0; m < 8; ++m) {
    const int o = tid + 256 * m;
    const int ord = o >> 10, side = (o >> 9) & 1, c = o & 511;
    const float delta = fabsf(min_decay + (float)c * ((max_decay - min_decay) / 511.0f));
    bh* grow = gt + (size_t)(ord * 512 + c) * (2 * L);
#pragma unroll
    for (int pp = 0; pp < 4; ++pp) {
      const int pos = pos0 + pp;
      const float t = (float)pos / (float)(L - 1);
      const bh val = f2bf(acc[m][pp] * expf(-t * delta));
      if (side == 0) grow[L - 1 - pos] = val;
      else if (pos >= 1) grow[L - 1 + pos] = val;
    }
  }
}

__device__ __forceinline__ void rows_job(const Params& p, int job, bool first, const bh* src, const float* gres, int lgate, int gate_idx,
                         const float* gnext, int lnext, int shift_idx) {
  int tid_l_ = threadIdx.x; asm volatile("" : "+v"(tid_l_)); const int tid = tid_l_, lane = tid & 63, w = tid >> 6;
  const int rowb = job * 8 + w * 2;
  const int r = rowb < NTP ? 0 : 1 + ((rowb - NTP) >> 11);
  float4 y[2][4], m[2][4];
#pragma unroll
  for (int rr = 0; rr < 2; ++rr) {
    const int row = rowb + rr;
    const float* xin = first ? (row < NTP ? p.x_prompt + (size_t)row * 1024 : p.x_sample + (size_t)(row - NTP) * 1024)
                             : p.out + (size_t)row * 1024;
#pragma unroll
    for (int i = 0; i < 4; ++i) y[rr][i] = *(const float4*)(xin + i * 256 + lane * 4);
    if (src) {
#pragma unroll
      for (int i = 0; i < 4; ++i) { const u32x2 mv = *(const u32x2*)(src + (size_t)row * 1024 + i * 256 + lane * 4); m[rr][i] = make_float4(bflo(mv[0]), bfhi(mv[0]), bflo(mv[1]), bfhi(mv[1])); }
    }
  }
  if (src) {
    const float* gate = p.mod + (size_t)(lgate * 3 + r) * 6144 + gate_idx * 1024;
    float4 gg[4], gt[4];
#pragma unroll
    for (int i = 0; i < 4; ++i) {
      gg[i] = *(const float4*)(gres + i * 256 + lane * 4);
      gt[i] = *(const float4*)(gate + i * 256 + lane * 4);
    }
#pragma unroll
    for (int rr = 0; rr < 2; ++rr) {
      float ss = 0.f;
#pragma unroll
      for (int i = 0; i < 4; ++i)
        ss += m[rr][i].x * m[rr][i].x + m[rr][i].y * m[rr][i].y + m[rr][i].z * m[rr][i].z + m[rr][i].w * m[rr][i].w;
      ss = wave_sum(ss);
      const float rs = rsqrtf(ss * (1.f / 1024.f) + EPSF);
#pragma unroll
      for (int i = 0; i < 4; ++i) {
        y[rr][i].x += gt[i].x * (m[rr][i].x * rs * gg[i].x);
        y[rr][i].y += gt[i].y * (m[rr][i].y * rs * gg[i].y);
        y[rr][i].z += gt[i].z * (m[rr][i].z * rs * gg[i].z);
        y[rr][i].w += gt[i].w * (m[rr][i].w * rs * gg[i].w);
      }
    }
  }
  if (src) {
#pragma unroll
    for (int rr = 0; rr < 2; ++rr)
#pragma unroll
      for (int i = 0; i < 4; ++i) *(float4*)(p.out + (size_t)(rowb + rr) * 1024 + i * 256 + lane * 4) = y[rr][i];
  }
  if (gnext) {
    const float* sh = p.mod + (size_t)(lnext * 3 + r) * 6144 + shift_idx * 1024;
    const float* scl = sh + 1024;
    float4 gg[4], s4[4], c4[4];
#pragma unroll
    for (int i = 0; i < 4; ++i) {
      gg[i] = *(const float4*)(gnext + i * 256 + lane * 4);
      s4[i] = *(const float4*)(sh + i * 256 + lane * 4);
      c4[i] = *(const float4*)(scl + i * 256 + lane * 4);
    }
#pragma unroll
    for (int rr = 0; rr < 2; ++rr) {
      float ss = 0.f;
#pragma unroll
      for (int i = 0; i < 4; ++i)
        ss += y[rr][i].x * y[rr][i].x + y[rr][i].y * y[rr][i].y + y[rr][i].z * y[rr][i].z + y[rr][i].w * y[rr][i].w;
      ss = wave_sum(ss);
      const float rs = rsqrtf(ss * (1.f / 1024.f) + EPSF);
      bh* arow = p.act + (size_t)(rowb + rr) * 1024;
#pragma unroll
      for (int i = 0; i < 4; ++i) {
        ushort4 o;
        o.x = f2bf(y[rr][i].x * rs * gg[i].x * (1.f + c4[i].x) + s4[i].x);
        o.y = f2bf(y[rr][i].y * rs * gg[i].y * (1.f + c4[i].y) + s4[i].y);
        o.z = f2bf(y[rr][i].z * rs * gg[i].z * (1.f + c4[i].z) + s4[i].z);
        o.w = f2bf(y[rr][i].w * rs * gg[i].w * (1.f + c4[i].w) + s4[i].w);
        *(ushort4*)(arow + i * 256 + lane * 4) = o;
      }
    }
  }
}

template <int CTRL>
__device__ __forceinline__ float dppf(float v) {
  return __int_as_float(__builtin_amdgcn_update_dpp(0, __float_as_int(v), CTRL, 0xF, 0xF, true));
}
__device__ __forceinline__ float sum16(float v) {
  v += dppf<0xB1>(v); v += dppf<0x4E>(v); v += dppf<0x141>(v); v += dppf<0x140>(v);
  return v;
}
__device__ __forceinline__ float max16(float v) {
  v = fmaxf(v, dppf<0xB1>(v)); v = fmaxf(v, dppf<0x4E>(v)); v = fmaxf(v, dppf<0x141>(v)); v = fmaxf(v, dppf<0x140>(v));
  return v;
}

typedef short s16x4 __attribute__((ext_vector_type(4)));

#define OFF_SC_EVEN 188743680ull
#define OFF_SC_ODD 79691776ull
#define SC_SLOC 8388608ull
#define SC_DECT 16777216ull

template <int MODE, int SKIP = 0>
__device__ __forceinline__ void scan2_unit(const Params& p, int unit, char* smem) {
  constexpr int DK = MODE == 0 ? 128 : 64;
  constexpr int LD = MODE == 0 ? 4096 : 3104;
  constexpr int NQ = DK / 32;
  constexpr int NP = 256 / DK;
  constexpr int TPP = 16 / NP;
  constexpr int RS = DK + 8;
  constexpr int TPT = DK / 8;
  float* sq = (float*)smem;
  float* slf = sq + 16 * DK;
  float* skk = slf + 16 * DK;
  bh* QE = (bh*)(skk + 16 * DK);
  bh* KE = QE + 16 * RS;
  bh* KLT = KE + 16 * RS;
  bh* VT = KLT + DK * 24;
  float* dec = (float*)(VT + 128 * 24);
  float* sx = dec + DK;
  int tid_l_ = threadIdx.x; asm volatile("" : "+v"(tid_l_)); const int tid = tid_l_, lane = tid & 63, w = tid >> 6, r = lane & 15, g = lane >> 4;
  const int dir = unit & 1, h = (unit >> 1) & 3, ss = unit >> 3;
  const bool samp = ss >= 32;
  const int sb = (ss - 32) >> 3, seg = (ss - 32) & 7;
  const int rbase = samp ? (NTP + sb * 2048 + (dir ? 2047 - seg * 256 : seg * 256)) : (ss * 256 + (dir ? 255 : 0));
  const int sgn = dir ? -1 : 1;
  const bh* proj = (const bh*)p.R;
  char* scbase = p.R + (MODE == 0 ? OFF_SC_EVEN : OFF_SC_ODD);
  bh* QB = (bh*)scbase;
  float* odir = (float*)(p.R + OFF_ODIR) + (size_t)dir * NT * 512;
  __syncthreads();
  if (MODE == 0) {
    for (int k = tid; k < 128; k += 256) {
      int ci = dir * 512 + h * 128 + k;
      float x0 = p.hgrn_lb[ci], x1 = p.hgrn_lb[1024 + ci], x2 = p.hgrn_lb[2048 + ci];
      float mx = fmaxf(x0, fmaxf(x1, x2));
      float e0 = expf(x0 - mx), e1 = expf(x1 - mx), e2 = expf(x2 - mx);
      sx[k] = e0 / (e0 + e1 + e2);
    }
  } else {
    for (int i = tid; i < 1024; i += 256) {
      int rr = i >> 6, k = i & 63;
      sx[i] = p.gla_aw[(size_t)(dir * 16 + rr) * 256 + h * 64 + k];
    }
    if (tid < 64) sx[1024 + tid] = p.gla_ab[dir * 256 + h * 64 + tid];
  }
  f32x4 S[2 * NQ][2];
#pragma unroll
  for (int a = 0; a < 2 * NQ; ++a) { S[a][0] = (f32x4){0.f, 0.f, 0.f, 0.f}; S[a][1] = (f32x4){0.f, 0.f, 0.f, 0.f}; }
  constexpr int EPT = MODE == 0 ? 8 : 4;
  const int li = tid >> 4, lk8 = (tid & 15) * EPT;
  const int vi = tid >> 4, v8 = (tid & 15) * 8;
  const int pk = tid % DK, ppart = tid / DK;
  float basec = 0.f;
  u32x4 rq = {0, 0, 0, 0}, rf = {0, 0, 0, 0}, rv = {0, 0, 0, 0}, rd0 = {0, 0, 0, 0}, rd1 = {0, 0, 0, 0};
  auto issue = [&](int c) {
    {
      const bh* pr = proj + (size_t)(rbase + sgn * (c * 16 + li)) * LD;
      if (MODE == 0) {
        rq = *(const u32x4*)(pr + h * 128 + lk8);
        rf = *(const u32x4*)(pr + 512 + dir * 512 + h * 128 + lk8);
      } else {
        const u32x2 q2 = *(const u32x2*)(pr + 1536 + h * 64 + lk8);
        const u32x2 k2 = *(const u32x2*)(pr + 1792 + h * 64 + lk8);
        rq[0] = q2[0]; rq[1] = q2[1]; rf[0] = k2[0]; rf[1] = k2[1];
        rd0 = *(const u32x4*)(pr + 3072 + dir * 16);
        rd1 = *(const u32x4*)(pr + 3072 + dir * 16 + 8);
      }
    }
    {
      const bh* pr = proj + (size_t)(rbase + sgn * (c * 16 + vi)) * LD;
      rv = *(const u32x4*)(pr + (MODE == 0 ? 1536 : 2048) + h * 128 + v8);
    }
  };
  issue(0);
#pragma unroll 1
  for (int c = 0; c < 16; ++c) {
    __syncthreads();
    if (SKIP != 3) {
      float oq[EPT], ol[EPT], ok[EPT];
      if (MODE == 0) {
#pragma unroll
        for (int e = 0; e < EPT; ++e) {
          float q = (e & 1) ? bfhi(rq[e >> 1]) : bflo(rq[e >> 1]);
          float ff = (e & 1) ? bfhi(rf[e >> 1]) : bflo(rf[e >> 1]);
          float lb = sx[lk8 + e];
          float f = lb + (1.f - lb) * sigmoidf_(ff);
          oq[e] = siluf_(q) * 0.08838834764831845f;
          ol[e] = __logf(f);
          ok[e] = 1.f - f;
        }
      } else {
        float da[16];
#pragma unroll
        for (int rr = 0; rr < 16; ++rr) {
          unsigned wd = rr < 8 ? rd0[(rr & 7) >> 1] : rd1[(rr & 7) >> 1];
          da[rr] = (rr & 1) ? bfhi(wd) : bflo(wd);
        }
        float xx[4];
        {
          float4 b0_ = *(const float4*)(sx + 1024 + lk8);
          xx[0] = b0_.x; xx[1] = b0_.y; xx[2] = b0_.z; xx[3] = b0_.w;
        }
#pragma unroll
        for (int rr = 0; rr < 16; ++rr) {
          float4 a0_ = *(const float4*)(sx + rr * 64 + lk8);
          xx[0] += da[rr] * a0_.x; xx[1] += da[rr] * a0_.y; xx[2] += da[rr] * a0_.z; xx[3] += da[rr] * a0_.w;
        }
#pragma unroll
        for (int e = 0; e < 4; ++e) {
          float q = (e & 1) ? bfhi(rq[e >> 1]) : bflo(rq[e >> 1]);
          float kk = (e & 1) ? bfhi(rf[e >> 1]) : bflo(rf[e >> 1]);
          float x = xx[e];
          float ls = fminf(x, 0.f) - __logf(1.f + __expf(-fabsf(x)));
          oq[e] = q * 0.125f;
          ol[e] = ls * 0.0625f;
          ok[e] = kk;
        }
      }
      float* dq_ = sq + li * DK + lk8;
      float* dl_ = slf + li * DK + lk8;
      float* dk_ = skk + li * DK + lk8;
#pragma unroll
      for (int e4 = 0; e4 < EPT; e4 += 4) {
        *(float4*)(dq_ + e4) = make_float4(oq[e4], oq[e4 + 1], oq[e4 + 2], oq[e4 + 3]);
        *(float4*)(dl_ + e4) = make_float4(ol[e4], ol[e4 + 1], ol[e4 + 2], ol[e4 + 3]);
        *(float4*)(dk_ + e4) = make_float4(ok[e4], ok[e4 + 1], ok[e4 + 2], ok[e4 + 3]);
      }
    }
#pragma unroll
    for (int e = 0; e < 8; ++e) {
      unsigned wv = rv[e >> 1];
      VT[(v8 + e) * 24 + vi] = (bh)((e & 1) ? (wv >> 16) : (wv & 0xffffu));
    }
    __syncthreads();
    if (c + 1 < 16) issue(c + 1);
    {
      float total = 0.f, pre = 0.f;
#pragma unroll
      for (int i = 0; i < 16; ++i) {
        float l = slf[i * DK + pk];
        if (i < ppart * TPP) pre += l;
        total += l;
      }
      unsigned kw[TPP / 2];
#pragma unroll
      for (int ii = 0; ii < TPP; ii += 2) {
        float klv[2];
#pragma unroll
        for (int u = 0; u < 2; ++u) {
          const int i = ppart * TPP + ii + u;
          pre += slf[i * DK + pk];
          const float qv = sq[i * DK + pk], kv = skk[i * DK + pk];
          QE[i * RS + pk] = f2bf(qv * __expf(pre));
          KE[i * RS + pk] = f2bf(kv * __expf(-pre));
          klv[u] = kv * __expf(total - pre);
          if (samp) {
            const int row = rbase + sgn * (c * 16 + i);
            QB[((size_t)dir * 4096 + (row - NTP)) * (4 * DK) + h * DK + pk] = f2bf(qv * __expf(basec + pre));
          }
        }
        kw[ii >> 1] = pk2(klv[0], klv[1]);
      }
      if (TPP == 8) {
        u32x4 kv4 = {kw[0], kw[1], kw[(TPP / 2) > 2 ? 2 : 0], kw[(TPP / 2) > 3 ? 3 : 0]};
        *(u32x4*)(KLT + pk * 24 + ppart * 8) = kv4;
      } else {
        u32x2 kv2 = {kw[0], kw[1]};
        *(u32x2*)(KLT + pk * 24 + ppart * 4) = kv2;
      }
      if (ppart == 0) dec[pk] = __expf(total);
      basec += total;
    }
    __syncthreads();
    {
      bf16x8 qf[NQ], kf[NQ];
#pragma unroll
      for (int q = 0; q < NQ; ++q) {
        qf[q] = *(const bf16x8*)(QE + r * RS + q * 32 + g * 8);
        kf[q] = *(const bf16x8*)(KE + r * RS + q * 32 + g * 8);
      }
      f32x4 at = (f32x4){0.f, 0.f, 0.f, 0.f};
#pragma unroll
      for (int q = 0; q < NQ; ++q) at = __builtin_amdgcn_mfma_f32_16x16x32_bf16(kf[q], qf[q], at, 0, 0, 0);
      u32x2 paw;
      paw[0] = pk2((g * 4 + 0 <= r) ? at[0] : 0.f, (g * 4 + 1 <= r) ? at[1] : 0.f);
      paw[1] = pk2((g * 4 + 2 <= r) ? at[2] : 0.f, (g * 4 + 3 <= r) ? at[3] : 0.f);
      const s16x4 pa = __builtin_bit_cast(s16x4, paw);
      s16x4 vf[2];
      f32x4 o[2];
#pragma unroll
      for (int nt = 0; nt < 2; ++nt) {
        vf[nt] = *(const s16x4*)(VT + (w * 32 + nt * 16 + r) * 24 + g * 4);
        o[nt] = __builtin_amdgcn_mfma_f32_16x16x16bf16_1k(pa, vf[nt], (f32x4){0.f, 0.f, 0.f, 0.f}, 0, 0, 0);
      }
#pragma unroll
      for (int q = 0; q < NQ; ++q) {
#pragma unroll
        for (int half = 0; half < 2; ++half) {
          const s16x4 qa = half == 0 ? __builtin_shufflevector(qf[q], qf[q], 0, 1, 2, 3)
                                     : __builtin_shufflevector(qf[q], qf[q], 4, 5, 6, 7);
#pragma unroll
          for (int nt = 0; nt < 2; ++nt) {
            const f32x4 sv_ = S[2 * q + half][nt];
            u32x2 sw;
            sw[0] = pk2(sv_[0], sv_[1]);
            sw[1] = pk2(sv_[2], sv_[3]);
            o[nt] = __builtin_amdgcn_mfma_f32_16x16x16bf16_1k(qa, __builtin_bit_cast(s16x4, sw), o[nt], 0, 0, 0);
          }
        }
      }
#pragma unroll
      for (int nt = 0; nt < 2; ++nt)
#pragma unroll
        for (int j = 0; j < 4; ++j) {
          const int row = rbase + sgn * (c * 16 + g * 4 + j);
          odir[(size_t)row * 512 + h * 128 + w * 32 + nt * 16 + r] = o[nt][j];
        }
#pragma unroll
      for (int q = 0; q < NQ; ++q) {
#pragma unroll
        for (int half = 0; half < 2; ++half) {
          const float4 d4 = *(const float4*)(dec + q * 32 + g * 8 + half * 4);
          const int ka = q * 32 + (r >> 2) * 8 + half * 4 + (r & 3);
          const s16x4 ka4 = *(const s16x4*)(KLT + ka * 24 + g * 4);
#pragma unroll
          for (int nt = 0; nt < 2; ++nt) {
            f32x4 sv_ = S[2 * q + half][nt];
            sv_[0] *= d4.x; sv_[1] *= d4.y; sv_[2] *= d4.z; sv_[3] *= d4.w;
            S[2 * q + half][nt] = __builtin_amdgcn_mfma_f32_16x16x16bf16_1k(ka4, vf[nt], sv_, 0, 0, 0);
          }
        }
      }
    }
  }
  {
    float* so;
    if (!samp) so = p.out + (MODE == 0 ? OUT_HGRN : OUT_GLA) + ((size_t)(ss * 2 + dir) * 4 + h) * DK * 128;
    else {
      const int us = ((sb * 4 + h) * 2 + dir) * 8 + seg;
      so = (float*)(scbase + SC_SLOC) + (size_t)us * DK * 128;
      if (ppart == 0) ((float*)(scbase + SC_DECT))[us * DK + pk] = __expf(basec);
    }
#pragma unroll
    for (int q = 0; q < NQ; ++q)
#pragma unroll
      for (int half = 0; half < 2; ++half)
#pragma unroll
        for (int nt = 0; nt < 2; ++nt)
#pragma unroll
          for (int j = 0; j < 4; ++j)
            so[(size_t)(q * 32 + g * 8 + half * 4 + j) * 128 + w * 32 + nt * 16 + r] = S[2 * q + half][nt][j];
  }
}

template <int MODE>
__device__ __forceinline__ void fixup_unit(const Params& p, int unit, char* smem) {
  constexpr int DK = MODE == 0 ? 128 : 64;
  constexpr int NQ = DK / 32;
  constexpr int RS = DK + 8;
  bh* ST = (bh*)smem;
  int tid_l_ = threadIdx.x; asm volatile("" : "+v"(tid_l_)); const int tid = tid_l_, lane = tid & 63, w = tid >> 6, r = lane & 15, g = lane >> 4;
  const int seg = unit & 7, dir = (unit >> 3) & 1, h = (unit >> 4) & 3, sb = unit >> 6;
  const int unit0 = unit & ~7;
  char* scbase = p.R + (MODE == 0 ? OFF_SC_EVEN : OFF_SC_ODD);
  const bh* QB = (const bh*)scbase;
  const float* SLOC = (const float*)(scbase + SC_SLOC);
  const float* DECT = (const float*)(scbase + SC_DECT);
  const float* s0 = (MODE == 0 ? p.state_hgrn : p.state_gla) + ((size_t)(sb * 2 + dir) * 4 + h) * DK * 128;
  float* odir = (float*)(p.R + OFF_ODIR) + (size_t)dir * NT * 512;
  __syncthreads();
  for (int m = 0; m < DK * 128 / 256; ++m) {
    const int e = tid + 256 * m, k = e >> 7, v = e & 127;
    float cur = s0[e];
    for (int jj = 0; jj < seg; ++jj)
      cur = DECT[(unit0 + jj) * DK + k] * cur + SLOC[(size_t)(unit0 + jj) * DK * 128 + e];
    ST[v * RS + k] = f2bf(cur);
  }
  __syncthreads();
  const int rbase = NTP + sb * 2048 + (dir ? 2047 - seg * 256 : seg * 256);
  const int sgn = dir ? -1 : 1;
#pragma unroll 1
  for (int mt = 0; mt < 4; ++mt) {
    f32x4 acc[8];
#pragma unroll
    for (int nt = 0; nt < 8; ++nt) acc[nt] = (f32x4){0.f, 0.f, 0.f, 0.f};
    const int rowa = rbase + sgn * (w * 64 + mt * 16 + r);
    const bh* qrow = QB + ((size_t)dir * 4096 + (rowa - NTP)) * (4 * DK) + h * DK + g * 8;
#pragma unroll
    for (int q = 0; q < NQ; ++q) {
      const bf16x8 a = *(const bf16x8*)(qrow + q * 32);
#pragma unroll
      for (int nt = 0; nt < 8; ++nt) {
        const bf16x8 b = *(const bf16x8*)(ST + (nt * 16 + r) * RS + q * 32 + g * 8);
        acc[nt] = __builtin_amdgcn_mfma_f32_16x16x32_bf16(a, b, acc[nt], 0, 0, 0);
      }
    }
#pragma unroll
    for (int nt = 0; nt < 8; ++nt)
#pragma unroll
      for (int j = 0; j < 4; ++j) {
        const int row = rbase + sgn * (w * 64 + mt * 16 + g * 4 + j);
        float* dst = odir + (size_t)row * 512 + h * 128 + nt * 16 + r;
        *dst += acc[nt][j];
      }
  }
}

__device__ __forceinline__ void scan_final_job(const Params& p, int job, int mode) {
  int tid_l_ = threadIdx.x; asm volatile("" : "+v"(tid_l_)); const int tid = tid_l_, lane = tid & 63, w = tid >> 6;
  const int rowb = job * 8 + w * 2;
  const int ld = mode == 0 ? 4096 : 3104;
  const int gcol = mode == 0 ? 2048 : 2560;
  const float* nrm = mode == 0 ? p.hgrn_norm : p.gla_norm;
  float2 a[2][4], b[2][4];
  unsigned gw[2][4];
#pragma unroll
  for (int rr = 0; rr < 2; ++rr) {
    const int row = rowb + rr;
    const float* o0 = (const float*)(p.R + OFF_ODIR) + (size_t)row * 512;
    const float* o1 = o0 + (size_t)NT * 512;
    const bh* proj = (const bh*)p.R + (size_t)row * ld;
#pragma unroll
    for (int h = 0; h < 4; ++h) {
      const int c = h * 128 + lane * 2;
      a[rr][h] = *(const float2*)(o0 + c);
      b[rr][h] = *(const float2*)(o1 + c);
      gw[rr][h] = *(const unsigned*)(proj + gcol + c);
    }
  }
  float2 nv[4];
#pragma unroll
  for (int h = 0; h < 4; ++h) nv[h] = *(const float2*)(nrm + h * 128 + lane * 2);
#pragma unroll
  for (int rr = 0; rr < 2; ++rr) {
    bh* arow = p.act + (size_t)(rowb + rr) * 1024 + (mode == 0 ? 0 : 512);
#pragma unroll
    for (int h = 0; h < 4; ++h) {
      const int c = h * 128 + lane * 2;
      float v0 = a[rr][h].x + b[rr][h].x, v1 = a[rr][h].y + b[rr][h].y;
      float ss = wave_sum(v0 * v0 + v1 * v1);
      float rs = rsqrtf(ss * (1.f / 128.f) + EPSF);
      float g0 = bflo(gw[rr][h]), g1 = bfhi(gw[rr][h]);
      *(unsigned*)(arow + c) = pk2(v0 * rs * nv[h].x * siluf_(g0), v1 * rs * nv[h].y * siluf_(g1));
    }
  }
}

using f32x16 = __attribute__((ext_vector_type(16))) float;
__device__ __forceinline__ bf16x8 toep_frag(const unsigned* Gd, int m0) {
  const int q = m0 >> 1;
  const unsigned sh = (unsigned)(m0 & 1) * 2u;
  const unsigned D0 = Gd[q], D1 = Gd[q + 1], D2 = Gd[q + 2], D3 = Gd[q + 3], D4 = Gd[q + 4];
  u32x4 f;
  f[0] = __builtin_amdgcn_alignbyte(D1, D0, sh);
  f[1] = __builtin_amdgcn_alignbyte(D2, D1, sh);
  f[2] = __builtin_amdgcn_alignbyte(D3, D2, sh);
  f[3] = __builtin_amdgcn_alignbyte(D4, D3, sh);
  return __builtin_bit_cast(bf16x8, f);
}
__device__ __forceinline__ void conv4(const bh* raw, int t, int L, float w0, float w1, float w2, float bb, float* out) {
  const u32x2 x = *(const u32x2*)(raw + t);
  const float xm = t > 0 ? bf2f(raw[t - 1]) : 0.f;
  const float xp = (t + 4 < L) ? bf2f(raw[t + 4]) : 0.f;
  const float x0 = bflo(x[0]), x1 = bfhi(x[0]), x2 = bflo(x[1]), x3 = bfhi(x[1]);
  out[0] = w0 * xm + w1 * x0 + w2 * x1 + bb;
  out[1] = w0 * x0 + w1 * x1 + w2 * x2 + bb;
  out[2] = w0 * x1 + w1 * x2 + w2 * x3 + bb;
  out[3] = w0 * x2 + w1 * x3 + w2 * xp + bb;
}
__device__ __forceinline__ u32x4 conv8(const bh* raw, int t, int L, float w0, float w1, float w2, float bb) {
  const u32x4 x = *(const u32x4*)(raw + t);
  float v[10];
  v[0] = t > 0 ? bf2f(raw[t - 1]) : 0.f;
  v[9] = (t + 8 < L) ? bf2f(raw[t + 8]) : 0.f;
#pragma unroll
  for (int e = 0; e < 4; ++e) { v[1 + 2 * e] = bflo(x[e]); v[2 + 2 * e] = bfhi(x[e]); }
  u32x4 o;
#pragma unroll
  for (int e = 0; e < 4; ++e)
    o[e] = pk2(w0 * v[2 * e] + w1 * v[2 * e + 1] + w2 * v[2 * e + 2] + bb, w0 * v[2 * e + 1] + w1 * v[2 * e + 2] + w2 * v[2 * e + 3] + bb);
  return o;
}

__device__ __forceinline__ void hyena_sample_job(const Params& p, int job, char* smem) {
  int tid_l_ = threadIdx.x; asm volatile("" : "+v"(tid_l_)); const int tid = tid_l_, lane = tid & 63, w = tid >> 6;
  const int col = lane & 31, kh = lane >> 5;
  const int cc = w >> 1, nh = w & 1;
  const int sb = job & 1, c0 = (job >> 1) * 2, c = c0 + cc;
  bh* G = (bh*)(smem + cc * 12288);
  bh* U = G + 4096;
  const unsigned* Gd = (const unsigned*)G;
  const bh* HYT = (const bh*)(p.R + OFF_HYT);
  const int rowoff = NTP + sb * 2048;
  __syncthreads();
  {
    const float vw0 = p.hy_conv_w[c], vw1 = p.hy_conv_w[1536 + c], vw2 = p.hy_conv_w[3072 + c], vb = p.hy_conv_b[c];
    const bh* raw = HYT + (size_t)c * NT + rowoff;
#pragma unroll
    for (int i = 0; i < 2; ++i) {
      const int t0 = (nh * 128 + lane + 64 * i) * 8;
      *(u32x4*)(U + t0) = conv8(raw, t0, 2048, vw0, vw1, vw2, vb);
    }
  }
#pragma unroll 1
  for (int ord = 0; ord < 2; ++ord) {
    {
      const bh* gsrc = p.gt2048 + (size_t)(ord * 512 + c) * 4096;
#pragma unroll
      for (int i = 0; i < 4; ++i) {
        const int e8 = (nh * 256 + lane + 64 * i) * 8;
        *(u32x4*)(G + e8) = *(const u32x4*)(gsrc + e8);
      }
    }
    __syncthreads();
    f32x16 acc;
#pragma unroll
    for (int i = 0; i < 16; ++i) acc[i] = 0.f;
    const int mbase = 2047 - col + kh * 8;
    const int dlo = nh == 0 ? -63 : -31, dhi = nh == 0 ? 31 : 63;
#pragma unroll 2
    for (int d = dlo; d <= dhi; ++d) {
      const bf16x8 a0 = toep_frag(Gd, mbase - d * 32);
      const bf16x8 a1 = toep_frag(Gd, mbase - d * 32 + 16);
      const int s1 = nh * 32 + col - d;
      const bool ok = (unsigned)s1 < 64u;
      const int s1c = ok ? s1 : 0;
      u32x4 b0 = *(const u32x4*)(U + s1c * 32 + kh * 8);
      u32x4 b1 = *(const u32x4*)(U + s1c * 32 + 16 + kh * 8);
      if (!ok) { b0 = (u32x4){0, 0, 0, 0}; b1 = (u32x4){0, 0, 0, 0}; }
      acc = __builtin_amdgcn_mfma_f32_32x32x16_bf16(a0, __builtin_bit_cast(bf16x8, b0), acc, 0, 0, 0);
      acc = __builtin_amdgcn_mfma_f32_32x32x16_bf16(a1, __builtin_bit_cast(bf16x8, b1), acc, 0, 0, 0);
    }
    __syncthreads();
    const int gi = (ord + 1) * 512 + c;
    const float gw0 = p.hy_conv_w[gi], gw1 = p.hy_conv_w[1536 + gi], gw2 = p.hy_conv_w[3072 + gi], gb = p.hy_conv_b[gi];
    const float dd = p.hy_d[ord * 512 + c];
    const bh* graw = HYT + (size_t)gi * NT + rowoff;
#pragma unroll
    for (int rq = 0; rq < 4; ++rq) {
      const int trun = (nh * 32 + col) * 32 + 8 * rq + 4 * kh;
      float gte[4];
      conv4(graw, trun, 2048, gw0, gw1, gw2, gb, gte);
      const u32x2 uo = *(const u32x2*)(U + trun);
      u32x2 zo;
      zo[0] = pk2(gte[0] * (acc[rq * 4 + 0] + bflo(uo[0]) * dd), gte[1] * (acc[rq * 4 + 1] + bfhi(uo[0]) * dd));
      zo[1] = pk2(gte[2] * (acc[rq * 4 + 2] + bflo(uo[1]) * dd), gte[3] * (acc[rq * 4 + 3] + bfhi(uo[1]) * dd));
      *(u32x2*)(U + trun) = zo;
    }
    __syncthreads();
  }
#pragma unroll
  for (int rr = 0; rr < 8; ++rr) {
    const int t = tid + 256 * rr;
    const unsigned z0 = *(const bh*)(smem + 8192 + t * 2);
    const unsigned z1 = *(const bh*)(smem + 12288 + 8192 + t * 2);
    *(unsigned*)(p.act + (size_t)(rowoff + t) * 1024 + 512 + c0) = z0 | (z1 << 16);
  }
}

__device__ __forceinline__ void hyena_prompt_job(const Params& p, int job, char* smem) {
  int tid_l_ = threadIdx.x; asm volatile("" : "+v"(tid_l_)); const int tid = tid_l_, lane = tid & 63, w = tid >> 6;
  const int col = lane & 31, kh = lane >> 5;
  const int cc = w >> 1, th = w & 1;
  const int c0 = job * 2, c = c0 + cc;
  bh* Uall = (bh*)smem;
  bh* Gall = (bh*)(smem + 2 * 32 * 264 * 2);
  bh* U = Uall + cc * 32 * 264;
  const unsigned* Gd = (const unsigned*)(Gall + cc * 512);
  const bh* HYT = (const bh*)(p.R + OFF_HYT);
  __syncthreads();
#pragma unroll 1
  for (int c2 = 0; c2 < 2; ++c2) {
    const int ch = c0 + c2;
    const float vw0 = p.hy_conv_w[ch], vw1 = p.hy_conv_w[1536 + ch], vw2 = p.hy_conv_w[3072 + ch], vb = p.hy_conv_b[ch];
#pragma unroll
    for (int i = 0; i < 4; ++i) {
      const int tg = (tid + 256 * i) * 8, b = tg >> 8, t = tg & 255;
      *(u32x4*)(Uall + c2 * 32 * 264 + b * 264 + t) = conv8(HYT + (size_t)ch * NT + b * 256, t, 256, vw0, vw1, vw2, vb);
    }
  }
#pragma unroll 1
  for (int ord = 0; ord < 2; ++ord) {
    if (tid < 128) {
      const int c2 = tid >> 6, l2 = tid & 63;
      *(u32x4*)(Gall + c2 * 512 + l2 * 8) = *(const u32x4*)(p.gt256 + (size_t)(ord * 512 + c0 + c2) * 512 + l2 * 8);
    }
    __syncthreads();
    f32x16 acc[4];
#pragma unroll
    for (int q = 0; q < 4; ++q)
#pragma unroll
      for (int i = 0; i < 16; ++i) acc[q][i] = 0.f;
    const int mbase = 255 - col + kh * 8;
#pragma unroll
    for (int q = 0; q < 4; ++q) {
      const int t1 = th * 4 + q;
#pragma unroll 2
      for (int s1 = 0; s1 < 8; ++s1) {
        const int d = t1 - s1;
        const bf16x8 a0 = toep_frag(Gd, mbase - d * 32);
        const bf16x8 a1 = toep_frag(Gd, mbase - d * 32 + 16);
        const bf16x8 b0 = *(const bf16x8*)(U + col * 264 + s1 * 32 + kh * 8);
        const bf16x8 b1 = *(const bf16x8*)(U + col * 264 + s1 * 32 + 16 + kh * 8);
        acc[q] = __builtin_amdgcn_mfma_f32_32x32x16_bf16(a0, b0, acc[q], 0, 0, 0);
        acc[q] = __builtin_amdgcn_mfma_f32_32x32x16_bf16(a1, b1, acc[q], 0, 0, 0);
      }
    }
    __syncthreads();
    const int gi = (ord + 1) * 512 + c;
    const float gw0 = p.hy_conv_w[gi], gw1 = p.hy_conv_w[1536 + gi], gw2 = p.hy_conv_w[3072 + gi], gb = p.hy_conv_b[gi];
    const float dd = p.hy_d[ord * 512 + c];
    const bh* graw = HYT + (size_t)gi * NT + col * 256;
#pragma unroll
    for (int q = 0; q < 4; ++q)
#pragma unroll
      for (int rq = 0; rq < 4; ++rq) {
        const int trun = (th * 4 + q) * 32 + 8 * rq + 4 * kh;
        float gte[4];
        conv4(graw, trun, 256, gw0, gw1, gw2, gb, gte);
        bh* up = U + col * 264 + trun;
        const u32x2 uo = *(const u32x2*)up;
        u32x2 zo;
        zo[0] = pk2(gte[0] * (acc[q][rq * 4 + 0] + bflo(uo[0]) * dd), gte[1] * (acc[q][rq * 4 + 1] + bfhi(uo[0]) * dd));
        zo[1] = pk2(gte[2] * (acc[q][rq * 4 + 2] + bflo(uo[1]) * dd), gte[3] * (acc[q][rq * 4 + 3] + bfhi(uo[1]) * dd));
        *(u32x2*)up = zo;
      }
    __syncthreads();
  }
#pragma unroll 4
  for (int i = 0; i < 32; ++i) {
    const int e = tid + 256 * i, b = e >> 8, t = e & 255;
    const unsigned z0 = Uall[b * 264 + t], z1 = Uall[32 * 264 + b * 264 + t];
    *(unsigned*)(p.act + (size_t)e * 1024 + 512 + c0) = z0 | (z1 << 16);
  }
}

__device__ __forceinline__ void oddrow_job(const Params& p, int job) {
  int tid_l_ = threadIdx.x; asm volatile("" : "+v"(tid_l_)); const int tid = tid_l_, lane = tid & 63, w = tid >> 6;
  const int row = job * 4 + w;
  const bh* pr = (const bh*)p.R + (size_t)row * 3104;
  bh* Q = (bh*)(p.R + OFF_Q) + (size_t)row * 512;
  bh* KB = (bh*)(p.R + OFF_KB);
  if (row < NTP) {
    const int b = row >> 8, t = row & 255;
    const int e0 = lane * 8, h = e0 >> 7, x = e0 & 127;
    const u32x4 qv = *(const u32x4*)(pr + e0);
    const u32x4 kv = *(const u32x4*)(pr + 512 + e0);
    const u32x4 vv = *(const u32x4*)(pr + 1024 + e0);
    const size_t idx = ((size_t)(b * 4 + h) * 256 + t) * 128 + x;
    *(u32x4*)(Q + e0) = qv;
    *(u32x4*)(KB + idx) = kv;
    float4 k0 = make_float4(bflo(kv[0]), bfhi(kv[0]), bflo(kv[1]), bfhi(kv[1]));
    float4 k1 = make_float4(bflo(kv[2]), bfhi(kv[2]), bflo(kv[3]), bfhi(kv[3]));
    float4 v0 = make_float4(bflo(vv[0]), bfhi(vv[0]), bflo(vv[1]), bfhi(vv[1]));
    float4 v1 = make_float4(bflo(vv[2]), bfhi(vv[2]), bflo(vv[3]), bfhi(vv[3]));
    *(float4*)(p.out + OUT_CK + idx) = k0;
    *(float4*)(p.out + OUT_CK + idx + 4) = k1;
    *(float4*)(p.out + OUT_CV + idx) = v0;
    *(float4*)(p.out + OUT_CV + idx + 4) = v1;
  } else {
    const int sb = (row - NTP) >> 11, t = (row - NTP) & 2047;
    const int rpos = t >> 6, cpos = t & 63;
    float q1[4], q2[4], k1[4], k2[4];
#pragma unroll
    for (int m = 0; m < 4; ++m) {
      int pi = lane + 64 * m;
      int h = pi >> 6, rem = pi & 63, pp = rem >> 5, part = (rem >> 4) & 1, i = rem & 15;
      int d1 = h * 128 + pp * 64 + part * 32 + i, d2 = d1 + 16;
      q1[m] = bf2f(pr[d1]); q2[m] = bf2f(pr[d2]);
      k1[m] = bf2f(pr[512 + d1]); k2[m] = bf2f(pr[512 + d2]);
    }
#pragma unroll
    for (int m = 0; m < 4; ++m) {
      int pi = lane + 64 * m;
      int h = pi >> 6, rem = pi & 63, pp = rem >> 5, part = (rem >> 4) & 1, i = rem & 15;
      int d1 = h * 128 + pp * 64 + part * 32 + i, d2 = d1 + 16;
      float pos = (float)(part ? cpos : rpos);
      float inv = expf(-(float)i * (9.210340371976184f / 16.f));
      float ang = pos * inv;
      float cs = cosf(ang), sn = sinf(ang);
      Q[d1] = f2bf(q1[m] * cs - q2[m] * sn);
      Q[d2] = f2bf(q1[m] * sn + q2[m] * cs);
      size_t kb = KV_SAMPLE_BASE + ((size_t)(sb * 4 + h) * 2304 + 256 + t) * 128;
      KB[kb + (d1 - h * 128)] = f2bf(k1[m] * cs - k2[m] * sn);
      KB[kb + (d2 - h * 128)] = f2bf(k1[m] * sn + k2[m] * cs);
    }
  }
}
__device__ __forceinline__ void ctxk_job(const Params& p, int job) {
  bh* KB = (bh*)(p.R + OFF_KB);
  int tidl = threadIdx.x; asm volatile("" : "+v"(tidl));
#pragma unroll
  for (int i = 0; i < 4; ++i) {
    int e = job * 1024 + i * 256 + tidl;
    int x = e & 127, j = (e >> 7) & 255, hh = (e >> 15) & 3, sb = e >> 17;
    KB[KV_SAMPLE_BASE + ((size_t)(sb * 4 + hh) * 2304 + j) * 128 + x] = f2bf(p.cache_k[e]);
  }
}
__device__ __forceinline__ void vt_job(const Params& p, int job, char* smem) {
  bh* tl = (bh*)smem;
  int tid_l_ = threadIdx.x; asm volatile("" : "+v"(tid_l_)); const int tid = tid_l_;
  int seq, h, kt, Lk;
  if (job < 288) { seq = 32 + job / 144; int r = job % 144; h = r / 36; kt = r % 36; Lk = 2304; }
  else { int j = job - 288; seq = j >> 4; h = (j >> 2) & 3; kt = j & 3; Lk = 256; }
  const bh* proj = (const bh*)p.R;
  __syncthreads();
#pragma unroll 16
  for (int i = 0; i < 32; ++i) {
    int e = tid + i * 256, key = e >> 7, dv = e & 127;
    bh val;
    if (seq < 32) val = proj[(size_t)(seq * 256 + kt * 64 + key) * 3104 + 1024 + h * 128 + dv];
    else if (kt < 4) val = f2bf(p.cache_v[((size_t)((seq - 32) * 4 + h) * 256 + kt * 64 + key) * 128 + dv]);
    else val = proj[(size_t)(NTP + (seq - 32) * 2048 + (kt - 4) * 64 + key) * 3104 + 1024 + h * 128 + dv];
    tl[key * 130 + dv] = val;
  }
  __syncthreads();
  bh* VT = (bh*)(p.R + OFF_VT) + (seq < 32 ? (size_t)(seq * 4 + h) * 128 * 256
                                            : (size_t)KV_SAMPLE_BASE + (size_t)((seq - 32) * 4 + h) * 128 * 2304);
#pragma unroll 4
  for (int i = 0; i < 32; ++i) {
    int e = tid + i * 256, dv = e >> 6, key = e & 63;
    VT[(size_t)dv * Lk + kt * 64 + key] = tl[key * 130 + dv];
  }
}

__device__ __forceinline__ void attn_unit(const Params& p, int unit, char* smem) {
  bh* Pl = (bh*)smem;
  float* sred = (float*)(smem + 10240);
  int tid_l_ = threadIdx.x; asm volatile("" : "+v"(tid_l_)); const int tid = tid_l_, lane = tid & 63, w = tid >> 6, r = lane & 15, g = lane >> 4;
  int seq, h, qb, Lk;
  if (unit < 256) { seq = 32 + (unit >> 7); h = (unit >> 5) & 3; qb = unit & 31; Lk = 2304; }
  else { int u = unit - 256; seq = u >> 4; h = (u >> 2) & 3; qb = u & 3; Lk = 256; }
  const int row0 = seq < 32 ? seq * 256 : NTP + (seq - 32) * 2048;
  const bh* Q = (const bh*)(p.R + OFF_Q);
  const bh* KB = (const bh*)(p.R + OFF_KB) + (seq < 32 ? (size_t)(seq * 4 + h) * 256 * 128
                                                       : (size_t)KV_SAMPLE_BASE + (size_t)((seq - 32) * 4 + h) * 2304 * 128);
  const bh* VT = (const bh*)(p.R + OFF_VT) + (seq < 32 ? (size_t)(seq * 4 + h) * 128 * 256
                                                       : (size_t)KV_SAMPLE_BASE + (size_t)((seq - 32) * 4 + h) * 128 * 2304);
  __syncthreads();
  if (tid < 64) {
    float a = p.diff_lambda[tid] * p.diff_lambda[64 + tid];
    float b = p.diff_lambda[128 + tid] * p.diff_lambda[192 + tid];
    a = wave_sum(a); b = wave_sum(b);
    if (tid == 0) sred[0] = expf(a) - expf(b);
  }
  __syncthreads();
  const float lam_init = 0.8f - 0.6f * expf(-0.3f * 1.0f);
  const float lam = sred[0] + lam_init;
  const int qrow = row0 + qb * 64 + w * 16;
  bf16x8 aq[2][2];
#pragma unroll
  for (int pp = 0; pp < 2; ++pp)
#pragma unroll
    for (int kk = 0; kk < 2; ++kk)
      aq[pp][kk] = *(const bf16x8*)(Q + (size_t)(qrow + r) * 512 + h * 128 + pp * 64 + kk * 32 + g * 8);
  float mrun[2][4], lrun[2][4];
  f32x4 O[2][8];
#pragma unroll
  for (int pp = 0; pp < 2; ++pp) {
#pragma unroll
    for (int j = 0; j < 4; ++j) { mrun[pp][j] = -1e30f; lrun[pp][j] = 0.f; }
#pragma unroll
    for (int n = 0; n < 8; ++n) O[pp][n] = (f32x4){0.f, 0.f, 0.f, 0.f};
  }
  bh* Pw = Pl + w * (2 * 16 * 40);
  const float scale = 0.125f;
  bh* Ks = (bh*)(smem + 10752);
  bh* Vs = Ks + 64 * 128;
  u32x4 pk_[4], pv_[4];
  auto tload = [&](int kt) {
#pragma unroll
    for (int i = 0; i < 4; ++i) {
      const int pz = tid + 256 * i;
      pk_[i] = *(const u32x4*)(KB + (size_t)(kt + (pz >> 4)) * 128 + (pz & 15) * 8);
      pv_[i] = *(const u32x4*)(VT + (size_t)(pz >> 3) * Lk + kt + (pz & 7) * 8);
    }
  };
  tload(0);
#pragma unroll 1
  for (int kt = 0; kt < Lk; kt += 64) {
    __syncthreads();
#pragma unroll
    for (int i = 0; i < 4; ++i) {
      const int pz = tid + 256 * i;
      const int key = pz >> 4, ck = pz & 15, dv = pz >> 3, cv = pz & 7;
      *(u32x4*)(Ks + key * 128 + ((ck ^ (key & 15)) << 3)) = pk_[i];
      *(u32x4*)(Vs + dv * 64 + ((cv ^ ((dv >> 1) & 7)) << 3)) = pv_[i];
    }
    __syncthreads();
    if (kt + 64 < Lk) tload(kt + 64);
#pragma unroll
    for (int h2 = 0; h2 < 2; ++h2) {
      f32x4 s[2][2];
#pragma unroll
      for (int sub = 0; sub < 2; ++sub) {
        const int key = h2 * 32 + sub * 16 + r;
#pragma unroll
        for (int pp = 0; pp < 2; ++pp) {
          const bf16x8 b0 = *(const bf16x8*)(Ks + key * 128 + (((pp * 8 + g) ^ (key & 15)) << 3));
          const bf16x8 b1 = *(const bf16x8*)(Ks + key * 128 + (((pp * 8 + 4 + g) ^ (key & 15)) << 3));
          f32x4 z = (f32x4){0.f, 0.f, 0.f, 0.f};
          z = __builtin_amdgcn_mfma_f32_16x16x32_bf16(aq[pp][0], b0, z, 0, 0, 0);
          z = __builtin_amdgcn_mfma_f32_16x16x32_bf16(aq[pp][1], b1, z, 0, 0, 0);
          s[pp][sub] = z;
        }
      }
#pragma unroll
      for (int pp = 0; pp < 2; ++pp) {
#pragma unroll
        for (int j = 0; j < 4; ++j) {
          float s0 = s[pp][0][j] * scale, s1 = s[pp][1][j] * scale;
          float mx = max16(fmaxf(s0, s1));
          float mnew = fmaxf(mrun[pp][j], mx);
          float alpha = __expf(mrun[pp][j] - mnew);
          float p0 = __expf(s0 - mnew), p1 = __expf(s1 - mnew);
          float rs = sum16(p0 + p1);
          lrun[pp][j] = lrun[pp][j] * alpha + rs;
          mrun[pp][j] = mnew;
#pragma unroll
          for (int n = 0; n < 8; ++n) O[pp][n][j] *= alpha;
          Pw[(pp * 16 + g * 4 + j) * 40 + r] = f2bf(p0);
          Pw[(pp * 16 + g * 4 + j) * 40 + 16 + r] = f2bf(p1);
        }
      }
      __builtin_amdgcn_fence(__ATOMIC_RELEASE, "wavefront");
      __builtin_amdgcn_wave_barrier();
      __builtin_amdgcn_fence(__ATOMIC_ACQUIRE, "wavefront");
      bf16x8 pa0 = *(const bf16x8*)(Pw + (0 * 16 + r) * 40 + g * 8);
      bf16x8 pa1 = *(const bf16x8*)(Pw + (1 * 16 + r) * 40 + g * 8);
#pragma unroll
      for (int n = 0; n < 8; ++n) {
        const int dv = n * 16 + r;
        const bf16x8 vb = *(const bf16x8*)(Vs + dv * 64 + (((h2 * 4 + g) ^ ((dv >> 1) & 7)) << 3));
        O[0][n] = __builtin_amdgcn_mfma_f32_16x16x32_bf16(pa0, vb, O[0][n], 0, 0, 0);
        O[1][n] = __builtin_amdgcn_mfma_f32_16x16x32_bf16(pa1, vb, O[1][n], 0, 0, 0);
      }
      __builtin_amdgcn_fence(__ATOMIC_RELEASE, "wavefront");
      __builtin_amdgcn_wave_barrier();
    }
  }
#pragma unroll
  for (int j = 0; j < 4; ++j) {
    float i0 = 1.f / lrun[0][j], i1 = lam / lrun[1][j];
    float o[8];
    float ss = 0.f;
#pragma unroll
    for (int n = 0; n < 8; ++n) { o[n] = O[0][n][j] * i0 - O[1][n][j] * i1; ss += o[n] * o[n]; }
    ss = sum16(ss);
    float rs = rsqrtf(ss * (1.f / 128.f) + EPSF) * (1.f - lam_init);
    bh* arow = p.act + (size_t)(qrow + g * 4 + j) * 1024 + h * 128;
#pragma unroll
    for (int n = 0; n < 8; ++n) arow[n * 16 + r] = f2bf(o[n] * rs * p.diff_norm[h * 128 + n * 16 + r]);
  }
}

__device__ __forceinline__ void ffnact_job(const Params& p, int layer, int job) {
  int tidl = threadIdx.x; asm volatile("" : "+v"(tidl));
  const int item = job * 256 + tidl;
  const int rc = item / 352, j = (item % 352) * 8;
  const int t0 = rc * 8;
  const bh* U = (const bh*)p.R;
  bh* AO = (bh*)(p.R + OFF_ACTF);
  const float* cw = p.ffn_conv_w + (size_t)layer * 3 * 5632;
  const float* cb = p.ffn_conv_b + (size_t)layer * 5632;
  const bool start = (t0 < NTP) ? ((t0 & 255) == 0) : ((t0 & 2047) == 0);
  const bool endd = (t0 < NTP) ? (((t0 + 8) & 255) == 0) : (((t0 + 8) & 2047) == 0);
  u32x4 ua[10], ug[10];
  const u32x4 zz = {0, 0, 0, 0};
#pragma unroll
  for (int i = 0; i < 10; ++i) {
    const int t = t0 - 1 + i;
    const bool ok = (i == 0) ? !start : ((i == 9) ? !endd : true);
    ua[i] = ok ? *(const u32x4*)(U + (size_t)t * 5632 + j) : zz;
    ug[i] = ok ? *(const u32x4*)(U + (size_t)t * 5632 + 2816 + j) : zz;
  }
  float wa[3][8], wg[3][8], ba[8], bg[8];
#pragma unroll
  for (int tp = 0; tp < 3; ++tp) {
    float4 x0 = *(const float4*)(cw + tp * 5632 + j), x1 = *(const float4*)(cw + tp * 5632 + j + 4);
    float4 y0 = *(const float4*)(cw + tp * 5632 + 2816 + j), y1 = *(const float4*)(cw + tp * 5632 + 2816 + j + 4);
    wa[tp][0] = x0.x; wa[tp][1] = x0.y; wa[tp][2] = x0.z; wa[tp][3] = x0.w; wa[tp][4] = x1.x; wa[tp][5] = x1.y; wa[tp][6] = x1.z; wa[tp][7] = x1.w;
    wg[tp][0] = y0.x; wg[tp][1] = y0.y; wg[tp][2] = y0.z; wg[tp][3] = y0.w; wg[tp][4] = y1.x; wg[tp][5] = y1.y; wg[tp][6] = y1.z; wg[tp][7] = y1.w;
  }
  {
    float4 x0 = *(const float4*)(cb + j), x1 = *(const float4*)(cb + j + 4);
    float4 y0 = *(const float4*)(cb + 2816 + j), y1 = *(const float4*)(cb + 2816 + j + 4);
    ba[0] = x0.x; ba[1] = x0.y; ba[2] = x0.z; ba[3] = x0.w; ba[4] = x1.x; ba[5] = x1.y; ba[6] = x1.z; ba[7] = x1.w;
    bg[0] = y0.x; bg[1] = y0.y; bg[2] = y0.z; bg[3] = y0.w; bg[4] = y1.x; bg[5] = y1.y; bg[6] = y1.z; bg[7] = y1.w;
  }
#pragma unroll
  for (int i = 0; i < 8; ++i) {
    u32x4 ov;
#pragma unroll
    for (int e2 = 0; e2 < 4; ++e2) {
      float res[2];
#pragma unroll
      for (int hl = 0; hl < 2; ++hl) {
        const int e = e2 * 2 + hl;
        float am = hl ? bfhi(ua[i][e2]) : bflo(ua[i][e2]);
        float a0 = hl ? bfhi(ua[i + 1][e2]) : bflo(ua[i + 1][e2]);
        float ap = hl ? bfhi(ua[i + 2][e2]) : bflo(ua[i + 2][e2]);
        float gm = hl ? bfhi(ug[i][e2]) : bflo(ug[i][e2]);
        float g0 = hl ? bfhi(ug[i + 1][e2]) : bflo(ug[i + 1][e2]);
        float gp = hl ? bfhi(ug[i + 2][e2]) : bflo(ug[i + 2][e2]);
        float av = wa[0][e] * am + wa[1][e] * a0 + wa[2][e] * ap + ba[e];
        float gv = wg[0][e] * gm + wg[1][e] * g0 + wg[2][e] * gp + bg[e];
        res[hl] = siluf_(gv) * av;
      }
      ov[e2] = pk2(res[0], res[1]);
    }
    *(u32x4*)(AO + (size_t)(t0 + i) * 2816 + j) = ov;
  }
}

#define XB_TMO      128
#define XB_XCNT(j)  (256  + 64 * (j))
#define XB_XSUB(j)  (1280 + 64 * (j))
#define XB_XGEN(j)  (2304 + 64 * (j))
#define XB_TOP      3328
#define XB_TOPGEN   3392
#define XCD_BAR_WORDS 3456
#define XB_SPIN_CAP (1u << 18)
#define LAS __attribute__((address_space(3)))

__device__ __forceinline__ unsigned xb_ld(unsigned* p)              { return __hip_atomic_load(p, __ATOMIC_RELAXED, __HIP_MEMORY_SCOPE_AGENT); }
__device__ __forceinline__ unsigned xb_add(unsigned* p, unsigned v) { return __hip_atomic_fetch_add(p, v, __ATOMIC_RELAXED, __HIP_MEMORY_SCOPE_AGENT); }
__device__ __forceinline__ unsigned xb_xcc_id() { return (unsigned)__builtin_amdgcn_s_getreg((3 << 11) | 20) & 0xFu; }
#define XB_SPIN(cond, bar) do { unsigned _sp = 0; while (cond) { __builtin_amdgcn_s_sleep(1); \
    if ((++_sp & 255u) == 0u) { if (xb_ld(&(bar)[XB_TMO])) break; if (_sp > XB_SPIN_CAP) { atomicAdd(&(bar)[XB_TMO], 1u); break; } } } } while (0)

struct XcdBarrier {
    unsigned* bar; unsigned x;
    volatile LAS unsigned* st;
};

__device__ __forceinline__ XcdBarrier xcd_barrier_post(unsigned* bar, volatile LAS unsigned* st) {
    XcdBarrier b; b.bar = bar; b.x = xb_xcc_id(); b.st = st;
    if (threadIdx.x == 0) (void)xb_add(&bar[XB_XCNT(b.x)], 1u);
    return b;
}
__device__ __forceinline__ void xcd_barrier_complete(unsigned* bar, unsigned x, unsigned& nloc, unsigned& nx) {
    const unsigned G = gridDim.x * gridDim.y * gridDim.z;
    unsigned sum, cnt, mine, sp = 0u;
    for (;;) {
        sum = 0u; cnt = 0u; mine = 0u;
#pragma unroll
        for (unsigned j = 0; j < 16; ++j) { const unsigned c = xb_ld(&bar[XB_XCNT(j)]); sum += c; cnt += (c > 0u) ? 1u : 0u; mine = (j == x) ? c : mine; }
        if (sum == G) break;
        __builtin_amdgcn_s_sleep(1);
        if ((++sp & 255u) == 0u) { if (xb_ld(&bar[XB_TMO])) break; if (sp > XB_SPIN_CAP) { atomicAdd(&bar[XB_TMO], 1u); break; } }
    }
    nloc = mine > 0u ? mine : 1u; nx = cnt > 0u ? cnt : 1u;
}

__device__ __forceinline__ void xcd_barrier(const XcdBarrier& b) {
    asm volatile("s_waitcnt vmcnt(0)" ::: "memory");
    __syncthreads();
    if (threadIdx.x == 0) {
        unsigned* bar = b.bar;
        __builtin_amdgcn_s_waitcnt(0);
        unsigned nloc = b.st[0], nx = b.st[1];
        if (nloc == 0u) { xcd_barrier_complete(bar, b.x, nloc, nx); b.st[0] = nloc; b.st[1] = nx; }
        const unsigned old = xb_add(&bar[XB_XSUB(b.x)], 1u);
        const unsigned gen = old / nloc;
        if (old + 1u == (gen + 1u) * nloc) {
            __builtin_amdgcn_fence(__ATOMIC_RELEASE, "agent");
            asm volatile("s_waitcnt vmcnt(0)" ::: "memory");
            const unsigned og = xb_add(&bar[XB_TOP], 1u);
            const unsigned tg = og / nx;
            if (og + 1u == (tg + 1u) * nx) xb_add(&bar[XB_TOPGEN], 1u);
            else XB_SPIN(xb_ld(&bar[XB_TOPGEN]) == tg, bar);
            __builtin_amdgcn_fence(__ATOMIC_ACQUIRE, "agent");
            xb_add(&bar[XB_XGEN(b.x)], 1u);
            asm volatile("s_waitcnt vmcnt(0)" ::: "memory");
        } else {
            XB_SPIN(xb_ld(&bar[XB_XGEN(b.x)]) == gen, bar);
            __builtin_amdgcn_fence(__ATOMIC_ACQUIRE, "agent");
            asm volatile("s_waitcnt vmcnt(0)" ::: "memory");
        }
    }
    __syncthreads();
}


template <int ph>
__device__ __forceinline__ void run_phase(const Params& p, int bid, int nb, char* smem, bool rep = false) {
  const float* ng = p.norm_g;
  const bh* Rf = (const bh*)p.R;
  if (ph == 0) {
    for (int j = bid + (rep ? 768 : 0); j < 768 + 576 + 1024; j += nb) {
      if (j < 768) gemv_job(p, j, smem);
      else if (j < 1344) filter_job(p, j - 768, smem);
      else convert_tile(p.w_in_even, 1024, 4096, p.wt, j - 1344, smem);
    }
  } else if (ph == 1) {
    for (int j = bid; j < 1536; j += nb) rows_job(p, j, true, nullptr, nullptr, 0, 0, ng + 0 * 1024, 0, 0);
  } else if (ph == 2) {
    gemm_phase<2, 192, 3>(p.act, 1024, p.wt, 1024, p.R, 4096, 4096, 32, bid, nb, smem);
  } else if (ph == 3) {
    for (int j = bid + (rep ? 512 : 0); j < (rep ? 896 : 512 + 384 + 256 + 256); j += nb) {
      if (j < 512) hyena_sample_job(p, j, smem);
      else if (j < 896) scan2_unit<0>(p, j - 512, smem);
      else if (j < 1152) hyena_prompt_job(p, j - 896, smem);
      else convert_tile(p.w_out_even, 1024, 1024, p.wt, j - 1152, smem);
    }
  } else if (ph == 4) {
    for (int j = bid; j < 128 + 1024; j += nb) {
      if (j < 128) fixup_unit<0>(p, j, smem);
      else scan_final_job(p, j - 128, 0);
    }
  } else if (ph == 5) {
    for (int j = bid; j < 512; j += nb) scan_final_job(p, 1024 + j, 0);
  } else if (ph == 6) {
    gemm_phase<1, 192, 3>(p.act, 1024, p.wt, 1024, p.R, 1024, 1024, 8, bid, nb, smem);
  } else if (ph == 7) {
    for (int j = bid; j < 1536 + 1408 + 704; j += nb) {
      if (j < 1536) rows_job(p, j, true, Rf, ng + 1 * 1024, 0, 2, ng + 2 * 1024, 0, 3);
      else if (j < 2944) convert_tile(p.ffn_up, 1024, 5632, p.wt, j - 1536, smem, true);
      else convert_tile(p.ffn_down, 2816, 1024, p.wt2, j - 2944, smem);
    }
  } else if (ph == 8) {
    gemm_phase<3, 192, 3>(p.act, 1024, p.wt, 1024, p.R + OFF_ACTF, 2816, 5632, 44, bid, nb, smem, p.ffn_conv_w, p.ffn_conv_b);
  } else if (ph == 9) {
  } else if (ph == 10) {
    gemm_phase<1, 192, 3>((const bh*)(p.R + OFF_ACTF), 2816, p.wt2, 2816, p.R, 1024, 1024, 8, bid, nb, smem);
  } else if (ph == 11) {
    for (int j = bid; j < 1536 + 800; j += nb) {
      if (j < 1536) rows_job(p, j, false, Rf, ng + 3 * 1024, 0, 5, ng + 4 * 1024, 1, 0);
      else convert_tile(p.w_in_odd, 1024, 3104, p.wt, j - 1536, smem);
    }
  } else if (ph == 12) {
    gemm_phase<1, 128, 3>(p.act, 1024, p.wt, 1024, p.R, 3104, 3104, 25, bid, nb, smem);
  } else if (ph == 13) {
    for (int j = bid; j < (rep ? 384 : 384 + 800 + 3072 + 256 + 256); j += nb) {
      if (j < 384) scan2_unit<1>(p, j, smem);
      else if (j < 1184) vt_job(p, j - 384, smem);
      else if (j < 4256) oddrow_job(p, j - 1184);
      else if (j < 4512) ctxk_job(p, j - 4256);
      else convert_tile(p.w_out_odd, 1024, 1024, p.wt, j - 4512, smem);
    }
  } else if (ph == 14) {
    for (int j = bid; j < (rep ? 768 : 768 + 128 + 1024); j += nb) {
      if (j < 768) attn_unit(p, j, smem);
      else if (j < 896) fixup_unit<1>(p, j - 768, smem);
      else scan_final_job(p, j - 896, 1);
    }
  } else if (ph == 15) {
    for (int j = bid; j < 512; j += nb) scan_final_job(p, 1024 + j, 1);
  } else if (ph == 16) {
    gemm_phase<1, 192, 3>(p.act, 1024, p.wt, 1024, p.R, 1024, 1024, 8, bid, nb, smem);
  } else if (ph == 17) {
    for (int j = bid; j < 1536 + 1408 + 704; j += nb) {
      if (j < 1536) rows_job(p, j, false, Rf, ng + 5 * 1024, 1, 2, ng + 6 * 1024, 1, 3);
      else if (j < 2944) convert_tile(p.ffn_up + (size_t)1024 * 5632, 1024, 5632, p.wt, j - 1536, smem, true);
      else convert_tile(p.ffn_down + (size_t)2816 * 1024, 2816, 1024, p.wt2, j - 2944, smem);
    }
  } else if (ph == 18) {
    gemm_phase<3, 192, 3>(p.act, 1024, p.wt, 1024, p.R + OFF_ACTF, 2816, 5632, 44, bid, nb, smem, p.ffn_conv_w + 3 * 5632, p.ffn_conv_b + 5632);
  } else if (ph == 19) {
  } else if (ph == 20) {
    gemm_phase<1, 192, 3>((const bh*)(p.R + OFF_ACTF), 2816, p.wt2, 2816, p.R, 1024, 1024, 8, bid, nb, smem);
  } else if (ph == 21) {
    for (int j = bid; j < 1536; j += nb) rows_job(p, j, false, Rf, ng + 7 * 1024, 1, 5, nullptr, 0, 0);
  }
}

template <int PH>
__device__ __forceinline__ void phase_step(const Params& p, int ph0, int ph1, char* smem, cg::grid_group& grid, const XcdBarrier& xb) {
  if (PH == 9 || PH == 19) return;
  if (PH >= ph0 && PH < ph1) {
    if (PH == REP_PH) { run_phase<PH>(p, blockIdx.x, gridDim.x, smem, true); xcd_barrier(xb); }
    run_phase<PH>(p, blockIdx.x, gridDim.x, smem);
    if (PH + 1 < ph1) {
      xcd_barrier(xb);
    }
  }
}

__global__ void __launch_bounds__(256, 2) mega_kernel(Params p, int ph0, int ph1) {
  __shared__ __attribute__((aligned(16))) char smem[49152];
  cg::grid_group grid = cg::this_grid();
  __shared__ uint4 xb_words;
  if (threadIdx.x == 0) xb_words = make_uint4(0u, 0u, 0u, 0u);
  __syncthreads();
  XcdBarrier xb = xcd_barrier_post(p.bar, (volatile LAS unsigned*)&xb_words);
#ifdef EXTRA_SYNCS
  for (int i = 0; i < EXTRA_SYNCS; ++i) xcd_barrier(xb);
#endif
  phase_step<0>(p, ph0, ph1, smem, grid, xb);
  phase_step<1>(p, ph0, ph1, smem, grid, xb);
  phase_step<2>(p, ph0, ph1, smem, grid, xb);
  phase_step<3>(p, ph0, ph1, smem, grid, xb);
  phase_step<4>(p, ph0, ph1, smem, grid, xb);
  phase_step<5>(p, ph0, ph1, smem, grid, xb);
  phase_step<6>(p, ph0, ph1, smem, grid, xb);
  phase_step<7>(p, ph0, ph1, smem, grid, xb);
  phase_step<8>(p, ph0, ph1, smem, grid, xb);
  phase_step<9>(p, ph0, ph1, smem, grid, xb);
  phase_step<10>(p, ph0, ph1, smem, grid, xb);
  phase_step<11>(p, ph0, ph1, smem, grid, xb);
  phase_step<12>(p, ph0, ph1, smem, grid, xb);
  phase_step<13>(p, ph0, ph1, smem, grid, xb);
  phase_step<14>(p, ph0, ph1, smem, grid, xb);
  phase_step<15>(p, ph0, ph1, smem, grid, xb);
  phase_step<16>(p, ph0, ph1, smem, grid, xb);
  phase_step<17>(p, ph0, ph1, smem, grid, xb);
  phase_step<18>(p, ph0, ph1, smem, grid, xb);
  phase_step<19>(p, ph0, ph1, smem, grid, xb);
  phase_step<20>(p, ph0, ph1, smem, grid, xb);
  phase_step<21>(p, ph0, ph1, smem, grid, xb);
}

extern "C" void kernel_launch(void* const* d_in, const int* in_sizes, int n_in, void* d_out, int out_size, void* d_ws,
                              size_t ws_size, hipStream_t stream) {
  static int grid_blocks = 0;
  if (!grid_blocks) {
    int dev = 0, cus = 0, per_cu = 0;
    hipGetDevice(&dev);
    hipDeviceGetAttribute(&cus, hipDeviceAttributeMultiprocessorCount, dev);
    hipOccupancyMaxActiveBlocksPerMultiprocessor(&per_cu, mega_kernel, 256, 0);
    if (per_cu > 2) per_cu = 2;
    if (per_cu < 1) per_cu = 1;
    grid_blocks = cus * per_cu;
  }
  Params p{};
  const float** pf = (const float**)&p;
  for (int i = 0; i < 35; ++i) pf[i] = (const float*)d_in[i];
  p.out = (float*)d_out;
  char* ws = (char*)d_ws;
  size_t off = 0;
  p.act = (bh*)(ws + off); off += (size_t)NT * 1024 * 2;
  p.wt = (bh*)(ws + off); off += (size_t)5632 * 1024 * 2;
  p.wt2 = (bh*)(ws + off); off += (size_t)1024 * 2816 * 2;
  p.R = ws + off; off += R_BYTES;
  p.mod = (float*)(ws + off); off += (size_t)2 * 3 * 6144 * 4;
  p.bar = (unsigned*)(ws + off); off += (size_t)XCD_BAR_WORDS * 4;
  p.gt256 = (bh*)(ws + off); off += (size_t)2 * 512 * 512 * 2;
  p.gt2048 = (bh*)(ws + off); off += (size_t)2 * 512 * 4096 * 2;
  if (off > ws_size) { fprintf(stderr, "workspace too small: need %zu have %zu\n", off, ws_size); return; }
  hipMemsetAsync(p.mod, 0, (size_t)2 * 3 * 6144 * 4 + (size_t)XCD_BAR_WORDS * 4, stream);
#if MEGA
  int ph0 = 0, ph1 = NPHASE;
  void* args[] = {&p, &ph0, &ph1};
  hipError_t e = hipLaunchCooperativeKernel((void*)mega_kernel, dim3(grid_blocks), dim3(256), args, 0, stream);
  if (e != hipSuccess) fprintf(stderr, "cooperative launch failed: %s (grid %d)\n", hipGetErrorString(e), grid_blocks);
#else
  for (int ph = 0; ph < NPHASE; ++ph) {
    int ph0 = ph, ph1 = ph + 1;
    void* args[] = {&p, &ph0, &ph1};
    hipError_t e = hipLaunchCooperativeKernel((void*)mega_kernel, dim3(grid_blocks), dim3(256), args, 0, stream);
    if (e != hipSuccess) fprintf(stderr, "launch failed: %s\n", hipGetErrorString(e));
  }
#endif
}
```

```cpp
#include <hip/hip_runtime.h>
#include <hip/hip_cooperative_groups.h>
#include <stdint.h>
#include <cstdio>
namespace cg = cooperative_groups;

#ifndef MEGA
#define MEGA 1
#endif
#ifndef REP_PH
#define REP_PH -1
#endif

typedef unsigned short bh;
using bf16x8 = __attribute__((ext_vector_type(8))) short;
using f32x4 = __attribute__((ext_vector_type(4))) float;
using u32x4 = __attribute__((ext_vector_type(4))) unsigned int;

#define NT 12288
#define NTP 8192
#define EPSF 1e-6f
#define NPHASE 22

#define OUT_HGRN 12582912
#define OUT_CK 16777216
#define OUT_CV 20971520
#define OUT_GLA 25165824

#define OFF_ODIR 100663296ull
#define OFF_Z1 150994944ull
#define OFF_HYT 150994944ull
#define OFF_ACTF 138412032ull
#define OFF_Q 150994944ull
#define OFF_KB 163577856ull
#define OFF_VT 176685056ull
#define R_BYTES 207618048ull
#define KV_SAMPLE_BASE 4194304

struct Params {
  const float *x_prompt, *x_sample, *state_hgrn, *cache_k, *cache_v, *state_gla, *c, *c_ctx;
  const float *ada_w, *ada_b, *norm_g, *ffn_up, *ffn_conv_w, *ffn_conv_b, *ffn_down;
  const float *w_in_even, *w_out_even, *hgrn_lb, *hgrn_norm, *hy_conv_w, *hy_conv_b;
  const float *hy_w1, *hy_b1, *hy_w2, *hy_b2, *hy_w3, *hy_freq, *hy_d;
  const float *w_in_odd, *w_out_odd, *diff_lambda, *diff_norm, *gla_aw, *gla_ab, *gla_norm;
  float* out;
  bh* act;
  bh* wt;
  bh* wt2;
  char* R;
  float* mod;
  bh* gt256;
  bh* gt2048;
  unsigned* bar;
};

typedef __bf16 bf2_t __attribute__((ext_vector_type(2)));
typedef float f2_t __attribute__((ext_vector_type(2)));
typedef unsigned int u32x2 __attribute__((ext_vector_type(2)));
__device__ __forceinline__ unsigned pk2(float a, float b) {
  f2_t v = {a, b};
  return __builtin_bit_cast(unsigned, __builtin_convertvector(v, bf2_t));
}
__device__ __forceinline__ bh f2bf(float x) { return (bh)(pk2(x, x) & 0xffffu); }
__device__ __forceinline__ float bflo(unsigned w) { return __uint_as_float(w << 16); }
__device__ __forceinline__ float bfhi(unsigned w) { return __uint_as_float(w & 0xffff0000u); }
__device__ __forceinline__ float bf2f(bh h) { return __uint_as_float(((uint32_t)h) << 16); }
__device__ __forceinline__ float sigmoidf_(float x) { return __builtin_amdgcn_rcpf(1.f + __expf(-x)); }
__device__ __forceinline__ float siluf_(float x) { return x * __builtin_amdgcn_rcpf(1.f + __expf(-x)); }
template <int CTRL>
__device__ __forceinline__ float dppf0(float v) {
  return __int_as_float(__builtin_amdgcn_update_dpp(0, __float_as_int(v), CTRL, 0xF, 0xF, true));
}
__device__ __forceinline__ float wave_sum(float v) {
  v += dppf0<0xB1>(v); v += dppf0<0x4E>(v); v += dppf0<0x141>(v); v += dppf0<0x140>(v);
  v += __shfl_xor(v, 16);
  v += __shfl_xor(v, 32);
  return v;
}

template <int OUT_BF16, int BM, int DEPTH>
__device__ __forceinline__ void gemm_phase(const bh* __restrict__ A, int lda, const bh* __restrict__ Bt, int K, void* Cv, int ldc,
                           int N, int ntn, int bid, int nb, char* smem, const float* cw = nullptr, const float* cb = nullptr) {
  constexpr int MT = BM / 32;
  constexpr int NPA = BM / 32;
  bh* As = (bh*)smem;
  bh* Bs = As + BM * 64;
  int tid_l_ = threadIdx.x; asm volatile("" : "+v"(tid_l_)); const int tid = tid_l_, lane = tid & 63, w = tid >> 6, wr = w >> 1, wc = w & 1, r = lane & 15, g = lane >> 4;
  constexpr int MB = (NT / BM) / 8;
  const int xcd = bid & 7, nloc = nb >> 3;
  const int qend = OUT_BF16 == 3 ? MB * ntn + (ntn + 7) / 8 : MB * ntn;
  for (int q = bid >> 3; q < qend; q += nloc) {
    int mt = xcd * MB + (q % MB), nt = q / MB;
    if (OUT_BF16 == 3 && q >= MB * ntn) { mt = 64; nt = (q - MB * ntn) * 8 + xcd; if (nt >= ntn) continue; }
    const int trow0 = OUT_BF16 == 3 ? mt * 190 - 1 : mt * BM;
    const bh* Ag = A;
    const bh* Bg = Bt + (size_t)(nt * 128) * K;
    f32x4 acc[MT][4];
#pragma unroll
    for (int m = 0; m < MT; ++m)
#pragma unroll
      for (int n = 0; n < 4; ++n) acc[m][n] = (f32x4){0.f, 0.f, 0.f, 0.f};
    u32x4 pa0[NPA], pb0[4], pa1[NPA], pb1[4];
    auto gload = [&](u32x4* pa, u32x4* pb, int kofs) {
#pragma unroll
      for (int i = 0; i < NPA; ++i) {
        int pz = tid + i * 256, row = pz >> 3, cp = pz & 7;
        int tr = trow0 + row;
        if (OUT_BF16 == 3) tr = min(max(tr, 0), NT - 1);
        pa[i] = *(const u32x4*)(Ag + (size_t)tr * lda + kofs + cp * 8);
      }
#pragma unroll
      for (int i = 0; i < 4; ++i) {
        int pz = tid + i * 256, row = pz >> 3, cp = pz & 7;
        pb[i] = *(const u32x4*)(Bg + (size_t)row * K + kofs + cp * 8);
      }
    };
    auto kstep = [&](u32x4* pa, u32x4* pb, int knext) {
      __syncthreads();
#pragma unroll
      for (int i = 0; i < NPA; ++i) {
        int pz = tid + i * 256, row = pz >> 3, cp = pz & 7;
        *(u32x4*)(As + row * 64 + ((cp ^ ((row >> 1) & 7)) << 3)) = pa[i];
      }
#pragma unroll
      for (int i = 0; i < 4; ++i) {
        int pz = tid + i * 256, row = pz >> 3, cp = pz & 7;
        *(u32x4*)(Bs + row * 64 + ((cp ^ ((row >> 1) & 7)) << 3)) = pb[i];
      }
      __syncthreads();
      if (knext < K) gload(pa, pb, knext);
#pragma unroll
      for (int kk = 0; kk < 2; ++kk) {
        bf16x8 af[MT], bfr[4];
#pragma unroll
        for (int m = 0; m < MT; ++m) { const int row = wr * (BM / 2) + m * 16 + r; af[m] = *(const bf16x8*)(As + row * 64 + (((kk * 4 + g) ^ ((row >> 1) & 7)) << 3)); }
#pragma unroll
        for (int n = 0; n < 4; ++n) { const int row = wc * 64 + n * 16 + r; bfr[n] = *(const bf16x8*)(Bs + row * 64 + (((kk * 4 + g) ^ ((row >> 1) & 7)) << 3)); }
        __builtin_amdgcn_sched_barrier(0);
#pragma unroll
        for (int m = 0; m < MT; ++m)
#pragma unroll
          for (int n = 0; n < 4; ++n)
            acc[m][n] = (OUT_BF16 == 1 || OUT_BF16 == 3) ? __builtin_amdgcn_mfma_f32_16x16x32_bf16(bfr[n], af[m], acc[m][n], 0, 0, 0)
                                        : __builtin_amdgcn_mfma_f32_16x16x32_bf16(af[m], bfr[n], acc[m][n], 0, 0, 0);
        __builtin_amdgcn_sched_barrier(0);
      }
    };
    if (DEPTH == 3) {
      constexpr int NA3 = BM / 64;
      bh* As3 = (bh*)smem;
      bh* Bs3 = As3 + 2 * BM * 32;
      u32x4 ra0[NA3], rb0[2], ra1[NA3], rb1[2];
      auto ld3 = [&](u32x4* ra, u32x4* rb, int kofs) {
#pragma unroll
        for (int i = 0; i < NA3; ++i) {
          int pz = tid + i * 256, row = pz >> 2, c = pz & 3;
          int tr = trow0 + row;
          if (OUT_BF16 == 3) tr = min(max(tr, 0), NT - 1);
          ra[i] = *(const u32x4*)(Ag + (size_t)tr * lda + kofs + c * 8);
        }
#pragma unroll
        for (int i = 0; i < 2; ++i) {
          int pz = tid + i * 256, row = pz >> 2, c = pz & 3;
          rb[i] = *(const u32x4*)(Bg + (size_t)row * K + kofs + c * 8);
        }
      };
      auto st3 = [&](const u32x4* ra, const u32x4* rb, int stg) {
#pragma unroll
        for (int i = 0; i < NA3; ++i) {
          int pz = tid + i * 256, row = pz >> 2, c = pz & 3;
          *(u32x4*)(As3 + stg * BM * 32 + row * 32 + ((c ^ (((row >> 3) & 1) << 1)) << 3)) = ra[i];
        }
#pragma unroll
        for (int i = 0; i < 2; ++i) {
          int pz = tid + i * 256, row = pz >> 2, c = pz & 3;
          *(u32x4*)(Bs3 + stg * 128 * 32 + row * 32 + ((c ^ (((row >> 3) & 1) << 1)) << 3)) = rb[i];
        }
      };
      auto comp3 = [&](int cur) {
        bf16x8 af[MT], bfr[4];
#pragma unroll
        for (int m = 0; m < MT; ++m) {
          const int row = wr * (BM / 2) + m * 16 + r;
          af[m] = *(const bf16x8*)(As3 + cur * BM * 32 + row * 32 + ((g ^ (((row >> 3) & 1) << 1)) << 3));
        }
#pragma unroll
        for (int n = 0; n < 4; ++n) {
          const int row = wc * 64 + n * 16 + r;
          bfr[n] = *(const bf16x8*)(Bs3 + cur * 128 * 32 + row * 32 + ((g ^ (((row >> 3) & 1) << 1)) << 3));
        }
#pragma unroll
        for (int m = 0; m < MT; ++m)
#pragma unroll
          for (int n = 0; n < 4; ++n)
            acc[m][n] = (OUT_BF16 == 1 || OUT_BF16 == 3) ? __builtin_amdgcn_mfma_f32_16x16x32_bf16(bfr[n], af[m], acc[m][n], 0, 0, 0)
                                        : __builtin_amdgcn_mfma_f32_16x16x32_bf16(af[m], bfr[n], acc[m][n], 0, 0, 0);
      };
      const int nk = K >> 5;
      __syncthreads();
      ld3(ra0, rb0, 0);
      ld3(ra1, rb1, 32);
      st3(ra0, rb0, 0);
      ld3(ra0, rb0, 64);
      __syncthreads();
      for (int ks = 0; ks < nk; ks += 2) {
        comp3(0);
        st3(ra1, rb1, 1);
        if (ks + 3 < nk) ld3(ra1, rb1, (ks + 3) << 5);
        __syncthreads();
        comp3(1);
        if (ks + 2 < nk) st3(ra0, rb0, 0);
        if (ks + 4 < nk) ld3(ra0, rb0, (ks + 4) << 5);
        __syncthreads();
      }
    } else {
    gload(pa0, pb0, 0);
    if (DEPTH == 2) {
      gload(pa1, pb1, 64);
      for (int k0 = 0; k0 < K; k0 += 128) {
        kstep(pa0, pb0, k0 + 128);
        kstep(pa1, pb1, k0 + 192);
      }
    } else {
      for (int k0 = 0; k0 < K; k0 += 64) kstep(pa0, pb0, k0 + 64);
    }
    }
    if (OUT_BF16 == 1 || OUT_BF16 == 3) {
      __syncthreads();
      bh* Ct = (bh*)smem;
#pragma unroll
      for (int m = 0; m < MT; ++m)
#pragma unroll
        for (int n = 0; n < 4; ++n) {
          const int row = wr * (BM / 2) + m * 16 + r;
          const int sl = wc * 16 + n * 4 + g;
          u32x2 pv;
          pv[0] = pk2(acc[m][n][0], acc[m][n][1]);
          pv[1] = pk2(acc[m][n][2], acc[m][n][3]);
          *(u32x2*)(Ct + row * 128 + ((sl ^ ((row & 15) << 1)) << 2)) = pv;
        }
      __syncthreads();
      if (OUT_BF16 == 1) {
#pragma unroll 2
        for (int i = 0; i < BM / 16; ++i) {
          const int pz = tid + i * 256, row = pz >> 4, pc = pz & 15;
          const u32x4 v = *(const u32x4*)(Ct + row * 128 + ((pc ^ (row & 15)) << 3));
          const int col = nt * 128 + pc * 8;
          if (col < N) *(u32x4*)((bh*)Cv + ((size_t)mt * BM + row) * ldc + col) = v;
        }
      } else {
        const int c8 = tid & 7, rs = tid >> 3;
        const int ja = nt * 64 + c8 * 8;
        float wa[3][8], wg[3][8], ba[8], bg[8];
#pragma unroll
        for (int tp = 0; tp < 3; ++tp) {
          const float4 x0 = *(const float4*)(cw + tp * 5632 + ja), x1 = *(const float4*)(cw + tp * 5632 + ja + 4);
          const float4 y0 = *(const float4*)(cw + tp * 5632 + 2816 + ja), y1 = *(const float4*)(cw + tp * 5632 + 2816 + ja + 4);
          wa[tp][0] = x0.x; wa[tp][1] = x0.y; wa[tp][2] = x0.z; wa[tp][3] = x0.w; wa[tp][4] = x1.x; wa[tp][5] = x1.y; wa[tp][6] = x1.z; wa[tp][7] = x1.w;
          wg[tp][0] = y0.x; wg[tp][1] = y0.y; wg[tp][2] = y0.z; wg[tp][3] = y0.w; wg[tp][4] = y1.x; wg[tp][5] = y1.y; wg[tp][6] = y1.z; wg[tp][7] = y1.w;
        }
        {
          const float4 x0 = *(const float4*)(cb + ja), x1 = *(const float4*)(cb + ja + 4);
          const float4 y0 = *(const float4*)(cb + 2816 + ja), y1 = *(const float4*)(cb + 2816 + ja + 4);
          ba[0] = x0.x; ba[1] = x0.y; ba[2] = x0.z; ba[3] = x0.w; ba[4] = x1.x; ba[5] = x1.y; ba[6] = x1.z; ba[7] = x1.w;
          bg[0] = y0.x; bg[1] = y0.y; bg[2] = y0.z; bg[3] = y0.w; bg[4] = y1.x; bg[5] = y1.y; bg[6] = y1.z; bg[7] = y1.w;
        }
#pragma unroll 1
        for (int i = 0; i < 6; ++i) {
          const int rr = 1 + rs + 32 * i;
          const int t = trow0 + rr;
          if (rr <= 190 && t < NT) {
            const bool start = (t < NTP) ? ((t & 255) == 0) : ((t & 2047) == 0);
            const bool endd = (t < NTP) ? ((t & 255) == 255) : ((t & 2047) == 2047);
            u32x4 am = *(const u32x4*)(Ct + (rr - 1) * 128 + ((c8 ^ ((rr - 1) & 15)) << 3));
            u32x4 gm = *(const u32x4*)(Ct + (rr - 1) * 128 + (((8 + c8) ^ ((rr - 1) & 15)) << 3));
            const u32x4 a0 = *(const u32x4*)(Ct + rr * 128 + ((c8 ^ (rr & 15)) << 3));
            const u32x4 g0 = *(const u32x4*)(Ct + rr * 128 + (((8 + c8) ^ (rr & 15)) << 3));
            u32x4 ap = *(const u32x4*)(Ct + (rr + 1) * 128 + ((c8 ^ ((rr + 1) & 15)) << 3));
            u32x4 gp = *(const u32x4*)(Ct + (rr + 1) * 128 + (((8 + c8) ^ ((rr + 1) & 15)) << 3));
            if (start) { am = (u32x4){0, 0, 0, 0}; gm = (u32x4){0, 0, 0, 0}; }
            if (endd) { ap = (u32x4){0, 0, 0, 0}; gp = (u32x4){0, 0, 0, 0}; }
            u32x4 ov;
#pragma unroll
            for (int e2 = 0; e2 < 4; ++e2) {
              float res[2];
#pragma unroll
              for (int hl = 0; hl < 2; ++hl) {
                const int e = e2 * 2 + hl;
                const float av = wa[0][e] * (hl ? bfhi(am[e2]) : bflo(am[e2])) + wa[1][e] * (hl ? bfhi(a0[e2]) : bflo(a0[e2])) +
                                 wa[2][e] * (hl ? bfhi(ap[e2]) : bflo(ap[e2])) + ba[e];
                const float gv = wg[0][e] * (hl ? bfhi(gm[e2]) : bflo(gm[e2])) + wg[1][e] * (hl ? bfhi(g0[e2]) : bflo(g0[e2])) +
                                 wg[2][e] * (hl ? bfhi(gp[e2]) : bflo(gp[e2])) + bg[e];
                res[hl] = siluf_(gv) * av;
              }
              ov[e2] = pk2(res[0], res[1]);
            }
            *(u32x4*)((bh*)Cv + (size_t)t * 2816 + ja) = ov;
          }
        }
      }
    }
#pragma unroll
    for (int m = 0; m < MT; ++m)
#pragma unroll
      for (int n = 0; n < 4; ++n) {
        if (OUT_BF16 == 1 || OUT_BF16 == 3) continue;
        int col = nt * 128 + wc * 64 + n * 16 + r;
        const size_t rowb = (size_t)mt * BM + wr * (BM / 2) + m * 16 + g * 4;
        if (OUT_BF16 == 2 && nt >= 20) {
          bh* hyt = (bh*)((char*)Cv + OFF_HYT) + (size_t)(col - 2560) * NT + rowb;
          u32x2 pv;
          pv[0] = pk2(acc[m][n][0], acc[m][n][1]);
          pv[1] = pk2(acc[m][n][2], acc[m][n][3]);
          *(u32x2*)hyt = pv;
        } else if (col < N) {
#pragma unroll
          for (int j = 0; j < 4; ++j) {
            size_t row = rowb + j;
            if (OUT_BF16) ((bh*)Cv)[row * ldc + col] = f2bf(acc[m][n][j]);
            else ((float*)Cv)[row * ldc + col] = acc[m][n][j];
          }
        }
      }
  }
}

__device__ __forceinline__ void convert_tile(const float* __restrict__ W, int K, int N, bh* __restrict__ WT, int tile, char* smem, bool perm = false) {
  float* tl = (float*)smem;
  int tid_l_ = threadIdx.x; asm volatile("" : "+v"(tid_l_)); const int tid = tid_l_;
  const int ntk = K >> 6;
  const int kt = tile % ntk, ntile = tile / ntk;
  __syncthreads();
#pragma unroll
  for (int i = 0; i < 16; ++i) {
    int e = tid + i * 256, kk = e >> 6, nn = e & 63, n = ntile * 64 + nn;
    tl[kk * 65 + nn] = (n < N) ? W[(size_t)(kt * 64 + kk) * N + n] : 0.f;
  }
  __syncthreads();
#pragma unroll
  for (int i = 0; i < 16; ++i) {
    int e = tid + i * 256, nn = e >> 6, kk = e & 63;
    const int orow = perm ? (ntile % 44) * 128 + (ntile / 44) * 64 + nn : ntile * 64 + nn;
    WT[(size_t)orow * K + kt * 64 + kk] = f2bf(tl[kk * 65 + nn]);
  }
}

__device__ __forceinline__ void gemv_job(const Params& p, int job, char* smem) {
  float* sc = (float*)smem;
  float* rd = sc + 768;
  int tid_l_ = threadIdx.x; asm volatile("" : "+v"(tid_l_)); const int tid = tid_l_;
  const int iq = job & 3, jb = (job >> 2) % 96, l = (job >> 2) / 96;
  __syncthreads();
  for (int i = tid; i < 768; i += 256) {
    int r = i >> 8, idx = iq * 256 + (i & 255);
    float v = (r == 0) ? p.c_ctx[idx] : p.c[(r - 1) * 1024 + idx];
    sc[i] = siluf_(v);
  }
  __syncthreads();
  const int jl = tid & 63, ig = tid >> 6, j = jb * 64 + jl;
  const float* W = p.ada_w + (size_t)l * 1024 * 6144 + (size_t)(iq * 256 + ig * 64) * 6144 + j;
  float a0 = 0.f, a1 = 0.f, a2 = 0.f;
#pragma unroll 16
  for (int i = 0; i < 64; ++i) {
    float wv = W[(size_t)i * 6144];
    a0 += sc[ig * 64 + i] * wv;
    a1 += sc[256 + ig * 64 + i] * wv;
    a2 += sc[512 + ig * 64 + i] * wv;
  }
  rd[(ig * 3 + 0) * 64 + jl] = a0;
  rd[(ig * 3 + 1) * 64 + jl] = a1;
  rd[(ig * 3 + 2) * 64 + jl] = a2;
  __syncthreads();
  if (tid < 192) {
    int r = tid >> 6, jl2 = tid & 63, j2 = jb * 64 + jl2;
    float sacc = (iq == 0) ? p.ada_b[l * 6144 + j2] : 0.f;
    for (int q = 0; q < 4; ++q) sacc += rd[(q * 3 + r) * 64 + jl2];
    atomicAdd(p.mod + (size_t)(l * 3 + r) * 6144 + j2, sacc);
  }
}

__device__ __forceinline__ void filter_job(const Params& p, int job, char* smem) {
  float* sh2 = (float*)smem;
  int tid_l_ = threadIdx.x; asm volatile("" : "+v"(tid_l_)); const int tid = tid_l_, lane = tid & 63, w = tid >> 6;
  int L, pos0;
  bh* gt;
  if (job < 64) { L = 256; pos0 = job * 4; gt = p.gt256; }
  else { L = 2048; pos0 = (job - 64) * 4; gt = p.gt2048; }
  __syncthreads();
  {
    const int pos = pos0 + w;
    const float t = (float)pos / (float)(L - 1);
    const float wv = 2.0f * 3.14159265358979323846f * (float)pos / (float)L;
    float zv = 0.f;
    if (lane == 0) zv = t;
    else if (lane <= 16) { float fb = 1e-4f + (float)(lane - 1) * ((15.0f - 1e-4f) / 15.0f); zv = cosf(fb * wv); }
    else if (lane <= 32) { float fb = 1e-4f + (float)(lane - 17) * ((15.0f - 1e-4f) / 15.0f); zv = -sinf(fb * wv); }
    const float fr = p.hy_freq[lane];
    float a = p.hy_b1[lane];
    for (int i = 0; i < 33; ++i) a += __shfl(zv, i) * p.hy_w1[i * 64 + lane];
    const float h1 = sinf(fr * a);
    a = p.hy_b2[lane];
    for (int i = 0; i < 64; ++i) a += __shfl(h1, i) * p.hy_w2[i * 64 + lane];
    sh2[w * 64 + lane] = sinf(fr * a);
  }
  __syncthreads();
  float acc[8][4];
#pragma unroll
  for (int m = 0; m < 8; ++m)
#pragma unroll
    for (int pp = 0; pp < 4; ++pp) acc[m][pp] = 0.f;
#pragma unroll 8
  for (int i = 0; i < 64; ++i) {
    const float h0 = sh2[i], h1 = sh2[64 + i], h2 = sh2[128 + i], h3 = sh2[192 + i];
#pragma unroll
    for (int m = 0; m < 8; ++m) {
      const float wv = p.hy_w3[i * 2048 + tid + 256 * m];
      acc[m][0] += wv * h0; acc[m][1] += wv * h1; acc[m][2] += wv * h2; acc[m][3] += wv * h3;
    }
  }
  const float min_decay = logf(1e-2f) / 1.5f, max_decay = logf(1e-2f) / 0.3f;
#pragma unroll
  for (int m = 0; m < 8; ++m) {
    const int o = tid + 256 * m;
    const int ord = o >> 10, side = (o >> 9) & 1, c = o & 511;
    const float delta = fabsf(min_decay + (float)c * ((max_decay - min_decay) / 511.0f));
    bh* grow = gt + (size_t)(ord * 512 + c) * (2 * L);
#pragma unroll
    for (int pp = 0; pp < 4; ++pp) {
      const int pos = pos0 + pp;
      const float t = (float)pos / (float)(L - 1);
      const bh val = f2bf(acc[m][pp] * expf(-t * delta));
      if (side == 0) grow[L - 1 - pos] = val;
      else if (pos >= 1) grow[L - 1 + pos] = val;
    }
  }
}

__device__ __forceinline__ void rows_job(const Params& p, int job, bool first, const bh* src, const float* gres, int lgate, int gate_idx,
                         const float* gnext, int lnext, int shift_idx) {
  int tid_l_ = threadIdx.x; asm volatile("" : "+v"(tid_l_)); const int tid = tid_l_, lane = tid & 63, w = tid >> 6;
  const int rowb = job * 8 + w * 2;
  const int r = rowb < NTP ? 0 : 1 + ((rowb - NTP) >> 11);
  float4 y[2][4], m[2][4];
#pragma unroll
  for (int rr = 0; rr < 2; ++rr) {
    const int row = rowb + rr;
    const float* xin = first ? (row < NTP ? p.x_prompt + (size_t)row * 1024 : p.x_sample + (size_t)(row - NTP) * 1024)
                             : p.out + (size_t)row * 1024;
#pragma unroll
    for (int i = 0; i < 4; ++i) y[rr][i] = *(const float4*)(xin + i * 256 + lane * 4);
    if (src) {
#pragma unroll
      for (int i = 0; i < 4; ++i) { const u32x2 mv = *(const u32x2*)(src + (size_t)row * 1024 + i * 256 + lane * 4); m[rr][i] = make_float4(bflo(mv[0]), bfhi(mv[0]), bflo(mv[1]), bfhi(mv[1])); }
    }
  }
  if (src) {
    const float* gate = p.mod + (size_t)(lgate * 3 + r) * 6144 + gate_idx * 1024;
    float4 gg[4], gt[4];
#pragma unroll
    for (int i = 0; i < 4; ++i) {
      gg[i] = *(const float4*)(gres + i * 256 + lane * 4);
      gt[i] = *(const float4*)(gate + i * 256 + lane * 4);
    }
#pragma unroll
    for (int rr = 0; rr < 2; ++rr) {
      float ss = 0.f;
#pragma unroll
      for (int i = 0; i < 4; ++i)
        ss += m[rr][i].x * m[rr][i].x + m[rr][i].y * m[rr][i].y + m[rr][i].z * m[rr][i].z + m[rr][i].w * m[rr][i].w;
      ss = wave_sum(ss);
      const float rs = rsqrtf(ss * (1.f / 1024.f) + EPSF);
#pragma unroll
      for (int i = 0; i < 4; ++i) {
        y[rr][i].x += gt[i].x * (m[rr][i].x * rs * gg[i].x);
        y[rr][i].y += gt[i].y * (m[rr][i].y * rs * gg[i].y);
        y[rr][i].z += gt[i].z * (m[rr][i].z * rs * gg[i].z);
        y[rr][i].w += gt[i].w * (m[rr][i].w * rs * gg[i].w);
      }
    }
  }
  if (src) {
#pragma unroll
    for (int rr = 0; rr < 2; ++rr)
#pragma unroll
      for (int i = 0; i < 4; ++i) *(float4*)(p.out + (size_t)(rowb + rr) * 1024 + i * 256 + lane * 4) = y[rr][i];
  }
  if (gnext) {
    const float* sh = p.mod + (size_t)(lnext * 3 + r) * 6144 + shift_idx * 1024;
    const float* scl = sh + 1024;
    float4 gg[4], s4[4], c4[4];
#pragma unroll
    for (int i = 0; i < 4; ++i) {
      gg[i] = *(const float4*)(gnext + i * 256 + lane * 4);
      s4[i] = *(const float4*)(sh + i * 256 + lane * 4);
      c4[i] = *(const float4*)(scl + i * 256 + lane * 4);
    }
#pragma unroll
    for (int rr = 0; rr < 2; ++rr) {
      float ss = 0.f;
#pragma unroll
      for (int i = 0; i < 4; ++i)
        ss += y[rr][i].x * y[rr][i].x + y[rr][i].y * y[rr][i].y + y[rr][i].z * y[rr][i].z + y[rr][i].w * y[rr][i].w;
      ss = wave_sum(ss);
      const float rs = rsqrtf(ss * (1.f / 1024.f) + EPSF);
      bh* arow = p.act + (size_t)(rowb + rr) * 1024;
#pragma unroll
      for (int i = 0; i < 4; ++i) {
        ushort4 o;
        o.x = f2bf(y[rr][i].x * rs * gg[i].x * (1.f + c4[i].x) + s4[i].x);
        o.y = f2bf(y[rr][i].y * rs * gg[i].y * (1.f + c4[i].y) + s4[i].y);
        o.z = f2bf(y[rr][i].z * rs * gg[i].z * (1.f + c4[i].z) + s4[i].z);
        o.w = f2bf(y[rr][i].w * rs * gg[i].w * (1.f + c4[i].w) + s4[i].w);
        *(ushort4*)(arow + i * 256 + lane * 4) = o;
      }
    }
  }
}

template <int CTRL>
__device__ __forceinline__ float dppf(float v) {
  return __int_as_float(__builtin_amdgcn_update_dpp(0, __float_as_int(v), CTRL, 0xF, 0xF, true));
}
__device__ __forceinline__ float sum16(float v) {
  v += dppf<0xB1>(v); v += dppf<0x4E>(v); v += dppf<0x141>(v); v += dppf<0x140>(v);
  return v;
}
__device__ __forceinline__ float max16(float v) {
  v = fmaxf(v, dppf<0xB1>(v)); v = fmaxf(v, dppf<0x4E>(v)); v = fmaxf(v, dppf<0x141>(v)); v = fmaxf(v, dppf<0x140>(v));
  return v;
}

typedef short s16x4 __attribute__((ext_vector_type(4)));

#define OFF_SC_EVEN 188743680ull
#define OFF_SC_ODD 79691776ull
#define SC_SLOC 8388608ull
#define SC_DECT 16777216ull

template <int MODE, int SKIP = 0>
__device__ __forceinline__ void scan2_unit(const Params& p, int unit, char* smem) {
  constexpr int DK = MODE == 0 ? 128 : 64;
  constexpr int LD = MODE == 0 ? 4096 : 3104;
  constexpr int NQ = DK / 32;
  constexpr int NP = 256 / DK;
  constexpr int TPP = 16 / NP;
  constexpr int RS = DK + 8;
  constexpr int TPT = DK / 8;
  float* sq = (float*)smem;
  float* slf = sq + 16 * DK;
  float* skk = slf + 16 * DK;
  bh* QE = (bh*)(skk + 16 * DK);
  bh* KE = QE + 16 * RS;
  bh* KLT = KE + 16 * RS;
  bh* VT = KLT + DK * 24;
  float* dec = (float*)(VT + 128 * 24);
  float* sx = dec + DK;
  int tid_l_ = threadIdx.x; asm volatile("" : "+v"(tid_l_)); const int tid = tid_l_, lane = tid & 63, w = tid >> 6, r = lane & 15, g = lane >> 4;
  const int dir = unit & 1, h = (unit >> 1) & 3, ss = unit >> 3;
  const bool samp = ss >= 32;
  const int sb = (ss - 32) >> 3, seg = (ss - 32) & 7;
  const int rbase = samp ? (NTP + sb * 2048 + (dir ? 2047 - seg * 256 : seg * 256)) : (ss * 256 + (dir ? 255 : 0));
  const int sgn = dir ? -1 : 1;
  const bh* proj = (const bh*)p.R;
  char* scbase = p.R + (MODE == 0 ? OFF_SC_EVEN : OFF_SC_ODD);
  bh* QB = (bh*)scbase;
  float* odir = (float*)(p.R + OFF_ODIR) + (size_t)dir * NT * 512;
  __syncthreads();
  if (MODE == 0) {
    for (int k = tid; k < 128; k += 256) {
      int ci = dir * 512 + h * 128 + k;
      float x0 = p.hgrn_lb[ci], x1 = p.hgrn_lb[1024 + ci], x2 = p.hgrn_lb[2048 + ci];
      float mx = fmaxf(x0, fmaxf(x1, x2));
      float e0 = expf(x0 - mx), e1 = expf(x1 - mx), e2 = expf(x2 - mx);
      sx[k] = e0 / (e0 + e1 + e2);
    }
  } else {
    for (int i = tid; i < 1024; i += 256) {
      int rr = i >> 6, k = i & 63;
      sx[i] = p.gla_aw[(size_t)(dir * 16 + rr) * 256 + h * 64 + k];
    }
    if (tid < 64) sx[1024 + tid] = p.gla_ab[dir * 256 + h * 64 + tid];
  }
  f32x4 S[2 * NQ][2];
#pragma unroll
  for (int a = 0; a < 2 * NQ; ++a) { S[a][0] = (f32x4){0.f, 0.f, 0.f, 0.f}; S[a][1] = (f32x4){0.f, 0.f, 0.f, 0.f}; }
  constexpr int EPT = MODE == 0 ? 8 : 4;
  const int li = tid >> 4, lk8 = (tid & 15) * EPT;
  const int vi = tid >> 4, v8 = (tid & 15) * 8;
  const int pk = tid % DK, ppart = tid / DK;
  float basec = 0.f;
  u32x4 rq = {0, 0, 0, 0}, rf = {0, 0, 0, 0}, rv = {0, 0, 0, 0}, rd0 = {0, 0, 0, 0}, rd1 = {0, 0, 0, 0};
  auto issue = [&](int c) {
    {
      const bh* pr = proj + (size_t)(rbase + sgn * (c * 16 + li)) * LD;
      if (MODE == 0) {
        rq = *(const u32x4*)(pr + h * 128 + lk8);
        rf = *(const u32x4*)(pr + 512 + dir * 512 + h * 128 + lk8);
      } else {
        const u32x2 q2 = *(const u32x2*)(pr + 1536 + h * 64 + lk8);
        const u32x2 k2 = *(const u32x2*)(pr + 1792 + h * 64 + lk8);
        rq[0] = q2[0]; rq[1] = q2[1]; rf[0] = k2[0]; rf[1] = k2[1];
        rd0 = *(const u32x4*)(pr + 3072 + dir * 16);
        rd1 = *(const u32x4*)(pr + 3072 + dir * 16 + 8);
      }
    }
    {
      const bh* pr = proj + (size_t)(rbase + sgn * (c * 16 + vi)) * LD;
      rv = *(const u32x4*)(pr + (MODE == 0 ? 1536 : 2048) + h * 128 + v8);
    }
  };
  issue(0);
#pragma unroll 1
  for (int c = 0; c < 16; ++c) {
    __syncthreads();
    if (SKIP != 3) {
      float oq[EPT], ol[EPT], ok[EPT];
      if (MODE == 0) {
#pragma unroll
        for (int e = 0; e < EPT; ++e) {
          float q = (e & 1) ? bfhi(rq[e >> 1]) : bflo(rq[e >> 1]);
          float ff = (e & 1) ? bfhi(rf[e >> 1]) : bflo(rf[e >> 1]);
          float lb = sx[lk8 + e];
          float f = lb + (1.f - lb) * sigmoidf_(ff);
          oq[e] = siluf_(q) * 0.08838834764831845f;
          ol[e] = __logf(f);
          ok[e] = 1.f - f;
        }
      } else {
        float da[16];
#pragma unroll
        for (int rr = 0; rr < 16; ++rr) {
          unsigned wd = rr < 8 ? rd0[(rr & 7) >> 1] : rd1[(rr & 7) >> 1];
          da[rr] = (rr & 1) ? bfhi(wd) : bflo(wd);
        }
        float xx[4];
        {
          float4 b0_ = *(const float4*)(sx + 1024 + lk8);
          xx[0] = b0_.x; xx[1] = b0_.y; xx[2] = b0_.z; xx[3] = b0_.w;
        }
#pragma unroll
        for (int rr = 0; rr < 16; ++rr) {
          float4 a0_ = *(const float4*)(sx + rr * 64 + lk8);
          xx[0] += da[rr] * a0_.x; xx[1] += da[rr] * a0_.y; xx[2] += da[rr] * a0_.z; xx[3] += da[rr] * a0_.w;
        }
#pragma unroll
        for (int e = 0; e < 4; ++e) {
          float q = (e & 1) ? bfhi(rq[e >> 1]) : bflo(rq[e >> 1]);
          float kk = (e & 1) ? bfhi(rf[e >> 1]) : bflo(rf[e >> 1]);
          float x = xx[e];
          float ls = fminf(x, 0.f) - __logf(1.f + __expf(-fabsf(x)));
          oq[e] = q * 0.125f;
          ol[e] = ls * 0.0625f;
          ok[e] = kk;
        }
      }
      float* dq_ = sq + li * DK + lk8;
      float* dl_ = slf + li * DK + lk8;
      float* dk_ = skk + li * DK + lk8;
#pragma unroll
      for (int e4 = 0; e4 < EPT; e4 += 4) {
        *(float4*)(dq_ + e4) = make_float4(oq[e4], oq[e4 + 1], oq[e4 + 2], oq[e4 + 3]);
        *(float4*)(dl_ + e4) = make_float4(ol[e4], ol[e4 + 1], ol[e4 + 2], ol[e4 + 3]);
        *(float4*)(dk_ + e4) = make_float4(ok[e4], ok[e4 + 1], ok[e4 + 2], ok[e4 + 3]);
      }
    }
#pragma unroll
    for (int e = 0; e < 8; ++e) {
      unsigned wv = rv[e >> 1];
      VT[(v8 + e) * 24 + vi] = (bh)((e & 1) ? (wv >> 16) : (wv & 0xffffu));
    }
    __syncthreads();
    if (c + 1 < 16) issue(c + 1);
    {
      float total = 0.f, pre = 0.f;
#pragma unroll
      for (int i = 0; i < 16; ++i) {
        float l = slf[i * DK + pk];
        if (i < ppart * TPP) pre += l;
        total += l;
      }
      unsigned kw[TPP / 2];
#pragma unroll
      for (int ii = 0; ii < TPP; ii += 2) {
        float klv[2];
#pragma unroll
        for (int u = 0; u < 2; ++u) {
          const int i = ppart * TPP + ii + u;
          pre += slf[i * DK + pk];
          const float qv = sq[i * DK + pk], kv = skk[i * DK + pk];
          QE[i * RS + pk] = f2bf(qv * __expf(pre));
          KE[i * RS + pk] = f2bf(kv * __expf(-pre));
          klv[u] = kv * __expf(total - pre);
          if (samp) {
            const int row = rbase + sgn * (c * 16 + i);
            QB[((size_t)dir * 4096 + (row - NTP)) * (4 * DK) + h * DK + pk] = f2bf(qv * __expf(basec + pre));
          }
        }
        kw[ii >> 1] = pk2(klv[0], klv[1]);
      }
      if (TPP == 8) {
        u32x4 kv4 = {kw[0], kw[1], kw[(TPP / 2) > 2 ? 2 : 0], kw[(TPP / 2) > 3 ? 3 : 0]};
        *(u32x4*)(KLT + pk * 24 + ppart * 8) = kv4;
      } else {
        u32x2 kv2 = {kw[0], kw[1]};
        *(u32x2*)(KLT + pk * 24 + ppart * 4) = kv2;
      }
      if (ppart == 0) dec[pk] = __expf(total);
      basec += total;
    }
    __syncthreads();
    {
      bf16x8 qf[NQ], kf[NQ];
#pragma unroll
      for (int q = 0; q < NQ; ++q) {
        qf[q] = *(const bf16x8*)(QE + r * RS + q * 32 + g * 8);
        kf[q] = *(const bf16x8*)(KE + r * RS + q * 32 + g * 8);
      }
      f32x4 at = (f32x4){0.f, 0.f, 0.f, 0.f};
#pragma unroll
      for (int q = 0; q < NQ; ++q) at = __builtin_amdgcn_mfma_f32_16x16x32_bf16(kf[q], qf[q], at, 0, 0, 0);
      u32x2 paw;
      paw[0] = pk2((g * 4 + 0 <= r) ? at[0] : 0.f, (g * 4 + 1 <= r) ? at[1] : 0.f);
      paw[1] = pk2((g * 4 + 2 <= r) ? at[2] : 0.f, (g * 4 + 3 <= r) ? at[3] : 0.f);
      const s16x4 pa = __builtin_bit_cast(s16x4, paw);
      s16x4 vf[2];
      f32x4 o[2];
#pragma unroll
      for (int nt = 0; nt < 2; ++nt) {
        vf[nt] = *(const s16x4*)(VT + (w * 32 + nt * 16 + r) * 24 + g * 4);
        o[nt] = __builtin_amdgcn_mfma_f32_16x16x16bf16_1k(pa, vf[nt], (f32x4){0.f, 0.f, 0.f, 0.f}, 0, 0, 0);
      }
#pragma unroll
      for (int q = 0; q < NQ; ++q) {
#pragma unroll
        for (int half = 0; half < 2; ++half) {
          const s16x4 qa = half == 0 ? __builtin_shufflevector(qf[q], qf[q], 0, 1, 2, 3)
                                     : __builtin_shufflevector(qf[q], qf[q], 4, 5, 6, 7);
#pragma unroll
          for (int nt = 0; nt < 2; ++nt) {
            const f32x4 sv_ = S[2 * q + half][nt];
            u32x2 sw;
            sw[0] = pk2(sv_[0], sv_[1]);
            sw[1] = pk2(sv_[2], sv_[3]);
            o[nt] = __builtin_amdgcn_mfma_f32_16x16x16bf16_1k(qa, __builtin_bit_cast(s16x4, sw), o[nt], 0, 0, 0);
          }
        }
      }
#pragma unroll
      for (int nt = 0; nt < 2; ++nt)
#pragma unroll
        for (int j = 0; j < 4; ++j) {
          const int row = rbase + sgn * (c * 16 + g * 4 + j);
          odir[(size_t)row * 512 + h * 128 + w * 32 + nt * 16 + r] = o[nt][j];
        }
#pragma unroll
      for (int q = 0; q < NQ; ++q) {
#pragma unroll
        for (int half = 0; half < 2; ++half) {
          const float4 d4 = *(const float4*)(dec + q * 32 + g * 8 + half * 4);
          const int ka = q * 32 + (r >> 2) * 8 + half * 4 + (r & 3);
          const s16x4 ka4 = *(const s16x4*)(KLT + ka * 24 + g * 4);
#pragma unroll
          for (int nt = 0; nt < 2; ++nt) {
            f32x4 sv_ = S[2 * q + half][nt];
            sv_[0] *= d4.x; sv_[1] *= d4.y; sv_[2] *= d4.z; sv_[3] *= d4.w;
            S[2 * q + half][nt] = __builtin_amdgcn_mfma_f32_16x16x16bf16_1k(ka4, vf[nt], sv_, 0, 0, 0);
          }
        }
      }
    }
  }
  {
    float* so;
    if (!samp) so = p.out + (MODE == 0 ? OUT_HGRN : OUT_GLA) + ((size_t)(ss * 2 + dir) * 4 + h) * DK * 128;
    else {
      const int us = ((sb * 4 + h) * 2 + dir) * 8 + seg;
      so = (float*)(scbase + SC_SLOC) + (size_t)us * DK * 128;
      if (ppart == 0) ((float*)(scbase + SC_DECT))[us * DK + pk] = __expf(basec);
    }
#pragma unroll
    for (int q = 0; q < NQ; ++q)
#pragma unroll
      for (int half = 0; half < 2; ++half)
#pragma unroll
        for (int nt = 0; nt < 2; ++nt)
#pragma unroll
          for (int j = 0; j < 4; ++j)
            so[(size_t)(q * 32 + g * 8 + half * 4 + j) * 128 + w * 32 + nt * 16 + r] = S[2 * q + half][nt][j];
  }
}

template <int MODE>
__device__ __forceinline__ void fixup_unit(const Params& p, int unit, char* smem) {
  constexpr int DK = MODE == 0 ? 128 : 64;
  constexpr int NQ = DK / 32;
  constexpr int RS = DK + 8;
  bh* ST = (bh*)smem;
  int tid_l_ = threadIdx.x; asm volatile("" : "+v"(tid_l_)); const int tid = tid_l_, lane = tid & 63, w = tid >> 6, r = lane & 15, g = lane >> 4;
  const int seg = unit & 7, dir = (unit >> 3) & 1, h = (unit >> 4) & 3, sb = unit >> 6;
  const int unit0 = unit & ~7;
  char* scbase = p.R + (MODE == 0 ? OFF_SC_EVEN : OFF_SC_ODD);
  const bh* QB = (const bh*)scbase;
  const float* SLOC = (const float*)(scbase + SC_SLOC);
  const float* DECT = (const float*)(scbase + SC_DECT);
  const float* s0 = (MODE == 0 ? p.state_hgrn : p.state_gla) + ((size_t)(sb * 2 + dir) * 4 + h) * DK * 128;
  float* odir = (float*)(p.R + OFF_ODIR) + (size_t)dir * NT * 512;
  __syncthreads();
  for (int m = 0; m < DK * 128 / 256; ++m) {
    const int e = tid + 256 * m, k = e >> 7, v = e & 127;
    float cur = s0[e];
    for (int jj = 0; jj < seg; ++jj)
      cur = DECT[(unit0 + jj) * DK + k] * cur + SLOC[(size_t)(unit0 + jj) * DK * 128 + e];
    ST[v * RS + k] = f2bf(cur);
  }
  __syncthreads();
  const int rbase = NTP + sb * 2048 + (dir ? 2047 - seg * 256 : seg * 256);
  const int sgn = dir ? -1 : 1;
#pragma unroll 1
  for (int mt = 0; mt < 4; ++mt) {
    f32x4 acc[8];
#pragma unroll
    for (int nt = 0; nt < 8; ++nt) acc[nt] = (f32x4){0.f, 0.f, 0.f, 0.f};
    const int rowa = rbase + sgn * (w * 64 + mt * 16 + r);
    const bh* qrow = QB + ((size_t)dir * 4096 + (rowa - NTP)) * (4 * DK) + h * DK + g * 8;
#pragma unroll
    for (int q = 0; q < NQ; ++q) {
      const bf16x8 a = *(const bf16x8*)(qrow + q * 32);
#pragma unroll
      for (int nt = 0; nt < 8; ++nt) {
        const bf16x8 b = *(const bf16x8*)(ST + (nt * 16 + r) * RS + q * 32 + g * 8);
        acc[nt] = __builtin_amdgcn_mfma_f32_16x16x32_bf16(a, b, acc[nt], 0, 0, 0);
      }
    }
#pragma unroll
    for (int nt = 0; nt < 8; ++nt)
#pragma unroll
      for (int j = 0; j < 4; ++j) {
        const int row = rbase + sgn * (w * 64 + mt * 16 + g * 4 + j);
        float* dst = odir + (size_t)row * 512 + h * 128 + nt * 16 + r;
        *dst += acc[nt][j];
      }
  }
}

__device__ __forceinline__ void scan_final_job(const Params& p, int job, int mode) {
  int tid_l_ = threadIdx.x; asm volatile("" : "+v"(tid_l_)); const int tid = tid_l_, lane = tid & 63, w = tid >> 6;
  const int rowb = job * 8 + w * 2;
  const int ld = mode == 0 ? 4096 : 3104;
  const int gcol = mode == 0 ? 2048 : 2560;
  const float* nrm = mode == 0 ? p.hgrn_norm : p.gla_norm;
  float2 a[2][4], b[2][4];
  unsigned gw[2][4];
#pragma unroll
  for (int rr = 0; rr < 2; ++rr) {
    const int row = rowb + rr;
    const float* o0 = (const float*)(p.R + OFF_ODIR) + (size_t)row * 512;
    const float* o1 = o0 + (size_t)NT * 512;
    const bh* proj = (const bh*)p.R + (size_t)row * ld;
#pragma unroll
    for (int h = 0; h < 4; ++h) {
      const int c = h * 128 + lane * 2;
      a[rr][h] = *(const float2*)(o0 + c);
      b[rr][h] = *(const float2*)(o1 + c);
      gw[rr][h] = *(const unsigned*)(proj + gcol + c);
    }
  }
  float2 nv[4];
#pragma unroll
  for (int h = 0; h < 4; ++h) nv[h] = *(const float2*)(nrm + h * 128 + lane * 2);
#pragma unroll
  for (int rr = 0; rr < 2; ++rr) {
    bh* arow = p.act + (size_t)(rowb + rr) * 1024 + (mode == 0 ? 0 : 512);
#pragma unroll
    for (int h = 0; h < 4; ++h) {
      const int c = h * 128 + lane * 2;
      float v0 = a[rr][h].x + b[rr][h].x, v1 = a[rr][h].y + b[rr][h].y;
      float ss = wave_sum(v0 * v0 + v1 * v1);
      float rs = rsqrtf(ss * (1.f / 128.f) + EPSF);
      float g0 = bflo(gw[rr][h]), g1 = bfhi(gw[rr][h]);
      *(unsigned*)(arow + c) = pk2(v0 * rs * nv[h].x * siluf_(g0), v1 * rs * nv[h].y * siluf_(g1));
    }
  }
}

using f32x16 = __attribute__((ext_vector_type(16))) float;
__device__ __forceinline__ bf16x8 toep_frag(const unsigned* Gd, int m0) {
  const int q = m0 >> 1;
  const unsigned sh = (unsigned)(m0 & 1) * 2u;
  const unsigned D0 = Gd[q], D1 = Gd[q + 1], D2 = Gd[q + 2], D3 = Gd[q + 3], D4 = Gd[q + 4];
  u32x4 f;
  f[0] = __builtin_amdgcn_alignbyte(D1, D0, sh);
  f[1] = __builtin_amdgcn_alignbyte(D2, D1, sh);
  f[2] = __builtin_amdgcn_alignbyte(D3, D2, sh);
  f[3] = __builtin_amdgcn_alignbyte(D4, D3, sh);
  return __builtin_bit_cast(bf16x8, f);
}
__device__ __forceinline__ void conv4(const bh* raw, int t, int L, float w0, float w1, float w2, float bb, float* out) {
  const u32x2 x = *(const u32x2*)(raw + t);
  const float xm = t > 0 ? bf2f(raw[t - 1]) : 0.f;
  const float xp = (t + 4 < L) ? bf2f(raw[t + 4]) : 0.f;
  const float x0 = bflo(x[0]), x1 = bfhi(x[0]), x2 = bflo(x[1]), x3 = bfhi(x[1]);
  out[0] = w0 * xm + w1 * x0 + w2 * x1 + bb;
  out[1] = w0 * x0 + w1 * x1 + w2 * x2 + bb;
  out[2] = w0 * x1 + w1 * x2 + w2 * x3 + bb;
  out[3] = w0 * x2 + w1 * x3 + w2 * xp + bb;
}
__device__ __forceinline__ u32x4 conv8(const bh* raw, int t, int L, float w0, float w1, float w2, float bb) {
  const u32x4 x = *(const u32x4*)(raw + t);
  float v[10];
  v[0] = t > 0 ? bf2f(raw[t - 1]) : 0.f;
  v[9] = (t + 8 < L) ? bf2f(raw[t + 8]) : 0.f;
#pragma unroll
  for (int e = 0; e < 4; ++e) { v[1 + 2 * e] = bflo(x[e]); v[2 + 2 * e] = bfhi(x[e]); }
  u32x4 o;
#pragma unroll
  for (int e = 0; e < 4; ++e)
    o[e] = pk2(w0 * v[2 * e] + w1 * v[2 * e + 1] + w2 * v[2 * e + 2] + bb, w0 * v[2 * e + 1] + w1 * v[2 * e + 2] + w2 * v[2 * e + 3] + bb);
  return o;
}

__device__ __forceinline__ void hyena_sample_job(const Params& p, int job, char* smem) {
  int tid_l_ = threadIdx.x; asm volatile("" : "+v"(tid_l_)); const int tid = tid_l_, lane = tid & 63, w = tid >> 6;
  const int col = lane & 31, kh = lane >> 5;
  const int cc = w >> 1, nh = w & 1;
  const int sb = job & 1, c0 = (job >> 1) * 2, c = c0 + cc;
  bh* G = (bh*)(smem + cc * 12288);
  bh* U = G + 4096;
  const unsigned* Gd = (const unsigned*)G;
  const bh* HYT = (const bh*)(p.R + OFF_HYT);
  const int rowoff = NTP + sb * 2048;
  __syncthreads();
  {
    const float vw0 = p.hy_conv_w[c], vw1 = p.hy_conv_w[1536 + c], vw2 = p.hy_conv_w[3072 + c], vb = p.hy_conv_b[c];
    const bh* raw = HYT + (size_t)c * NT + rowoff;
#pragma unroll
    for (int i = 0; i < 2; ++i) {
      const int t0 = (nh * 128 + lane + 64 * i) * 8;
      *(u32x4*)(U + t0) = conv8(raw, t0, 2048, vw0, vw1, vw2, vb);
    }
  }
#pragma unroll 1
  for (int ord = 0; ord < 2; ++ord) {
    {
      const bh* gsrc = p.gt2048 + (size_t)(ord * 512 + c) * 4096;
#pragma unroll
      for (int i = 0; i < 4; ++i) {
        const int e8 = (nh * 256 + lane + 64 * i) * 8;
        *(u32x4*)(G + e8) = *(const u32x4*)(gsrc + e8);
      }
    }
    __syncthreads();
    f32x16 acc;
#pragma unroll
    for (int i = 0; i < 16; ++i) acc[i] = 0.f;
    const int mbase = 2047 - col + kh * 8;
    const int dlo = nh == 0 ? -63 : -31, dhi = nh == 0 ? 31 : 63;
#pragma unroll 2
    for (int d = dlo; d <= dhi; ++d) {
      const bf16x8 a0 = toep_frag(Gd, mbase - d * 32);
      const bf16x8 a1 = toep_frag(Gd, mbase - d * 32 + 16);
      const int s1 = nh * 32 + col - d;
      const bool ok = (unsigned)s1 < 64u;
      const int s1c = ok ? s1 : 0;
      u32x4 b0 = *(const u32x4*)(U + s1c * 32 + kh * 8);
      u32x4 b1 = *(const u32x4*)(U + s1c * 32 + 16 + kh * 8);
      if (!ok) { b0 = (u32x4){0, 0, 0, 0}; b1 = (u32x4){0, 0, 0, 0}; }
      acc = __builtin_amdgcn_mfma_f32_32x32x16_bf16(a0, __builtin_bit_cast(bf16x8, b0), acc, 0, 0, 0);
      acc = __builtin_amdgcn_mfma_f32_32x32x16_bf16(a1, __builtin_bit_cast(bf16x8, b1), acc, 0, 0, 0);
    }
    __syncthreads();
    const int gi = (ord + 1) * 512 + c;
    const float gw0 = p.hy_conv_w[gi], gw1 = p.hy_conv_w[1536 + gi], gw2 = p.hy_conv_w[3072 + gi], gb = p.hy_conv_b[gi];
    const float dd = p.hy_d[ord * 512 + c];
    const bh* graw = HYT + (size_t)gi * NT + rowoff;
#pragma unroll
    for (int rq = 0; rq < 4; ++rq) {
      const int trun = (nh * 32 + col) * 32 + 8 * rq + 4 * kh;
      float gte[4];
      conv4(graw, trun, 2048, gw0, gw1, gw2, gb, gte);
      const u32x2 uo = *(const u32x2*)(U + trun);
      u32x2 zo;
      zo[0] = pk2(gte[0] * (acc[rq * 4 + 0] + bflo(uo[0]) * dd), gte[1] * (acc[rq * 4 + 1] + bfhi(uo[0]) * dd));
      zo[1] = pk2(gte[2] * (acc[rq * 4 + 2] + bflo(uo[1]) * dd), gte[3] * (acc[rq * 4 + 3] + bfhi(uo[1]) * dd));
      *(u32x2*)(U + trun) = zo;
    }
    __syncthreads();
  }
#pragma unroll
  for (int rr = 0; rr < 8; ++rr) {
    const int t = tid + 256 * rr;
    const unsigned z0 = *(const bh*)(smem + 8192 + t * 2);
    const unsigned z1 = *(const bh*)(smem + 12288 + 8192 + t * 2);
    *(unsigned*)(p.act + (size_t)(rowoff + t) * 1024 + 512 + c0) = z0 | (z1 << 16);
  }
}

__device__ __forceinline__ void hyena_prompt_job(const Params& p, int job, char* smem) {
  int tid_l_ = threadIdx.x; asm volatile("" : "+v"(tid_l_)); const int tid = tid_l_, lane = tid & 63, w = tid >> 6;
  const int col = lane & 31, kh = lane >> 5;
  const int cc = w >> 1, th = w & 1;
  const int c0 = job * 2, c = c0 + cc;
  bh* Uall = (bh*)smem;
  bh* Gall = (bh*)(smem + 2 * 32 * 264 * 2);
  bh* U = Uall + cc * 32 * 264;
  const unsigned* Gd = (const unsigned*)(Gall + cc * 512);
  const bh* HYT = (const bh*)(p.R + OFF_HYT);
  __syncthreads();
#pragma unroll 1
  for (int c2 = 0; c2 < 2; ++c2) {
    const int ch = c0 + c2;
    const float vw0 = p.hy_conv_w[ch], vw1 = p.hy_conv_w[1536 + ch], vw2 = p.hy_conv_w[3072 + ch], vb = p.hy_conv_b[ch];
#pragma unroll
    for (int i = 0; i < 4; ++i) {
      const int tg = (tid + 256 * i) * 8, b = tg >> 8, t = tg & 255;
      *(u32x4*)(Uall + c2 * 32 * 264 + b * 264 + t) = conv8(HYT + (size_t)ch * NT + b * 256, t, 256, vw0, vw1, vw2, vb);
    }
  }
#pragma unroll 1
  for (int ord = 0; ord < 2; ++ord) {
    if (tid < 128) {
      const int c2 = tid >> 6, l2 = tid & 63;
      *(u32x4*)(Gall + c2 * 512 + l2 * 8) = *(const u32x4*)(p.gt256 + (size_t)(ord * 512 + c0 + c2) * 512 + l2 * 8);
    }
    __syncthreads();
    f32x16 acc[4];
#pragma unroll
    for (int q = 0; q < 4; ++q)
#pragma unroll
      for (int i = 0; i < 16; ++i) acc[q][i] = 0.f;
    const int mbase = 255 - col + kh * 8;
#pragma unroll
    for (int q = 0; q < 4; ++q) {
      const int t1 = th * 4 + q;
#pragma unroll 2
      for (int s1 = 0; s1 < 8; ++s1) {
        const int d = t1 - s1;
        const bf16x8 a0 = toep_frag(Gd, mbase - d * 32);
        const bf16x8 a1 = toep_frag(Gd, mbase - d * 32 + 16);
        const bf16x8 b0 = *(const bf16x8*)(U + col * 264 + s1 * 32 + kh * 8);
        const bf16x8 b1 = *(const bf16x8*)(U + col * 264 + s1 * 32 + 16 + kh * 8);
        acc[q] = __builtin_amdgcn_mfma_f32_32x32x16_bf16(a0, b0, acc[q], 0, 0, 0);
        acc[q] = __builtin_amdgcn_mfma_f32_32x32x16_bf16(a1, b1, acc[q], 0, 0, 0);
      }
    }
    __syncthreads();
    const int gi = (ord + 1) * 512 + c;
    const float gw0 = p.hy_conv_w[gi], gw1 = p.hy_conv_w[1536 + gi], gw2 = p.hy_conv_w[3072 + gi], gb = p.hy_conv_b[gi];
    const float dd = p.hy_d[ord * 512 + c];
    const bh* graw = HYT + (size_t)gi * NT + col * 256;
#pragma unroll
    for (int q = 0; q < 4; ++q)
#pragma unroll
      for (int rq = 0; rq < 4; ++rq) {
        const int trun = (th * 4 + q) * 32 + 8 * rq + 4 * kh;
        float gte[4];
        conv4(graw, trun, 256, gw0, gw1, gw2, gb, gte);
        bh* up = U + col * 264 + trun;
        const u32x2 uo = *(const u32x2*)up;
        u32x2 zo;
        zo[0] = pk2(gte[0] * (acc[q][rq * 4 + 0] + bflo(uo[0]) * dd), gte[1] * (acc[q][rq * 4 + 1] + bfhi(uo[0]) * dd));
        zo[1] = pk2(gte[2] * (acc[q][rq * 4 + 2] + bflo(uo[1]) * dd), gte[3] * (acc[q][rq * 4 + 3] + bfhi(uo[1]) * dd));
        *(u32x2*)up = zo;
      }
    __syncthreads();
  }
#pragma unroll 4
  for (int i = 0; i < 32; ++i) {
    const int e = tid + 256 * i, b = e >> 8, t = e & 255;
    const unsigned z0 = Uall[b * 264 + t], z1 = Uall[32 * 264 + b * 264 + t];
    *(unsigned*)(p.act + (size_t)e * 1024 + 512 + c0) = z0 | (z1 << 16);
  }
}

__device__ __forceinline__ void oddrow_job(const Params& p, int job) {
  int tid_l_ = threadIdx.x; asm volatile("" : "+v"(tid_l_)); const int tid = tid_l_, lane = tid & 63, w = tid >> 6;
  const int row = job * 4 + w;
  const bh* pr = (const bh*)p.R + (size_t)row * 3104;
  bh* Q = (bh*)(p.R + OFF_Q) + (size_t)row * 512;
  bh* KB = (bh*)(p.R + OFF_KB);
  if (row < NTP) {
    const int b = row >> 8, t = row & 255;
    const int e0 = lane * 8, h = e0 >> 7, x = e0 & 127;
    const u32x4 qv = *(const u32x4*)(pr + e0);
    const u32x4 kv = *(const u32x4*)(pr + 512 + e0);
    const u32x4 vv = *(const u32x4*)(pr + 1024 + e0);
    const size_t idx = ((size_t)(b * 4 + h) * 256 + t) * 128 + x;
    *(u32x4*)(Q + e0) = qv;
    *(u32x4*)(KB + idx) = kv;
    float4 k0 = make_float4(bflo(kv[0]), bfhi(kv[0]), bflo(kv[1]), bfhi(kv[1]));
    float4 k1 = make_float4(bflo(kv[2]), bfhi(kv[2]), bflo(kv[3]), bfhi(kv[3]));
    float4 v0 = make_float4(bflo(vv[0]), bfhi(vv[0]), bflo(vv[1]), bfhi(vv[1]));
    float4 v1 = make_float4(bflo(vv[2]), bfhi(vv[2]), bflo(vv[3]), bfhi(vv[3]));
    *(float4*)(p.out + OUT_CK + idx) = k0;
    *(float4*)(p.out + OUT_CK + idx + 4) = k1;
    *(float4*)(p.out + OUT_CV + idx) = v0;
    *(float4*)(p.out + OUT_CV + idx + 4) = v1;
  } else {
    const int sb = (row - NTP) >> 11, t = (row - NTP) & 2047;
    const int rpos = t >> 6, cpos = t & 63;
    float q1[4], q2[4], k1[4], k2[4];
#pragma unroll
    for (int m = 0; m < 4; ++m) {
      int pi = lane + 64 * m;
      int h = pi >> 6, rem = pi & 63, pp = rem >> 5, part = (rem >> 4) & 1, i = rem & 15;
      int d1 = h * 128 + pp * 64 + part * 32 + i, d2 = d1 + 16;
      q1[m] = bf2f(pr[d1]); q2[m] = bf2f(pr[d2]);
      k1[m] = bf2f(pr[512 + d1]); k2[m] = bf2f(pr[512 + d2]);
    }
#pragma unroll
    for (int m = 0; m < 4; ++m) {
      int pi = lane + 64 * m;
      int h = pi >> 6, rem = pi & 63, pp = rem >> 5, part = (rem >> 4) & 1, i = rem & 15;
      int d1 = h * 128 + pp * 64 + part * 32 + i, d2 = d1 + 16;
      float pos = (float)(part ? cpos : rpos);
      float inv = expf(-(float)i * (9.210340371976184f / 16.f));
      float ang = pos * inv;
      float cs = cosf(ang), sn = sinf(ang);
      Q[d1] = f2bf(q1[m] * cs - q2[m] * sn);
      Q[d2] = f2bf(q1[m] * sn + q2[m] * cs);
      size_t kb = KV_SAMPLE_BASE + ((size_t)(sb * 4 + h) * 2304 + 256 + t) * 128;
      KB[kb + (d1 - h * 128)] = f2bf(k1[m] * cs - k2[m] * sn);
      KB[kb + (d2 - h * 128)] = f2bf(k1[m] * sn + k2[m] * cs);
    }
  }
}
__device__ __forceinline__ void ctxk_job(const Params& p, int job) {
  bh* KB = (bh*)(p.R + OFF_KB);
  int tidl = threadIdx.x; asm volatile("" : "+v"(tidl));
#pragma unroll
  for (int i = 0; i < 4; ++i) {
    int e = job * 1024 + i * 256 + tidl;
    int x = e & 127, j = (e >> 7) & 255, hh = (e >> 15) & 3, sb = e >> 17;
    KB[KV_SAMPLE_BASE + ((size_t)(sb * 4 + hh) * 2304 + j) * 128 + x] = f2bf(p.cache_k[e]);
  }
}
__device__ __forceinline__ void vt_job(const Params& p, int job, char* smem) {
  bh* tl = (bh*)smem;
  int tid_l_ = threadIdx.x; asm volatile("" : "+v"(tid_l_)); const int tid = tid_l_;
  int seq, h, kt, Lk;
  if (job < 288) { seq = 32 + job / 144; int r = job % 144; h = r / 36; kt = r % 36; Lk = 2304; }
  else { int j = job - 288; seq = j >> 4; h = (j >> 2) & 3; kt = j & 3; Lk = 256; }
  const bh* proj = (const bh*)p.R;
  __syncthreads();
#pragma unroll 16
  for (int i = 0; i < 32; ++i) {
    int e = tid + i * 256, key = e >> 7, dv = e & 127;
    bh val;
    if (seq < 32) val = proj[(size_t)(seq * 256 + kt * 64 + key) * 3104 + 1024 + h * 128 + dv];
    else if (kt < 4) val = f2bf(p.cache_v[((size_t)((seq - 32) * 4 + h) * 256 + kt * 64 + key) * 128 + dv]);
    else val = proj[(size_t)(NTP + (seq - 32) * 2048 + (kt - 4) * 64 + key) * 3104 + 1024 + h * 128 + dv];
    tl[key * 130 + dv] = val;
  }
  __syncthreads();
  bh* VT = (bh*)(p.R + OFF_VT) + (seq < 32 ? (size_t)(seq * 4 + h) * 128 * 256
                                            : (size_t)KV_SAMPLE_BASE + (size_t)((seq - 32) * 4 + h) * 128 * 2304);
#pragma unroll 4
  for (int i = 0; i < 32; ++i) {
    int e = tid + i * 256, dv = e >> 6, key = e & 63;
    VT[(size_t)dv * Lk + kt * 64 + key] = tl[key * 130 + dv];
  }
}

__device__ __forceinline__ void attn_unit(const Params& p, int unit, char* smem) {
  bh* Pl = (bh*)smem;
  float* sred = (float*)(smem + 10240);
  int tid_l_ = threadIdx.x; asm volatile("" : "+v"(tid_l_)); const int tid = tid_l_, lane = tid & 63, w = tid >> 6, r = lane & 15, g = lane >> 4;
  int seq, h, qb, Lk;
  if (unit < 256) { seq = 32 + (unit >> 7); h = (unit >> 5) & 3; qb = unit & 31; Lk = 2304; }
  else { int u = unit - 256; seq = u >> 4; h = (u >> 2) & 3; qb = u & 3; Lk = 256; }
  const int row0 = seq < 32 ? seq * 256 : NTP + (seq - 32) * 2048;
  const bh* Q = (const bh*)(p.R + OFF_Q);
  const bh* KB = (const bh*)(p.R + OFF_KB) + (seq < 32 ? (size_t)(seq * 4 + h) * 256 * 128
                                                       : (size_t)KV_SAMPLE_BASE + (size_t)((seq - 32) * 4 + h) * 2304 * 128);
  const bh* VT = (const bh*)(p.R + OFF_VT) + (seq < 32 ? (size_t)(seq * 4 + h) * 128 * 256
                                                       : (size_t)KV_SAMPLE_BASE + (size_t)((seq - 32) * 4 + h) * 128 * 2304);
  __syncthreads();
  if (tid < 64) {
    float a = p.diff_lambda[tid] * p.diff_lambda[64 + tid];
    float b = p.diff_lambda[128 + tid] * p.diff_lambda[192 + tid];
    a = wave_sum(a); b = wave_sum(b);
    if (tid == 0) sred[0] = expf(a) - expf(b);
  }
  __syncthreads();
  const float lam_init = 0.8f - 0.6f * expf(-0.3f * 1.0f);
  const float lam = sred[0] + lam_init;
  const int qrow = row0 + qb * 64 + w * 16;
  bf16x8 aq[2][2];
#pragma unroll
  for (int pp = 0; pp < 2; ++pp)
#pragma unroll
    for (int kk = 0; kk < 2; ++kk)
      aq[pp][kk] = *(const bf16x8*)(Q + (size_t)(qrow + r) * 512 + h * 128 + pp * 64 + kk * 32 + g * 8);
  float mrun[2][4], lrun[2][4];
  f32x4 O[2][8];
#pragma unroll
  for (int pp = 0; pp < 2; ++pp) {
#pragma unroll
    for (int j = 0; j < 4; ++j) { mrun[pp][j] = -1e30f; lrun[pp][j] = 0.f; }
#pragma unroll
    for (int n = 0; n < 8; ++n) O[pp][n] = (f32x4){0.f, 0.f, 0.f, 0.f};
  }
  bh* Pw = Pl + w * (2 * 16 * 40);
  const float scale = 0.125f;
  bh* Ks = (bh*)(smem + 10752);
  bh* Vs = Ks + 64 * 128;
  u32x4 pk_[4], pv_[4];
  auto tload = [&](int kt) {
#pragma unroll
    for (int i = 0; i < 4; ++i) {
      const int pz = tid + 256 * i;
      pk_[i] = *(const u32x4*)(KB + (size_t)(kt + (pz >> 4)) * 128 + (pz & 15) * 8);
      pv_[i] = *(const u32x4*)(VT + (size_t)(pz >> 3) * Lk + kt + (pz & 7) * 8);
    }
  };
  tload(0);
#pragma unroll 1
  for (int kt = 0; kt < Lk; kt += 64) {
    __syncthreads();
#pragma unroll
    for (int i = 0; i < 4; ++i) {
      const int pz = tid + 256 * i;
      const int key = pz >> 4, ck = pz & 15, dv = pz >> 3, cv = pz & 7;
      *(u32x4*)(Ks + key * 128 + ((ck ^ (key & 15)) << 3)) = pk_[i];
      *(u32x4*)(Vs + dv * 64 + ((cv ^ ((dv >> 1) & 7)) << 3)) = pv_[i];
    }
    __syncthreads();
    if (kt + 64 < Lk) tload(kt + 64);
#pragma unroll
    for (int h2 = 0; h2 < 2; ++h2) {
      f32x4 s[2][2];
#pragma unroll
      for (int sub = 0; sub < 2; ++sub) {
        const int key = h2 * 32 + sub * 16 + r;
#pragma unroll
        for (int pp = 0; pp < 2; ++pp) {
          const bf16x8 b0 = *(const bf16x8*)(Ks + key * 128 + (((pp * 8 + g) ^ (key & 15)) << 3));
          const bf16x8 b1 = *(const bf16x8*)(Ks + key * 128 + (((pp * 8 + 4 + g) ^ (key & 15)) << 3));
          f32x4 z = (f32x4){0.f, 0.f, 0.f, 0.f};
          z = __builtin_amdgcn_mfma_f32_16x16x32_bf16(aq[pp][0], b0, z, 0, 0, 0);
          z = __builtin_amdgcn_mfma_f32_16x16x32_bf16(aq[pp][1], b1, z, 0, 0, 0);
          s[pp][sub] = z;
        }
      }
#pragma unroll
      for (int pp = 0; pp < 2; ++pp) {
#pragma unroll
        for (int j = 0; j < 4; ++j) {
          float s0 = s[pp][0][j] * scale, s1 = s[pp][1][j] * scale;
          float mx = max16(fmaxf(s0, s1));
          float mnew = fmaxf(mrun[pp][j], mx);
          float alpha = __expf(mrun[pp][j] - mnew);
          float p0 = __expf(s0 - mnew), p1 = __expf(s1 - mnew);
          float rs = sum16(p0 + p1);
          lrun[pp][j] = lrun[pp][j] * alpha + rs;
          mrun[pp][j] = mnew;
#pragma unroll
          for (int n = 0; n < 8; ++n) O[pp][n][j] *= alpha;
          Pw[(pp * 16 + g * 4 + j) * 40 + r] = f2bf(p0);
          Pw[(pp * 16 + g * 4 + j) * 40 + 16 + r] = f2bf(p1);
        }
      }
      __builtin_amdgcn_fence(__ATOMIC_RELEASE, "wavefront");
      __builtin_amdgcn_wave_barrier();
      __builtin_amdgcn_fence(__ATOMIC_ACQUIRE, "wavefront");
      bf16x8 pa0 = *(const bf16x8*)(Pw + (0 * 16 + r) * 40 + g * 8);
      bf16x8 pa1 = *(const bf16x8*)(Pw + (1 * 16 + r) * 40 + g * 8);
#pragma unroll
      for (int n = 0; n < 8; ++n) {
        const int dv = n * 16 + r;
        const bf16x8 vb = *(const bf16x8*)(Vs + dv * 64 + (((h2 * 4 + g) ^ ((dv >> 1) & 7)) << 3));
        O[0][n] = __builtin_amdgcn_mfma_f32_16x16x32_bf16(pa0, vb, O[0][n], 0, 0, 0);
        O[1][n] = __builtin_amdgcn_mfma_f32_16x16x32_bf16(pa1, vb, O[1][n], 0, 0, 0);
      }
      __builtin_amdgcn_fence(__ATOMIC_RELEASE, "wavefront");
      __builtin_amdgcn_wave_barrier();
    }
  }
#pragma unroll
  for (int j = 0; j < 4; ++j) {
    float i0 = 1.f / lrun[0][j], i1 = lam / lrun[1][j];
    float o[8];
    float ss = 0.f;
#pragma unroll
    for (int n = 0; n < 8; ++n) { o[n] = O[0][n][j] * i0 - O[1][n][j] * i1; ss += o[n] * o[n]; }
    ss = sum16(ss);
    float rs = rsqrtf(ss * (1.f / 128.f) + EPSF) * (1.f - lam_init);
    bh* arow = p.act + (size_t)(qrow + g * 4 + j) * 1024 + h * 128;
#pragma unroll
    for (int n = 0; n < 8; ++n) arow[n * 16 + r] = f2bf(o[n] * rs * p.diff_norm[h * 128 + n * 16 + r]);
  }
}

__device__ __forceinline__ void ffnact_job(const Params& p, int layer, int job) {
  int tidl = threadIdx.x; asm volatile("" : "+v"(tidl));
  const int item = job * 256 + tidl;
  const int rc = item / 352, j = (item % 352) * 8;
  const int t0 = rc * 8;
  const bh* U = (const bh*)p.R;
  bh* AO = (bh*)(p.R + OFF_ACTF);
  const float* cw = p.ffn_conv_w + (size_t)layer * 3 * 5632;
  const float* cb = p.ffn_conv_b + (size_t)layer * 5632;
  const bool start = (t0 < NTP) ? ((t0 & 255) == 0) : ((t0 & 2047) == 0);
  const bool endd = (t0 < NTP) ? (((t0 + 8) & 255) == 0) : (((t0 + 8) & 2047) == 0);
  u32x4 ua[10], ug[10];
  const u32x4 zz = {0, 0, 0, 0};
#pragma unroll
  for (int i = 0; i < 10; ++i) {
    const int t = t0 - 1 + i;
    const bool ok = (i == 0) ? !start : ((i == 9) ? !endd : true);
    ua[i] = ok ? *(const u32x4*)(U + (size_t)t * 5632 + j) : zz;
    ug[i] = ok ? *(const u32x4*)(U + (size_t)t * 5632 + 2816 + j) : zz;
  }
  float wa[3][8], wg[3][8], ba[8], bg[8];
#pragma unroll
  for (int tp = 0; tp < 3; ++tp) {
    float4 x0 = *(const float4*)(cw + tp * 5632 + j), x1 = *(const float4*)(cw + tp * 5632 + j + 4);
    float4 y0 = *(const float4*)(cw + tp * 5632 + 2816 + j), y1 = *(const float4*)(cw + tp * 5632 + 2816 + j + 4);
    wa[tp][0] = x0.x; wa[tp][1] = x0.y; wa[tp][2] = x0.z; wa[tp][3] = x0.w; wa[tp][4] = x1.x; wa[tp][5] = x1.y; wa[tp][6] = x1.z; wa[tp][7] = x1.w;
    wg[tp][0] = y0.x; wg[tp][1] = y0.y; wg[tp][2] = y0.z; wg[tp][3] = y0.w; wg[tp][4] = y1.x; wg[tp][5] = y1.y; wg[tp][6] = y1.z; wg[tp][7] = y1.w;
  }
  {
    float4 x0 = *(const float4*)(cb + j), x1 = *(const float4*)(cb + j + 4);
    float4 y0 = *(const float4*)(cb + 2816 + j), y1 = *(const float4*)(cb + 2816 + j + 4);
    ba[0] = x0.x; ba[1] = x0.y; ba[2] = x0.z; ba[3] = x0.w; ba[4] = x1.x; ba[5] = x1.y; ba[6] = x1.z; ba[7] = x1.w;
    bg[0] = y0.x; bg[1] = y0.y; bg[2] = y0.z; bg[3] = y0.w; bg[4] = y1.x; bg[5] = y1.y; bg[6] = y1.z; bg[7] = y1.w;
  }
#pragma unroll
  for (int i = 0; i < 8; ++i) {
    u32x4 ov;
#pragma unroll
    for (int e2 = 0; e2 < 4; ++e2) {
      float res[2];
#pragma unroll
      for (int hl = 0; hl < 2; ++hl) {
        const int e = e2 * 2 + hl;
        float am = hl ? bfhi(ua[i][e2]) : bflo(ua[i][e2]);
        float a0 = hl ? bfhi(ua[i + 1][e2]) : bflo(ua[i + 1][e2]);
        float ap = hl ? bfhi(ua[i + 2][e2]) : bflo(ua[i + 2][e2]);
        float gm = hl ? bfhi(ug[i][e2]) : bflo(ug[i][e2]);
        float g0 = hl ? bfhi(ug[i + 1][e2]) : bflo(ug[i + 1][e2]);
        float gp = hl ? bfhi(ug[i + 2][e2]) : bflo(ug[i + 2][e2]);
        float av = wa[0][e] * am + wa[1][e] * a0 + wa[2][e] * ap + ba[e];
        float gv = wg[0][e] * gm + wg[1][e] * g0 + wg[2][e] * gp + bg[e];
        res[hl] = siluf_(gv) * av;
      }
      ov[e2] = pk2(res[0], res[1]);
    }
    *(u32x4*)(AO + (size_t)(t0 + i) * 2816 + j) = ov;
  }
}

#define XB_TMO      128
#define XB_XCNT(j)  (256  + 64 * (j))
#define XB_XSUB(j)  (1280 + 64 * (j))
#define XB_XGEN(j)  (2304 + 64 * (j))
#define XB_TOP      3328
#define XB_TOPGEN   3392
#define XCD_BAR_WORDS 3456
#define XB_SPIN_CAP (1u << 18)
#define LAS __attribute__((address_space(3)))

__device__ __forceinline__ unsigned xb_ld(unsigned* p)              { return __hip_atomic_load(p, __ATOMIC_RELAXED, __HIP_MEMORY_SCOPE_AGENT); }
__device__ __forceinline__ unsigned xb_add(unsigned* p, unsigned v) { return __hip_atomic_fetch_add(p, v, __ATOMIC_RELAXED, __HIP_MEMORY_SCOPE_AGENT); }
__device__ __forceinline__ unsigned xb_xcc_id() { return (unsigned)__builtin_amdgcn_s_getreg((3 << 11) | 20) & 0xFu; }
#define XB_SPIN(cond, bar) do { unsigned _sp = 0; while (cond) { __builtin_amdgcn_s_sleep(1); \
    if ((++_sp & 255u) == 0u) { if (xb_ld(&(bar)[XB_TMO])) break; if (_sp > XB_SPIN_CAP) { atomicAdd(&(bar)[XB_TMO], 1u); break; } } } } while (0)

struct XcdBarrier {
    unsigned* bar; unsigned x;
    volatile LAS unsigned* st;
};

__device__ __forceinline__ XcdBarrier xcd_barrier_post(unsigned* bar, volatile LAS unsigned* st) {
    XcdBarrier b; b.bar = bar; b.x = xb_xcc_id(); b.st = st;
    if (threadIdx.x == 0) (void)xb_add(&bar[XB_XCNT(b.x)], 1u);
    return b;
}
__device__ __forceinline__ void xcd_barrier_complete(unsigned* bar, unsigned x, unsigned& nloc, unsigned& nx) {
    const unsigned G = gridDim.x * gridDim.y * gridDim.z;
    unsigned sum, cnt, mine, sp = 0u;
    for (;;) {
        sum = 0u; cnt = 0u; mine = 0u;
#pragma unroll
        for (unsigned j = 0; j < 16; ++j) { const unsigned c = xb_ld(&bar[XB_XCNT(j)]); sum += c; cnt += (c > 0u) ? 1u : 0u; mine = (j == x) ? c : mine; }
        if (sum == G) break;
        __builtin_amdgcn_s_sleep(1);
        if ((++sp & 255u) == 0u) { if (xb_ld(&bar[XB_TMO])) break; if (sp > XB_SPIN_CAP) { atomicAdd(&bar[XB_TMO], 1u); break; } }
    }
    nloc = mine > 0u ? mine : 1u; nx = cnt > 0u ? cnt : 1u;
}

__device__ __forceinline__ void xcd_barrier(const XcdBarrier& b) {
    asm volatile("s_waitcnt vmcnt(0)" ::: "memory");
    __syncthreads();
    if (threadIdx.x == 0) {
        unsigned* bar = b.bar;
        __builtin_amdgcn_s_waitcnt(0);
        unsigned nloc = b.st[0], nx = b.st[1];
        if (nloc == 0u) { xcd_barrier_complete(bar, b.x, nloc, nx); b.st[0] = nloc; b.st[1] = nx; }
        const unsigned old = xb_add(&bar[XB_XSUB(b.x)], 1u);
        const unsigned gen = old / nloc;
        if (old + 1u == (gen + 1u) * nloc) {
            __builtin_amdgcn_fence(__ATOMIC_RELEASE, "agent");
            asm volatile("s_waitcnt vmcnt(0)" ::: "memory");
            const unsigned og = xb_add(&bar[XB_TOP], 1u);
            const unsigned tg = og / nx;
            if (og + 1u == (tg + 1u) * nx) xb_add(&bar[XB_TOPGEN], 1u);
            else XB_SPIN(xb_ld(&bar[XB_TOPGEN]) == tg, bar);
            __builtin_amdgcn_fence(__ATOMIC_ACQUIRE, "agent");
            xb_add(&bar[XB_XGEN(b.x)], 1u);
            asm volatile("s_waitcnt vmcnt(0)" ::: "memory");
        } else {
            XB_SPIN(xb_ld(&bar[XB_XGEN(b.x)]) == gen, bar);
            __builtin_amdgcn_fence(__ATOMIC_ACQUIRE, "agent");
            asm volatile("s_waitcnt vmcnt(0)" ::: "memory");
        }
    }
    __syncthreads();
}


template <int ph>
__device__ __forceinline__ void run_phase(const Params& p, int bid, int nb, char* smem, bool rep = false) {
  const float* ng = p.norm_g;
  const bh* Rf = (const bh*)p.R;
  if (ph == 0) {
    for (int j = bid + (rep ? 768 : 0); j < 768 + 576 + 1024; j += nb) {
      if (j < 768) gemv_job(p, j, smem);
      else if (j < 1344) filter_job(p, j - 768, smem);
      else convert_tile(p.w_in_even, 1024, 4096, p.wt, j - 1344, smem);
    }
  } else if (ph == 1) {
    for (int j = bid; j < 1536; j += nb) rows_job(p, j, true, nullptr, nullptr, 0, 0, ng + 0 * 1024, 0, 0);
  } else if (ph == 2) {
    gemm_phase<2, 192, 3>(p.act, 1024, p.wt, 1024, p.R, 4096, 4096, 32, bid, nb, smem);
  } else if (ph == 3) {
    if (nb == 512 && !rep) {
      hyena_sample_job(p, bid, smem);
      if (bid < 384) scan2_unit<0>(p, bid, smem);
      else {
        const int q = bid - 384;
        hyena_prompt_job(p, q, smem);
        hyena_prompt_job(p, q + 128, smem);
        convert_tile(p.w_out_even, 1024, 1024, p.wt, q, smem);
        convert_tile(p.w_out_even, 1024, 1024, p.wt, q + 128, smem);
      }
    } else {
      for (int j = bid + (rep ? 512 : 0); j < (rep ? 896 : 512 + 384 + 256 + 256); j += nb) {
        if (j < 512) hyena_sample_job(p, j, smem);
        else if (j < 896) scan2_unit<0>(p, j - 512, smem);
        else if (j < 1152) hyena_prompt_job(p, j - 896, smem);
        else convert_tile(p.w_out_even, 1024, 1024, p.wt, j - 1152, smem);
      }
    }
  } else if (ph == 4) {
    for (int j = bid; j < 128 + 1024; j += nb) {
      if (j < 128) fixup_unit<0>(p, j, smem);
      else scan_final_job(p, j - 128, 0);
    }
  } else if (ph == 5) {
    for (int j = bid; j < 512; j += nb) scan_final_job(p, 1024 + j, 0);
  } else if (ph == 6) {
    gemm_phase<1, 192, 3>(p.act, 1024, p.wt, 1024, p.R, 1024, 1024, 8, bid, nb, smem);
  } else if (ph == 7) {
    for (int j = bid; j < 1536 + 1408 + 704; j += nb) {
      if (j < 1536) rows_job(p, j, true, Rf, ng + 1 * 1024, 0, 2, ng + 2 * 1024, 0, 3);
      else if (j < 2944) convert_tile(p.ffn_up, 1024, 5632, p.wt, j - 1536, smem, true);
      else convert_tile(p.ffn_down, 2816, 1024, p.wt2, j - 2944, smem);
    }
  } else if (ph == 8) {
    gemm_phase<3, 192, 3>(p.act, 1024, p.wt, 1024, p.R + OFF_ACTF, 2816, 5632, 44, bid, nb, smem, p.ffn_conv_w, p.ffn_conv_b);
  } else if (ph == 9) {
  } else if (ph == 10) {
    gemm_phase<1, 192, 3>((const bh*)(p.R + OFF_ACTF), 2816, p.wt2, 2816, p.R, 1024, 1024, 8, bid, nb, smem);
  } else if (ph == 11) {
    for (int j = bid; j < 1536 + 800; j += nb) {
      if (j < 1536) rows_job(p, j, false, Rf, ng + 3 * 1024, 0, 5, ng + 4 * 1024, 1, 0);
      else convert_tile(p.w_in_odd, 1024, 3104, p.wt, j - 1536, smem);
    }
  } else if (ph == 12) {
    gemm_phase<1, 128, 3>(p.act, 1024, p.wt, 1024, p.R, 3104, 3104, 25, bid, nb, smem);
  } else if (ph == 13) {
    auto small13 = [&](int sj) {
      if (sj < 800) vt_job(p, sj, smem);
      else if (sj < 3872) oddrow_job(p, sj - 800);
      else if (sj < 4128) ctxk_job(p, sj - 3872);
      else convert_tile(p.w_out_odd, 1024, 1024, p.wt, sj - 4128, smem);
    };
    if (nb == 512 && !rep) {
      if (bid < 384) {
        scan2_unit<1>(p, bid, smem);
        for (int sj = 3072 + bid; sj < 4384; sj += 384) small13(sj);
      } else {
        for (int k = 0; k < 24; ++k) small13((bid - 384) + 128 * k);
      }
    } else {
      for (int j = bid; j < (rep ? 384 : 384 + 4384); j += nb) {
        if (j < 384) scan2_unit<1>(p, j, smem);
        else small13(j - 384);
      }
    }
  } else if (ph == 14) {
    if (nb == 512 && !rep) {
      if (bid < 256) attn_unit(p, bid, smem);
      else {
        const int q = bid - 256;
        attn_unit(p, 256 + q, smem);
        attn_unit(p, 512 + q, smem);
        if (q < 128) fixup_unit<1>(p, q, smem);
        for (int k = 0; k < 4; ++k) scan_final_job(p, q + 256 * k, 1);
      }
    } else {
      for (int j = bid; j < (rep ? 768 : 768 + 128 + 1024); j += nb) {
        if (j < 768) attn_unit(p, j, smem);
        else if (j < 896) fixup_unit<1>(p, j - 768, smem);
        else scan_final_job(p, j - 896, 1);
      }
    }
  } else if (ph == 15) {
    for (int j = bid; j < 512; j += nb) scan_final_job(p, 1024 + j, 1);
  } else if (ph == 16) {
    gemm_phase<1, 192, 3>(p.act, 1024, p.wt, 1024, p.R, 1024, 1024, 8, bid, nb, smem);
  } else if (ph == 17) {
    for (int j = bid; j < 1536 + 1408 + 704; j += nb) {
      if (j < 1536) rows_job(p, j, false, Rf, ng + 5 * 1024, 1, 2, ng + 6 * 1024, 1, 3);
      else if (j < 2944) convert_tile(p.ffn_up + (size_t)1024 * 5632, 1024, 5632, p.wt, j - 1536, smem, true);
      else convert_tile(p.ffn_down + (size_t)2816 * 1024, 2816, 1024, p.wt2, j - 2944, smem);
    }
  } else if (ph == 18) {
    gemm_phase<3, 192, 3>(p.act, 1024, p.wt, 1024, p.R + OFF_ACTF, 2816, 5632, 44, bid, nb, smem, p.ffn_conv_w + 3 * 5632, p.ffn_conv_b + 5632);
  } else if (ph == 19) {
  } else if (ph == 20) {
    gemm_phase<1, 192, 3>((const bh*)(p.R + OFF_ACTF), 2816, p.wt2, 2816, p.R, 1024, 1024, 8, bid, nb, smem);
  } else if (ph == 21) {
    for (int j = bid; j < 1536; j += nb) rows_job(p, j, false, Rf, ng + 7 * 1024, 1, 5, nullptr, 0, 0);
  }
}

template <int PH>
__device__ __forceinline__ void phase_step(const Params& p, int ph0, int ph1, char* smem, cg::grid_group& grid, const XcdBarrier& xb) {
  if (PH == 9 || PH == 19) return;
  if (PH >= ph0 && PH < ph1) {
    if (PH == REP_PH) { run_phase<PH>(p, blockIdx.x, gridDim.x, smem, true); xcd_barrier(xb); }
    run_phase<PH>(p, blockIdx.x, gridDim.x, smem);
    if (PH + 1 < ph1) {
      xcd_barrier(xb);
    }
  }
}

__global__ void __launch_bounds__(256, 2) mega_kernel(Params p, int ph0, int ph1) {
  __shared__ __attribute__((aligned(16))) char smem[49152];
  cg::grid_group grid = cg::this_grid();
  __shared__ uint4 xb_words;
  if (threadIdx.x == 0) xb_words = make_uint4(0u, 0u, 0u, 0u);
  __syncthreads();
  XcdBarrier xb = xcd_barrier_post(p.bar, (volatile LAS unsigned*)&xb_words);
#ifdef EXTRA_SYNCS
  for (int i = 0; i < EXTRA_SYNCS; ++i) xcd_barrier(xb);
#endif
  phase_step<0>(p, ph0, ph1, smem, grid, xb);
  phase_step<1>(p, ph0, ph1, smem, grid, xb);
  phase_step<2>(p, ph0, ph1, smem, grid, xb);
  phase_step<3>(p, ph0, ph1, smem, grid, xb);
  phase_step<4>(p, ph0, ph1, smem, grid, xb);
  phase_step<5>(p, ph0, ph1, smem, grid, xb);
  phase_step<6>(p, ph0, ph1, smem, grid, xb);
  phase_step<7>(p, ph0, ph1, smem, grid, xb);
  phase_step<8>(p, ph0, ph1, smem, grid, xb);
  phase_step<9>(p, ph0, ph1, smem, grid, xb);
  phase_step<10>(p, ph0, ph1, smem, grid, xb);
  phase_step<11>(p, ph0, ph1, smem, grid, xb);
  phase_step<12>(p, ph0, ph1, smem, grid, xb);
  phase_step<13>(p, ph0, ph1, smem, grid, xb);
  phase_step<14>(p, ph0, ph1, smem, grid, xb);
  phase_step<15>(p, ph0, ph1, smem, grid, xb);
  phase_step<16>(p, ph0, ph1, smem, grid, xb);
  phase_step<17>(p, ph0, ph1, smem, grid, xb);
  phase_step<18>(p, ph0, ph1, smem, grid, xb);
  phase_step<19>(p, ph0, ph1, smem, grid, xb);
  phase_step<20>(p, ph0, ph1, smem, grid, xb);
  phase_step<21>(p, ph0, ph1, smem, grid, xb);
}

extern "C" void kernel_launch(void* const* d_in, const int* in_sizes, int n_in, void* d_out, int out_size, void* d_ws,
                              size_t ws_size, hipStream_t stream) {
  static int grid_blocks = 0;
  if (!grid_blocks) {
    int dev = 0, cus = 0, per_cu = 0;
    hipGetDevice(&dev);
    hipDeviceGetAttribute(&cus, hipDeviceAttributeMultiprocessorCount, dev);
    hipOccupancyMaxActiveBlocksPerMultiprocessor(&per_cu, mega_kernel, 256, 0);
    if (per_cu > 2) per_cu = 2;
    if (per_cu < 1) per_cu = 1;
    grid_blocks = cus * per_cu;
  }
  Params p{};
  const float** pf = (const float**)&p;
  for (int i = 0; i < 35; ++i) pf[i] = (const float*)d_in[i];
  p.out = (float*)d_out;
  char* ws = (char*)d_ws;
  size_t off = 0;
  p.act = (bh*)(ws + off); off += (size_t)NT * 1024 * 2;
  p.wt = (bh*)(ws + off); off += (size_t)5632 * 1024 * 2;
  p.wt2 = (bh*)(ws + off); off += (size_t)1024 * 2816 * 2;
  p.R = ws + off; off += R_BYTES;
  p.mod = (float*)(ws + off); off += (size_t)2 * 3 * 6144 * 4;
  p.bar = (unsigned*)(ws + off); off += (size_t)XCD_BAR_WORDS * 4;
  p.gt256 = (bh*)(ws + off); off += (size_t)2 * 512 * 512 * 2;
  p.gt2048 = (bh*)(ws + off); off += (size_t)2 * 512 * 4096 * 2;
  if (off > ws_size) { fprintf(stderr, "workspace too small: need %zu have %zu\n", off, ws_size); return; }
  hipMemsetAsync(p.mod, 0, (size_t)2 * 3 * 6144 * 4 + (size_t)XCD_BAR_WORDS * 4, stream);
#if MEGA
  int ph0 = 0, ph1 = NPHASE;
  void* args[] = {&p, &ph0, &ph1};
  hipError_t e = hipLaunchCooperativeKernel((void*)mega_kernel, dim3(grid_blocks), dim3(256), args, 0, stream);
  if (e != hipSuccess) fprintf(stderr, "cooperative launch failed: %s (grid %d)\n", hipGetErrorString(e), grid_blocks);
#else
  for (int ph = 0; ph < NPHASE; ++ph) {
    int ph0 = ph, ph1 = ph + 1;
    void* args[] = {&p, &ph0, &ph1};
    hipError_t e = hipLaunchCooperativeKernel((void*)mega_kernel, dim3(grid_blocks), dim3(256), args, 0, stream);
    if (e != hipSuccess) fprintf(stderr, "launch failed: %s\n", hipGetErrorString(e));
  }
#endif
}
```

```cpp
#include <hip/hip_runtime.h>
#include <hip/hip_cooperative_groups.h>
#include <stdint.h>
#include <cstdio>
namespace cg = cooperative_groups;

#ifndef MEGA
#define MEGA 1
#endif
#ifndef REP_PH
#define REP_PH -1
#endif

typedef unsigned short bh;
using bf16x8 = __attribute__((ext_vector_type(8))) short;
using f32x4 = __attribute__((ext_vector_type(4))) float;
using u32x4 = __attribute__((ext_vector_type(4))) unsigned int;

#define NT 12288
#define NTP 8192
#define EPSF 1e-6f
#define NPHASE 22

#define OUT_HGRN 12582912
#define OUT_CK 16777216
#define OUT_CV 20971520
#define OUT_GLA 25165824

#define OFF_ODIR 100663296ull
#define OFF_Z1 150994944ull
#define OFF_HYT 150994944ull
#define OFF_ACTF 138412032ull
#define OFF_Q 150994944ull
#define OFF_KB 163577856ull
#define OFF_VT 176685056ull
#define R_BYTES 207618048ull
#define KV_SAMPLE_BASE 4194304

struct Params {
  const float *x_prompt, *x_sample, *state_hgrn, *cache_k, *cache_v, *state_gla, *c, *c_ctx;
  const float *ada_w, *ada_b, *norm_g, *ffn_up, *ffn_conv_w, *ffn_conv_b, *ffn_down;
  const float *w_in_even, *w_out_even, *hgrn_lb, *hgrn_norm, *hy_conv_w, *hy_conv_b;
  const float *hy_w1, *hy_b1, *hy_w2, *hy_b2, *hy_w3, *hy_freq, *hy_d;
  const float *w_in_odd, *w_out_odd, *diff_lambda, *diff_norm, *gla_aw, *gla_ab, *gla_norm;
  float* out;
  bh* act;
  bh* wt;
  bh* wt2;
  char* R;
  float* mod;
  bh* gt256;
  bh* gt2048;
  unsigned* bar;
};

typedef __bf16 bf2_t __attribute__((ext_vector_type(2)));
typedef float f2_t __attribute__((ext_vector_type(2)));
typedef unsigned int u32x2 __attribute__((ext_vector_type(2)));
__device__ __forceinline__ unsigned pk2(float a, float b) {
  f2_t v = {a, b};
  return __builtin_bit_cast(unsigned, __builtin_convertvector(v, bf2_t));
}
__device__ __forceinline__ bh f2bf(float x) { return (bh)(pk2(x, x) & 0xffffu); }
__device__ __forceinline__ float bflo(unsigned w) { return __uint_as_float(w << 16); }
__device__ __forceinline__ float bfhi(unsigned w) { return __uint_as_float(w & 0xffff0000u); }
__device__ __forceinline__ float bf2f(bh h) { return __uint_as_float(((uint32_t)h) << 16); }
__device__ __forceinline__ float sigmoidf_(float x) { return __builtin_amdgcn_rcpf(1.f + __expf(-x)); }
__device__ __forceinline__ float siluf_(float x) { return x * __builtin_amdgcn_rcpf(1.f + __expf(-x)); }
template <int CTRL>
__device__ __forceinline__ float dppf0(float v) {
  return __int_as_float(__builtin_amdgcn_update_dpp(0, __float_as_int(v), CTRL, 0xF, 0xF, true));
}
__device__ __forceinline__ float wave_sum(float v) {
  v += dppf0<0xB1>(v); v += dppf0<0x4E>(v); v += dppf0<0x141>(v); v += dppf0<0x140>(v);
  v += __shfl_xor(v, 16);
  v += __shfl_xor(v, 32);
  return v;
}

template <int OUT_BF16, int BM, int DEPTH>
__device__ __forceinline__ void gemm_phase(const bh* __restrict__ A, int lda, const bh* __restrict__ Bt, int K, void* Cv, int ldc,
                           int N, int ntn, int bid, int nb, char* smem, const float* cw = nullptr, const float* cb = nullptr) {
  constexpr int MT = BM / 32;
  constexpr int NPA = BM / 32;
  bh* As = (bh*)smem;
  bh* Bs = As + BM * 64;
  int tid_l_ = threadIdx.x; asm volatile("" : "+v"(tid_l_)); const int tid = tid_l_, lane = tid & 63, w = tid >> 6, wr = w >> 1, wc = w & 1, r = lane & 15, g = lane >> 4;
  constexpr int MB = (NT / BM) / 8;
  const int xcd = bid & 7, nloc = nb >> 3;
  const int qend = OUT_BF16 == 3 ? MB * ntn + (ntn + 7) / 8 : MB * ntn;
  for (int q = bid >> 3; q < qend; q += nloc) {
    int mt = xcd * MB + (q % MB), nt = q / MB;
    if (OUT_BF16 == 3 && q >= MB * ntn) { mt = 64; nt = (q - MB * ntn) * 8 + xcd; if (nt >= ntn) continue; }
    const int trow0 = OUT_BF16 == 3 ? mt * 190 - 1 : mt * BM;
    const bh* Ag = A;
    const bh* Bg = Bt + (size_t)(nt * 128) * K;
    f32x4 acc[MT][4];
#pragma unroll
    for (int m = 0; m < MT; ++m)
#pragma unroll
      for (int n = 0; n < 4; ++n) acc[m][n] = (f32x4){0.f, 0.f, 0.f, 0.f};
    u32x4 pa0[NPA], pb0[4], pa1[NPA], pb1[4];
    auto gload = [&](u32x4* pa, u32x4* pb, int kofs) {
#pragma unroll
      for (int i = 0; i < NPA; ++i) {
        int pz = tid + i * 256, row = pz >> 3, cp = pz & 7;
        int tr = trow0 + row;
        if (OUT_BF16 == 3) tr = min(max(tr, 0), NT - 1);
        pa[i] = *(const u32x4*)(Ag + (size_t)tr * lda + kofs + cp * 8);
      }
#pragma unroll
      for (int i = 0; i < 4; ++i) {
        int pz = tid + i * 256, row = pz >> 3, cp = pz & 7;
        pb[i] = *(const u32x4*)(Bg + (size_t)row * K + kofs + cp * 8);
      }
    };
    auto kstep = [&](u32x4* pa, u32x4* pb, int knext) {
      __syncthreads();
#pragma unroll
      for (int i = 0; i < NPA; ++i) {
        int pz = tid + i * 256, row = pz >> 3, cp = pz & 7;
        *(u32x4*)(As + row * 64 + ((cp ^ ((row >> 1) & 7)) << 3)) = pa[i];
      }
#pragma unroll
      for (int i = 0; i < 4; ++i) {
        int pz = tid + i * 256, row = pz >> 3, cp = pz & 7;
        *(u32x4*)(Bs + row * 64 + ((cp ^ ((row >> 1) & 7)) << 3)) = pb[i];
      }
      __syncthreads();
      if (knext < K) gload(pa, pb, knext);
#pragma unroll
      for (int kk = 0; kk < 2; ++kk) {
        bf16x8 af[MT], bfr[4];
#pragma unroll
        for (int m = 0; m < MT; ++m) { const int row = wr * (BM / 2) + m * 16 + r; af[m] = *(const bf16x8*)(As + row * 64 + (((kk * 4 + g) ^ ((row >> 1) & 7)) << 3)); }
#pragma unroll
        for (int n = 0; n < 4; ++n) { const int row = wc * 64 + n * 16 + r; bfr[n] = *(const bf16x8*)(Bs + row * 64 + (((kk * 4 + g) ^ ((row >> 1) & 7)) << 3)); }
        __builtin_amdgcn_sched_barrier(0);
#pragma unroll
        for (int m = 0; m < MT; ++m)
#pragma unroll
          for (int n = 0; n < 4; ++n)
            acc[m][n] = (OUT_BF16 == 1 || OUT_BF16 == 3) ? __builtin_amdgcn_mfma_f32_16x16x32_bf16(bfr[n], af[m], acc[m][n], 0, 0, 0)
                                        : __builtin_amdgcn_mfma_f32_16x16x32_bf16(af[m], bfr[n], acc[m][n], 0, 0, 0);
        __builtin_amdgcn_sched_barrier(0);
      }
    };
    if (DEPTH == 3) {
      constexpr int NA3 = BM / 64;
      bh* As3 = (bh*)smem;
      bh* Bs3 = As3 + 2 * BM * 32;
      u32x4 ra0[NA3], rb0[2], ra1[NA3], rb1[2];
      auto ld3 = [&](u32x4* ra, u32x4* rb, int kofs) {
#pragma unroll
        for (int i = 0; i < NA3; ++i) {
          int pz = tid + i * 256, row = pz >> 2, c = pz & 3;
          int tr = trow0 + row;
          if (OUT_BF16 == 3) tr = min(max(tr, 0), NT - 1);
          ra[i] = *(const u32x4*)(Ag + (size_t)tr * lda + kofs + c * 8);
        }
#pragma unroll
        for (int i = 0; i < 2; ++i) {
          int pz = tid + i * 256, row = pz >> 2, c = pz & 3;
          rb[i] = *(const u32x4*)(Bg + (size_t)row * K + kofs + c * 8);
        }
      };
      auto st3 = [&](const u32x4* ra, const u32x4* rb, int stg) {
#pragma unroll
        for (int i = 0; i < NA3; ++i) {
          int pz = tid + i * 256, row = pz >> 2, c = pz & 3;
          *(u32x4*)(As3 + stg * BM * 32 + row * 32 + ((c ^ (((row >> 3) & 1) << 1)) << 3)) = ra[i];
        }
#pragma unroll
        for (int i = 0; i < 2; ++i) {
          int pz = tid + i * 256, row = pz >> 2, c = pz & 3;
          *(u32x4*)(Bs3 + stg * 128 * 32 + row * 32 + ((c ^ (((row >> 3) & 1) << 1)) << 3)) = rb[i];
        }
      };
      auto comp3 = [&](int cur) {
        bf16x8 af[MT], bfr[4];
#pragma unroll
        for (int m = 0; m < MT; ++m) {
          const int row = wr * (BM / 2) + m * 16 + r;
          af[m] = *(const bf16x8*)(As3 + cur * BM * 32 + row * 32 + ((g ^ (((row >> 3) & 1) << 1)) << 3));
        }
#pragma unroll
        for (int n = 0; n < 4; ++n) {
          const int row = wc * 64 + n * 16 + r;
          bfr[n] = *(const bf16x8*)(Bs3 + cur * 128 * 32 + row * 32 + ((g ^ (((row >> 3) & 1) << 1)) << 3));
        }
        __builtin_amdgcn_s_setprio(1);
#pragma unroll
        for (int m = 0; m < MT; ++m)
#pragma unroll
          for (int n = 0; n < 4; ++n)
            acc[m][n] = (OUT_BF16 == 1 || OUT_BF16 == 3) ? __builtin_amdgcn_mfma_f32_16x16x32_bf16(bfr[n], af[m], acc[m][n], 0, 0, 0)
                                        : __builtin_amdgcn_mfma_f32_16x16x32_bf16(af[m], bfr[n], acc[m][n], 0, 0, 0);
        __builtin_amdgcn_s_setprio(0);
      };
      const int nk = K >> 5;
      __syncthreads();
      ld3(ra0, rb0, 0);
      ld3(ra1, rb1, 32);
      st3(ra0, rb0, 0);
      ld3(ra0, rb0, 64);
      __syncthreads();
      for (int ks = 0; ks < nk; ks += 2) {
        comp3(0);
        st3(ra1, rb1, 1);
        if (ks + 3 < nk) ld3(ra1, rb1, (ks + 3) << 5);
        __syncthreads();
        comp3(1);
        if (ks + 2 < nk) st3(ra0, rb0, 0);
        if (ks + 4 < nk) ld3(ra0, rb0, (ks + 4) << 5);
        __syncthreads();
      }
    } else {
    gload(pa0, pb0, 0);
    if (DEPTH == 2) {
      gload(pa1, pb1, 64);
      for (int k0 = 0; k0 < K; k0 += 128) {
        kstep(pa0, pb0, k0 + 128);
        kstep(pa1, pb1, k0 + 192);
      }
    } else {
      for (int k0 = 0; k0 < K; k0 += 64) kstep(pa0, pb0, k0 + 64);
    }
    }
    if (OUT_BF16 == 1 || OUT_BF16 == 3) {
      __syncthreads();
      bh* Ct = (bh*)smem;
#pragma unroll
      for (int m = 0; m < MT; ++m)
#pragma unroll
        for (int n = 0; n < 4; ++n) {
          const int row = wr * (BM / 2) + m * 16 + r;
          const int sl = wc * 16 + n * 4 + g;
          u32x2 pv;
          pv[0] = pk2(acc[m][n][0], acc[m][n][1]);
          pv[1] = pk2(acc[m][n][2], acc[m][n][3]);
          *(u32x2*)(Ct + row * 128 + ((sl ^ ((row & 15) << 1)) << 2)) = pv;
        }
      __syncthreads();
      if (OUT_BF16 == 1) {
#pragma unroll 2
        for (int i = 0; i < BM / 16; ++i) {
          const int pz = tid + i * 256, row = pz >> 4, pc = pz & 15;
          const u32x4 v = *(const u32x4*)(Ct + row * 128 + ((pc ^ (row & 15)) << 3));
          const int col = nt * 128 + pc * 8;
          if (col < N) *(u32x4*)((bh*)Cv + ((size_t)mt * BM + row) * ldc + col) = v;
        }
      } else {
        const int c8 = tid & 7, rs = tid >> 3;
        const int ja = nt * 64 + c8 * 8;
        float wa[3][8], wg[3][8], ba[8], bg[8];
#pragma unroll
        for (int tp = 0; tp < 3; ++tp) {
          const float4 x0 = *(const float4*)(cw + tp * 5632 + ja), x1 = *(const float4*)(cw + tp * 5632 + ja + 4);
          const float4 y0 = *(const float4*)(cw + tp * 5632 + 2816 + ja), y1 = *(const float4*)(cw + tp * 5632 + 2816 + ja + 4);
          wa[tp][0] = x0.x; wa[tp][1] = x0.y; wa[tp][2] = x0.z; wa[tp][3] = x0.w; wa[tp][4] = x1.x; wa[tp][5] = x1.y; wa[tp][6] = x1.z; wa[tp][7] = x1.w;
          wg[tp][0] = y0.x; wg[tp][1] = y0.y; wg[tp][2] = y0.z; wg[tp][3] = y0.w; wg[tp][4] = y1.x; wg[tp][5] = y1.y; wg[tp][6] = y1.z; wg[tp][7] = y1.w;
        }
        {
          const float4 x0 = *(const float4*)(cb + ja), x1 = *(const float4*)(cb + ja + 4);
          const float4 y0 = *(const float4*)(cb + 2816 + ja), y1 = *(const float4*)(cb + 2816 + ja + 4);
          ba[0] = x0.x; ba[1] = x0.y; ba[2] = x0.z; ba[3] = x0.w; ba[4] = x1.x; ba[5] = x1.y; ba[6] = x1.z; ba[7] = x1.w;
          bg[0] = y0.x; bg[1] = y0.y; bg[2] = y0.z; bg[3] = y0.w; bg[4] = y1.x; bg[5] = y1.y; bg[6] = y1.z; bg[7] = y1.w;
        }
#pragma unroll 1
        for (int i = 0; i < 6; ++i) {
          const int rr = 1 + rs + 32 * i;
          const int t = trow0 + rr;
          if (rr <= 190 && t < NT) {
            const bool start = (t < NTP) ? ((t & 255) == 0) : ((t & 2047) == 0);
            const bool endd = (t < NTP) ? ((t & 255) == 255) : ((t & 2047) == 2047);
            u32x4 am = *(const u32x4*)(Ct + (rr - 1) * 128 + ((c8 ^ ((rr - 1) & 15)) << 3));
            u32x4 gm = *(const u32x4*)(Ct + (rr - 1) * 128 + (((8 + c8) ^ ((rr - 1) & 15)) << 3));
            const u32x4 a0 = *(const u32x4*)(Ct + rr * 128 + ((c8 ^ (rr & 15)) << 3));
            const u32x4 g0 = *(const u32x4*)(Ct + rr * 128 + (((8 + c8) ^ (rr & 15)) << 3));
            u32x4 ap = *(const u32x4*)(Ct + (rr + 1) * 128 + ((c8 ^ ((rr + 1) & 15)) << 3));
            u32x4 gp = *(const u32x4*)(Ct + (rr + 1) * 128 + (((8 + c8) ^ ((rr + 1) & 15)) << 3));
            if (start) { am = (u32x4){0, 0, 0, 0}; gm = (u32x4){0, 0, 0, 0}; }
            if (endd) { ap = (u32x4){0, 0, 0, 0}; gp = (u32x4){0, 0, 0, 0}; }
            u32x4 ov;
#pragma unroll
            for (int e2 = 0; e2 < 4; ++e2) {
              float res[2];
#pragma unroll
              for (int hl = 0; hl < 2; ++hl) {
                const int e = e2 * 2 + hl;
                const float av = wa[0][e] * (hl ? bfhi(am[e2]) : bflo(am[e2])) + wa[1][e] * (hl ? bfhi(a0[e2]) : bflo(a0[e2])) +
                                 wa[2][e] * (hl ? bfhi(ap[e2]) : bflo(ap[e2])) + ba[e];
                const float gv = wg[0][e] * (hl ? bfhi(gm[e2]) : bflo(gm[e2])) + wg[1][e] * (hl ? bfhi(g0[e2]) : bflo(g0[e2])) +
                                 wg[2][e] * (hl ? bfhi(gp[e2]) : bflo(gp[e2])) + bg[e];
                res[hl] = siluf_(gv) * av;
              }
              ov[e2] = pk2(res[0], res[1]);
            }
            *(u32x4*)((bh*)Cv + (size_t)t * 2816 + ja) = ov;
          }
        }
      }
    }
#pragma unroll
    for (int m = 0; m < MT; ++m)
#pragma unroll
      for (int n = 0; n < 4; ++n) {
        if (OUT_BF16 == 1 || OUT_BF16 == 3) continue;
        int col = nt * 128 + wc * 64 + n * 16 + r;
        const size_t rowb = (size_t)mt * BM + wr * (BM / 2) + m * 16 + g * 4;
        if (OUT_BF16 == 2 && nt >= 20) {
          bh* hyt = (bh*)((char*)Cv + OFF_HYT) + (size_t)(col - 2560) * NT + rowb;
          u32x2 pv;
          pv[0] = pk2(acc[m][n][0], acc[m][n][1]);
          pv[1] = pk2(acc[m][n][2], acc[m][n][3]);
          *(u32x2*)hyt = pv;
        } else if (col < N) {
#pragma unroll
          for (int j = 0; j < 4; ++j) {
            size_t row = rowb + j;
            if (OUT_BF16) ((bh*)Cv)[row * ldc + col] = f2bf(acc[m][n][j]);
            else ((float*)Cv)[row * ldc + col] = acc[m][n][j];
          }
        }
      }
  }
}

__device__ __forceinline__ void convert_tile(const float* __restrict__ W, int K, int N, bh* __restrict__ WT, int tile, char* smem, bool perm = false) {
  float* tl = (float*)smem;
  int tid_l_ = threadIdx.x; asm volatile("" : "+v"(tid_l_)); const int tid = tid_l_;
  const int ntk = K >> 6;
  const int kt = tile % ntk, ntile = tile / ntk;
  __syncthreads();
#pragma unroll
  for (int i = 0; i < 16; ++i) {
    int e = tid + i * 256, kk = e >> 6, nn = e & 63, n = ntile * 64 + nn;
    tl[kk * 65 + nn] = (n < N) ? W[(size_t)(kt * 64 + kk) * N + n] : 0.f;
  }
  __syncthreads();
#pragma unroll
  for (int i = 0; i < 16; ++i) {
    int e = tid + i * 256, nn = e >> 6, kk = e & 63;
    const int orow = perm ? (ntile % 44) * 128 + (ntile / 44) * 64 + nn : ntile * 64 + nn;
    WT[(size_t)orow * K + kt * 64 + kk] = f2bf(tl[kk * 65 + nn]);
  }
}

__device__ __forceinline__ void gemv_job(const Params& p, int job, char* smem) {
  float* sc = (float*)smem;
  float* rd = sc + 768;
  int tid_l_ = threadIdx.x; asm volatile("" : "+v"(tid_l_)); const int tid = tid_l_;
  const int iq = job & 3, jb = (job >> 2) % 96, l = (job >> 2) / 96;
  __syncthreads();
  for (int i = tid; i < 768; i += 256) {
    int r = i >> 8, idx = iq * 256 + (i & 255);
    float v = (r == 0) ? p.c_ctx[idx] : p.c[(r - 1) * 1024 + idx];
    sc[i] = siluf_(v);
  }
  __syncthreads();
  const int jl = tid & 63, ig = tid >> 6, j = jb * 64 + jl;
  const float* W = p.ada_w + (size_t)l * 1024 * 6144 + (size_t)(iq * 256 + ig * 64) * 6144 + j;
  float a0 = 0.f, a1 = 0.f, a2 = 0.f;
#pragma unroll 16
  for (int i = 0; i < 64; ++i) {
    float wv = W[(size_t)i * 6144];
    a0 += sc[ig * 64 + i] * wv;
    a1 += sc[256 + ig * 64 + i] * wv;
    a2 += sc[512 + ig * 64 + i] * wv;
  }
  rd[(ig * 3 + 0) * 64 + jl] = a0;
  rd[(ig * 3 + 1) * 64 + jl] = a1;
  rd[(ig * 3 + 2) * 64 + jl] = a2;
  __syncthreads();
  if (tid < 192) {
    int r = tid >> 6, jl2 = tid & 63, j2 = jb * 64 + jl2;
    float sacc = (iq == 0) ? p.ada_b[l * 6144 + j2] : 0.f;
    for (int q = 0; q < 4; ++q) sacc += rd[(q * 3 + r) * 64 + jl2];
    atomicAdd(p.mod + (size_t)(l * 3 + r) * 6144 + j2, sacc);
  }
}

__device__ __forceinline__ void filter_job(const Params& p, int job, char* smem) {
  float* sh2 = (float*)smem;
  int tid_l_ = threadIdx.x; asm volatile("" : "+v"(tid_l_)); const int tid = tid_l_, lane = tid & 63, w = tid >> 6;
  int L, pos0;
  bh* gt;
  if (job < 64) { L = 256; pos0 = job * 4; gt = p.gt256; }
  else { L = 2048; pos0 = (job - 64) * 4; gt = p.gt2048; }
  __syncthreads();
  {
    const int pos = pos0 + w;
    const float t = (float)pos / (float)(L - 1);
    const float wv = 2.0f * 3.14159265358979323846f * (float)pos / (float)L;
    float zv = 0.f;
    if (lane == 0) zv = t;
    else if (lane <= 16) { float fb = 1e-4f + (float)(lane - 1) * ((15.0f - 1e-4f) / 15.0f); zv = cosf(fb * wv); }
    else if (lane <= 32) { float fb = 1e-4f + (float)(lane - 17) * ((15.0f - 1e-4f) / 15.0f); zv = -sinf(fb * wv); }
    const float fr = p.hy_freq[lane];
    float a = p.hy_b1[lane];
    for (int i = 0; i < 33; ++i) a += __shfl(zv, i) * p.hy_w1[i * 64 + lane];
    const float h1 = sinf(fr * a);
    a = p.hy_b2[lane];
    for (int i = 0; i < 64; ++i) a += __shfl(h1, i) * p.hy_w2[i * 64 + lane];
    sh2[w * 64 + lane] = sinf(fr * a);
  }
  __syncthreads();
  float acc[8][4];
#pragma unroll
  for (int m = 0; m < 8; ++m)
#pragma unroll
    for (int pp = 0; pp < 4; ++pp) acc[m][pp] = 0.f;
#pragma unroll 8
  for (int i = 0; i < 64; ++i) {
    const float h0 = sh2[i], h1 = sh2[64 + i], h2 = sh2[128 + i], h3 = sh2[192 + i];
#pragma unroll
    for (int m = 0; m < 8; ++m) {
      const float wv = p.hy_w3[i * 2048 + tid + 256 * m];
      acc[m][0] += wv * h0; acc[m][1] += wv * h1; acc[m][2] += wv * h2; acc[m][3] += wv * h3;
    }
  }
  const float min_decay = logf(1e-2f) / 1.5f, max_decay = logf(1e-2f) / 0.3f;
#pragma unroll
  for (int m = 0; m < 8; ++m) {
    const int o = tid + 256 * m;
    const int ord = o >> 10, side = (o >> 9) & 1, c = o & 511;
    const float delta = fabsf(min_decay + (float)c * ((max_decay - min_decay) / 511.0f));
    bh* grow = gt + (size_t)(ord * 512 + c) * (2 * L);
#pragma unroll
    for (int pp = 0; pp < 4; ++pp) {
      const int pos = pos0 + pp;
      const float t = (float)pos / (float)(L - 1);
      const bh val = f2bf(acc[m][pp] * expf(-t * delta));
      if (side == 0) grow[L - 1 - pos] = val;
      else if (pos >= 1) grow[L - 1 + pos] = val;
    }
  }
}

__device__ __forceinline__ void rows_job(const Params& p, int job, bool first, const bh* src, const float* gres, int lgate, int gate_idx,
                         const float* gnext, int lnext, int shift_idx) {
  int tid_l_ = threadIdx.x; asm volatile("" : "+v"(tid_l_)); const int tid = tid_l_, lane = tid & 63, w = tid >> 6;
  const int rowb = job * 8 + w * 2;
  const int r = rowb < NTP ? 0 : 1 + ((rowb - NTP) >> 11);
  float4 y[2][4], m[2][4];
#pragma unroll
  for (int rr = 0; rr < 2; ++rr) {
    const int row = rowb + rr;
    const float* xin = first ? (row < NTP ? p.x_prompt + (size_t)row * 1024 : p.x_sample + (size_t)(row - NTP) * 1024)
                             : p.out + (size_t)row * 1024;
#pragma unroll
    for (int i = 0; i < 4; ++i) y[rr][i] = *(const float4*)(xin + i * 256 + lane * 4);
    if (src) {
#pragma unroll
      for (int i = 0; i < 4; ++i) { const u32x2 mv = *(const u32x2*)(src + (size_t)row * 1024 + i * 256 + lane * 4); m[rr][i] = make_float4(bflo(mv[0]), bfhi(mv[0]), bflo(mv[1]), bfhi(mv[1])); }
    }
  }
  if (src) {
    const float* gate = p.mod + (size_t)(lgate * 3 + r) * 6144 + gate_idx * 1024;
    float4 gg[4], gt[4];
#pragma unroll
    for (int i = 0; i < 4; ++i) {
      gg[i] = *(const float4*)(gres + i * 256 + lane * 4);
      gt[i] = *(const float4*)(gate + i * 256 + lane * 4);
    }
#pragma unroll
    for (int rr = 0; rr < 2; ++rr) {
      float ss = 0.f;
#pragma unroll
      for (int i = 0; i < 4; ++i)
        ss += m[rr][i].x * m[rr][i].x + m[rr][i].y * m[rr][i].y + m[rr][i].z * m[rr][i].z + m[rr][i].w * m[rr][i].w;
      ss = wave_sum(ss);
      const float rs = rsqrtf(ss * (1.f / 1024.f) + EPSF);
#pragma unroll
      for (int i = 0; i < 4; ++i) {
        y[rr][i].x += gt[i].x * (m[rr][i].x * rs * gg[i].x);
        y[rr][i].y += gt[i].y * (m[rr][i].y * rs * gg[i].y);
        y[rr][i].z += gt[i].z * (m[rr][i].z * rs * gg[i].z);
        y[rr][i].w += gt[i].w * (m[rr][i].w * rs * gg[i].w);
      }
    }
  }
  if (src) {
#pragma unroll
    for (int rr = 0; rr < 2; ++rr)
#pragma unroll
      for (int i = 0; i < 4; ++i) *(float4*)(p.out + (size_t)(rowb + rr) * 1024 + i * 256 + lane * 4) = y[rr][i];
  }
  if (gnext) {
    const float* sh = p.mod + (size_t)(lnext * 3 + r) * 6144 + shift_idx * 1024;
    const float* scl = sh + 1024;
    float4 gg[4], s4[4], c4[4];
#pragma unroll
    for (int i = 0; i < 4; ++i) {
      gg[i] = *(const float4*)(gnext + i * 256 + lane * 4);
      s4[i] = *(const float4*)(sh + i * 256 + lane * 4);
      c4[i] = *(const float4*)(scl + i * 256 + lane * 4);
    }
#pragma unroll
    for (int rr = 0; rr < 2; ++rr) {
      float ss = 0.f;
#pragma unroll
      for (int i = 0; i < 4; ++i)
        ss += y[rr][i].x * y[rr][i].x + y[rr][i].y * y[rr][i].y + y[rr][i].z * y[rr][i].z + y[rr][i].w * y[rr][i].w;
      ss = wave_sum(ss);
      const float rs = rsqrtf(ss * (1.f / 1024.f) + EPSF);
      bh* arow = p.act + (size_t)(rowb + rr) * 1024;
#pragma unroll
      for (int i = 0; i < 4; ++i) {
        ushort4 o;
        o.x = f2bf(y[rr][i].x * rs * gg[i].x * (1.f + c4[i].x) + s4[i].x);
        o.y = f2bf(y[rr][i].y * rs * gg[i].y * (1.f + c4[i].y) + s4[i].y);
        o.z = f2bf(y[rr][i].z * rs * gg[i].z * (1.f + c4[i].z) + s4[i].z);
        o.w = f2bf(y[rr][i].w * rs * gg[i].w * (1.f + c4[i].w) + s4[i].w);
        *(ushort4*)(arow + i * 256 + lane * 4) = o;
      }
    }
  }
}

template <int CTRL>
__device__ __forceinline__ float dppf(float v) {
  return __int_as_float(__builtin_amdgcn_update_dpp(0, __float_as_int(v), CTRL, 0xF, 0xF, true));
}
__device__ __forceinline__ float sum16(float v) {
  v += dppf<0xB1>(v); v += dppf<0x4E>(v); v += dppf<0x141>(v); v += dppf<0x140>(v);
  return v;
}
__device__ __forceinline__ float max16(float v) {
  v = fmaxf(v, dppf<0xB1>(v)); v = fmaxf(v, dppf<0x4E>(v)); v = fmaxf(v, dppf<0x141>(v)); v = fmaxf(v, dppf<0x140>(v));
  return v;
}

typedef short s16x4 __attribute__((ext_vector_type(4)));

#define OFF_SC_EVEN 188743680ull
#define OFF_SC_ODD 79691776ull
#define SC_SLOC 8388608ull
#define SC_DECT 16777216ull

template <int MODE, int SKIP = 0>
__device__ __forceinline__ void scan2_unit(const Params& p, int unit, char* smem) {
  constexpr int DK = MODE == 0 ? 128 : 64;
  constexpr int LD = MODE == 0 ? 4096 : 3104;
  constexpr int NQ = DK / 32;
  constexpr int NP = 256 / DK;
  constexpr int TPP = 16 / NP;
  constexpr int RS = DK + 8;
  constexpr int TPT = DK / 8;
  float* sq = (float*)smem;
  float* slf = sq + 16 * DK;
  float* skk = slf + 16 * DK;
  bh* QE = (bh*)(skk + 16 * DK);
  bh* KE = QE + 16 * RS;
  bh* KLT = KE + 16 * RS;
  bh* VT = KLT + DK * 24;
  float* dec = (float*)(VT + 128 * 24);
  float* sx = dec + DK;
  int tid_l_ = threadIdx.x; asm volatile("" : "+v"(tid_l_)); const int tid = tid_l_, lane = tid & 63, w = tid >> 6, r = lane & 15, g = lane >> 4;
  const int dir = unit & 1, h = (unit >> 1) & 3, ss = unit >> 3;
  const bool samp = ss >= 32;
  const int sb = (ss - 32) >> 3, seg = (ss - 32) & 7;
  const int rbase = samp ? (NTP + sb * 2048 + (dir ? 2047 - seg * 256 : seg * 256)) : (ss * 256 + (dir ? 255 : 0));
  const int sgn = dir ? -1 : 1;
  const bh* proj = (const bh*)p.R;
  char* scbase = p.R + (MODE == 0 ? OFF_SC_EVEN : OFF_SC_ODD);
  bh* QB = (bh*)scbase;
  float* odir = (float*)(p.R + OFF_ODIR) + (size_t)dir * NT * 512;
  __syncthreads();
  if (MODE == 0) {
    for (int k = tid; k < 128; k += 256) {
      int ci = dir * 512 + h * 128 + k;
      float x0 = p.hgrn_lb[ci], x1 = p.hgrn_lb[1024 + ci], x2 = p.hgrn_lb[2048 + ci];
      float mx = fmaxf(x0, fmaxf(x1, x2));
      float e0 = expf(x0 - mx), e1 = expf(x1 - mx), e2 = expf(x2 - mx);
      sx[k] = e0 / (e0 + e1 + e2);
    }
  } else {
    for (int i = tid; i < 1024; i += 256) {
      int rr = i >> 6, k = i & 63;
      sx[i] = p.gla_aw[(size_t)(dir * 16 + rr) * 256 + h * 64 + k];
    }
    if (tid < 64) sx[1024 + tid] = p.gla_ab[dir * 256 + h * 64 + tid];
  }
  f32x4 S[2 * NQ][2];
#pragma unroll
  for (int a = 0; a < 2 * NQ; ++a) { S[a][0] = (f32x4){0.f, 0.f, 0.f, 0.f}; S[a][1] = (f32x4){0.f, 0.f, 0.f, 0.f}; }
  constexpr int EPT = MODE == 0 ? 8 : 4;
  const int li = tid >> 4, lk8 = (tid & 15) * EPT;
  const int vi = tid >> 4, v8 = (tid & 15) * 8;
  const int pk = tid % DK, ppart = tid / DK;
  float basec = 0.f;
  u32x4 rq = {0, 0, 0, 0}, rf = {0, 0, 0, 0}, rv = {0, 0, 0, 0}, rd0 = {0, 0, 0, 0}, rd1 = {0, 0, 0, 0};
  auto issue = [&](int c) {
    {
      const bh* pr = proj + (size_t)(rbase + sgn * (c * 16 + li)) * LD;
      if (MODE == 0) {
        rq = *(const u32x4*)(pr + h * 128 + lk8);
        rf = *(const u32x4*)(pr + 512 + dir * 512 + h * 128 + lk8);
      } else {
        const u32x2 q2 = *(const u32x2*)(pr + 1536 + h * 64 + lk8);
        const u32x2 k2 = *(const u32x2*)(pr + 1792 + h * 64 + lk8);
        rq[0] = q2[0]; rq[1] = q2[1]; rf[0] = k2[0]; rf[1] = k2[1];
        rd0 = *(const u32x4*)(pr + 3072 + dir * 16);
        rd1 = *(const u32x4*)(pr + 3072 + dir * 16 + 8);
      }
    }
    {
      const bh* pr = proj + (size_t)(rbase + sgn * (c * 16 + vi)) * LD;
      rv = *(const u32x4*)(pr + (MODE == 0 ? 1536 : 2048) + h * 128 + v8);
    }
  };
  issue(0);
#pragma unroll 1
  for (int c = 0; c < 16; ++c) {
    __syncthreads();
    if (SKIP != 3) {
      float oq[EPT], ol[EPT], ok[EPT];
      if (MODE == 0) {
#pragma unroll
        for (int e = 0; e < EPT; ++e) {
          float q = (e & 1) ? bfhi(rq[e >> 1]) : bflo(rq[e >> 1]);
          float ff = (e & 1) ? bfhi(rf[e >> 1]) : bflo(rf[e >> 1]);
          float lb = sx[lk8 + e];
          float f = lb + (1.f - lb) * sigmoidf_(ff);
          oq[e] = siluf_(q) * 0.08838834764831845f;
          ol[e] = __logf(f);
          ok[e] = 1.f - f;
        }
      } else {
        float da[16];
#pragma unroll
        for (int rr = 0; rr < 16; ++rr) {
          unsigned wd = rr < 8 ? rd0[(rr & 7) >> 1] : rd1[(rr & 7) >> 1];
          da[rr] = (rr & 1) ? bfhi(wd) : bflo(wd);
        }
        float xx[4];
        {
          float4 b0_ = *(const float4*)(sx + 1024 + lk8);
          xx[0] = b0_.x; xx[1] = b0_.y; xx[2] = b0_.z; xx[3] = b0_.w;
        }
#pragma unroll
        for (int rr = 0; rr < 16; ++rr) {
          float4 a0_ = *(const float4*)(sx + rr * 64 + lk8);
          xx[0] += da[rr] * a0_.x; xx[1] += da[rr] * a0_.y; xx[2] += da[rr] * a0_.z; xx[3] += da[rr] * a0_.w;
        }
#pragma unroll
        for (int e = 0; e < 4; ++e) {
          float q = (e & 1) ? bfhi(rq[e >> 1]) : bflo(rq[e >> 1]);
          float kk = (e & 1) ? bfhi(rf[e >> 1]) : bflo(rf[e >> 1]);
          float x = xx[e];
          float ls = fminf(x, 0.f) - __logf(1.f + __expf(-fabsf(x)));
          oq[e] = q * 0.125f;
          ol[e] = ls * 0.0625f;
          ok[e] = kk;
        }
      }
      float* dq_ = sq + li * DK + lk8;
      float* dl_ = slf + li * DK + lk8;
      float* dk_ = skk + li * DK + lk8;
#pragma unroll
      for (int e4 = 0; e4 < EPT; e4 += 4) {
        *(float4*)(dq_ + e4) = make_float4(oq[e4], oq[e4 + 1], oq[e4 + 2], oq[e4 + 3]);
        *(float4*)(dl_ + e4) = make_float4(ol[e4], ol[e4 + 1], ol[e4 + 2], ol[e4 + 3]);
        *(float4*)(dk_ + e4) = make_float4(ok[e4], ok[e4 + 1], ok[e4 + 2], ok[e4 + 3]);
      }
    }
#pragma unroll
    for (int e = 0; e < 8; ++e) {
      unsigned wv = rv[e >> 1];
      VT[(v8 + e) * 24 + vi] = (bh)((e & 1) ? (wv >> 16) : (wv & 0xffffu));
    }
    __syncthreads();
    if (c + 1 < 16) issue(c + 1);
    {
      float total = 0.f, pre = 0.f;
#pragma unroll
      for (int i = 0; i < 16; ++i) {
        float l = slf[i * DK + pk];
        if (i < ppart * TPP) pre += l;
        total += l;
      }
      unsigned kw[TPP / 2];
#pragma unroll
      for (int ii = 0; ii < TPP; ii += 2) {
        float klv[2];
#pragma unroll
        for (int u = 0; u < 2; ++u) {
          const int i = ppart * TPP + ii + u;
          pre += slf[i * DK + pk];
          const float qv = sq[i * DK + pk], kv = skk[i * DK + pk];
          QE[i * RS + pk] = f2bf(qv * __expf(pre));
          KE[i * RS + pk] = f2bf(kv * __expf(-pre));
          klv[u] = kv * __expf(total - pre);
          if (samp) {
            const int row = rbase + sgn * (c * 16 + i);
            QB[((size_t)dir * 4096 + (row - NTP)) * (4 * DK) + h * DK + pk] = f2bf(qv * __expf(basec + pre));
          }
        }
        kw[ii >> 1] = pk2(klv[0], klv[1]);
      }
      if (TPP == 8) {
        u32x4 kv4 = {kw[0], kw[1], kw[(TPP / 2) > 2 ? 2 : 0], kw[(TPP / 2) > 3 ? 3 : 0]};
        *(u32x4*)(KLT + pk * 24 + ppart * 8) = kv4;
      } else {
        u32x2 kv2 = {kw[0], kw[1]};
        *(u32x2*)(KLT + pk * 24 + ppart * 4) = kv2;
      }
      if (ppart == 0) dec[pk] = __expf(total);
      basec += total;
    }
    __syncthreads();
    {
      bf16x8 qf[NQ], kf[NQ];
#pragma unroll
      for (int q = 0; q < NQ; ++q) {
        qf[q] = *(const bf16x8*)(QE + r * RS + q * 32 + g * 8);
        kf[q] = *(const bf16x8*)(KE + r * RS + q * 32 + g * 8);
      }
      f32x4 at = (f32x4){0.f, 0.f, 0.f, 0.f};
#pragma unroll
      for (int q = 0; q < NQ; ++q) at = __builtin_amdgcn_mfma_f32_16x16x32_bf16(kf[q], qf[q], at, 0, 0, 0);
      u32x2 paw;
      paw[0] = pk2((g * 4 + 0 <= r) ? at[0] : 0.f, (g * 4 + 1 <= r) ? at[1] : 0.f);
      paw[1] = pk2((g * 4 + 2 <= r) ? at[2] : 0.f, (g * 4 + 3 <= r) ? at[3] : 0.f);
      const s16x4 pa = __builtin_bit_cast(s16x4, paw);
      s16x4 vf[2];
      f32x4 o[2];
#pragma unroll
      for (int nt = 0; nt < 2; ++nt) {
        vf[nt] = *(const s16x4*)(VT + (w * 32 + nt * 16 + r) * 24 + g * 4);
        o[nt] = __builtin_amdgcn_mfma_f32_16x16x16bf16_1k(pa, vf[nt], (f32x4){0.f, 0.f, 0.f, 0.f}, 0, 0, 0);
      }
#pragma unroll
      for (int q = 0; q < NQ; ++q) {
#pragma unroll
        for (int half = 0; half < 2; ++half) {
          const s16x4 qa = half == 0 ? __builtin_shufflevector(qf[q], qf[q], 0, 1, 2, 3)
                                     : __builtin_shufflevector(qf[q], qf[q], 4, 5, 6, 7);
#pragma unroll
          for (int nt = 0; nt < 2; ++nt) {
            const f32x4 sv_ = S[2 * q + half][nt];
            u32x2 sw;
            sw[0] = pk2(sv_[0], sv_[1]);
            sw[1] = pk2(sv_[2], sv_[3]);
            o[nt] = __builtin_amdgcn_mfma_f32_16x16x16bf16_1k(qa, __builtin_bit_cast(s16x4, sw), o[nt], 0, 0, 0);
          }
        }
      }
#pragma unroll
      for (int nt = 0; nt < 2; ++nt)
#pragma unroll
        for (int j = 0; j < 4; ++j) {
          const int row = rbase + sgn * (c * 16 + g * 4 + j);
          odir[(size_t)row * 512 + h * 128 + w * 32 + nt * 16 + r] = o[nt][j];
        }
#pragma unroll
      for (int q = 0; q < NQ; ++q) {
#pragma unroll
        for (int half = 0; half < 2; ++half) {
          const float4 d4 = *(const float4*)(dec + q * 32 + g * 8 + half * 4);
          const int ka = q * 32 + (r >> 2) * 8 + half * 4 + (r & 3);
          const s16x4 ka4 = *(const s16x4*)(KLT + ka * 24 + g * 4);
#pragma unroll
          for (int nt = 0; nt < 2; ++nt) {
            f32x4 sv_ = S[2 * q + half][nt];
            sv_[0] *= d4.x; sv_[1] *= d4.y; sv_[2] *= d4.z; sv_[3] *= d4.w;
            S[2 * q + half][nt] = __builtin_amdgcn_mfma_f32_16x16x16bf16_1k(ka4, vf[nt], sv_, 0, 0, 0);
          }
        }
      }
    }
  }
  {
    float* so;
    if (!samp) so = p.out + (MODE == 0 ? OUT_HGRN : OUT_GLA) + ((size_t)(ss * 2 + dir) * 4 + h) * DK * 128;
    else {
      const int us = ((sb * 4 + h) * 2 + dir) * 8 + seg;
      so = (float*)(scbase + SC_SLOC) + (size_t)us * DK * 128;
      if (ppart == 0) ((float*)(scbase + SC_DECT))[us * DK + pk] = __expf(basec);
    }
#pragma unroll
    for (int q = 0; q < NQ; ++q)
#pragma unroll
      for (int half = 0; half < 2; ++half)
#pragma unroll
        for (int nt = 0; nt < 2; ++nt)
#pragma unroll
          for (int j = 0; j < 4; ++j)
            so[(size_t)(q * 32 + g * 8 + half * 4 + j) * 128 + w * 32 + nt * 16 + r] = S[2 * q + half][nt][j];
  }
}

template <int MODE>
__device__ __forceinline__ void fixup_unit(const Params& p, int unit, char* smem) {
  constexpr int DK = MODE == 0 ? 128 : 64;
  constexpr int NQ = DK / 32;
  constexpr int RS = DK + 8;
  bh* ST = (bh*)smem;
  int tid_l_ = threadIdx.x; asm volatile("" : "+v"(tid_l_)); const int tid = tid_l_, lane = tid & 63, w = tid >> 6, r = lane & 15, g = lane >> 4;
  const int seg = unit & 7, dir = (unit >> 3) & 1, h = (unit >> 4) & 3, sb = unit >> 6;
  const int unit0 = unit & ~7;
  char* scbase = p.R + (MODE == 0 ? OFF_SC_EVEN : OFF_SC_ODD);
  const bh* QB = (const bh*)scbase;
  const float* SLOC = (const float*)(scbase + SC_SLOC);
  const float* DECT = (const float*)(scbase + SC_DECT);
  const float* s0 = (MODE == 0 ? p.state_hgrn : p.state_gla) + ((size_t)(sb * 2 + dir) * 4 + h) * DK * 128;
  float* odir = (float*)(p.R + OFF_ODIR) + (size_t)dir * NT * 512;
  __syncthreads();
  for (int m = 0; m < DK * 128 / 256; ++m) {
    const int e = tid + 256 * m, k = e >> 7, v = e & 127;
    float cur = s0[e];
    for (int jj = 0; jj < seg; ++jj)
      cur = DECT[(unit0 + jj) * DK + k] * cur + SLOC[(size_t)(unit0 + jj) * DK * 128 + e];
    ST[v * RS + k] = f2bf(cur);
  }
  __syncthreads();
  const int rbase = NTP + sb * 2048 + (dir ? 2047 - seg * 256 : seg * 256);
  const int sgn = dir ? -1 : 1;
#pragma unroll 1
  for (int mt = 0; mt < 4; ++mt) {
    f32x4 acc[8];
#pragma unroll
    for (int nt = 0; nt < 8; ++nt) acc[nt] = (f32x4){0.f, 0.f, 0.f, 0.f};
    const int rowa = rbase + sgn * (w * 64 + mt * 16 + r);
    const bh* qrow = QB + ((size_t)dir * 4096 + (rowa - NTP)) * (4 * DK) + h * DK + g * 8;
#pragma unroll
    for (int q = 0; q < NQ; ++q) {
      const bf16x8 a = *(const bf16x8*)(qrow + q * 32);
#pragma unroll
      for (int nt = 0; nt < 8; ++nt) {
        const bf16x8 b = *(const bf16x8*)(ST + (nt * 16 + r) * RS + q * 32 + g * 8);
        acc[nt] = __builtin_amdgcn_mfma_f32_16x16x32_bf16(a, b, acc[nt], 0, 0, 0);
      }
    }
#pragma unroll
    for (int nt = 0; nt < 8; ++nt)
#pragma unroll
      for (int j = 0; j < 4; ++j) {
        const int row = rbase + sgn * (w * 64 + mt * 16 + g * 4 + j);
        float* dst = odir + (size_t)row * 512 + h * 128 + nt * 16 + r;
        *dst += acc[nt][j];
      }
  }
}

__device__ __forceinline__ void scan_final_job(const Params& p, int job, int mode) {
  int tid_l_ = threadIdx.x; asm volatile("" : "+v"(tid_l_)); const int tid = tid_l_, lane = tid & 63, w = tid >> 6;
  const int rowb = job * 8 + w * 2;
  const int ld = mode == 0 ? 4096 : 3104;
  const int gcol = mode == 0 ? 2048 : 2560;
  const float* nrm = mode == 0 ? p.hgrn_norm : p.gla_norm;
  float2 a[2][4], b[2][4];
  unsigned gw[2][4];
#pragma unroll
  for (int rr = 0; rr < 2; ++rr) {
    const int row = rowb + rr;
    const float* o0 = (const float*)(p.R + OFF_ODIR) + (size_t)row * 512;
    const float* o1 = o0 + (size_t)NT * 512;
    const bh* proj = (const bh*)p.R + (size_t)row * ld;
#pragma unroll
    for (int h = 0; h < 4; ++h) {
      const int c = h * 128 + lane * 2;
      a[rr][h] = *(const float2*)(o0 + c);
      b[rr][h] = *(const float2*)(o1 + c);
      gw[rr][h] = *(const unsigned*)(proj + gcol + c);
    }
  }
  float2 nv[4];
#pragma unroll
  for (int h = 0; h < 4; ++h) nv[h] = *(const float2*)(nrm + h * 128 + lane * 2);
#pragma unroll
  for (int rr = 0; rr < 2; ++rr) {
    bh* arow = p.act + (size_t)(rowb + rr) * 1024 + (mode == 0 ? 0 : 512);
#pragma unroll
    for (int h = 0; h < 4; ++h) {
      const int c = h * 128 + lane * 2;
      float v0 = a[rr][h].x + b[rr][h].x, v1 = a[rr][h].y + b[rr][h].y;
      float ss = wave_sum(v0 * v0 + v1 * v1);
      float rs = rsqrtf(ss * (1.f / 128.f) + EPSF);
      float g0 = bflo(gw[rr][h]), g1 = bfhi(gw[rr][h]);
      *(unsigned*)(arow + c) = pk2(v0 * rs * nv[h].x * siluf_(g0), v1 * rs * nv[h].y * siluf_(g1));
    }
  }
}

using f32x16 = __attribute__((ext_vector_type(16))) float;
__device__ __forceinline__ bf16x8 toep_frag(const unsigned* Gd, int m0) {
  const int q = m0 >> 1;
  const unsigned sh = (unsigned)(m0 & 1) * 2u;
  const unsigned D0 = Gd[q], D1 = Gd[q + 1], D2 = Gd[q + 2], D3 = Gd[q + 3], D4 = Gd[q + 4];
  u32x4 f;
  f[0] = __builtin_amdgcn_alignbyte(D1, D0, sh);
  f[1] = __builtin_amdgcn_alignbyte(D2, D1, sh);
  f[2] = __builtin_amdgcn_alignbyte(D3, D2, sh);
  f[3] = __builtin_amdgcn_alignbyte(D4, D3, sh);
  return __builtin_bit_cast(bf16x8, f);
}
__device__ __forceinline__ void conv4(const bh* raw, int t, int L, float w0, float w1, float w2, float bb, float* out) {
  const u32x2 x = *(const u32x2*)(raw + t);
  const float xm = t > 0 ? bf2f(raw[t - 1]) : 0.f;
  const float xp = (t + 4 < L) ? bf2f(raw[t + 4]) : 0.f;
  const float x0 = bflo(x[0]), x1 = bfhi(x[0]), x2 = bflo(x[1]), x3 = bfhi(x[1]);
  out[0] = w0 * xm + w1 * x0 + w2 * x1 + bb;
  out[1] = w0 * x0 + w1 * x1 + w2 * x2 + bb;
  out[2] = w0 * x1 + w1 * x2 + w2 * x3 + bb;
  out[3] = w0 * x2 + w1 * x3 + w2 * xp + bb;
}
__device__ __forceinline__ u32x4 conv8(const bh* raw, int t, int L, float w0, float w1, float w2, float bb) {
  const u32x4 x = *(const u32x4*)(raw + t);
  float v[10];
  v[0] = t > 0 ? bf2f(raw[t - 1]) : 0.f;
  v[9] = (t + 8 < L) ? bf2f(raw[t + 8]) : 0.f;
#pragma unroll
  for (int e = 0; e < 4; ++e) { v[1 + 2 * e] = bflo(x[e]); v[2 + 2 * e] = bfhi(x[e]); }
  u32x4 o;
#pragma unroll
  for (int e = 0; e < 4; ++e)
    o[e] = pk2(w0 * v[2 * e] + w1 * v[2 * e + 1] + w2 * v[2 * e + 2] + bb, w0 * v[2 * e + 1] + w1 * v[2 * e + 2] + w2 * v[2 * e + 3] + bb);
  return o;
}

__device__ __forceinline__ void hyena_sample_job(const Params& p, int job, char* smem) {
  int tid_l_ = threadIdx.x; asm volatile("" : "+v"(tid_l_)); const int tid = tid_l_, lane = tid & 63, w = tid >> 6;
  const int col = lane & 31, kh = lane >> 5;
  const int cc = w >> 1, nh = w & 1;
  const int sb = job & 1, c0 = (job >> 1) * 2, c = c0 + cc;
  bh* G = (bh*)(smem + cc * 12288);
  bh* U = G + 4096;
  const unsigned* Gd = (const unsigned*)G;
  const bh* HYT = (const bh*)(p.R + OFF_HYT);
  const int rowoff = NTP + sb * 2048;
  __syncthreads();
  {
    const float vw0 = p.hy_conv_w[c], vw1 = p.hy_conv_w[1536 + c], vw2 = p.hy_conv_w[3072 + c], vb = p.hy_conv_b[c];
    const bh* raw = HYT + (size_t)c * NT + rowoff;
#pragma unroll
    for (int i = 0; i < 2; ++i) {
      const int t0 = (nh * 128 + lane + 64 * i) * 8;
      *(u32x4*)(U + t0) = conv8(raw, t0, 2048, vw0, vw1, vw2, vb);
    }
  }
#pragma unroll 1
  for (int ord = 0; ord < 2; ++ord) {
    {
      const bh* gsrc = p.gt2048 + (size_t)(ord * 512 + c) * 4096;
#pragma unroll
      for (int i = 0; i < 4; ++i) {
        const int e8 = (nh * 256 + lane + 64 * i) * 8;
        *(u32x4*)(G + e8) = *(const u32x4*)(gsrc + e8);
      }
    }
    __syncthreads();
    f32x16 acc;
#pragma unroll
    for (int i = 0; i < 16; ++i) acc[i] = 0.f;
    const int mbase = 2047 - col + kh * 8;
    const int dlo = nh == 0 ? -63 : -31, dhi = nh == 0 ? 31 : 63;
#pragma unroll 2
    for (int d = dlo; d <= dhi; ++d) {
      const bf16x8 a0 = toep_frag(Gd, mbase - d * 32);
      const bf16x8 a1 = toep_frag(Gd, mbase - d * 32 + 16);
      const int s1 = nh * 32 + col - d;
      const bool ok = (unsigned)s1 < 64u;
      const int s1c = ok ? s1 : 0;
      u32x4 b0 = *(const u32x4*)(U + s1c * 32 + kh * 8);
      u32x4 b1 = *(const u32x4*)(U + s1c * 32 + 16 + kh * 8);
      if (!ok) { b0 = (u32x4){0, 0, 0, 0}; b1 = (u32x4){0, 0, 0, 0}; }
      acc = __builtin_amdgcn_mfma_f32_32x32x16_bf16(a0, __builtin_bit_cast(bf16x8, b0), acc, 0, 0, 0);
      acc = __builtin_amdgcn_mfma_f32_32x32x16_bf16(a1, __builtin_bit_cast(bf16x8, b1), acc, 0, 0, 0);
    }
    __syncthreads();
    const int gi = (ord + 1) * 512 + c;
    const float gw0 = p.hy_conv_w[gi], gw1 = p.hy_conv_w[1536 + gi], gw2 = p.hy_conv_w[3072 + gi], gb = p.hy_conv_b[gi];
    const float dd = p.hy_d[ord * 512 + c];
    const bh* graw = HYT + (size_t)gi * NT + rowoff;
#pragma unroll
    for (int rq = 0; rq < 4; ++rq) {
      const int trun = (nh * 32 + col) * 32 + 8 * rq + 4 * kh;
      float gte[4];
      conv4(graw, trun, 2048, gw0, gw1, gw2, gb, gte);
      const u32x2 uo = *(const u32x2*)(U + trun);
      u32x2 zo;
      zo[0] = pk2(gte[0] * (acc[rq * 4 + 0] + bflo(uo[0]) * dd), gte[1] * (acc[rq * 4 + 1] + bfhi(uo[0]) * dd));
      zo[1] = pk2(gte[2] * (acc[rq * 4 + 2] + bflo(uo[1]) * dd), gte[3] * (acc[rq * 4 + 3] + bfhi(uo[1]) * dd));
      *(u32x2*)(U + trun) = zo;
    }
    __syncthreads();
  }
#pragma unroll
  for (int rr = 0; rr < 8; ++rr) {
    const int t = tid + 256 * rr;
    const unsigned z0 = *(const bh*)(smem + 8192 + t * 2);
    const unsigned z1 = *(const bh*)(smem + 12288 + 8192 + t * 2);
    *(unsigned*)(p.act + (size_t)(rowoff + t) * 1024 + 512 + c0) = z0 | (z1 << 16);
  }
}

__device__ __forceinline__ void hyena_prompt_job(const Params& p, int job, char* smem) {
  int tid_l_ = threadIdx.x; asm volatile("" : "+v"(tid_l_)); const int tid = tid_l_, lane = tid & 63, w = tid >> 6;
  const int col = lane & 31, kh = lane >> 5;
  const int cc = w >> 1, th = w & 1;
  const int c0 = job * 2, c = c0 + cc;
  bh* Uall = (bh*)smem;
  bh* Gall = (bh*)(smem + 2 * 32 * 264 * 2);
  bh* U = Uall + cc * 32 * 264;
  const unsigned* Gd = (const unsigned*)(Gall + cc * 512);
  const bh* HYT = (const bh*)(p.R + OFF_HYT);
  __syncthreads();
#pragma unroll 1
  for (int c2 = 0; c2 < 2; ++c2) {
    const int ch = c0 + c2;
    const float vw0 = p.hy_conv_w[ch], vw1 = p.hy_conv_w[1536 + ch], vw2 = p.hy_conv_w[3072 + ch], vb = p.hy_conv_b[ch];
#pragma unroll
    for (int i = 0; i < 4; ++i) {
      const int tg = (tid + 256 * i) * 8, b = tg >> 8, t = tg & 255;
      *(u32x4*)(Uall + c2 * 32 * 264 + b * 264 + t) = conv8(HYT + (size_t)ch * NT + b * 256, t, 256, vw0, vw1, vw2, vb);
    }
  }
#pragma unroll 1
  for (int ord = 0; ord < 2; ++ord) {
    if (tid < 128) {
      const int c2 = tid >> 6, l2 = tid & 63;
      *(u32x4*)(Gall + c2 * 512 + l2 * 8) = *(const u32x4*)(p.gt256 + (size_t)(ord * 512 + c0 + c2) * 512 + l2 * 8);
    }
    __syncthreads();
    f32x16 acc[4];
#pragma unroll
    for (int q = 0; q < 4; ++q)
#pragma unroll
      for (int i = 0; i < 16; ++i) acc[q][i] = 0.f;
    const int mbase = 255 - col + kh * 8;
#pragma unroll
    for (int q = 0; q < 4; ++q) {
      const int t1 = th * 4 + q;
#pragma unroll 2
      for (int s1 = 0; s1 < 8; ++s1) {
        const int d = t1 - s1;
        const bf16x8 a0 = toep_frag(Gd, mbase - d * 32);
        const bf16x8 a1 = toep_frag(Gd, mbase - d * 32 + 16);
        const bf16x8 b0 = *(const bf16x8*)(U + col * 264 + s1 * 32 + kh * 8);
        const bf16x8 b1 = *(const bf16x8*)(U + col * 264 + s1 * 32 + 16 + kh * 8);
        acc[q] = __builtin_amdgcn_mfma_f32_32x32x16_bf16(a0, b0, acc[q], 0, 0, 0);
        acc[q] = __builtin_amdgcn_mfma_f32_32x32x16_bf16(a1, b1, acc[q], 0, 0, 0);
      }
    }
    __syncthreads();
    const int gi = (ord + 1) * 512 + c;
    const float gw0 = p.hy_conv_w[gi], gw1 = p.hy_conv_w[1536 + gi], gw2 = p.hy_conv_w[3072 + gi], gb = p.hy_conv_b[gi];
    const float dd = p.hy_d[ord * 512 + c];
    const bh* graw = HYT + (size_t)gi * NT + col * 256;
#pragma unroll
    for (int q = 0; q < 4; ++q)
#pragma unroll
      for (int rq = 0; rq < 4; ++rq) {
        const int trun = (th * 4 + q) * 32 + 8 * rq + 4 * kh;
        float gte[4];
        conv4(graw, trun, 256, gw0, gw1, gw2, gb, gte);
        bh* up = U + col * 264 + trun;
        const u32x2 uo = *(const u32x2*)up;
        u32x2 zo;
        zo[0] = pk2(gte[0] * (acc[q][rq * 4 + 0] + bflo(uo[0]) * dd), gte[1] * (acc[q][rq * 4 + 1] + bfhi(uo[0]) * dd));
        zo[1] = pk2(gte[2] * (acc[q][rq * 4 + 2] + bflo(uo[1]) * dd), gte[3] * (acc[q][rq * 4 + 3] + bfhi(uo[1]) * dd));
        *(u32x2*)up = zo;
      }
    __syncthreads();
  }
#pragma unroll 4
  for (int i = 0; i < 32; ++i) {
    const int e = tid + 256 * i, b = e >> 8, t = e & 255;
    const unsigned z0 = Uall[b * 264 + t], z1 = Uall[32 * 264 + b * 264 + t];
    *(unsigned*)(p.act + (size_t)e * 1024 + 512 + c0) = z0 | (z1 << 16);
  }
}

__device__ __forceinline__ void oddrow_job(const Params& p, int job) {
  int tid_l_ = threadIdx.x; asm volatile("" : "+v"(tid_l_)); const int tid = tid_l_, lane = tid & 63, w = tid >> 6;
  const int row = job * 4 + w;
  const bh* pr = (const bh*)p.R + (size_t)row * 3104;
  bh* Q = (bh*)(p.R + OFF_Q) + (size_t)row * 512;
  bh* KB = (bh*)(p.R + OFF_KB);
  if (row < NTP) {
    const int b = row >> 8, t = row & 255;
    const int e0 = lane * 8, h = e0 >> 7, x = e0 & 127;
    const u32x4 qv = *(const u32x4*)(pr + e0);
    const u32x4 kv = *(const u32x4*)(pr + 512 + e0);
    const u32x4 vv = *(const u32x4*)(pr + 1024 + e0);
    const size_t idx = ((size_t)(b * 4 + h) * 256 + t) * 128 + x;
    *(u32x4*)(Q + e0) = qv;
    *(u32x4*)(KB + idx) = kv;
    float4 k0 = make_float4(bflo(kv[0]), bfhi(kv[0]), bflo(kv[1]), bfhi(kv[1]));
    float4 k1 = make_float4(bflo(kv[2]), bfhi(kv[2]), bflo(kv[3]), bfhi(kv[3]));
    float4 v0 = make_float4(bflo(vv[0]), bfhi(vv[0]), bflo(vv[1]), bfhi(vv[1]));
    float4 v1 = make_float4(bflo(vv[2]), bfhi(vv[2]), bflo(vv[3]), bfhi(vv[3]));
    *(float4*)(p.out + OUT_CK + idx) = k0;
    *(float4*)(p.out + OUT_CK + idx + 4) = k1;
    *(float4*)(p.out + OUT_CV + idx) = v0;
    *(float4*)(p.out + OUT_CV + idx + 4) = v1;
  } else {
    const int sb = (row - NTP) >> 11, t = (row - NTP) & 2047;
    const int rpos = t >> 6, cpos = t & 63;
    float q1[4], q2[4], k1[4], k2[4];
#pragma unroll
    for (int m = 0; m < 4; ++m) {
      int pi = lane + 64 * m;
      int h = pi >> 6, rem = pi & 63, pp = rem >> 5, part = (rem >> 4) & 1, i = rem & 15;
      int d1 = h * 128 + pp * 64 + part * 32 + i, d2 = d1 + 16;
      q1[m] = bf2f(pr[d1]); q2[m] = bf2f(pr[d2]);
      k1[m] = bf2f(pr[512 + d1]); k2[m] = bf2f(pr[512 + d2]);
    }
#pragma unroll
    for (int m = 0; m < 4; ++m) {
      int pi = lane + 64 * m;
      int h = pi >> 6, rem = pi & 63, pp = rem >> 5, part = (rem >> 4) & 1, i = rem & 15;
      int d1 = h * 128 + pp * 64 + part * 32 + i, d2 = d1 + 16;
      float pos = (float)(part ? cpos : rpos);
      float inv = expf(-(float)i * (9.210340371976184f / 16.f));
      float ang = pos * inv;
      float cs = cosf(ang), sn = sinf(ang);
      Q[d1] = f2bf(q1[m] * cs - q2[m] * sn);
      Q[d2] = f2bf(q1[m] * sn + q2[m] * cs);
      size_t kb = KV_SAMPLE_BASE + ((size_t)(sb * 4 + h) * 2304 + 256 + t) * 128;
      KB[kb + (d1 - h * 128)] = f2bf(k1[m] * cs - k2[m] * sn);
      KB[kb + (d2 - h * 128)] = f2bf(k1[m] * sn + k2[m] * cs);
    }
  }
}
__device__ __forceinline__ void ctxk_job(const Params& p, int job) {
  bh* KB = (bh*)(p.R + OFF_KB);
  int tidl = threadIdx.x; asm volatile("" : "+v"(tidl));
#pragma unroll
  for (int i = 0; i < 4; ++i) {
    int e = job * 1024 + i * 256 + tidl;
    int x = e & 127, j = (e >> 7) & 255, hh = (e >> 15) & 3, sb = e >> 17;
    KB[KV_SAMPLE_BASE + ((size_t)(sb * 4 + hh) * 2304 + j) * 128 + x] = f2bf(p.cache_k[e]);
  }
}
__device__ __forceinline__ void vt_job(const Params& p, int job, char* smem) {
  bh* tl = (bh*)smem;
  int tid_l_ = threadIdx.x; asm volatile("" : "+v"(tid_l_)); const int tid = tid_l_;
  int seq, h, kt, Lk;
  if (job < 288) { seq = 32 + job / 144; int r = job % 144; h = r / 36; kt = r % 36; Lk = 2304; }
  else { int j = job - 288; seq = j >> 4; h = (j >> 2) & 3; kt = j & 3; Lk = 256; }
  const bh* proj = (const bh*)p.R;
  __syncthreads();
#pragma unroll 16
  for (int i = 0; i < 32; ++i) {
    int e = tid + i * 256, key = e >> 7, dv = e & 127;
    bh val;
    if (seq < 32) val = proj[(size_t)(seq * 256 + kt * 64 + key) * 3104 + 1024 + h * 128 + dv];
    else if (kt < 4) val = f2bf(p.cache_v[((size_t)((seq - 32) * 4 + h) * 256 + kt * 64 + key) * 128 + dv]);
    else val = proj[(size_t)(NTP + (seq - 32) * 2048 + (kt - 4) * 64 + key) * 3104 + 1024 + h * 128 + dv];
    tl[key * 130 + dv] = val;
  }
  __syncthreads();
  bh* VT = (bh*)(p.R + OFF_VT) + (seq < 32 ? (size_t)(seq * 4 + h) * 128 * 256
                                            : (size_t)KV_SAMPLE_BASE + (size_t)((seq - 32) * 4 + h) * 128 * 2304);
#pragma unroll 4
  for (int i = 0; i < 32; ++i) {
    int e = tid + i * 256, dv = e >> 6, key = e & 63;
    VT[(size_t)dv * Lk + kt * 64 + key] = tl[key * 130 + dv];
  }
}

__device__ __forceinline__ void attn_unit(const Params& p, int unit, char* smem) {
  bh* Pl = (bh*)smem;
  float* sred = (float*)(smem + 10240);
  int tid_l_ = threadIdx.x; asm volatile("" : "+v"(tid_l_)); const int tid = tid_l_, lane = tid & 63, w = tid >> 6, r = lane & 15, g = lane >> 4;
  int seq, h, qb, Lk;
  if (unit < 256) { seq = 32 + (unit >> 7); h = (unit >> 5) & 3; qb = unit & 31; Lk = 2304; }
  else { int u = unit - 256; seq = u >> 4; h = (u >> 2) & 3; qb = u & 3; Lk = 256; }
  const int row0 = seq < 32 ? seq * 256 : NTP + (seq - 32) * 2048;
  const bh* Q = (const bh*)(p.R + OFF_Q);
  const bh* KB = (const bh*)(p.R + OFF_KB) + (seq < 32 ? (size_t)(seq * 4 + h) * 256 * 128
                                                       : (size_t)KV_SAMPLE_BASE + (size_t)((seq - 32) * 4 + h) * 2304 * 128);
  const bh* VT = (const bh*)(p.R + OFF_VT) + (seq < 32 ? (size_t)(seq * 4 + h) * 128 * 256
                                                       : (size_t)KV_SAMPLE_BASE + (size_t)((seq - 32) * 4 + h) * 128 * 2304);
  __syncthreads();
  if (tid < 64) {
    float a = p.diff_lambda[tid] * p.diff_lambda[64 + tid];
    float b = p.diff_lambda[128 + tid] * p.diff_lambda[192 + tid];
    a = wave_sum(a); b = wave_sum(b);
    if (tid == 0) sred[0] = expf(a) - expf(b);
  }
  __syncthreads();
  const float lam_init = 0.8f - 0.6f * expf(-0.3f * 1.0f);
  const float lam = sred[0] + lam_init;
  const int qrow = row0 + qb * 64 + w * 16;
  bf16x8 aq[2][2];
#pragma unroll
  for (int pp = 0; pp < 2; ++pp)
#pragma unroll
    for (int kk = 0; kk < 2; ++kk)
      aq[pp][kk] = *(const bf16x8*)(Q + (size_t)(qrow + r) * 512 + h * 128 + pp * 64 + kk * 32 + g * 8);
  float mrun[2][4], lrun[2][4];
  f32x4 O[2][8];
#pragma unroll
  for (int pp = 0; pp < 2; ++pp) {
#pragma unroll
    for (int j = 0; j < 4; ++j) { mrun[pp][j] = -1e30f; lrun[pp][j] = 0.f; }
#pragma unroll
    for (int n = 0; n < 8; ++n) O[pp][n] = (f32x4){0.f, 0.f, 0.f, 0.f};
  }
  bh* Pw = Pl + w * (2 * 16 * 40);
  const float scale = 0.125f;
  bh* Ks = (bh*)(smem + 10752);
  bh* Vs = Ks + 64 * 128;
  u32x4 pk_[4], pv_[4];
  auto tload = [&](int kt) {
#pragma unroll
    for (int i = 0; i < 4; ++i) {
      const int pz = tid + 256 * i;
      pk_[i] = *(const u32x4*)(KB + (size_t)(kt + (pz >> 4)) * 128 + (pz & 15) * 8);
      pv_[i] = *(const u32x4*)(VT + (size_t)(pz >> 3) * Lk + kt + (pz & 7) * 8);
    }
  };
  tload(0);
#pragma unroll 1
  for (int kt = 0; kt < Lk; kt += 64) {
    __syncthreads();
#pragma unroll
    for (int i = 0; i < 4; ++i) {
      const int pz = tid + 256 * i;
      const int key = pz >> 4, ck = pz & 15, dv = pz >> 3, cv = pz & 7;
      *(u32x4*)(Ks + key * 128 + ((ck ^ (key & 15)) << 3)) = pk_[i];
      *(u32x4*)(Vs + dv * 64 + ((cv ^ ((dv >> 1) & 7)) << 3)) = pv_[i];
    }
    __syncthreads();
    if (kt + 64 < Lk) tload(kt + 64);
#pragma unroll
    for (int h2 = 0; h2 < 2; ++h2) {
      f32x4 s[2][2];
#pragma unroll
      for (int sub = 0; sub < 2; ++sub) {
        const int key = h2 * 32 + sub * 16 + r;
#pragma unroll
        for (int pp = 0; pp < 2; ++pp) {
          const bf16x8 b0 = *(const bf16x8*)(Ks + key * 128 + (((pp * 8 + g) ^ (key & 15)) << 3));
          const bf16x8 b1 = *(const bf16x8*)(Ks + key * 128 + (((pp * 8 + 4 + g) ^ (key & 15)) << 3));
          f32x4 z = (f32x4){0.f, 0.f, 0.f, 0.f};
          z = __builtin_amdgcn_mfma_f32_16x16x32_bf16(aq[pp][0], b0, z, 0, 0, 0);
          z = __builtin_amdgcn_mfma_f32_16x16x32_bf16(aq[pp][1], b1, z, 0, 0, 0);
          s[pp][sub] = z;
        }
      }
#pragma unroll
      for (int pp = 0; pp < 2; ++pp) {
#pragma unroll
        for (int j = 0; j < 4; ++j) {
          float s0 = s[pp][0][j] * scale, s1 = s[pp][1][j] * scale;
          float mx = max16(fmaxf(s0, s1));
          float mnew = fmaxf(mrun[pp][j], mx);
          float alpha = __expf(mrun[pp][j] - mnew);
          float p0 = __expf(s0 - mnew), p1 = __expf(s1 - mnew);
          float rs = sum16(p0 + p1);
          lrun[pp][j] = lrun[pp][j] * alpha + rs;
          mrun[pp][j] = mnew;
#pragma unroll
          for (int n = 0; n < 8; ++n) O[pp][n][j] *= alpha;
          Pw[(pp * 16 + g * 4 + j) * 40 + r] = f2bf(p0);
          Pw[(pp * 16 + g * 4 + j) * 40 + 16 + r] = f2bf(p1);
        }
      }
      __builtin_amdgcn_fence(__ATOMIC_RELEASE, "wavefront");
      __builtin_amdgcn_wave_barrier();
      __builtin_amdgcn_fence(__ATOMIC_ACQUIRE, "wavefront");
      bf16x8 pa0 = *(const bf16x8*)(Pw + (0 * 16 + r) * 40 + g * 8);
      bf16x8 pa1 = *(const bf16x8*)(Pw + (1 * 16 + r) * 40 + g * 8);
#pragma unroll
      for (int n = 0; n < 8; ++n) {
        const int dv = n * 16 + r;
        const bf16x8 vb = *(const bf16x8*)(Vs + dv * 64 + (((h2 * 4 + g) ^ ((dv >> 1) & 7)) << 3));
        O[0][n] = __builtin_amdgcn_mfma_f32_16x16x32_bf16(pa0, vb, O[0][n], 0, 0, 0);
        O[1][n] = __builtin_amdgcn_mfma_f32_16x16x32_bf16(pa1, vb, O[1][n], 0, 0, 0);
      }
      __builtin_amdgcn_fence(__ATOMIC_RELEASE, "wavefront");
      __builtin_amdgcn_wave_barrier();
    }
  }
#pragma unroll
  for (int j = 0; j < 4; ++j) {
    float i0 = 1.f / lrun[0][j], i1 = lam / lrun[1][j];
    float o[8];
    float ss = 0.f;
#pragma unroll
    for (int n = 0; n < 8; ++n) { o[n] = O[0][n][j] * i0 - O[1][n][j] * i1; ss += o[n] * o[n]; }
    ss = sum16(ss);
    float rs = rsqrtf(ss * (1.f / 128.f) + EPSF) * (1.f - lam_init);
    bh* arow = p.act + (size_t)(qrow + g * 4 + j) * 1024 + h * 128;
#pragma unroll
    for (int n = 0; n < 8; ++n) arow[n * 16 + r] = f2bf(o[n] * rs * p.diff_norm[h * 128 + n * 16 + r]);
  }
}

__device__ __forceinline__ void ffnact_job(const Params& p, int layer, int job) {
  int tidl = threadIdx.x; asm volatile("" : "+v"(tidl));
  const int item = job * 256 + tidl;
  const int rc = item / 352, j = (item % 352) * 8;
  const int t0 = rc * 8;
  const bh* U = (const bh*)p.R;
  bh* AO = (bh*)(p.R + OFF_ACTF);
  const float* cw = p.ffn_conv_w + (size_t)layer * 3 * 5632;
  const float* cb = p.ffn_conv_b + (size_t)layer * 5632;
  const bool start = (t0 < NTP) ? ((t0 & 255) == 0) : ((t0 & 2047) == 0);
  const bool endd = (t0 < NTP) ? (((t0 + 8) & 255) == 0) : (((t0 + 8) & 2047) == 0);
  u32x4 ua[10], ug[10];
  const u32x4 zz = {0, 0, 0, 0};
#pragma unroll
  for (int i = 0; i < 10; ++i) {
    const int t = t0 - 1 + i;
    const bool ok = (i == 0) ? !start : ((i == 9) ? !endd : true);
    ua[i] = ok ? *(const u32x4*)(U + (size_t)t * 5632 + j) : zz;
    ug[i] = ok ? *(const u32x4*)(U + (size_t)t * 5632 + 2816 + j) : zz;
  }
  float wa[3][8], wg[3][8], ba[8], bg[8];
#pragma unroll
  for (int tp = 0; tp < 3; ++tp) {
    float4 x0 = *(const float4*)(cw + tp * 5632 + j), x1 = *(const float4*)(cw + tp * 5632 + j + 4);
    float4 y0 = *(const float4*)(cw + tp * 5632 + 2816 + j), y1 = *(const float4*)(cw + tp * 5632 + 2816 + j + 4);
    wa[tp][0] = x0.x; wa[tp][1] = x0.y; wa[tp][2] = x0.z; wa[tp][3] = x0.w; wa[tp][4] = x1.x; wa[tp][5] = x1.y; wa[tp][6] = x1.z; wa[tp][7] = x1.w;
    wg[tp][0] = y0.x; wg[tp][1] = y0.y; wg[tp][2] = y0.z; wg[tp][3] = y0.w; wg[tp][4] = y1.x; wg[tp][5] = y1.y; wg[tp][6] = y1.z; wg[tp][7] = y1.w;
  }
  {
    float4 x0 = *(const float4*)(cb + j), x1 = *(const float4*)(cb + j + 4);
    float4 y0 = *(const float4*)(cb + 2816 + j), y1 = *(const float4*)(cb + 2816 + j + 4);
    ba[0] = x0.x; ba[1] = x0.y; ba[2] = x0.z; ba[3] = x0.w; ba[4] = x1.x; ba[5] = x1.y; ba[6] = x1.z; ba[7] = x1.w;
    bg[0] = y0.x; bg[1] = y0.y; bg[2] = y0.z; bg[3] = y0.w; bg[4] = y1.x; bg[5] = y1.y; bg[6] = y1.z; bg[7] = y1.w;
  }
#pragma unroll
  for (int i = 0; i < 8; ++i) {
    u32x4 ov;
#pragma unroll
    for (int e2 = 0; e2 < 4; ++e2) {
      float res[2];
#pragma unroll
      for (int hl = 0; hl < 2; ++hl) {
        const int e = e2 * 2 + hl;
        float am = hl ? bfhi(ua[i][e2]) : bflo(ua[i][e2]);
        float a0 = hl ? bfhi(ua[i + 1][e2]) : bflo(ua[i + 1][e2]);
        float ap = hl ? bfhi(ua[i + 2][e2]) : bflo(ua[i + 2][e2]);
        float gm = hl ? bfhi(ug[i][e2]) : bflo(ug[i][e2]);
        float g0 = hl ? bfhi(ug[i + 1][e2]) : bflo(ug[i + 1][e2]);
        float gp = hl ? bfhi(ug[i + 2][e2]) : bflo(ug[i + 2][e2]);
        float av = wa[0][e] * am + wa[1][e] * a0 + wa[2][e] * ap + ba[e];
        float gv = wg[0][e] * gm + wg[1][e] * g0 + wg[2][e] * gp + bg[e];
        res[hl] = siluf_(gv) * av;
      }
      ov[e2] = pk2(res[0], res[1]);
    }
    *(u32x4*)(AO + (size_t)(t0 + i) * 2816 + j) = ov;
  }
}

#define XB_TMO      128
#define XB_XCNT(j)  (256  + 64 * (j))
#define XB_XSUB(j)  (1280 + 64 * (j))
#define XB_XGEN(j)  (2304 + 64 * (j))
#define XB_TOP      3328
#define XB_TOPGEN   3392
#define XCD_BAR_WORDS 3456
#define XB_SPIN_CAP (1u << 18)
#define LAS __attribute__((address_space(3)))

__device__ __forceinline__ unsigned xb_ld(unsigned* p)              { return __hip_atomic_load(p, __ATOMIC_RELAXED, __HIP_MEMORY_SCOPE_AGENT); }
__device__ __forceinline__ unsigned xb_add(unsigned* p, unsigned v) { return __hip_atomic_fetch_add(p, v, __ATOMIC_RELAXED, __HIP_MEMORY_SCOPE_AGENT); }
__device__ __forceinline__ unsigned xb_xcc_id() { return (unsigned)__builtin_amdgcn_s_getreg((3 << 11) | 20) & 0xFu; }
#define XB_SPIN(cond, bar) do { unsigned _sp = 0; while (cond) { __builtin_amdgcn_s_sleep(1); \
    if ((++_sp & 255u) == 0u) { if (xb_ld(&(bar)[XB_TMO])) break; if (_sp > XB_SPIN_CAP) { atomicAdd(&(bar)[XB_TMO], 1u); break; } } } } while (0)

struct XcdBarrier {
    unsigned* bar; unsigned x;
    volatile LAS unsigned* st;
};

__device__ __forceinline__ XcdBarrier xcd_barrier_post(unsigned* bar, volatile LAS unsigned* st) {
    XcdBarrier b; b.bar = bar; b.x = xb_xcc_id(); b.st = st;
    if (threadIdx.x == 0) (void)xb_add(&bar[XB_XCNT(b.x)], 1u);
    return b;
}
__device__ __forceinline__ void xcd_barrier_complete(unsigned* bar, unsigned x, unsigned& nloc, unsigned& nx) {
    const unsigned G = gridDim.x * gridDim.y * gridDim.z;
    unsigned sum, cnt, mine, sp = 0u;
    for (;;) {
        sum = 0u; cnt = 0u; mine = 0u;
#pragma unroll
        for (unsigned j = 0; j < 16; ++j) { const unsigned c = xb_ld(&bar[XB_XCNT(j)]); sum += c; cnt += (c > 0u) ? 1u : 0u; mine = (j == x) ? c : mine; }
        if (sum == G) break;
        __builtin_amdgcn_s_sleep(1);
        if ((++sp & 255u) == 0u) { if (xb_ld(&bar[XB_TMO])) break; if (sp > XB_SPIN_CAP) { atomicAdd(&bar[XB_TMO], 1u); break; } }
    }
    nloc = mine > 0u ? mine : 1u; nx = cnt > 0u ? cnt : 1u;
}

__device__ __forceinline__ void xcd_barrier(const XcdBarrier& b) {
    asm volatile("s_waitcnt vmcnt(0)" ::: "memory");
    __syncthreads();
    if (threadIdx.x == 0) {
        unsigned* bar = b.bar;
        __builtin_amdgcn_s_waitcnt(0);
        unsigned nloc = b.st[0], nx = b.st[1];
        if (nloc == 0u) { xcd_barrier_complete(bar, b.x, nloc, nx); b.st[0] = nloc; b.st[1] = nx; }
        const unsigned old = xb_add(&bar[XB_XSUB(b.x)], 1u);
        const unsigned gen = old / nloc;
        if (old + 1u == (gen + 1u) * nloc) {
            __builtin_amdgcn_fence(__ATOMIC_RELEASE, "agent");
            asm volatile("s_waitcnt vmcnt(0)" ::: "memory");
            const unsigned og = xb_add(&bar[XB_TOP], 1u);
            const unsigned tg = og / nx;
            if (og + 1u == (tg + 1u) * nx) xb_add(&bar[XB_TOPGEN], 1u);
            else XB_SPIN(xb_ld(&bar[XB_TOPGEN]) == tg, bar);
            __builtin_amdgcn_fence(__ATOMIC_ACQUIRE, "agent");
            xb_add(&bar[XB_XGEN(b.x)], 1u);
            asm volatile("s_waitcnt vmcnt(0)" ::: "memory");
        } else {
            XB_SPIN(xb_ld(&bar[XB_XGEN(b.x)]) == gen, bar);
            __builtin_amdgcn_fence(__ATOMIC_ACQUIRE, "agent");
            asm volatile("s_waitcnt vmcnt(0)" ::: "memory");
        }
    }
    __syncthreads();
}


template <int ph>
__device__ __forceinline__ void run_phase(const Params& p, int bid, int nb, char* smem, bool rep = false) {
  const float* ng = p.norm_g;
  const bh* Rf = (const bh*)p.R;
  if (ph == 0) {
    for (int j = bid + (rep ? 768 : 0); j < 768 + 576 + 1024; j += nb) {
      if (j < 768) gemv_job(p, j, smem);
      else if (j < 1344) filter_job(p, j - 768, smem);
      else convert_tile(p.w_in_even, 1024, 4096, p.wt, j - 1344, smem);
    }
  } else if (ph == 1) {
    for (int j = bid; j < 1536; j += nb) rows_job(p, j, true, nullptr, nullptr, 0, 0, ng + 0 * 1024, 0, 0);
  } else if (ph == 2) {
    gemm_phase<2, 192, 3>(p.act, 1024, p.wt, 1024, p.R, 4096, 4096, 32, bid, nb, smem);
  } else if (ph == 3) {
    if (nb == 512 && !rep) {
      hyena_sample_job(p, bid, smem);
      if (bid < 384) scan2_unit<0>(p, bid, smem);
      else {
        const int q = bid - 384;
        hyena_prompt_job(p, q, smem);
        hyena_prompt_job(p, q + 128, smem);
        convert_tile(p.w_out_even, 1024, 1024, p.wt, q, smem);
        convert_tile(p.w_out_even, 1024, 1024, p.wt, q + 128, smem);
      }
    } else {
      for (int j = bid + (rep ? 512 : 0); j < (rep ? 896 : 512 + 384 + 256 + 256); j += nb) {
        if (j < 512) hyena_sample_job(p, j, smem);
        else if (j < 896) scan2_unit<0>(p, j - 512, smem);
        else if (j < 1152) hyena_prompt_job(p, j - 896, smem);
        else convert_tile(p.w_out_even, 1024, 1024, p.wt, j - 1152, smem);
      }
    }
  } else if (ph == 4) {
    for (int j = bid; j < 128 + 1024; j += nb) {
      if (j < 128) fixup_unit<0>(p, j, smem);
      else scan_final_job(p, j - 128, 0);
    }
  } else if (ph == 5) {
    for (int j = bid; j < 512; j += nb) scan_final_job(p, 1024 + j, 0);
  } else if (ph == 6) {
    gemm_phase<1, 192, 3>(p.act, 1024, p.wt, 1024, p.R, 1024, 1024, 8, bid, nb, smem);
  } else if (ph == 7) {
    for (int j = bid; j < 1536 + 1408 + 704; j += nb) {
      if (j < 1536) rows_job(p, j, true, Rf, ng + 1 * 1024, 0, 2, ng + 2 * 1024, 0, 3);
      else if (j < 2944) convert_tile(p.ffn_up, 1024, 5632, p.wt, j - 1536, smem, true);
      else convert_tile(p.ffn_down, 2816, 1024, p.wt2, j - 2944, smem);
    }
  } else if (ph == 8) {
    gemm_phase<3, 192, 3>(p.act, 1024, p.wt, 1024, p.R + OFF_ACTF, 2816, 5632, 44, bid, nb, smem, p.ffn_conv_w, p.ffn_conv_b);
  } else if (ph == 9) {
  } else if (ph == 10) {
    gemm_phase<1, 192, 3>((const bh*)(p.R + OFF_ACTF), 2816, p.wt2, 2816, p.R, 1024, 1024, 8, bid, nb, smem);
  } else if (ph == 11) {
    for (int j = bid; j < 1536 + 800; j += nb) {
      if (j < 1536) rows_job(p, j, false, Rf, ng + 3 * 1024, 0, 5, ng + 4 * 1024, 1, 0);
      else convert_tile(p.w_in_odd, 1024, 3104, p.wt, j - 1536, smem);
    }
  } else if (ph == 12) {
    gemm_phase<1, 128, 3>(p.act, 1024, p.wt, 1024, p.R, 3104, 3104, 25, bid, nb, smem);
  } else if (ph == 13) {
    auto small13 = [&](int sj) {
      if (sj < 800) vt_job(p, sj, smem);
      else if (sj < 3872) oddrow_job(p, sj - 800);
      else if (sj < 4128) ctxk_job(p, sj - 3872);
      else convert_tile(p.w_out_odd, 1024, 1024, p.wt, sj - 4128, smem);
    };
    if (nb == 512 && !rep) {
      if (bid < 384) {
        scan2_unit<1>(p, bid, smem);
        for (int sj = 3072 + bid; sj < 4384; sj += 384) small13(sj);
      } else {
        for (int k = 0; k < 24; ++k) small13((bid - 384) + 128 * k);
      }
    } else {
      for (int j = bid; j < (rep ? 384 : 384 + 4384); j += nb) {
        if (j < 384) scan2_unit<1>(p, j, smem);
        else small13(j - 384);
      }
    }
  } else if (ph == 14) {
    if (nb == 512 && !rep) {
      if (bid < 256) attn_unit(p, bid, smem);
      else {
        const int q = bid - 256;
        attn_unit(p, 256 + q, smem);
        attn_unit(p, 512 + q, smem);
        if (q < 128) fixup_unit<1>(p, q, smem);
        for (int k = 0; k < 4; ++k) scan_final_job(p, q + 256 * k, 1);
      }
    } else {
      for (int j = bid; j < (rep ? 768 : 768 + 128 + 1024); j += nb) {
        if (j < 768) attn_unit(p, j, smem);
        else if (j < 896) fixup_unit<1>(p, j - 768, smem);
        else scan_final_job(p, j - 896, 1);
      }
    }
  } else if (ph == 15) {
    for (int j = bid; j < 512; j += nb) scan_final_job(p, 1024 + j, 1);
  } else if (ph == 16) {
    gemm_phase<1, 192, 3>(p.act, 1024, p.wt, 1024, p.R, 1024, 1024, 8, bid, nb, smem);
  } else if (ph == 17) {
    for (int j = bid; j < 1536 + 1408 + 704; j += nb) {
      if (j < 1536) rows_job(p, j, false, Rf, ng + 5 * 1024, 1, 2, ng + 6 * 1024, 1, 3);
      else if (j < 2944) convert_tile(p.ffn_up + (size_t)1024 * 5632, 1024, 5632, p.wt, j - 1536, smem, true);
      else convert_tile(p.ffn_down + (size_t)2816 * 1024, 2816, 1024, p.wt2, j - 2944, smem);
    }
  } else if (ph == 18) {
    gemm_phase<3, 192, 3>(p.act, 1024, p.wt, 1024, p.R + OFF_ACTF, 2816, 5632, 44, bid, nb, smem, p.ffn_conv_w + 3 * 5632, p.ffn_conv_b + 5632);
  } else if (ph == 19) {
  } else if (ph == 20) {
    gemm_phase<1, 192, 3>((const bh*)(p.R + OFF_ACTF), 2816, p.wt2, 2816, p.R, 1024, 1024, 8, bid, nb, smem);
  } else if (ph == 21) {
    for (int j = bid; j < 1536; j += nb) rows_job(p, j, false, Rf, ng + 7 * 1024, 1, 5, nullptr, 0, 0);
  }
}

template <int PH>
__device__ __forceinline__ void phase_step(const Params& p, int ph0, int ph1, char* smem, cg::grid_group& grid, const XcdBarrier& xb) {
  if (PH == 9 || PH == 19) return;
  if (PH >= ph0 && PH < ph1) {
    if (PH == REP_PH) { run_phase<PH>(p, blockIdx.x, gridDim.x, smem, true); xcd_barrier(xb); }
    run_phase<PH>(p, blockIdx.x, gridDim.x, smem);
    if (PH + 1 < ph1) {
      xcd_barrier(xb);
    }
  }
}

__global__ void __launch_bounds__(256, 2) mega_kernel(Params p, int ph0, int ph1) {
  __shared__ __attribute__((aligned(16))) char smem[49152];
  cg::grid_group grid = cg::this_grid();
  __shared__ uint4 xb_words;
  if (threadIdx.x == 0) xb_words = make_uint4(0u, 0u, 0u, 0u);
  __syncthreads();
  XcdBarrier xb = xcd_barrier_post(p.bar, (volatile LAS unsigned*)&xb_words);
#ifdef EXTRA_SYNCS
  for (int i = 0; i < EXTRA_SYNCS; ++i) xcd_barrier(xb);
#endif
  phase_step<0>(p, ph0, ph1, smem, grid, xb);
  phase_step<1>(p, ph0, ph1, smem, grid, xb);
  phase_step<2>(p, ph0, ph1, smem, grid, xb);
  phase_step<3>(p, ph0, ph1, smem, grid, xb);
  phase_step<4>(p, ph0, ph1, smem, grid, xb);
  phase_step<5>(p, ph0, ph1, smem, grid, xb);
  phase_step<6>(p, ph0, ph1, smem, grid, xb);
  phase_step<7>(p, ph0, ph1, smem, grid, xb);
  phase_step<8>(p, ph0, ph1, smem, grid, xb);
  phase_step<9>(p, ph0, ph1, smem, grid, xb);
  phase_step<10>(p, ph0, ph1, smem, grid, xb);
  phase_step<11>(p, ph0, ph1, smem, grid, xb);
  phase_step<12>(p, ph0, ph1, smem, grid, xb);
  phase_step<13>(p, ph0, ph1, smem, grid, xb);
  phase_step<14>(p, ph0, ph1, smem, grid, xb);
  phase_step<15>(p, ph0, ph1, smem, grid, xb);
  phase_step<16>(p, ph0, ph1, smem, grid, xb);
  phase_step<17>(p, ph0, ph1, smem, grid, xb);
  phase_step<18>(p, ph0, ph1, smem, grid, xb);
  phase_step<19>(p, ph0, ph1, smem, grid, xb);
  phase_step<20>(p, ph0, ph1, smem, grid, xb);
  phase_step<21>(p, ph0, ph1, smem, grid, xb);
}

extern "C" void kernel_launch(void* const* d_in, const int* in_sizes, int n_in, void* d_out, int out_size, void* d_ws,
                              size_t ws_size, hipStream_t stream) {
  static int grid_blocks = 0;
  if (!grid_blocks) {
    int dev = 0, cus = 0, per_cu = 0;
    hipGetDevice(&dev);
    hipDeviceGetAttribute(&cus, hipDeviceAttributeMultiprocessorCount, dev);
    hipOccupancyMaxActiveBlocksPerMultiprocessor(&per_cu, mega_kernel, 256, 0);
    if (per_cu > 2) per_cu = 2;
    if (per_cu < 1) per_cu = 1;
    grid_blocks = cus * per_cu;
  }
  Params p{};
  const float** pf = (const float**)&p;
  for (int i = 0; i < 35; ++i) pf[i] = (const float*)d_in[i];
  p.out = (float*)d_out;
  char* ws = (char*)d_ws;
  size_t off = 0;
  p.act = (bh*)(ws + off); off += (size_t)NT * 1024 * 2;
  p.wt = (bh*)(ws + off); off += (size_t)5632 * 1024 * 2;
  p.wt2 = (bh*)(ws + off); off += (size_t)1024 * 2816 * 2;
  p.R = ws + off; off += R_BYTES;
  p.mod = (float*)(ws + off); off += (size_t)2 * 3 * 6144 * 4;
  p.bar = (unsigned*)(ws + off); off += (size_t)XCD_BAR_WORDS * 4;
  p.gt256 = (bh*)(ws + off); off += (size_t)2 * 512 * 512 * 2;
  p.gt2048 = (bh*)(ws + off); off += (size_t)2 * 512 * 4096 * 2;
  if (off > ws_size) { fprintf(stderr, "workspace too small: need %zu have %zu\n", off, ws_size); return; }
  hipMemsetAsync(p.mod, 0, (size_t)2 * 3 * 6144 * 4 + (size_t)XCD_BAR_WORDS * 4, stream);
#if MEGA
  int ph0 = 0, ph1 = NPHASE;
  void* args[] = {&p, &ph0, &ph1};
  hipError_t e = hipLaunchCooperativeKernel((void*)mega_kernel, dim3(grid_blocks), dim3(256), args, 0, stream);
  if (e != hipSuccess) fprintf(stderr, "cooperative launch failed: %s (grid %d)\n", hipGetErrorString(e), grid_blocks);
#else
  for (int ph = 0; ph < NPHASE; ++ph) {
    int ph0 = ph, ph1 = ph + 1;
    void* args[] = {&p, &ph0, &ph1};
    hipError_t e = hipLaunchCooperativeKernel((void*)mega_kernel, dim3(grid_blocks), dim3(256), args, 0, stream);
    if (e != hipSuccess) fprintf(stderr, "launch failed: %s\n", hipGetErrorString(e));
  }
#endif
}
```

```cpp
#include <hip/hip_runtime.h>
#include <hip/hip_cooperative_groups.h>
#include <stdint.h>
#include <cstdio>
namespace cg = cooperative_groups;

#ifndef MEGA
#define MEGA 1
#endif
#ifndef REP_PH
#define REP_PH -1
#endif

typedef unsigned short bh;
using bf16x8 = __attribute__((ext_vector_type(8))) short;
using f32x4 = __attribute__((ext_vector_type(4))) float;
using u32x4 = __attribute__((ext_vector_type(4))) unsigned int;

#define NT 12288
#define NTP 8192
#define EPSF 1e-6f
#define NPHASE 22

#define OUT_HGRN 12582912
#define OUT_CK 16777216
#define OUT_CV 20971520
#define OUT_GLA 25165824

#define OFF_ODIR 100663296ull
#define OFF_Z1 150994944ull
#define OFF_HYT 150994944ull
#define OFF_ACTF 138412032ull
#define OFF_Q 150994944ull
#define OFF_KB 163577856ull
#define OFF_VT 176685056ull
#define R_BYTES 207618048ull
#define KV_SAMPLE_BASE 4194304

struct Params {
  const float *x_prompt, *x_sample, *state_hgrn, *cache_k, *cache_v, *state_gla, *c, *c_ctx;
  const float *ada_w, *ada_b, *norm_g, *ffn_up, *ffn_conv_w, *ffn_conv_b, *ffn_down;
  const float *w_in_even, *w_out_even, *hgrn_lb, *hgrn_norm, *hy_conv_w, *hy_conv_b;
  const float *hy_w1, *hy_b1, *hy_w2, *hy_b2, *hy_w3, *hy_freq, *hy_d;
  const float *w_in_odd, *w_out_odd, *diff_lambda, *diff_norm, *gla_aw, *gla_ab, *gla_norm;
  float* out;
  bh* act;
  bh* wt;
  bh* wt2;
  char* R;
  float* mod;
  bh* gt256;
  bh* gt2048;
  unsigned* bar;
};

typedef __bf16 bf2_t __attribute__((ext_vector_type(2)));
typedef float f2_t __attribute__((ext_vector_type(2)));
typedef unsigned int u32x2 __attribute__((ext_vector_type(2)));
__device__ __forceinline__ unsigned pk2(float a, float b) {
  f2_t v = {a, b};
  return __builtin_bit_cast(unsigned, __builtin_convertvector(v, bf2_t));
}
__device__ __forceinline__ bh f2bf(float x) { return (bh)(pk2(x, x) & 0xffffu); }
__device__ __forceinline__ float bflo(unsigned w) { return __uint_as_float(w << 16); }
__device__ __forceinline__ float bfhi(unsigned w) { return __uint_as_float(w & 0xffff0000u); }
__device__ __forceinline__ float bf2f(bh h) { return __uint_as_float(((uint32_t)h) << 16); }
__device__ __forceinline__ float sigmoidf_(float x) { return __builtin_amdgcn_rcpf(1.f + __expf(-x)); }
__device__ __forceinline__ float siluf_(float x) { return x * __builtin_amdgcn_rcpf(1.f + __expf(-x)); }
template <int CTRL>
__device__ __forceinline__ float dppf0(float v) {
  return __int_as_float(__builtin_amdgcn_update_dpp(0, __float_as_int(v), CTRL, 0xF, 0xF, true));
}
__device__ __forceinline__ float wave_sum(float v) {
  v += dppf0<0xB1>(v); v += dppf0<0x4E>(v); v += dppf0<0x141>(v); v += dppf0<0x140>(v);
  v += __shfl_xor(v, 16);
  v += __shfl_xor(v, 32);
  return v;
}

template <int OUT_BF16, int BM, int DEPTH>
__device__ __forceinline__ void gemm_phase(const bh* __restrict__ A, int lda, const bh* __restrict__ Bt, int K, void* Cv, int ldc,
                           int N, int ntn, int bid, int nb, char* smem, const float* cw = nullptr, const float* cb = nullptr) {
  constexpr int MT = BM / 32;
  constexpr int NPA = BM / 32;
  bh* As = (bh*)smem;
  bh* Bs = As + BM * 64;
  int tid_l_ = threadIdx.x; asm volatile("" : "+v"(tid_l_)); const int tid = tid_l_, lane = tid & 63, w = tid >> 6, wr = w >> 1, wc = w & 1, r = lane & 15, g = lane >> 4;
  constexpr int MB = (NT / BM) / 8;
  const int xcd = bid & 7, nloc = nb >> 3;
  const int qend = OUT_BF16 == 3 ? MB * ntn + (ntn + 7) / 8 : MB * ntn;
  for (int q = bid >> 3; q < qend; q += nloc) {
    int mt = xcd * MB + (q % MB), nt = q / MB;
    if (OUT_BF16 == 3 && q >= MB * ntn) { mt = 64; nt = (q - MB * ntn) * 8 + xcd; if (nt >= ntn) continue; }
    const int trow0 = OUT_BF16 == 3 ? mt * 190 - 1 : mt * BM;
    const bh* Ag = A;
    const bh* Bg = Bt + (size_t)(nt * 128) * K;
    f32x4 acc[MT][4];
#pragma unroll
    for (int m = 0; m < MT; ++m)
#pragma unroll
      for (int n = 0; n < 4; ++n) acc[m][n] = (f32x4){0.f, 0.f, 0.f, 0.f};
    u32x4 pa0[NPA], pb0[4], pa1[NPA], pb1[4];
    auto gload = [&](u32x4* pa, u32x4* pb, int kofs) {
#pragma unroll
      for (int i = 0; i < NPA; ++i) {
        int pz = tid + i * 256, row = pz >> 3, cp = pz & 7;
        int tr = trow0 + row;
        if (OUT_BF16 == 3) tr = min(max(tr, 0), NT - 1);
        pa[i] = *(const u32x4*)(Ag + (size_t)tr * lda + kofs + cp * 8);
      }
#pragma unroll
      for (int i = 0; i < 4; ++i) {
        int pz = tid + i * 256, row = pz >> 3, cp = pz & 7;
        pb[i] = *(const u32x4*)(Bg + (size_t)row * K + kofs + cp * 8);
      }
    };
    auto kstep = [&](u32x4* pa, u32x4* pb, int knext) {
      __syncthreads();
#pragma unroll
      for (int i = 0; i < NPA; ++i) {
        int pz = tid + i * 256, row = pz >> 3, cp = pz & 7;
        *(u32x4*)(As + row * 64 + ((cp ^ ((row >> 1) & 7)) << 3)) = pa[i];
      }
#pragma unroll
      for (int i = 0; i < 4; ++i) {
        int pz = tid + i * 256, row = pz >> 3, cp = pz & 7;
        *(u32x4*)(Bs + row * 64 + ((cp ^ ((row >> 1) & 7)) << 3)) = pb[i];
      }
      __syncthreads();
      if (knext < K) gload(pa, pb, knext);
#pragma unroll
      for (int kk = 0; kk < 2; ++kk) {
        bf16x8 af[MT], bfr[4];
#pragma unroll
        for (int m = 0; m < MT; ++m) { const int row = wr * (BM / 2) + m * 16 + r; af[m] = *(const bf16x8*)(As + row * 64 + (((kk * 4 + g) ^ ((row >> 1) & 7)) << 3)); }
#pragma unroll
        for (int n = 0; n < 4; ++n) { const int row = wc * 64 + n * 16 + r; bfr[n] = *(const bf16x8*)(Bs + row * 64 + (((kk * 4 + g) ^ ((row >> 1) & 7)) << 3)); }
        __builtin_amdgcn_sched_barrier(0);
#pragma unroll
        for (int m = 0; m < MT; ++m)
#pragma unroll
          for (int n = 0; n < 4; ++n)
            acc[m][n] = (OUT_BF16 == 1 || OUT_BF16 == 3) ? __builtin_amdgcn_mfma_f32_16x16x32_bf16(bfr[n], af[m], acc[m][n], 0, 0, 0)
                                        : __builtin_amdgcn_mfma_f32_16x16x32_bf16(af[m], bfr[n], acc[m][n], 0, 0, 0);
        __builtin_amdgcn_sched_barrier(0);
      }
    };
    if (DEPTH == 3) {
      constexpr int NA3 = BM / 64;
      bh* As3 = (bh*)smem;
      bh* Bs3 = As3 + 2 * BM * 32;
      u32x4 ra0[NA3], rb0[2], ra1[NA3], rb1[2];
      auto ld3 = [&](u32x4* ra, u32x4* rb, int kofs) {
#pragma unroll
        for (int i = 0; i < NA3; ++i) {
          int pz = tid + i * 256, row = pz >> 2, c = pz & 3;
          int tr = trow0 + row;
          if (OUT_BF16 == 3) tr = min(max(tr, 0), NT - 1);
          ra[i] = *(const u32x4*)(Ag + (size_t)tr * lda + kofs + c * 8);
        }
#pragma unroll
        for (int i = 0; i < 2; ++i) {
          int pz = tid + i * 256, row = pz >> 2, c = pz & 3;
          rb[i] = *(const u32x4*)(Bg + (size_t)row * K + kofs + c * 8);
        }
      };
      auto st3 = [&](const u32x4* ra, const u32x4* rb, int stg) {
#pragma unroll
        for (int i = 0; i < NA3; ++i) {
          int pz = tid + i * 256, row = pz >> 2, c = pz & 3;
          *(u32x4*)(As3 + stg * BM * 32 + row * 32 + ((c ^ (((row >> 3) & 1) << 1)) << 3)) = ra[i];
        }
#pragma unroll
        for (int i = 0; i < 2; ++i) {
          int pz = tid + i * 256, row = pz >> 2, c = pz & 3;
          *(u32x4*)(Bs3 + stg * 128 * 32 + row * 32 + ((c ^ (((row >> 3) & 1) << 1)) << 3)) = rb[i];
        }
      };
      auto comp3 = [&](int cur) {
        __builtin_amdgcn_s_setprio(1);
        bf16x8 af[MT], bfr[4];
#pragma unroll
        for (int m = 0; m < MT; ++m) {
          const int row = wr * (BM / 2) + m * 16 + r;
          af[m] = *(const bf16x8*)(As3 + cur * BM * 32 + row * 32 + ((g ^ (((row >> 3) & 1) << 1)) << 3));
        }
#pragma unroll
        for (int n = 0; n < 4; ++n) {
          const int row = wc * 64 + n * 16 + r;
          bfr[n] = *(const bf16x8*)(Bs3 + cur * 128 * 32 + row * 32 + ((g ^ (((row >> 3) & 1) << 1)) << 3));
        }
#pragma unroll
        for (int m = 0; m < MT; ++m)
#pragma unroll
          for (int n = 0; n < 4; ++n)
            acc[m][n] = (OUT_BF16 == 1 || OUT_BF16 == 3) ? __builtin_amdgcn_mfma_f32_16x16x32_bf16(bfr[n], af[m], acc[m][n], 0, 0, 0)
                                        : __builtin_amdgcn_mfma_f32_16x16x32_bf16(af[m], bfr[n], acc[m][n], 0, 0, 0);
        __builtin_amdgcn_s_setprio(0);
      };
      const int nk = K >> 5;
      __syncthreads();
      ld3(ra0, rb0, 0);
      ld3(ra1, rb1, 32);
      st3(ra0, rb0, 0);
      ld3(ra0, rb0, 64);
      __syncthreads();
      for (int ks = 0; ks < nk; ks += 2) {
        comp3(0);
        st3(ra1, rb1, 1);
        if (ks + 3 < nk) ld3(ra1, rb1, (ks + 3) << 5);
        __syncthreads();
        comp3(1);
        if (ks + 2 < nk) st3(ra0, rb0, 0);
        if (ks + 4 < nk) ld3(ra0, rb0, (ks + 4) << 5);
        __syncthreads();
      }
    } else {
    gload(pa0, pb0, 0);
    if (DEPTH == 2) {
      gload(pa1, pb1, 64);
      for (int k0 = 0; k0 < K; k0 += 128) {
        kstep(pa0, pb0, k0 + 128);
        kstep(pa1, pb1, k0 + 192);
      }
    } else {
      for (int k0 = 0; k0 < K; k0 += 64) kstep(pa0, pb0, k0 + 64);
    }
    }
    if (OUT_BF16 == 1 || OUT_BF16 == 3) {
      __syncthreads();
      bh* Ct = (bh*)smem;
#pragma unroll
      for (int m = 0; m < MT; ++m)
#pragma unroll
        for (int n = 0; n < 4; ++n) {
          const int row = wr * (BM / 2) + m * 16 + r;
          const int sl = wc * 16 + n * 4 + g;
          u32x2 pv;
          pv[0] = pk2(acc[m][n][0], acc[m][n][1]);
          pv[1] = pk2(acc[m][n][2], acc[m][n][3]);
          *(u32x2*)(Ct + row * 128 + ((sl ^ ((row & 15) << 1)) << 2)) = pv;
        }
      __syncthreads();
      if (OUT_BF16 == 1) {
#pragma unroll 2
        for (int i = 0; i < BM / 16; ++i) {
          const int pz = tid + i * 256, row = pz >> 4, pc = pz & 15;
          const u32x4 v = *(const u32x4*)(Ct + row * 128 + ((pc ^ (row & 15)) << 3));
          const int col = nt * 128 + pc * 8;
          if (col < N) *(u32x4*)((bh*)Cv + ((size_t)mt * BM + row) * ldc + col) = v;
        }
      } else {
        const int c8 = tid & 7, rs = tid >> 3;
        const int ja = nt * 64 + c8 * 8;
        float wa[3][8], wg[3][8], ba[8], bg[8];
#pragma unroll
        for (int tp = 0; tp < 3; ++tp) {
          const float4 x0 = *(const float4*)(cw + tp * 5632 + ja), x1 = *(const float4*)(cw + tp * 5632 + ja + 4);
          const float4 y0 = *(const float4*)(cw + tp * 5632 + 2816 + ja), y1 = *(const float4*)(cw + tp * 5632 + 2816 + ja + 4);
          wa[tp][0] = x0.x; wa[tp][1] = x0.y; wa[tp][2] = x0.z; wa[tp][3] = x0.w; wa[tp][4] = x1.x; wa[tp][5] = x1.y; wa[tp][6] = x1.z; wa[tp][7] = x1.w;
          wg[tp][0] = y0.x; wg[tp][1] = y0.y; wg[tp][2] = y0.z; wg[tp][3] = y0.w; wg[tp][4] = y1.x; wg[tp][5] = y1.y; wg[tp][6] = y1.z; wg[tp][7] = y1.w;
        }
        {
          const float4 x0 = *(const float4*)(cb + ja), x1 = *(const float4*)(cb + ja + 4);
          const float4 y0 = *(const float4*)(cb + 2816 + ja), y1 = *(const float4*)(cb + 2816 + ja + 4);
          ba[0] = x0.x; ba[1] = x0.y; ba[2] = x0.z; ba[3] = x0.w; ba[4] = x1.x; ba[5] = x1.y; ba[6] = x1.z; ba[7] = x1.w;
          bg[0] = y0.x; bg[1] = y0.y; bg[2] = y0.z; bg[3] = y0.w; bg[4] = y1.x; bg[5] = y1.y; bg[6] = y1.z; bg[7] = y1.w;
        }
#pragma unroll 1
        for (int i = 0; i < 6; ++i) {
          const int rr = 1 + rs + 32 * i;
          const int t = trow0 + rr;
          if (rr <= 190 && t < NT) {
            const bool start = (t < NTP) ? ((t & 255) == 0) : ((t & 2047) == 0);
            const bool endd = (t < NTP) ? ((t & 255) == 255) : ((t & 2047) == 2047);
            u32x4 am = *(const u32x4*)(Ct + (rr - 1) * 128 + ((c8 ^ ((rr - 1) & 15)) << 3));
            u32x4 gm = *(const u32x4*)(Ct + (rr - 1) * 128 + (((8 + c8) ^ ((rr - 1) & 15)) << 3));
            const u32x4 a0 = *(const u32x4*)(Ct + rr * 128 + ((c8 ^ (rr & 15)) << 3));
            const u32x4 g0 = *(const u32x4*)(Ct + rr * 128 + (((8 + c8) ^ (rr & 15)) << 3));
            u32x4 ap = *(const u32x4*)(Ct + (rr + 1) * 128 + ((c8 ^ ((rr + 1) & 15)) << 3));
            u32x4 gp = *(const u32x4*)(Ct + (rr + 1) * 128 + (((8 + c8) ^ ((rr + 1) & 15)) << 3));
            if (start) { am = (u32x4){0, 0, 0, 0}; gm = (u32x4){0, 0, 0, 0}; }
            if (endd) { ap = (u32x4){0, 0, 0, 0}; gp = (u32x4){0, 0, 0, 0}; }
            u32x4 ov;
#pragma unroll
            for (int e2 = 0; e2 < 4; ++e2) {
              float res[2];
#pragma unroll
              for (int hl = 0; hl < 2; ++hl) {
                const int e = e2 * 2 + hl;
                const float av = wa[0][e] * (hl ? bfhi(am[e2]) : bflo(am[e2])) + wa[1][e] * (hl ? bfhi(a0[e2]) : bflo(a0[e2])) +
                                 wa[2][e] * (hl ? bfhi(ap[e2]) : bflo(ap[e2])) + ba[e];
                const float gv = wg[0][e] * (hl ? bfhi(gm[e2]) : bflo(gm[e2])) + wg[1][e] * (hl ? bfhi(g0[e2]) : bflo(g0[e2])) +
                                 wg[2][e] * (hl ? bfhi(gp[e2]) : bflo(gp[e2])) + bg[e];
                res[hl] = siluf_(gv) * av;
              }
              ov[e2] = pk2(res[0], res[1]);
            }
            *(u32x4*)((bh*)Cv + (size_t)t * 2816 + ja) = ov;
          }
        }
      }
    }
#pragma unroll
    for (int m = 0; m < MT; ++m)
#pragma unroll
      for (int n = 0; n < 4; ++n) {
        if (OUT_BF16 == 1 || OUT_BF16 == 3) continue;
        int col = nt * 128 + wc * 64 + n * 16 + r;
        const size_t rowb = (size_t)mt * BM + wr * (BM / 2) + m * 16 + g * 4;
        if (OUT_BF16 == 2 && nt >= 20) {
          bh* hyt = (bh*)((char*)Cv + OFF_HYT) + (size_t)(col - 2560) * NT + rowb;
          u32x2 pv;
          pv[0] = pk2(acc[m][n][0], acc[m][n][1]);
          pv[1] = pk2(acc[m][n][2], acc[m][n][3]);
          *(u32x2*)hyt = pv;
        } else if (col < N) {
#pragma unroll
          for (int j = 0; j < 4; ++j) {
            size_t row = rowb + j;
            if (OUT_BF16) ((bh*)Cv)[row * ldc + col] = f2bf(acc[m][n][j]);
            else ((float*)Cv)[row * ldc + col] = acc[m][n][j];
          }
        }
      }
  }
}

__device__ __forceinline__ void convert_tile(const float* __restrict__ W, int K, int N, bh* __restrict__ WT, int tile, char* smem, bool perm = false) {
  float* tl = (float*)smem;
  int tid_l_ = threadIdx.x; asm volatile("" : "+v"(tid_l_)); const int tid = tid_l_;
  const int ntk = K >> 6;
  const int kt = tile % ntk, ntile = tile / ntk;
  __syncthreads();
#pragma unroll
  for (int i = 0; i < 16; ++i) {
    int e = tid + i * 256, kk = e >> 6, nn = e & 63, n = ntile * 64 + nn;
    tl[kk * 65 + nn] = (n < N) ? W[(size_t)(kt * 64 + kk) * N + n] : 0.f;
  }
  __syncthreads();
#pragma unroll
  for (int i = 0; i < 16; ++i) {
    int e = tid + i * 256, nn = e >> 6, kk = e & 63;
    const int orow = perm ? (ntile % 44) * 128 + (ntile / 44) * 64 + nn : ntile * 64 + nn;
    WT[(size_t)orow * K + kt * 64 + kk] = f2bf(tl[kk * 65 + nn]);
  }
}

__device__ __forceinline__ void gemv_job(const Params& p, int job, char* smem) {
  float* sc = (float*)smem;
  float* rd = sc + 768;
  int tid_l_ = threadIdx.x; asm volatile("" : "+v"(tid_l_)); const int tid = tid_l_;
  const int iq = job & 3, jb = (job >> 2) % 96, l = (job >> 2) / 96;
  __syncthreads();
  for (int i = tid; i < 768; i += 256) {
    int r = i >> 8, idx = iq * 256 + (i & 255);
    float v = (r == 0) ? p.c_ctx[idx] : p.c[(r - 1) * 1024 + idx];
    sc[i] = siluf_(v);
  }
  __syncthreads();
  const int jl = tid & 63, ig = tid >> 6, j = jb * 64 + jl;
  const float* W = p.ada_w + (size_t)l * 1024 * 6144 + (size_t)(iq * 256 + ig * 64) * 6144 + j;
  float a0 = 0.f, a1 = 0.f, a2 = 0.f;
#pragma unroll 16
  for (int i = 0; i < 64; ++i) {
    float wv = W[(size_t)i * 6144];
    a0 += sc[ig * 64 + i] * wv;
    a1 += sc[256 + ig * 64 + i] * wv;
    a2 += sc[512 + ig * 64 + i] * wv;
  }
  rd[(ig * 3 + 0) * 64 + jl] = a0;
  rd[(ig * 3 + 1) * 64 + jl] = a1;
  rd[(ig * 3 + 2) * 64 + jl] = a2;
  __syncthreads();
  if (tid < 192) {
    int r = tid >> 6, jl2 = tid & 63, j2 = jb * 64 + jl2;
    float sacc = (iq == 0) ? p.ada_b[l * 6144 + j2] : 0.f;
    for (int q = 0; q < 4; ++q) sacc += rd[(q * 3 + r) * 64 + jl2];
    atomicAdd(p.mod + (size_t)(l * 3 + r) * 6144 + j2, sacc);
  }
}

__device__ __forceinline__ void filter_job(const Params& p, int job, char* smem) {
  float* sh2 = (float*)smem;
  int tid_l_ = threadIdx.x; asm volatile("" : "+v"(tid_l_)); const int tid = tid_l_, lane = tid & 63, w = tid >> 6;
  int L, pos0;
  bh* gt;
  if (job < 64) { L = 256; pos0 = job * 4; gt = p.gt256; }
  else { L = 2048; pos0 = (job - 64) * 4; gt = p.gt2048; }
  __syncthreads();
  {
    const int pos = pos0 + w;
    const float t = (float)pos / (float)(L - 1);
    const float wv = 2.0f * 3.14159265358979323846f * (float)pos / (float)L;
    float zv = 0.f;
    if (lane == 0) zv = t;
    else if (lane <= 16) { float fb = 1e-4f + (float)(lane - 1) * ((15.0f - 1e-4f) / 15.0f); zv = cosf(fb * wv); }
    else if (lane <= 32) { float fb = 1e-4f + (float)(lane - 17) * ((15.0f - 1e-4f) / 15.0f); zv = -sinf(fb * wv); }
    const float fr = p.hy_freq[lane];
    float a = p.hy_b1[lane];
    for (int i = 0; i < 33; ++i) a += __shfl(zv, i) * p.hy_w1[i * 64 + lane];
    const float h1 = sinf(fr * a);
    a = p.hy_b2[lane];
    for (int i = 0; i < 64; ++i) a += __shfl(h1, i) * p.hy_w2[i * 64 + lane];
    sh2[w * 64 + lane] = sinf(fr * a);
  }
  __syncthreads();
  float acc[8][4];
#pragma unroll
  for (int m = 0; m < 8; ++m)
#pragma unroll
    for (int pp = 0; pp < 4; ++pp) acc[m][pp] = 0.f;
#pragma unroll 8
  for (int i = 0; i < 64; ++i) {
    const float h0 = sh2[i], h1 = sh2[64 + i], h2 = sh2[128 + i], h3 = sh2[192 + i];
#pragma unroll
    for (int m = 0; m < 8; ++m) {
      const float wv = p.hy_w3[i * 2048 + tid + 256 * m];
      acc[m][0] += wv * h0; acc[m][1] += wv * h1; acc[m][2] += wv * h2; acc[m][3] += wv * h3;
    }
  }
  const float min_decay = logf(1e-2f) / 1.5f, max_decay = logf(1e-2f) / 0.3f;
#pragma unroll
  for (int m = 0; m < 8; ++m) {
    const int o = tid + 256 * m;
    const int ord = o >> 10, side = (o >> 9) & 1, c = o & 511;
    const float delta = fabsf(min_decay + (float)c * ((max_decay - min_decay) / 511.0f));
    bh* grow = gt + (size_t)(ord * 512 + c) * (2 * L);
#pragma unroll
    for (int pp = 0; pp < 4; ++pp) {
      const int pos = pos0 + pp;
      const float t = (float)pos / (float)(L - 1);
      const bh val = f2bf(acc[m][pp] * expf(-t * delta));
      if (side == 0) grow[L - 1 - pos] = val;
      else if (pos >= 1) grow[L - 1 + pos] = val;
    }
  }
}

__device__ __forceinline__ void rows_job(const Params& p, int job, bool first, const bh* src, const float* gres, int lgate, int gate_idx,
                         const float* gnext, int lnext, int shift_idx) {
  int tid_l_ = threadIdx.x; asm volatile("" : "+v"(tid_l_)); const int tid = tid_l_, lane = tid & 63, w = tid >> 6;
  const int rowb = job * 8 + w * 2;
  const int r = rowb < NTP ? 0 : 1 + ((rowb - NTP) >> 11);
  float4 y[2][4], m[2][4];
#pragma unroll
  for (int rr = 0; rr < 2; ++rr) {
    const int row = rowb + rr;
    const float* xin = first ? (row < NTP ? p.x_prompt + (size_t)row * 1024 : p.x_sample + (size_t)(row - NTP) * 1024)
                             : p.out + (size_t)row * 1024;
#pragma unroll
    for (int i = 0; i < 4; ++i) y[rr][i] = *(const float4*)(xin + i * 256 + lane * 4);
    if (src) {
#pragma unroll
      for (int i = 0; i < 4; ++i) { const u32x2 mv = *(const u32x2*)(src + (size_t)row * 1024 + i * 256 + lane * 4); m[rr][i] = make_float4(bflo(mv[0]), bfhi(mv[0]), bflo(mv[1]), bfhi(mv[1])); }
    }
  }
  if (src) {
    const float* gate = p.mod + (size_t)(lgate * 3 + r) * 6144 + gate_idx * 1024;
    float4 gg[4], gt[4];
#pragma unroll
    for (int i = 0; i < 4; ++i) {
      gg[i] = *(const float4*)(gres + i * 256 + lane * 4);
      gt[i] = *(const float4*)(gate + i * 256 + lane * 4);
    }
#pragma unroll
    for (int rr = 0; rr < 2; ++rr) {
      float ss = 0.f;
#pragma unroll
      for (int i = 0; i < 4; ++i)
        ss += m[rr][i].x * m[rr][i].x + m[rr][i].y * m[rr][i].y + m[rr][i].z * m[rr][i].z + m[rr][i].w * m[rr][i].w;
      ss = wave_sum(ss);
      const float rs = rsqrtf(ss * (1.f / 1024.f) + EPSF);
#pragma unroll
      for (int i = 0; i < 4; ++i) {
        y[rr][i].x += gt[i].x * (m[rr][i].x * rs * gg[i].x);
        y[rr][i].y += gt[i].y * (m[rr][i].y * rs * gg[i].y);
        y[rr][i].z += gt[i].z * (m[rr][i].z * rs * gg[i].z);
        y[rr][i].w += gt[i].w * (m[rr][i].w * rs * gg[i].w);
      }
    }
  }
  if (src) {
#pragma unroll
    for (int rr = 0; rr < 2; ++rr)
#pragma unroll
      for (int i = 0; i < 4; ++i) *(float4*)(p.out + (size_t)(rowb + rr) * 1024 + i * 256 + lane * 4) = y[rr][i];
  }
  if (gnext) {
    const float* sh = p.mod + (size_t)(lnext * 3 + r) * 6144 + shift_idx * 1024;
    const float* scl = sh + 1024;
    float4 gg[4], s4[4], c4[4];
#pragma unroll
    for (int i = 0; i < 4; ++i) {
      gg[i] = *(const float4*)(gnext + i * 256 + lane * 4);
      s4[i] = *(const float4*)(sh + i * 256 + lane * 4);
      c4[i] = *(const float4*)(scl + i * 256 + lane * 4);
    }
#pragma unroll
    for (int rr = 0; rr < 2; ++rr) {
      float ss = 0.f;
#pragma unroll
      for (int i = 0; i < 4; ++i)
        ss += y[rr][i].x * y[rr][i].x + y[rr][i].y * y[rr][i].y + y[rr][i].z * y[rr][i].z + y[rr][i].w * y[rr][i].w;
      ss = wave_sum(ss);
      const float rs = rsqrtf(ss * (1.f / 1024.f) + EPSF);
      bh* arow = p.act + (size_t)(rowb + rr) * 1024;
#pragma unroll
      for (int i = 0; i < 4; ++i) {
        ushort4 o;
        o.x = f2bf(y[rr][i].x * rs * gg[i].x * (1.f + c4[i].x) + s4[i].x);
        o.y = f2bf(y[rr][i].y * rs * gg[i].y * (1.f + c4[i].y) + s4[i].y);
        o.z = f2bf(y[rr][i].z * rs * gg[i].z * (1.f + c4[i].z) + s4[i].z);
        o.w = f2bf(y[rr][i].w * rs * gg[i].w * (1.f + c4[i].w) + s4[i].w);
        *(ushort4*)(arow + i * 256 + lane * 4) = o;
      }
    }
  }
}

template <int CTRL>
__device__ __forceinline__ float dppf(float v) {
  return __int_as_float(__builtin_amdgcn_update_dpp(0, __float_as_int(v), CTRL, 0xF, 0xF, true));
}
__device__ __forceinline__ float sum16(float v) {
  v += dppf<0xB1>(v); v += dppf<0x4E>(v); v += dppf<0x141>(v); v += dppf<0x140>(v);
  return v;
}
__device__ __forceinline__ float max16(float v) {
  v = fmaxf(v, dppf<0xB1>(v)); v = fmaxf(v, dppf<0x4E>(v)); v = fmaxf(v, dppf<0x141>(v)); v = fmaxf(v, dppf<0x140>(v));
  return v;
}

typedef short s16x4 __attribute__((ext_vector_type(4)));

#define OFF_SC_EVEN 188743680ull
#define OFF_SC_ODD 79691776ull
#define SC_SLOC 8388608ull
#define SC_DECT 16777216ull

template <int MODE, int SKIP = 0>
__device__ __forceinline__ void scan2_unit(const Params& p, int unit, char* smem) {
  constexpr int DK = MODE == 0 ? 128 : 64;
  constexpr int LD = MODE == 0 ? 4096 : 3104;
  constexpr int NQ = DK / 32;
  constexpr int NP = 256 / DK;
  constexpr int TPP = 16 / NP;
  constexpr int RS = DK + 8;
  constexpr int TPT = DK / 8;
  float* sq = (float*)smem;
  float* slf = sq + 16 * DK;
  float* skk = slf + 16 * DK;
  bh* QE = (bh*)(skk + 16 * DK);
  bh* KE = QE + 16 * RS;
  bh* KLT = KE + 16 * RS;
  bh* VT = KLT + DK * 24;
  float* dec = (float*)(VT + 128 * 24);
  float* sx = dec + DK;
  int tid_l_ = threadIdx.x; asm volatile("" : "+v"(tid_l_)); const int tid = tid_l_, lane = tid & 63, w = tid >> 6, r = lane & 15, g = lane >> 4;
  const int dir = unit & 1, h = (unit >> 1) & 3, ss = unit >> 3;
  const bool samp = ss >= 32;
  const int sb = (ss - 32) >> 3, seg = (ss - 32) & 7;
  const int rbase = samp ? (NTP + sb * 2048 + (dir ? 2047 - seg * 256 : seg * 256)) : (ss * 256 + (dir ? 255 : 0));
  const int sgn = dir ? -1 : 1;
  const bh* proj = (const bh*)p.R;
  char* scbase = p.R + (MODE == 0 ? OFF_SC_EVEN : OFF_SC_ODD);
  bh* QB = (bh*)scbase;
  float* odir = (float*)(p.R + OFF_ODIR) + (size_t)dir * NT * 512;
  __syncthreads();
  if (MODE == 0) {
    for (int k = tid; k < 128; k += 256) {
      int ci = dir * 512 + h * 128 + k;
      float x0 = p.hgrn_lb[ci], x1 = p.hgrn_lb[1024 + ci], x2 = p.hgrn_lb[2048 + ci];
      float mx = fmaxf(x0, fmaxf(x1, x2));
      float e0 = expf(x0 - mx), e1 = expf(x1 - mx), e2 = expf(x2 - mx);
      sx[k] = e0 / (e0 + e1 + e2);
    }
  } else {
    for (int i = tid; i < 1024; i += 256) {
      int rr = i >> 6, k = i & 63;
      sx[i] = p.gla_aw[(size_t)(dir * 16 + rr) * 256 + h * 64 + k];
    }
    if (tid < 64) sx[1024 + tid] = p.gla_ab[dir * 256 + h * 64 + tid];
  }
  f32x4 S[2 * NQ][2];
#pragma unroll
  for (int a = 0; a < 2 * NQ; ++a) { S[a][0] = (f32x4){0.f, 0.f, 0.f, 0.f}; S[a][1] = (f32x4){0.f, 0.f, 0.f, 0.f}; }
  constexpr int EPT = MODE == 0 ? 8 : 4;
  const int li = tid >> 4, lk8 = (tid & 15) * EPT;
  const int vi = tid >> 4, v8 = (tid & 15) * 8;
  const int pk = tid % DK, ppart = tid / DK;
  float basec = 0.f;
  u32x4 rq = {0, 0, 0, 0}, rf = {0, 0, 0, 0}, rv = {0, 0, 0, 0}, rd0 = {0, 0, 0, 0}, rd1 = {0, 0, 0, 0};
  auto issue = [&](int c) {
    {
      const bh* pr = proj + (size_t)(rbase + sgn * (c * 16 + li)) * LD;
      if (MODE == 0) {
        rq = *(const u32x4*)(pr + h * 128 + lk8);
        rf = *(const u32x4*)(pr + 512 + dir * 512 + h * 128 + lk8);
      } else {
        const u32x2 q2 = *(const u32x2*)(pr + 1536 + h * 64 + lk8);
        const u32x2 k2 = *(const u32x2*)(pr + 1792 + h * 64 + lk8);
        rq[0] = q2[0]; rq[1] = q2[1]; rf[0] = k2[0]; rf[1] = k2[1];
        rd0 = *(const u32x4*)(pr + 3072 + dir * 16);
        rd1 = *(const u32x4*)(pr + 3072 + dir * 16 + 8);
      }
    }
    {
      const bh* pr = proj + (size_t)(rbase + sgn * (c * 16 + vi)) * LD;
      rv = *(const u32x4*)(pr + (MODE == 0 ? 1536 : 2048) + h * 128 + v8);
    }
  };
  issue(0);
#pragma unroll 1
  for (int c = 0; c < 16; ++c) {
    __syncthreads();
    if (SKIP != 3) {
      float oq[EPT], ol[EPT], ok[EPT];
      if (MODE == 0) {
#pragma unroll
        for (int e = 0; e < EPT; ++e) {
          float q = (e & 1) ? bfhi(rq[e >> 1]) : bflo(rq[e >> 1]);
          float ff = (e & 1) ? bfhi(rf[e >> 1]) : bflo(rf[e >> 1]);
          float lb = sx[lk8 + e];
          float f = lb + (1.f - lb) * sigmoidf_(ff);
          oq[e] = siluf_(q) * 0.08838834764831845f;
          ol[e] = __logf(f);
          ok[e] = 1.f - f;
        }
      } else {
        float da[16];
#pragma unroll
        for (int rr = 0; rr < 16; ++rr) {
          unsigned wd = rr < 8 ? rd0[(rr & 7) >> 1] : rd1[(rr & 7) >> 1];
          da[rr] = (rr & 1) ? bfhi(wd) : bflo(wd);
        }
        float xx[4];
        {
          float4 b0_ = *(const float4*)(sx + 1024 + lk8);
          xx[0] = b0_.x; xx[1] = b0_.y; xx[2] = b0_.z; xx[3] = b0_.w;
        }
#pragma unroll
        for (int rr = 0; rr < 16; ++rr) {
          float4 a0_ = *(const float4*)(sx + rr * 64 + lk8);
          xx[0] += da[rr] * a0_.x; xx[1] += da[rr] * a0_.y; xx[2] += da[rr] * a0_.z; xx[3] += da[rr] * a0_.w;
        }
#pragma unroll
        for (int e = 0; e < 4; ++e) {
          float q = (e & 1) ? bfhi(rq[e >> 1]) : bflo(rq[e >> 1]);
          float kk = (e & 1) ? bfhi(rf[e >> 1]) : bflo(rf[e >> 1]);
          float x = xx[e];
          float ls = fminf(x, 0.f) - __logf(1.f + __expf(-fabsf(x)));
          oq[e] = q * 0.125f;
          ol[e] = ls * 0.0625f;
          ok[e] = kk;
        }
      }
      float* dq_ = sq + li * DK + lk8;
      float* dl_ = slf + li * DK + lk8;
      float* dk_ = skk + li * DK + lk8;
#pragma unroll
      for (int e4 = 0; e4 < EPT; e4 += 4) {
        *(float4*)(dq_ + e4) = make_float4(oq[e4], oq[e4 + 1], oq[e4 + 2], oq[e4 + 3]);
        *(float4*)(dl_ + e4) = make_float4(ol[e4], ol[e4 + 1], ol[e4 + 2], ol[e4 + 3]);
        *(float4*)(dk_ + e4) = make_float4(ok[e4], ok[e4 + 1], ok[e4 + 2], ok[e4 + 3]);
      }
    }
#pragma unroll
    for (int e = 0; e < 8; ++e) {
      unsigned wv = rv[e >> 1];
      VT[(v8 + e) * 24 + vi] = (bh)((e & 1) ? (wv >> 16) : (wv & 0xffffu));
    }
    __syncthreads();
    if (c + 1 < 16) issue(c + 1);
    {
      float total = 0.f, pre = 0.f;
#pragma unroll
      for (int i = 0; i < 16; ++i) {
        float l = slf[i * DK + pk];
        if (i < ppart * TPP) pre += l;
        total += l;
      }
      unsigned kw[TPP / 2];
#pragma unroll
      for (int ii = 0; ii < TPP; ii += 2) {
        float klv[2];
#pragma unroll
        for (int u = 0; u < 2; ++u) {
          const int i = ppart * TPP + ii + u;
          pre += slf[i * DK + pk];
          const float qv = sq[i * DK + pk], kv = skk[i * DK + pk];
          QE[i * RS + pk] = f2bf(qv * __expf(pre));
          KE[i * RS + pk] = f2bf(kv * __expf(-pre));
          klv[u] = kv * __expf(total - pre);
          if (samp) {
            const int row = rbase + sgn * (c * 16 + i);
            QB[((size_t)dir * 4096 + (row - NTP)) * (4 * DK) + h * DK + pk] = f2bf(qv * __expf(basec + pre));
          }
        }
        kw[ii >> 1] = pk2(klv[0], klv[1]);
      }
      if (TPP == 8) {
        u32x4 kv4 = {kw[0], kw[1], kw[(TPP / 2) > 2 ? 2 : 0], kw[(TPP / 2) > 3 ? 3 : 0]};
        *(u32x4*)(KLT + pk * 24 + ppart * 8) = kv4;
      } else {
        u32x2 kv2 = {kw[0], kw[1]};
        *(u32x2*)(KLT + pk * 24 + ppart * 4) = kv2;
      }
      if (ppart == 0) dec[pk] = __expf(total);
      basec += total;
    }
    __syncthreads();
    {
      bf16x8 qf[NQ], kf[NQ];
#pragma unroll
      for (int q = 0; q < NQ; ++q) {
        qf[q] = *(const bf16x8*)(QE + r * RS + q * 32 + g * 8);
        kf[q] = *(const bf16x8*)(KE + r * RS + q * 32 + g * 8);
      }
      f32x4 at = (f32x4){0.f, 0.f, 0.f, 0.f};
#pragma unroll
      for (int q = 0; q < NQ; ++q) at = __builtin_amdgcn_mfma_f32_16x16x32_bf16(kf[q], qf[q], at, 0, 0, 0);
      u32x2 paw;
      paw[0] = pk2((g * 4 + 0 <= r) ? at[0] : 0.f, (g * 4 + 1 <= r) ? at[1] : 0.f);
      paw[1] = pk2((g * 4 + 2 <= r) ? at[2] : 0.f, (g * 4 + 3 <= r) ? at[3] : 0.f);
      const s16x4 pa = __builtin_bit_cast(s16x4, paw);
      s16x4 vf[2];
      f32x4 o[2];
#pragma unroll
      for (int nt = 0; nt < 2; ++nt) {
        vf[nt] = *(const s16x4*)(VT + (w * 32 + nt * 16 + r) * 24 + g * 4);
        o[nt] = __builtin_amdgcn_mfma_f32_16x16x16bf16_1k(pa, vf[nt], (f32x4){0.f, 0.f, 0.f, 0.f}, 0, 0, 0);
      }
#pragma unroll
      for (int q = 0; q < NQ; ++q) {
#pragma unroll
        for (int half = 0; half < 2; ++half) {
          const s16x4 qa = half == 0 ? __builtin_shufflevector(qf[q], qf[q], 0, 1, 2, 3)
                                     : __builtin_shufflevector(qf[q], qf[q], 4, 5, 6, 7);
#pragma unroll
          for (int nt = 0; nt < 2; ++nt) {
            const f32x4 sv_ = S[2 * q + half][nt];
            u32x2 sw;
            sw[0] = pk2(sv_[0], sv_[1]);
            sw[1] = pk2(sv_[2], sv_[3]);
            o[nt] = __builtin_amdgcn_mfma_f32_16x16x16bf16_1k(qa, __builtin_bit_cast(s16x4, sw), o[nt], 0, 0, 0);
          }
        }
      }
#pragma unroll
      for (int nt = 0; nt < 2; ++nt)
#pragma unroll
        for (int j = 0; j < 4; ++j) {
          const int row = rbase + sgn * (c * 16 + g * 4 + j);
          odir[(size_t)row * 512 + h * 128 + w * 32 + nt * 16 + r] = o[nt][j];
        }
#pragma unroll
      for (int q = 0; q < NQ; ++q) {
#pragma unroll
        for (int half = 0; half < 2; ++half) {
          const float4 d4 = *(const float4*)(dec + q * 32 + g * 8 + half * 4);
          const int ka = q * 32 + (r >> 2) * 8 + half * 4 + (r & 3);
          const s16x4 ka4 = *(const s16x4*)(KLT + ka * 24 + g * 4);
#pragma unroll
          for (int nt = 0; nt < 2; ++nt) {
            f32x4 sv_ = S[2 * q + half][nt];
            sv_[0] *= d4.x; sv_[1] *= d4.y; sv_[2] *= d4.z; sv_[3] *= d4.w;
            S[2 * q + half][nt] = __builtin_amdgcn_mfma_f32_16x16x16bf16_1k(ka4, vf[nt], sv_, 0, 0, 0);
          }
        }
      }
    }
  }
  {
    float* so;
    if (!samp) so = p.out + (MODE == 0 ? OUT_HGRN : OUT_GLA) + ((size_t)(ss * 2 + dir) * 4 + h) * DK * 128;
    else {
      const int us = ((sb * 4 + h) * 2 + dir) * 8 + seg;
      so = (float*)(scbase + SC_SLOC) + (size_t)us * DK * 128;
      if (ppart == 0) ((float*)(scbase + SC_DECT))[us * DK + pk] = __expf(basec);
    }
#pragma unroll
    for (int q = 0; q < NQ; ++q)
#pragma unroll
      for (int half = 0; half < 2; ++half)
#pragma unroll
        for (int nt = 0; nt < 2; ++nt)
#pragma unroll
          for (int j = 0; j < 4; ++j)
            so[(size_t)(q * 32 + g * 8 + half * 4 + j) * 128 + w * 32 + nt * 16 + r] = S[2 * q + half][nt][j];
  }
}

template <int MODE>
__device__ __forceinline__ void fixup_unit(const Params& p, int unit, char* smem) {
  constexpr int DK = MODE == 0 ? 128 : 64;
  constexpr int NQ = DK / 32;
  constexpr int RS = DK + 8;
  bh* ST = (bh*)smem;
  int tid_l_ = threadIdx.x; asm volatile("" : "+v"(tid_l_)); const int tid = tid_l_, lane = tid & 63, w = tid >> 6, r = lane & 15, g = lane >> 4;
  const int seg = unit & 7, dir = (unit >> 3) & 1, h = (unit >> 4) & 3, sb = unit >> 6;
  const int unit0 = unit & ~7;
  char* scbase = p.R + (MODE == 0 ? OFF_SC_EVEN : OFF_SC_ODD);
  const bh* QB = (const bh*)scbase;
  const float* SLOC = (const float*)(scbase + SC_SLOC);
  const float* DECT = (const float*)(scbase + SC_DECT);
  const float* s0 = (MODE == 0 ? p.state_hgrn : p.state_gla) + ((size_t)(sb * 2 + dir) * 4 + h) * DK * 128;
  float* odir = (float*)(p.R + OFF_ODIR) + (size_t)dir * NT * 512;
  __syncthreads();
  for (int m = 0; m < DK * 128 / 256; ++m) {
    const int e = tid + 256 * m, k = e >> 7, v = e & 127;
    float cur = s0[e];
    for (int jj = 0; jj < seg; ++jj)
      cur = DECT[(unit0 + jj) * DK + k] * cur + SLOC[(size_t)(unit0 + jj) * DK * 128 + e];
    ST[v * RS + k] = f2bf(cur);
  }
  __syncthreads();
  const int rbase = NTP + sb * 2048 + (dir ? 2047 - seg * 256 : seg * 256);
  const int sgn = dir ? -1 : 1;
#pragma unroll 1
  for (int mt = 0; mt < 4; ++mt) {
    f32x4 acc[8];
#pragma unroll
    for (int nt = 0; nt < 8; ++nt) acc[nt] = (f32x4){0.f, 0.f, 0.f, 0.f};
    const int rowa = rbase + sgn * (w * 64 + mt * 16 + r);
    const bh* qrow = QB + ((size_t)dir * 4096 + (rowa - NTP)) * (4 * DK) + h * DK + g * 8;
#pragma unroll
    for (int q = 0; q < NQ; ++q) {
      const bf16x8 a = *(const bf16x8*)(qrow + q * 32);
#pragma unroll
      for (int nt = 0; nt < 8; ++nt) {
        const bf16x8 b = *(const bf16x8*)(ST + (nt * 16 + r) * RS + q * 32 + g * 8);
        acc[nt] = __builtin_amdgcn_mfma_f32_16x16x32_bf16(a, b, acc[nt], 0, 0, 0);
      }
    }
#pragma unroll
    for (int nt = 0; nt < 8; ++nt)
#pragma unroll
      for (int j = 0; j < 4; ++j) {
        const int row = rbase + sgn * (w * 64 + mt * 16 + g * 4 + j);
        float* dst = odir + (size_t)row * 512 + h * 128 + nt * 16 + r;
        *dst += acc[nt][j];
      }
  }
}

__device__ __forceinline__ void scan_final_job(const Params& p, int job, int mode) {
  int tid_l_ = threadIdx.x; asm volatile("" : "+v"(tid_l_)); const int tid = tid_l_, lane = tid & 63, w = tid >> 6;
  const int rowb = job * 8 + w * 2;
  const int ld = mode == 0 ? 4096 : 3104;
  const int gcol = mode == 0 ? 2048 : 2560;
  const float* nrm = mode == 0 ? p.hgrn_norm : p.gla_norm;
  float2 a[2][4], b[2][4];
  unsigned gw[2][4];
#pragma unroll
  for (int rr = 0; rr < 2; ++rr) {
    const int row = rowb + rr;
    const float* o0 = (const float*)(p.R + OFF_ODIR) + (size_t)row * 512;
    const float* o1 = o0 + (size_t)NT * 512;
    const bh* proj = (const bh*)p.R + (size_t)row * ld;
#pragma unroll
    for (int h = 0; h < 4; ++h) {
      const int c = h * 128 + lane * 2;
      a[rr][h] = *(const float2*)(o0 + c);
      b[rr][h] = *(const float2*)(o1 + c);
      gw[rr][h] = *(const unsigned*)(proj + gcol + c);
    }
  }
  float2 nv[4];
#pragma unroll
  for (int h = 0; h < 4; ++h) nv[h] = *(const float2*)(nrm + h * 128 + lane * 2);
#pragma unroll
  for (int rr = 0; rr < 2; ++rr) {
    bh* arow = p.act + (size_t)(rowb + rr) * 1024 + (mode == 0 ? 0 : 512);
#pragma unroll
    for (int h = 0; h < 4; ++h) {
      const int c = h * 128 + lane * 2;
      float v0 = a[rr][h].x + b[rr][h].x, v1 = a[rr][h].y + b[rr][h].y;
      float ss = wave_sum(v0 * v0 + v1 * v1);
      float rs = rsqrtf(ss * (1.f / 128.f) + EPSF);
      float g0 = bflo(gw[rr][h]), g1 = bfhi(gw[rr][h]);
      *(unsigned*)(arow + c) = pk2(v0 * rs * nv[h].x * siluf_(g0), v1 * rs * nv[h].y * siluf_(g1));
    }
  }
}

using f32x16 = __attribute__((ext_vector_type(16))) float;
__device__ __forceinline__ bf16x8 toep_frag(const unsigned* Gd, int m0) {
  const int q = m0 >> 1;
  const unsigned sh = (unsigned)(m0 & 1) * 2u;
  const unsigned D0 = Gd[q], D1 = Gd[q + 1], D2 = Gd[q + 2], D3 = Gd[q + 3], D4 = Gd[q + 4];
  u32x4 f;
  f[0] = __builtin_amdgcn_alignbyte(D1, D0, sh);
  f[1] = __builtin_amdgcn_alignbyte(D2, D1, sh);
  f[2] = __builtin_amdgcn_alignbyte(D3, D2, sh);
  f[3] = __builtin_amdgcn_alignbyte(D4, D3, sh);
  return __builtin_bit_cast(bf16x8, f);
}
__device__ __forceinline__ void conv4(const bh* raw, int t, int L, float w0, float w1, float w2, float bb, float* out) {
  const u32x2 x = *(const u32x2*)(raw + t);
  const float xm = t > 0 ? bf2f(raw[t - 1]) : 0.f;
  const float xp = (t + 4 < L) ? bf2f(raw[t + 4]) : 0.f;
  const float x0 = bflo(x[0]), x1 = bfhi(x[0]), x2 = bflo(x[1]), x3 = bfhi(x[1]);
  out[0] = w0 * xm + w1 * x0 + w2 * x1 + bb;
  out[1] = w0 * x0 + w1 * x1 + w2 * x2 + bb;
  out[2] = w0 * x1 + w1 * x2 + w2 * x3 + bb;
  out[3] = w0 * x2 + w1 * x3 + w2 * xp + bb;
}
__device__ __forceinline__ u32x4 conv8(const bh* raw, int t, int L, float w0, float w1, float w2, float bb) {
  const u32x4 x = *(const u32x4*)(raw + t);
  float v[10];
  v[0] = t > 0 ? bf2f(raw[t - 1]) : 0.f;
  v[9] = (t + 8 < L) ? bf2f(raw[t + 8]) : 0.f;
#pragma unroll
  for (int e = 0; e < 4; ++e) { v[1 + 2 * e] = bflo(x[e]); v[2 + 2 * e] = bfhi(x[e]); }
  u32x4 o;
#pragma unroll
  for (int e = 0; e < 4; ++e)
    o[e] = pk2(w0 * v[2 * e] + w1 * v[2 * e + 1] + w2 * v[2 * e + 2] + bb, w0 * v[2 * e + 1] + w1 * v[2 * e + 2] + w2 * v[2 * e + 3] + bb);
  return o;
}

__device__ __forceinline__ void hyena_sample_job(const Params& p, int job, char* smem) {
  int tid_l_ = threadIdx.x; asm volatile("" : "+v"(tid_l_)); const int tid = tid_l_, lane = tid & 63, w = tid >> 6;
  const int col = lane & 31, kh = lane >> 5;
  const int cc = w >> 1, nh = w & 1;
  const int sb = job & 1, c0 = (job >> 1) * 2, c = c0 + cc;
  bh* G = (bh*)(smem + cc * 12288);
  bh* U = G + 4096;
  const unsigned* Gd = (const unsigned*)G;
  const bh* HYT = (const bh*)(p.R + OFF_HYT);
  const int rowoff = NTP + sb * 2048;
  __syncthreads();
  {
    const float vw0 = p.hy_conv_w[c], vw1 = p.hy_conv_w[1536 + c], vw2 = p.hy_conv_w[3072 + c], vb = p.hy_conv_b[c];
    const bh* raw = HYT + (size_t)c * NT + rowoff;
#pragma unroll
    for (int i = 0; i < 2; ++i) {
      const int t0 = (nh * 128 + lane + 64 * i) * 8;
      *(u32x4*)(U + t0) = conv8(raw, t0, 2048, vw0, vw1, vw2, vb);
    }
  }
#pragma unroll 1
  for (int ord = 0; ord < 2; ++ord) {
    {
      const bh* gsrc = p.gt2048 + (size_t)(ord * 512 + c) * 4096;
#pragma unroll
      for (int i = 0; i < 4; ++i) {
        const int e8 = (nh * 256 + lane + 64 * i) * 8;
        *(u32x4*)(G + e8) = *(const u32x4*)(gsrc + e8);
      }
    }
    __syncthreads();
    f32x16 acc;
#pragma unroll
    for (int i = 0; i < 16; ++i) acc[i] = 0.f;
    const int mbase = 2047 - col + kh * 8;
    const int dlo = nh == 0 ? -63 : -31, dhi = nh == 0 ? 31 : 63;
#pragma unroll 2
    for (int d = dlo; d <= dhi; ++d) {
      const bf16x8 a0 = toep_frag(Gd, mbase - d * 32);
      const bf16x8 a1 = toep_frag(Gd, mbase - d * 32 + 16);
      const int s1 = nh * 32 + col - d;
      const bool ok = (unsigned)s1 < 64u;
      const int s1c = ok ? s1 : 0;
      u32x4 b0 = *(const u32x4*)(U + s1c * 32 + kh * 8);
      u32x4 b1 = *(const u32x4*)(U + s1c * 32 + 16 + kh * 8);
      if (!ok) { b0 = (u32x4){0, 0, 0, 0}; b1 = (u32x4){0, 0, 0, 0}; }
      acc = __builtin_amdgcn_mfma_f32_32x32x16_bf16(a0, __builtin_bit_cast(bf16x8, b0), acc, 0, 0, 0);
      acc = __builtin_amdgcn_mfma_f32_32x32x16_bf16(a1, __builtin_bit_cast(bf16x8, b1), acc, 0, 0, 0);
    }
    __syncthreads();
    const int gi = (ord + 1) * 512 + c;
    const float gw0 = p.hy_conv_w[gi], gw1 = p.hy_conv_w[1536 + gi], gw2 = p.hy_conv_w[3072 + gi], gb = p.hy_conv_b[gi];
    const float dd = p.hy_d[ord * 512 + c];
    const bh* graw = HYT + (size_t)gi * NT + rowoff;
#pragma unroll
    for (int rq = 0; rq < 4; ++rq) {
      const int trun = (nh * 32 + col) * 32 + 8 * rq + 4 * kh;
      float gte[4];
      conv4(graw, trun, 2048, gw0, gw1, gw2, gb, gte);
      const u32x2 uo = *(const u32x2*)(U + trun);
      u32x2 zo;
      zo[0] = pk2(gte[0] * (acc[rq * 4 + 0] + bflo(uo[0]) * dd), gte[1] * (acc[rq * 4 + 1] + bfhi(uo[0]) * dd));
      zo[1] = pk2(gte[2] * (acc[rq * 4 + 2] + bflo(uo[1]) * dd), gte[3] * (acc[rq * 4 + 3] + bfhi(uo[1]) * dd));
      *(u32x2*)(U + trun) = zo;
    }
    __syncthreads();
  }
#pragma unroll
  for (int rr = 0; rr < 8; ++rr) {
    const int t = tid + 256 * rr;
    const unsigned z0 = *(const bh*)(smem + 8192 + t * 2);
    const unsigned z1 = *(const bh*)(smem + 12288 + 8192 + t * 2);
    *(unsigned*)(p.act + (size_t)(rowoff + t) * 1024 + 512 + c0) = z0 | (z1 << 16);
  }
}

__device__ __forceinline__ void hyena_prompt_job(const Params& p, int job, char* smem) {
  int tid_l_ = threadIdx.x; asm volatile("" : "+v"(tid_l_)); const int tid = tid_l_, lane = tid & 63, w = tid >> 6;
  const int col = lane & 31, kh = lane >> 5;
  const int cc = w >> 1, th = w & 1;
  const int c0 = job * 2, c = c0 + cc;
  bh* Uall = (bh*)smem;
  bh* Gall = (bh*)(smem + 2 * 32 * 264 * 2);
  bh* U = Uall + cc * 32 * 264;
  const unsigned* Gd = (const unsigned*)(Gall + cc * 512);
  const bh* HYT = (const bh*)(p.R + OFF_HYT);
  __syncthreads();
#pragma unroll 1
  for (int c2 = 0; c2 < 2; ++c2) {
    const int ch = c0 + c2;
    const float vw0 = p.hy_conv_w[ch], vw1 = p.hy_conv_w[1536 + ch], vw2 = p.hy_conv_w[3072 + ch], vb = p.hy_conv_b[ch];
#pragma unroll
    for (int i = 0; i < 4; ++i) {
      const int tg = (tid + 256 * i) * 8, b = tg >> 8, t = tg & 255;
      *(u32x4*)(Uall + c2 * 32 * 264 + b * 264 + t) = conv8(HYT + (size_t)ch * NT + b * 256, t, 256, vw0, vw1, vw2, vb);
    }
  }
#pragma unroll 1
  for (int ord = 0; ord < 2; ++ord) {
    if (tid < 128) {
      const int c2 = tid >> 6, l2 = tid & 63;
      *(u32x4*)(Gall + c2 * 512 + l2 * 8) = *(const u32x4*)(p.gt256 + (size_t)(ord * 512 + c0 + c2) * 512 + l2 * 8);
    }
    __syncthreads();
    f32x16 acc[4];
#pragma unroll
    for (int q = 0; q < 4; ++q)
#pragma unroll
      for (int i = 0; i < 16; ++i) acc[q][i] = 0.f;
    const int mbase = 255 - col + kh * 8;
#pragma unroll
    for (int q = 0; q < 4; ++q) {
      const int t1 = th * 4 + q;
#pragma unroll 2
      for (int s1 = 0; s1 < 8; ++s1) {
        const int d = t1 - s1;
        const bf16x8 a0 = toep_frag(Gd, mbase - d * 32);
        const bf16x8 a1 = toep_frag(Gd, mbase - d * 32 + 16);
        const bf16x8 b0 = *(const bf16x8*)(U + col * 264 + s1 * 32 + kh * 8);
        const bf16x8 b1 = *(const bf16x8*)(U + col * 264 + s1 * 32 + 16 + kh * 8);
        acc[q] = __builtin_amdgcn_mfma_f32_32x32x16_bf16(a0, b0, acc[q], 0, 0, 0);
        acc[q] = __builtin_amdgcn_mfma_f32_32x32x16_bf16(a1, b1, acc[q], 0, 0, 0);
      }
    }
    __syncthreads();
    const int gi = (ord + 1) * 512 + c;
    const float gw0 = p.hy_conv_w[gi], gw1 = p.hy_conv_w[1536 + gi], gw2 = p.hy_conv_w[3072 + gi], gb = p.hy_conv_b[gi];
    const float dd = p.hy_d[ord * 512 + c];
    const bh* graw = HYT + (size_t)gi * NT + col * 256;
#pragma unroll
    for (int q = 0; q < 4; ++q)
#pragma unroll
      for (int rq = 0; rq < 4; ++rq) {
        const int trun = (th * 4 + q) * 32 + 8 * rq + 4 * kh;
        float gte[4];
        conv4(graw, trun, 256, gw0, gw1, gw2, gb, gte);
        bh* up = U + col * 264 + trun;
        const u32x2 uo = *(const u32x2*)up;
        u32x2 zo;
        zo[0] = pk2(gte[0] * (acc[q][rq * 4 + 0] + bflo(uo[0]) * dd), gte[1] * (acc[q][rq * 4 + 1] + bfhi(uo[0]) * dd));
        zo[1] = pk2(gte[2] * (acc[q][rq * 4 + 2] + bflo(uo[1]) * dd), gte[3] * (acc[q][rq * 4 + 3] + bfhi(uo[1]) * dd));
        *(u32x2*)up = zo;
      }
    __syncthreads();
  }
#pragma unroll 4
  for (int i = 0; i < 32; ++i) {
    const int e = tid + 256 * i, b = e >> 8, t = e & 255;
    const unsigned z0 = Uall[b * 264 + t], z1 = Uall[32 * 264 + b * 264 + t];
    *(unsigned*)(p.act + (size_t)e * 1024 + 512 + c0) = z0 | (z1 << 16);
  }
}

__device__ __forceinline__ void oddrow_job(const Params& p, int job) {
  int tid_l_ = threadIdx.x; asm volatile("" : "+v"(tid_l_)); const int tid = tid_l_, lane = tid & 63, w = tid >> 6;
  const int row = job * 4 + w;
  const bh* pr = (const bh*)p.R + (size_t)row * 3104;
  bh* Q = (bh*)(p.R + OFF_Q) + (size_t)row * 512;
  bh* KB = (bh*)(p.R + OFF_KB);
  if (row < NTP) {
    const int b = row >> 8, t = row & 255;
    const int e0 = lane * 8, h = e0 >> 7, x = e0 & 127;
    const u32x4 qv = *(const u32x4*)(pr + e0);
    const u32x4 kv = *(const u32x4*)(pr + 512 + e0);
    const u32x4 vv = *(const u32x4*)(pr + 1024 + e0);
    const size_t idx = ((size_t)(b * 4 + h) * 256 + t) * 128 + x;
    *(u32x4*)(Q + e0) = qv;
    *(u32x4*)(KB + idx) = kv;
    float4 k0 = make_float4(bflo(kv[0]), bfhi(kv[0]), bflo(kv[1]), bfhi(kv[1]));
    float4 k1 = make_float4(bflo(kv[2]), bfhi(kv[2]), bflo(kv[3]), bfhi(kv[3]));
    float4 v0 = make_float4(bflo(vv[0]), bfhi(vv[0]), bflo(vv[1]), bfhi(vv[1]));
    float4 v1 = make_float4(bflo(vv[2]), bfhi(vv[2]), bflo(vv[3]), bfhi(vv[3]));
    *(float4*)(p.out + OUT_CK + idx) = k0;
    *(float4*)(p.out + OUT_CK + idx + 4) = k1;
    *(float4*)(p.out + OUT_CV + idx) = v0;
    *(float4*)(p.out + OUT_CV + idx + 4) = v1;
  } else {
    const int sb = (row - NTP) >> 11, t = (row - NTP) & 2047;
    const int rpos = t >> 6, cpos = t & 63;
    float q1[4], q2[4], k1[4], k2[4];
#pragma unroll
    for (int m = 0; m < 4; ++m) {
      int pi = lane + 64 * m;
      int h = pi >> 6, rem = pi & 63, pp = rem >> 5, part = (rem >> 4) & 1, i = rem & 15;
      int d1 = h * 128 + pp * 64 + part * 32 + i, d2 = d1 + 16;
      q1[m] = bf2f(pr[d1]); q2[m] = bf2f(pr[d2]);
      k1[m] = bf2f(pr[512 + d1]); k2[m] = bf2f(pr[512 + d2]);
    }
#pragma unroll
    for (int m = 0; m < 4; ++m) {
      int pi = lane + 64 * m;
      int h = pi >> 6, rem = pi & 63, pp = rem >> 5, part = (rem >> 4) & 1, i = rem & 15;
      int d1 = h * 128 + pp * 64 + part * 32 + i, d2 = d1 + 16;
      float pos = (float)(part ? cpos : rpos);
      float inv = expf(-(float)i * (9.210340371976184f / 16.f));
      float ang = pos * inv;
      float cs = cosf(ang), sn = sinf(ang);
      Q[d1] = f2bf(q1[m] * cs - q2[m] * sn);
      Q[d2] = f2bf(q1[m] * sn + q2[m] * cs);
      size_t kb = KV_SAMPLE_BASE + ((size_t)(sb * 4 + h) * 2304 + 256 + t) * 128;
      KB[kb + (d1 - h * 128)] = f2bf(k1[m] * cs - k2[m] * sn);
      KB[kb + (d2 - h * 128)] = f2bf(k1[m] * sn + k2[m] * cs);
    }
  }
}
__device__ __forceinline__ void ctxk_job(const Params& p, int job) {
  bh* KB = (bh*)(p.R + OFF_KB);
  int tidl = threadIdx.x; asm volatile("" : "+v"(tidl));
#pragma unroll
  for (int i = 0; i < 4; ++i) {
    int e = job * 1024 + i * 256 + tidl;
    int x = e & 127, j = (e >> 7) & 255, hh = (e >> 15) & 3, sb = e >> 17;
    KB[KV_SAMPLE_BASE + ((size_t)(sb * 4 + hh) * 2304 + j) * 128 + x] = f2bf(p.cache_k[e]);
  }
}
__device__ __forceinline__ void vt_job(const Params& p, int job, char* smem) {
  bh* tl = (bh*)smem;
  int tid_l_ = threadIdx.x; asm volatile("" : "+v"(tid_l_)); const int tid = tid_l_;
  int seq, h, kt, Lk;
  if (job < 288) { seq = 32 + job / 144; int r = job % 144; h = r / 36; kt = r % 36; Lk = 2304; }
  else { int j = job - 288; seq = j >> 4; h = (j >> 2) & 3; kt = j & 3; Lk = 256; }
  const bh* proj = (const bh*)p.R;
  __syncthreads();
#pragma unroll 16
  for (int i = 0; i < 32; ++i) {
    int e = tid + i * 256, key = e >> 7, dv = e & 127;
    bh val;
    if (seq < 32) val = proj[(size_t)(seq * 256 + kt * 64 + key) * 3104 + 1024 + h * 128 + dv];
    else if (kt < 4) val = f2bf(p.cache_v[((size_t)((seq - 32) * 4 + h) * 256 + kt * 64 + key) * 128 + dv]);
    else val = proj[(size_t)(NTP + (seq - 32) * 2048 + (kt - 4) * 64 + key) * 3104 + 1024 + h * 128 + dv];
    tl[key * 130 + dv] = val;
  }
  __syncthreads();
  bh* VT = (bh*)(p.R + OFF_VT) + (seq < 32 ? (size_t)(seq * 4 + h) * 128 * 256
                                            : (size_t)KV_SAMPLE_BASE + (size_t)((seq - 32) * 4 + h) * 128 * 2304);
#pragma unroll 4
  for (int i = 0; i < 32; ++i) {
    int e = tid + i * 256, dv = e >> 6, key = e & 63;
    VT[(size_t)dv * Lk + kt * 64 + key] = tl[key * 130 + dv];
  }
}

__device__ __forceinline__ void attn_unit(const Params& p, int unit, char* smem) {
  bh* Pl = (bh*)smem;
  float* sred = (float*)(smem + 10240);
  int tid_l_ = threadIdx.x; asm volatile("" : "+v"(tid_l_)); const int tid = tid_l_, lane = tid & 63, w = tid >> 6, r = lane & 15, g = lane >> 4;
  int seq, h, qb, Lk;
  if (unit < 256) { seq = 32 + (unit >> 7); h = (unit >> 5) & 3; qb = unit & 31; Lk = 2304; }
  else { int u = unit - 256; seq = u >> 4; h = (u >> 2) & 3; qb = u & 3; Lk = 256; }
  const int row0 = seq < 32 ? seq * 256 : NTP + (seq - 32) * 2048;
  const bh* Q = (const bh*)(p.R + OFF_Q);
  const bh* KB = (const bh*)(p.R + OFF_KB) + (seq < 32 ? (size_t)(seq * 4 + h) * 256 * 128
                                                       : (size_t)KV_SAMPLE_BASE + (size_t)((seq - 32) * 4 + h) * 2304 * 128);
  const bh* VT = (const bh*)(p.R + OFF_VT) + (seq < 32 ? (size_t)(seq * 4 + h) * 128 * 256
                                                       : (size_t)KV_SAMPLE_BASE + (size_t)((seq - 32) * 4 + h) * 128 * 2304);
  __syncthreads();
  if (tid < 64) {
    float a = p.diff_lambda[tid] * p.diff_lambda[64 + tid];
    float b = p.diff_lambda[128 + tid] * p.diff_lambda[192 + tid];
    a = wave_sum(a); b = wave_sum(b);
    if (tid == 0) sred[0] = expf(a) - expf(b);
  }
  __syncthreads();
  const float lam_init = 0.8f - 0.6f * expf(-0.3f * 1.0f);
  const float lam = sred[0] + lam_init;
  const int qrow = row0 + qb * 64 + w * 16;
  bf16x8 aq[2][2];
#pragma unroll
  for (int pp = 0; pp < 2; ++pp)
#pragma unroll
    for (int kk = 0; kk < 2; ++kk)
      aq[pp][kk] = *(const bf16x8*)(Q + (size_t)(qrow + r) * 512 + h * 128 + pp * 64 + kk * 32 + g * 8);
  float mrun[2][4], lrun[2][4];
  f32x4 O[2][8];
#pragma unroll
  for (int pp = 0; pp < 2; ++pp) {
#pragma unroll
    for (int j = 0; j < 4; ++j) { mrun[pp][j] = -1e30f; lrun[pp][j] = 0.f; }
#pragma unroll
    for (int n = 0; n < 8; ++n) O[pp][n] = (f32x4){0.f, 0.f, 0.f, 0.f};
  }
  bh* Pw = Pl + w * (2 * 16 * 40);
  const float scale = 0.125f;
  bh* Ks = (bh*)(smem + 10752);
  bh* Vs = Ks + 64 * 128;
  u32x4 pk_[4], pv_[4];
  auto tload = [&](int kt) {
#pragma unroll
    for (int i = 0; i < 4; ++i) {
      const int pz = tid + 256 * i;
      pk_[i] = *(const u32x4*)(KB + (size_t)(kt + (pz >> 4)) * 128 + (pz & 15) * 8);
      pv_[i] = *(const u32x4*)(VT + (size_t)(pz >> 3) * Lk + kt + (pz & 7) * 8);
    }
  };
  tload(0);
#pragma unroll 1
  for (int kt = 0; kt < Lk; kt += 64) {
    __syncthreads();
#pragma unroll
    for (int i = 0; i < 4; ++i) {
      const int pz = tid + 256 * i;
      const int key = pz >> 4, ck = pz & 15, dv = pz >> 3, cv = pz & 7;
      *(u32x4*)(Ks + key * 128 + ((ck ^ (key & 15)) << 3)) = pk_[i];
      *(u32x4*)(Vs + dv * 64 + ((cv ^ ((dv >> 1) & 7)) << 3)) = pv_[i];
    }
    __syncthreads();
    if (kt + 64 < Lk) tload(kt + 64);
#pragma unroll
    for (int h2 = 0; h2 < 2; ++h2) {
      f32x4 s[2][2];
#pragma unroll
      for (int sub = 0; sub < 2; ++sub) {
        const int key = h2 * 32 + sub * 16 + r;
#pragma unroll
        for (int pp = 0; pp < 2; ++pp) {
          const bf16x8 b0 = *(const bf16x8*)(Ks + key * 128 + (((pp * 8 + g) ^ (key & 15)) << 3));
          const bf16x8 b1 = *(const bf16x8*)(Ks + key * 128 + (((pp * 8 + 4 + g) ^ (key & 15)) << 3));
          f32x4 z = (f32x4){0.f, 0.f, 0.f, 0.f};
          z = __builtin_amdgcn_mfma_f32_16x16x32_bf16(aq[pp][0], b0, z, 0, 0, 0);
          z = __builtin_amdgcn_mfma_f32_16x16x32_bf16(aq[pp][1], b1, z, 0, 0, 0);
          s[pp][sub] = z;
        }
      }
#pragma unroll
      for (int pp = 0; pp < 2; ++pp) {
#pragma unroll
        for (int j = 0; j < 4; ++j) {
          float s0 = s[pp][0][j] * scale, s1 = s[pp][1][j] * scale;
          float mx = max16(fmaxf(s0, s1));
          float mnew = fmaxf(mrun[pp][j], mx);
          float alpha = __expf(mrun[pp][j] - mnew);
          float p0 = __expf(s0 - mnew), p1 = __expf(s1 - mnew);
          float rs = sum16(p0 + p1);
          lrun[pp][j] = lrun[pp][j] * alpha + rs;
          mrun[pp][j] = mnew;
#pragma unroll
          for (int n = 0; n < 8; ++n) O[pp][n][j] *= alpha;
          Pw[(pp * 16 + g * 4 + j) * 40 + r] = f2bf(p0);
          Pw[(pp * 16 + g * 4 + j) * 40 + 16 + r] = f2bf(p1);
        }
      }
      __builtin_amdgcn_fence(__ATOMIC_RELEASE, "wavefront");
      __builtin_amdgcn_wave_barrier();
      __builtin_amdgcn_fence(__ATOMIC_ACQUIRE, "wavefront");
      bf16x8 pa0 = *(const bf16x8*)(Pw + (0 * 16 + r) * 40 + g * 8);
      bf16x8 pa1 = *(const bf16x8*)(Pw + (1 * 16 + r) * 40 + g * 8);
#pragma unroll
      for (int n = 0; n < 8; ++n) {
        const int dv = n * 16 + r;
        const bf16x8 vb = *(const bf16x8*)(Vs + dv * 64 + (((h2 * 4 + g) ^ ((dv >> 1) & 7)) << 3));
        O[0][n] = __builtin_amdgcn_mfma_f32_16x16x32_bf16(pa0, vb, O[0][n], 0, 0, 0);
        O[1][n] = __builtin_amdgcn_mfma_f32_16x16x32_bf16(pa1, vb, O[1][n], 0, 0, 0);
      }
      __builtin_amdgcn_fence(__ATOMIC_RELEASE, "wavefront");
      __builtin_amdgcn_wave_barrier();
    }
  }
#pragma unroll
  for (int j = 0; j < 4; ++j) {
    float i0 = 1.f / lrun[0][j], i1 = lam / lrun[1][j];
    float o[8];
    float ss = 0.f;
#pragma unroll
    for (int n = 0; n < 8; ++n) { o[n] = O[0][n][j] * i0 - O[1][n][j] * i1; ss += o[n] * o[n]; }
    ss = sum16(ss);
    float rs = rsqrtf(ss * (1.f / 128.f) + EPSF) * (1.f - lam_init);
    bh* arow = p.act + (size_t)(qrow + g * 4 + j) * 1024 + h * 128;
#pragma unroll
    for (int n = 0; n < 8; ++n) arow[n * 16 + r] = f2bf(o[n] * rs * p.diff_norm[h * 128 + n * 16 + r]);
  }
}

__device__ __forceinline__ void ffnact_job(const Params& p, int layer, int job) {
  int tidl = threadIdx.x; asm volatile("" : "+v"(tidl));
  const int item = job * 256 + tidl;
  const int rc = item / 352, j = (item % 352) * 8;
  const int t0 = rc * 8;
  const bh* U = (const bh*)p.R;
  bh* AO = (bh*)(p.R + OFF_ACTF);
  const float* cw = p.ffn_conv_w + (size_t)layer * 3 * 5632;
  const float* cb = p.ffn_conv_b + (size_t)layer * 5632;
  const bool start = (t0 < NTP) ? ((t0 & 255) == 0) : ((t0 & 2047) == 0);
  const bool endd = (t0 < NTP) ? (((t0 + 8) & 255) == 0) : (((t0 + 8) & 2047) == 0);
  u32x4 ua[10], ug[10];
  const u32x4 zz = {0, 0, 0, 0};
#pragma unroll
  for (int i = 0; i < 10; ++i) {
    const int t = t0 - 1 + i;
    const bool ok = (i == 0) ? !start : ((i == 9) ? !endd : true);
    ua[i] = ok ? *(const u32x4*)(U + (size_t)t * 5632 + j) : zz;
    ug[i] = ok ? *(const u32x4*)(U + (size_t)t * 5632 + 2816 + j) : zz;
  }
  float wa[3][8], wg[3][8], ba[8], bg[8];
#pragma unroll
  for (int tp = 0; tp < 3; ++tp) {
    float4 x0 = *(const float4*)(cw + tp * 5632 + j), x1 = *(const float4*)(cw + tp * 5632 + j + 4);
    float4 y0 = *(const float4*)(cw + tp * 5632 + 2816 + j), y1 = *(const float4*)(cw + tp * 5632 + 2816 + j + 4);
    wa[tp][0] = x0.x; wa[tp][1] = x0.y; wa[tp][2] = x0.z; wa[tp][3] = x0.w; wa[tp][4] = x1.x; wa[tp][5] = x1.y; wa[tp][6] = x1.z; wa[tp][7] = x1.w;
    wg[tp][0] = y0.x; wg[tp][1] = y0.y; wg[tp][2] = y0.z; wg[tp][3] = y0.w; wg[tp][4] = y1.x; wg[tp][5] = y1.y; wg[tp][6] = y1.z; wg[tp][7] = y1.w;
  }
  {
    float4 x0 = *(const float4*)(cb + j), x1 = *(const float4*)(cb + j + 4);
    float4 y0 = *(const float4*)(cb + 2816 + j), y1 = *(const float4*)(cb + 2816 + j + 4);
    ba[0] = x0.x; ba[1] = x0.y; ba[2] = x0.z; ba[3] = x0.w; ba[4] = x1.x; ba[5] = x1.y; ba[6] = x1.z; ba[7] = x1.w;
    bg[0] = y0.x; bg[1] = y0.y; bg[2] = y0.z; bg[3] = y0.w; bg[4] = y1.x; bg[5] = y1.y; bg[6] = y1.z; bg[7] = y1.w;
  }
#pragma unroll
  for (int i = 0; i < 8; ++i) {
    u32x4 ov;
#pragma unroll
    for (int e2 = 0; e2 < 4; ++e2) {
      float res[2];
#pragma unroll
      for (int hl = 0; hl < 2; ++hl) {
        const int e = e2 * 2 + hl;
        float am = hl ? bfhi(ua[i][e2]) : bflo(ua[i][e2]);
        float a0 = hl ? bfhi(ua[i + 1][e2]) : bflo(ua[i + 1][e2]);
        float ap = hl ? bfhi(ua[i + 2][e2]) : bflo(ua[i + 2][e2]);
        float gm = hl ? bfhi(ug[i][e2]) : bflo(ug[i][e2]);
        float g0 = hl ? bfhi(ug[i + 1][e2]) : bflo(ug[i + 1][e2]);
        float gp = hl ? bfhi(ug[i + 2][e2]) : bflo(ug[i + 2][e2]);
        float av = wa[0][e] * am + wa[1][e] * a0 + wa[2][e] * ap + ba[e];
        float gv = wg[0][e] * gm + wg[1][e] * g0 + wg[2][e] * gp + bg[e];
        res[hl] = siluf_(gv) * av;
      }
      ov[e2] = pk2(res[0], res[1]);
    }
    *(u32x4*)(AO + (size_t)(t0 + i) * 2816 + j) = ov;
  }
}

#define XB_TMO      128
#define XB_XCNT(j)  (256  + 64 * (j))
#define XB_XSUB(j)  (1280 + 64 * (j))
#define XB_XGEN(j)  (2304 + 64 * (j))
#define XB_TOP      3328
#define XB_TOPGEN   3392
#define XCD_BAR_WORDS 3456
#define XB_SPIN_CAP (1u << 18)
#define LAS __attribute__((address_space(3)))

__device__ __forceinline__ unsigned xb_ld(unsigned* p)              { return __hip_atomic_load(p, __ATOMIC_RELAXED, __HIP_MEMORY_SCOPE_AGENT); }
__device__ __forceinline__ unsigned xb_add(unsigned* p, unsigned v) { return __hip_atomic_fetch_add(p, v, __ATOMIC_RELAXED, __HIP_MEMORY_SCOPE_AGENT); }
__device__ __forceinline__ unsigned xb_xcc_id() { return (unsigned)__builtin_amdgcn_s_getreg((3 << 11) | 20) & 0xFu; }
#define XB_SPIN(cond, bar) do { unsigned _sp = 0; while (cond) { __builtin_amdgcn_s_sleep(1); \
    if ((++_sp & 255u) == 0u) { if (xb_ld(&(bar)[XB_TMO])) break; if (_sp > XB_SPIN_CAP) { atomicAdd(&(bar)[XB_TMO], 1u); break; } } } } while (0)

struct XcdBarrier {
    unsigned* bar; unsigned x;
    volatile LAS unsigned* st;
};

__device__ __forceinline__ XcdBarrier xcd_barrier_post(unsigned* bar, volatile LAS unsigned* st) {
    XcdBarrier b; b.bar = bar; b.x = xb_xcc_id(); b.st = st;
    if (threadIdx.x == 0) (void)xb_add(&bar[XB_XCNT(b.x)], 1u);
    return b;
}
__device__ __forceinline__ void xcd_barrier_complete(unsigned* bar, unsigned x, unsigned& nloc, unsigned& nx) {
    const unsigned G = gridDim.x * gridDim.y * gridDim.z;
    unsigned sum, cnt, mine, sp = 0u;
    for (;;) {
        sum = 0u; cnt = 0u; mine = 0u;
#pragma unroll
        for (unsigned j = 0; j < 16; ++j) { const unsigned c = xb_ld(&bar[XB_XCNT(j)]); sum += c; cnt += (c > 0u) ? 1u : 0u; mine = (j == x) ? c : mine; }
        if (sum == G) break;
        __builtin_amdgcn_s_sleep(1);
        if ((++sp & 255u) == 0u) { if (xb_ld(&bar[XB_TMO])) break; if (sp > XB_SPIN_CAP) { atomicAdd(&bar[XB_TMO], 1u); break; } }
    }
    nloc = mine > 0u ? mine : 1u; nx = cnt > 0u ? cnt : 1u;
}

__device__ __forceinline__ void xcd_barrier(const XcdBarrier& b) {
    asm volatile("s_waitcnt vmcnt(0)" ::: "memory");
    __syncthreads();
    if (threadIdx.x == 0) {
        unsigned* bar = b.bar;
        __builtin_amdgcn_s_waitcnt(0);
        unsigned nloc = b.st[0], nx = b.st[1];
        if (nloc == 0u) { xcd_barrier_complete(bar, b.x, nloc, nx); b.st[0] = nloc; b.st[1] = nx; }
        const unsigned old = xb_add(&bar[XB_XSUB(b.x)], 1u);
        const unsigned gen = old / nloc;
        if (old + 1u == (gen + 1u) * nloc) {
            __builtin_amdgcn_fence(__ATOMIC_RELEASE, "agent");
            asm volatile("s_waitcnt vmcnt(0)" ::: "memory");
            const unsigned og = xb_add(&bar[XB_TOP], 1u);
            const unsigned tg = og / nx;
            if (og + 1u == (tg + 1u) * nx) xb_add(&bar[XB_TOPGEN], 1u);
            else XB_SPIN(xb_ld(&bar[XB_TOPGEN]) == tg, bar);
            __builtin_amdgcn_fence(__ATOMIC_ACQUIRE, "agent");
            xb_add(&bar[XB_XGEN(b.x)], 1u);
            asm volatile("s_waitcnt vmcnt(0)" ::: "memory");
        } else {
            XB_SPIN(xb_ld(&bar[XB_XGEN(b.x)]) == gen, bar);
            __builtin_amdgcn_fence(__ATOMIC_ACQUIRE, "agent");
            asm volatile("s_waitcnt vmcnt(0)" ::: "memory");
        }
    }
    __syncthreads();
}


template <int ph>
__device__ __forceinline__ void run_phase(const Params& p, int bid, int nb, char* smem, bool rep = false) {
  const float* ng = p.norm_g;
  const bh* Rf = (const bh*)p.R;
  if (ph == 0) {
    for (int j = bid + (rep ? 768 : 0); j < 768 + 576 + 1024; j += nb) {
      if (j < 768) gemv_job(p, j, smem);
      else if (j < 1344) filter_job(p, j - 768, smem);
      else convert_tile(p.w_in_even, 1024, 4096, p.wt, j - 1344, smem);
    }
  } else if (ph == 1) {
    for (int j = bid; j < 1536; j += nb) rows_job(p, j, true, nullptr, nullptr, 0, 0, ng + 0 * 1024, 0, 0);
  } else if (ph == 2) {
    gemm_phase<2, 192, 3>(p.act, 1024, p.wt, 1024, p.R, 4096, 4096, 32, bid, nb, smem);
  } else if (ph == 3) {
    if (nb == 512 && !rep) {
      hyena_sample_job(p, bid, smem);
      if (bid < 384) scan2_unit<0>(p, bid, smem);
      else {
        const int q = bid - 384;
        hyena_prompt_job(p, q, smem);
        hyena_prompt_job(p, q + 128, smem);
        convert_tile(p.w_out_even, 1024, 1024, p.wt, q, smem);
        convert_tile(p.w_out_even, 1024, 1024, p.wt, q + 128, smem);
      }
    } else {
      for (int j = bid + (rep ? 512 : 0); j < (rep ? 896 : 512 + 384 + 256 + 256); j += nb) {
        if (j < 512) hyena_sample_job(p, j, smem);
        else if (j < 896) scan2_unit<0>(p, j - 512, smem);
        else if (j < 1152) hyena_prompt_job(p, j - 896, smem);
        else convert_tile(p.w_out_even, 1024, 1024, p.wt, j - 1152, smem);
      }
    }
  } else if (ph == 4) {
    for (int j = bid; j < 128 + 1024; j += nb) {
      if (j < 128) fixup_unit<0>(p, j, smem);
      else scan_final_job(p, j - 128, 0);
    }
  } else if (ph == 5) {
    for (int j = bid; j < 512; j += nb) scan_final_job(p, 1024 + j, 0);
  } else if (ph == 6) {
    gemm_phase<1, 192, 3>(p.act, 1024, p.wt, 1024, p.R, 1024, 1024, 8, bid, nb, smem);
  } else if (ph == 7) {
    for (int j = bid; j < 1536 + 1408 + 704; j += nb) {
      if (j < 1536) rows_job(p, j, true, Rf, ng + 1 * 1024, 0, 2, ng + 2 * 1024, 0, 3);
      else if (j < 2944) convert_tile(p.ffn_up, 1024, 5632, p.wt, j - 1536, smem, true);
      else convert_tile(p.ffn_down, 2816, 1024, p.wt2, j - 2944, smem);
    }
  } else if (ph == 8) {
    gemm_phase<3, 192, 3>(p.act, 1024, p.wt, 1024, p.R + OFF_ACTF, 2816, 5632, 44, bid, nb, smem, p.ffn_conv_w, p.ffn_conv_b);
  } else if (ph == 9) {
  } else if (ph == 10) {
    gemm_phase<1, 192, 3>((const bh*)(p.R + OFF_ACTF), 2816, p.wt2, 2816, p.R, 1024, 1024, 8, bid, nb, smem);
  } else if (ph == 11) {
    for (int j = bid; j < 1536 + 800; j += nb) {
      if (j < 1536) rows_job(p, j, false, Rf, ng + 3 * 1024, 0, 5, ng + 4 * 1024, 1, 0);
      else convert_tile(p.w_in_odd, 1024, 3104, p.wt, j - 1536, smem);
    }
  } else if (ph == 12) {
    gemm_phase<1, 128, 3>(p.act, 1024, p.wt, 1024, p.R, 3104, 3104, 25, bid, nb, smem);
  } else if (ph == 13) {
    auto small13 = [&](int sj) {
      if (sj < 800) vt_job(p, sj, smem);
      else if (sj < 3872) oddrow_job(p, sj - 800);
      else if (sj < 4128) ctxk_job(p, sj - 3872);
      else convert_tile(p.w_out_odd, 1024, 1024, p.wt, sj - 4128, smem);
    };
    if (nb == 512 && !rep) {
      if (bid < 384) {
        scan2_unit<1>(p, bid, smem);
        for (int sj = 3072 + bid; sj < 4384; sj += 384) small13(sj);
      } else {
        for (int k = 0; k < 24; ++k) small13((bid - 384) + 128 * k);
      }
    } else {
      for (int j = bid; j < (rep ? 384 : 384 + 4384); j += nb) {
        if (j < 384) scan2_unit<1>(p, j, smem);
        else small13(j - 384);
      }
    }
  } else if (ph == 14) {
    if (nb == 512 && !rep) {
      if (bid < 256) attn_unit(p, bid, smem);
      else {
        const int q = bid - 256;
        attn_unit(p, 256 + q, smem);
        attn_unit(p, 512 + q, smem);
        if (q < 128) fixup_unit<1>(p, q, smem);
        for (int k = 0; k < 4; ++k) scan_final_job(p, q + 256 * k, 1);
      }
    } else {
      for (int j = bid; j < (rep ? 768 : 768 + 128 + 1024); j += nb) {
        if (j < 768) attn_unit(p, j, smem);
        else if (j < 896) fixup_unit<1>(p, j - 768, smem);
        else scan_final_job(p, j - 896, 1);
      }
    }
  } else if (ph == 15) {
    for (int j = bid; j < 512; j += nb) scan_final_job(p, 1024 + j, 1);
  } else if (ph == 16) {
    gemm_phase<1, 192, 3>(p.act, 1024, p.wt, 1024, p.R, 1024, 1024, 8, bid, nb, smem);
  } else if (ph == 17) {
    for (int j = bid; j < 1536 + 1408 + 704; j += nb) {
      if (j < 1536) rows_job(p, j, false, Rf, ng + 5 * 1024, 1, 2, ng + 6 * 1024, 1, 3);
      else if (j < 2944) convert_tile(p.ffn_up + (size_t)1024 * 5632, 1024, 5632, p.wt, j - 1536, smem, true);
      else convert_tile(p.ffn_down + (size_t)2816 * 1024, 2816, 1024, p.wt2, j - 2944, smem);
    }
  } else if (ph == 18) {
    gemm_phase<3, 192, 3>(p.act, 1024, p.wt, 1024, p.R + OFF_ACTF, 2816, 5632, 44, bid, nb, smem, p.ffn_conv_w + 3 * 5632, p.ffn_conv_b + 5632);
  } else if (ph == 19) {
  } else if (ph == 20) {
    gemm_phase<1, 192, 3>((const bh*)(p.R + OFF_ACTF), 2816, p.wt2, 2816, p.R, 1024, 1024, 8, bid, nb, smem);
  } else if (ph == 21) {
    for (int j = bid; j < 1536; j += nb) rows_job(p, j, false, Rf, ng + 7 * 1024, 1, 5, nullptr, 0, 0);
  }
}

template <int PH>
__device__ __forceinline__ void phase_step(const Params& p, int ph0, int ph1, char* smem, cg::grid_group& grid, const XcdBarrier& xb) {
  if (PH == 9 || PH == 19) return;
  if (PH >= ph0 && PH < ph1) {
    if (PH == REP_PH) { run_phase<PH>(p, blockIdx.x, gridDim.x, smem, true); xcd_barrier(xb); }
    run_phase<PH>(p, blockIdx.x, gridDim.x, smem);
    if (PH + 1 < ph1) {
      xcd_barrier(xb);
    }
  }
}

__global__ void __launch_bounds__(256, 2) mega_kernel(Params p, int ph0, int ph1) {
  __shared__ __attribute__((aligned(16))) char smem[49152];
  cg::grid_group grid = cg::this_grid();
  __shared__ uint4 xb_words;
  if (threadIdx.x == 0) xb_words = make_uint4(0u, 0u, 0u, 0u);
  __syncthreads();
  XcdBarrier xb = xcd_barrier_post(p.bar, (volatile LAS unsigned*)&xb_words);
#ifdef EXTRA_SYNCS
  for (int i = 0; i < EXTRA_SYNCS; ++i) xcd_barrier(xb);
#endif
  phase_step<0>(p, ph0, ph1, smem, grid, xb);
  phase_step<1>(p, ph0, ph1, smem, grid, xb);
  phase_step<2>(p, ph0, ph1, smem, grid, xb);
  phase_step<3>(p, ph0, ph1, smem, grid, xb);
  phase_step<4>(p, ph0, ph1, smem, grid, xb);
  phase_step<5>(p, ph0, ph1, smem, grid, xb);
  phase_step<6>(p, ph0, ph1, smem, grid, xb);
  phase_step<7>(p, ph0, ph1, smem, grid, xb);
  phase_step<8>(p, ph0, ph1, smem, grid, xb);
  phase_step<9>(p, ph0, ph1, smem, grid, xb);
  phase_step<10>(p, ph0, ph1, smem, grid, xb);
  phase_step<11>(p, ph0, ph1, smem, grid, xb);
  phase_step<12>(p, ph0, ph1, smem, grid, xb);
  phase_step<13>(p, ph0, ph1, smem, grid, xb);
  phase_step<14>(p, ph0, ph1, smem, grid, xb);
  phase_step<15>(p, ph0, ph1, smem, grid, xb);
  phase_step<16>(p, ph0, ph1, smem, grid, xb);
  phase_step<17>(p, ph0, ph1, smem, grid, xb);
  phase_step<18>(p, ph0, ph1, smem, grid, xb);
  phase_step<19>(p, ph0, ph1, smem, grid, xb);
  phase_step<20>(p, ph0, ph1, smem, grid, xb);
  phase_step<21>(p, ph0, ph1, smem, grid, xb);
}

extern "C" void kernel_launch(void* const* d_in, const int* in_sizes, int n_in, void* d_out, int out_size, void* d_ws,
                              size_t ws_size, hipStream_t stream) {
  static int grid_blocks = 0;
  if (!grid_blocks) {
    int dev = 0, cus = 0, per_cu = 0;
    hipGetDevice(&dev);
    hipDeviceGetAttribute(&cus, hipDeviceAttributeMultiprocessorCount, dev);
    hipOccupancyMaxActiveBlocksPerMultiprocessor(&per_cu, mega_kernel, 256, 0);
    if (per_cu > 2) per_cu = 2;
    if (per_cu < 1) per_cu = 1;
    grid_blocks = cus * per_cu;
  }
  Params p{};
  const float** pf = (const float**)&p;
  for (int i = 0; i < 35; ++i) pf[i] = (const float*)d_in[i];
  p.out = (float*)d_out;
  char* ws = (char*)d_ws;
  size_t off = 0;
  p.act = (bh*)(ws + off); off += (size_t)NT * 1024 * 2;
  p.wt = (bh*)(ws + off); off += (size_t)5632 * 1024 * 2;
  p.wt2 = (bh*)(ws + off); off += (size_t)1024 * 2816 * 2;
  p.R = ws + off; off += R_BYTES;
  p.mod = (float*)(ws + off); off += (size_t)2 * 3 * 6144 * 4;
  p.bar = (unsigned*)(ws + off); off += (size_t)XCD_BAR_WORDS * 4;
  p.gt256 = (bh*)(ws + off); off += (size_t)2 * 512 * 512 * 2;
  p.gt2048 = (bh*)(ws + off); off += (size_t)2 * 512 * 4096 * 2;
  if (off > ws_size) { fprintf(stderr, "workspace too small: need %zu have %zu\n", off, ws_size); return; }
  hipMemsetAsync(p.mod, 0, (size_t)2 * 3 * 6144 * 4 + (size_t)XCD_BAR_WORDS * 4, stream);
#if MEGA
  int ph0 = 0, ph1 = NPHASE;
  void* args[] = {&p, &ph0, &ph1};
  hipError_t e = hipLaunchCooperativeKernel((void*)mega_kernel, dim3(grid_blocks), dim3(256), args, 0, stream);
  if (e != hipSuccess) fprintf(stderr, "cooperative launch failed: %s (grid %d)\n", hipGetErrorString(e), grid_blocks);
#else
  for (int ph = 0; ph < NPHASE; ++ph) {
    int ph0 = ph, ph1 = ph + 1;
    void* args[] = {&p, &ph0, &ph1};
    hipError_t e = hipLaunchCooperativeKernel((void*)mega_kernel, dim3(grid_blocks), dim3(256), args, 0, stream);
    if (e != hipSuccess) fprintf(stderr, "launch failed: %s\n", hipGetErrorString(e));
  }
#endif
}
```

```cpp
#include <hip/hip_runtime.h>
#include <hip/hip_cooperative_groups.h>
#include <stdint.h>
#include <cstdio>
namespace cg = cooperative_groups;

#ifndef MEGA
#define MEGA 1
#endif
#ifndef REP_PH
#define REP_PH -1
#endif

typedef unsigned short bh;
using bf16x8 = __attribute__((ext_vector_type(8))) short;
using f32x4 = __attribute__((ext_vector_type(4))) float;
using u32x4 = __attribute__((ext_vector_type(4))) unsigned int;

#define NT 12288
#define NTP 8192
#define EPSF 1e-6f
#define NPHASE 22

#define OUT_HGRN 12582912
#define OUT_CK 16777216
#define OUT_CV 20971520
#define OUT_GLA 25165824

#define OFF_ODIR 100663296ull
#define OFF_Z1 150994944ull
#define OFF_HYT 150994944ull
#define OFF_ACTF 138412032ull
#define OFF_Q 150994944ull
#define OFF_KB 163577856ull
#define OFF_VT 176685056ull
#define R_BYTES 207618048ull
#define KV_SAMPLE_BASE 4194304

struct Params {
  const float *x_prompt, *x_sample, *state_hgrn, *cache_k, *cache_v, *state_gla, *c, *c_ctx;
  const float *ada_w, *ada_b, *norm_g, *ffn_up, *ffn_conv_w, *ffn_conv_b, *ffn_down;
  const float *w_in_even, *w_out_even, *hgrn_lb, *hgrn_norm, *hy_conv_w, *hy_conv_b;
  const float *hy_w1, *hy_b1, *hy_w2, *hy_b2, *hy_w3, *hy_freq, *hy_d;
  const float *w_in_odd, *w_out_odd, *diff_lambda, *diff_norm, *gla_aw, *gla_ab, *gla_norm;
  float* out;
  bh* act;
  bh* wt;
  bh* wt2;
  char* R;
  float* mod;
  bh* gt256;
  bh* gt2048;
  unsigned* bar;
};

typedef __bf16 bf2_t __attribute__((ext_vector_type(2)));
typedef float f2_t __attribute__((ext_vector_type(2)));
typedef unsigned int u32x2 __attribute__((ext_vector_type(2)));
__device__ __forceinline__ unsigned pk2(float a, float b) {
  f2_t v = {a, b};
  return __builtin_bit_cast(unsigned, __builtin_convertvector(v, bf2_t));
}
__device__ __forceinline__ bh f2bf(float x) { return (bh)(pk2(x, x) & 0xffffu); }
__device__ __forceinline__ float bflo(unsigned w) { return __uint_as_float(w << 16); }
__device__ __forceinline__ float bfhi(unsigned w) { return __uint_as_float(w & 0xffff0000u); }
__device__ __forceinline__ float bf2f(bh h) { return __uint_as_float(((uint32_t)h) << 16); }
__device__ __forceinline__ float sigmoidf_(float x) { return __builtin_amdgcn_rcpf(1.f + __expf(-x)); }
__device__ __forceinline__ float siluf_(float x) { return x * __builtin_amdgcn_rcpf(1.f + __expf(-x)); }
template <int CTRL>
__device__ __forceinline__ float dppf0(float v) {
  return __int_as_float(__builtin_amdgcn_update_dpp(0, __float_as_int(v), CTRL, 0xF, 0xF, true));
}
__device__ __forceinline__ float wave_sum(float v) {
  v += dppf0<0xB1>(v); v += dppf0<0x4E>(v); v += dppf0<0x141>(v); v += dppf0<0x140>(v);
  v += __shfl_xor(v, 16);
  v += __shfl_xor(v, 32);
  return v;
}

template <int OUT_BF16, int BM, int DEPTH>
__device__ __forceinline__ void gemm_phase(const bh* __restrict__ A, int lda, const bh* __restrict__ Bt, int K, void* Cv, int ldc,
                           int N, int ntn, int bid, int nb, char* smem, const float* cw = nullptr, const float* cb = nullptr) {
  constexpr int MT = BM / 32;
  constexpr int NPA = BM / 32;
  bh* As = (bh*)smem;
  bh* Bs = As + BM * 64;
  int tid_l_ = threadIdx.x; asm volatile("" : "+v"(tid_l_)); const int tid = tid_l_, lane = tid & 63, w = tid >> 6, wr = w >> 1, wc = w & 1, r = lane & 15, g = lane >> 4;
  constexpr int MB = (NT / BM) / 8;
  const int xcd = bid & 7, nloc = nb >> 3;
  const int qend = OUT_BF16 == 3 ? MB * ntn + (ntn + 7) / 8 : MB * ntn;
  for (int q = bid >> 3; q < qend; q += nloc) {
    int mt = xcd * MB + (q % MB), nt = q / MB;
    if (OUT_BF16 == 3 && q >= MB * ntn) { mt = 64; nt = (q - MB * ntn) * 8 + xcd; if (nt >= ntn) continue; }
    const int trow0 = OUT_BF16 == 3 ? mt * 190 - 1 : mt * BM;
    const bh* Ag = A;
    const bh* Bg = Bt + (size_t)(nt * 128) * K;
    f32x4 acc[MT][4];
#pragma unroll
    for (int m = 0; m < MT; ++m)
#pragma unroll
      for (int n = 0; n < 4; ++n) acc[m][n] = (f32x4){0.f, 0.f, 0.f, 0.f};
    u32x4 pa0[NPA], pb0[4], pa1[NPA], pb1[4];
    auto gload = [&](u32x4* pa, u32x4* pb, int kofs) {
#pragma unroll
      for (int i = 0; i < NPA; ++i) {
        int pz = tid + i * 256, row = pz >> 3, cp = pz & 7;
        int tr = trow0 + row;
        if (OUT_BF16 == 3) tr = min(max(tr, 0), NT - 1);
        pa[i] = *(const u32x4*)(Ag + (size_t)tr * lda + kofs + cp * 8);
      }
#pragma unroll
      for (int i = 0; i < 4; ++i) {
        int pz = tid + i * 256, row = pz >> 3, cp = pz & 7;
        pb[i] = *(const u32x4*)(Bg + (size_t)row * K + kofs + cp * 8);
      }
    };
    auto kstep = [&](u32x4* pa, u32x4* pb, int knext) {
      __syncthreads();
#pragma unroll
      for (int i = 0; i < NPA; ++i) {
        int pz = tid + i * 256, row = pz >> 3, cp = pz & 7;
        *(u32x4*)(As + row * 64 + ((cp ^ ((row >> 1) & 7)) << 3)) = pa[i];
      }
#pragma unroll
      for (int i = 0; i < 4; ++i) {
        int pz = tid + i * 256, row = pz >> 3, cp = pz & 7;
        *(u32x4*)(Bs + row * 64 + ((cp ^ ((row >> 1) & 7)) << 3)) = pb[i];
      }
      __syncthreads();
      if (knext < K) gload(pa, pb, knext);
#pragma unroll
      for (int kk = 0; kk < 2; ++kk) {
        bf16x8 af[MT], bfr[4];
#pragma unroll
        for (int m = 0; m < MT; ++m) { const int row = wr * (BM / 2) + m * 16 + r; af[m] = *(const bf16x8*)(As + row * 64 + (((kk * 4 + g) ^ ((row >> 1) & 7)) << 3)); }
#pragma unroll
        for (int n = 0; n < 4; ++n) { const int row = wc * 64 + n * 16 + r; bfr[n] = *(const bf16x8*)(Bs + row * 64 + (((kk * 4 + g) ^ ((row >> 1) & 7)) << 3)); }
        __builtin_amdgcn_sched_barrier(0);
#pragma unroll
        for (int m = 0; m < MT; ++m)
#pragma unroll
          for (int n = 0; n < 4; ++n)
            acc[m][n] = (OUT_BF16 == 1 || OUT_BF16 == 3) ? __builtin_amdgcn_mfma_f32_16x16x32_bf16(bfr[n], af[m], acc[m][n], 0, 0, 0)
                                        : __builtin_amdgcn_mfma_f32_16x16x32_bf16(af[m], bfr[n], acc[m][n], 0, 0, 0);
        __builtin_amdgcn_sched_barrier(0);
      }
    };
    if (DEPTH == 3) {
      constexpr int NA3 = BM / 64;
      bh* As3 = (bh*)smem;
      bh* Bs3 = As3 + 2 * BM * 32;
      u32x4 ra0[NA3], rb0[2], ra1[NA3], rb1[2];
      auto ld3 = [&](u32x4* ra, u32x4* rb, int kofs) {
#pragma unroll
        for (int i = 0; i < NA3; ++i) {
          int pz = tid + i * 256, row = pz >> 2, c = pz & 3;
          int tr = trow0 + row;
          if (OUT_BF16 == 3) tr = min(max(tr, 0), NT - 1);
          ra[i] = *(const u32x4*)(Ag + (size_t)tr * lda + kofs + c * 8);
        }
#pragma unroll
        for (int i = 0; i < 2; ++i) {
          int pz = tid + i * 256, row = pz >> 2, c = pz & 3;
          rb[i] = *(const u32x4*)(Bg + (size_t)row * K + kofs + c * 8);
        }
      };
      auto st3 = [&](const u32x4* ra, const u32x4* rb, int stg) {
#pragma unroll
        for (int i = 0; i < NA3; ++i) {
          int pz = tid + i * 256, row = pz >> 2, c = pz & 3;
          *(u32x4*)(As3 + stg * BM * 32 + row * 32 + ((c ^ (((row >> 3) & 1) << 1)) << 3)) = ra[i];
        }
#pragma unroll
        for (int i = 0; i < 2; ++i) {
          int pz = tid + i * 256, row = pz >> 2, c = pz & 3;
          *(u32x4*)(Bs3 + stg * 128 * 32 + row * 32 + ((c ^ (((row >> 3) & 1) << 1)) << 3)) = rb[i];
        }
      };
      auto comp3 = [&](int cur) {
        __builtin_amdgcn_s_setprio(1);
        bf16x8 af[MT], bfr[4];
#pragma unroll
        for (int m = 0; m < MT; ++m) {
          const int row = wr * (BM / 2) + m * 16 + r;
          af[m] = *(const bf16x8*)(As3 + cur * BM * 32 + row * 32 + ((g ^ (((row >> 3) & 1) << 1)) << 3));
        }
#pragma unroll
        for (int n = 0; n < 4; ++n) {
          const int row = wc * 64 + n * 16 + r;
          bfr[n] = *(const bf16x8*)(Bs3 + cur * 128 * 32 + row * 32 + ((g ^ (((row >> 3) & 1) << 1)) << 3));
        }
#pragma unroll
        for (int m = 0; m < MT; ++m)
#pragma unroll
          for (int n = 0; n < 4; ++n)
            acc[m][n] = (OUT_BF16 == 1 || OUT_BF16 == 3) ? __builtin_amdgcn_mfma_f32_16x16x32_bf16(bfr[n], af[m], acc[m][n], 0, 0, 0)
                                        : __builtin_amdgcn_mfma_f32_16x16x32_bf16(af[m], bfr[n], acc[m][n], 0, 0, 0);
        __builtin_amdgcn_s_setprio(0);
      };
      const int nk = K >> 5;
      __syncthreads();
      ld3(ra0, rb0, 0);
      ld3(ra1, rb1, 32);
      st3(ra0, rb0, 0);
      ld3(ra0, rb0, 64);
      __syncthreads();
      for (int ks = 0; ks < nk; ks += 2) {
        comp3(0);
        st3(ra1, rb1, 1);
        if (ks + 3 < nk) ld3(ra1, rb1, (ks + 3) << 5);
        __syncthreads();
        comp3(1);
        if (ks + 2 < nk) st3(ra0, rb0, 0);
        if (ks + 4 < nk) ld3(ra0, rb0, (ks + 4) << 5);
        __syncthreads();
      }
    } else {
    gload(pa0, pb0, 0);
    if (DEPTH == 2) {
      gload(pa1, pb1, 64);
      for (int k0 = 0; k0 < K; k0 += 128) {
        kstep(pa0, pb0, k0 + 128);
        kstep(pa1, pb1, k0 + 192);
      }
    } else {
      for (int k0 = 0; k0 < K; k0 += 64) kstep(pa0, pb0, k0 + 64);
    }
    }
    if (OUT_BF16 == 1 || OUT_BF16 == 3) {
      __syncthreads();
      bh* Ct = (bh*)smem;
#pragma unroll
      for (int m = 0; m < MT; ++m)
#pragma unroll
        for (int n = 0; n < 4; ++n) {
          const int row = wr * (BM / 2) + m * 16 + r;
          const int sl = wc * 16 + n * 4 + g;
          u32x2 pv;
          pv[0] = pk2(acc[m][n][0], acc[m][n][1]);
          pv[1] = pk2(acc[m][n][2], acc[m][n][3]);
          *(u32x2*)(Ct + row * 128 + ((sl ^ ((row & 15) << 1)) << 2)) = pv;
        }
      __syncthreads();
      if (OUT_BF16 == 1) {
#pragma unroll 2
        for (int i = 0; i < BM / 16; ++i) {
          const int pz = tid + i * 256, row = pz >> 4, pc = pz & 15;
          const u32x4 v = *(const u32x4*)(Ct + row * 128 + ((pc ^ (row & 15)) << 3));
          const int col = nt * 128 + pc * 8;
          if (col < N) *(u32x4*)((bh*)Cv + ((size_t)mt * BM + row) * ldc + col) = v;
        }
      } else {
        const int c8 = tid & 7, rs = tid >> 3;
        const int ja = nt * 64 + c8 * 8;
        float wa[3][8], wg[3][8], ba[8], bg[8];
#pragma unroll
        for (int tp = 0; tp < 3; ++tp) {
          const float4 x0 = *(const float4*)(cw + tp * 5632 + ja), x1 = *(const float4*)(cw + tp * 5632 + ja + 4);
          const float4 y0 = *(const float4*)(cw + tp * 5632 + 2816 + ja), y1 = *(const float4*)(cw + tp * 5632 + 2816 + ja + 4);
          wa[tp][0] = x0.x; wa[tp][1] = x0.y; wa[tp][2] = x0.z; wa[tp][3] = x0.w; wa[tp][4] = x1.x; wa[tp][5] = x1.y; wa[tp][6] = x1.z; wa[tp][7] = x1.w;
          wg[tp][0] = y0.x; wg[tp][1] = y0.y; wg[tp][2] = y0.z; wg[tp][3] = y0.w; wg[tp][4] = y1.x; wg[tp][5] = y1.y; wg[tp][6] = y1.z; wg[tp][7] = y1.w;
        }
        {
          const float4 x0 = *(const float4*)(cb + ja), x1 = *(const float4*)(cb + ja + 4);
          const float4 y0 = *(const float4*)(cb + 2816 + ja), y1 = *(const float4*)(cb + 2816 + ja + 4);
          ba[0] = x0.x; ba[1] = x0.y; ba[2] = x0.z; ba[3] = x0.w; ba[4] = x1.x; ba[5] = x1.y; ba[6] = x1.z; ba[7] = x1.w;
          bg[0] = y0.x; bg[1] = y0.y; bg[2] = y0.z; bg[3] = y0.w; bg[4] = y1.x; bg[5] = y1.y; bg[6] = y1.z; bg[7] = y1.w;
        }
#pragma unroll 1
        for (int i = 0; i < 6; ++i) {
          const int rr = 1 + rs + 32 * i;
          const int t = trow0 + rr;
          if (rr <= 190 && t < NT) {
            const bool start = (t < NTP) ? ((t & 255) == 0) : ((t & 2047) == 0);
            const bool endd = (t < NTP) ? ((t & 255) == 255) : ((t & 2047) == 2047);
            u32x4 am = *(const u32x4*)(Ct + (rr - 1) * 128 + ((c8 ^ ((rr - 1) & 15)) << 3));
            u32x4 gm = *(const u32x4*)(Ct + (rr - 1) * 128 + (((8 + c8) ^ ((rr - 1) & 15)) << 3));
            const u32x4 a0 = *(const u32x4*)(Ct + rr * 128 + ((c8 ^ (rr & 15)) << 3));
            const u32x4 g0 = *(const u32x4*)(Ct + rr * 128 + (((8 + c8) ^ (rr & 15)) << 3));
            u32x4 ap = *(const u32x4*)(Ct + (rr + 1) * 128 + ((c8 ^ ((rr + 1) & 15)) << 3));
            u32x4 gp = *(const u32x4*)(Ct + (rr + 1) * 128 + (((8 + c8) ^ ((rr + 1) & 15)) << 3));
            if (start) { am = (u32x4){0, 0, 0, 0}; gm = (u32x4){0, 0, 0, 0}; }
            if (endd) { ap = (u32x4){0, 0, 0, 0}; gp = (u32x4){0, 0, 0, 0}; }
            u32x4 ov;
#pragma unroll
            for (int e2 = 0; e2 < 4; ++e2) {
              float res[2];
#pragma unroll
              for (int hl = 0; hl < 2; ++hl) {
                const int e = e2 * 2 + hl;
                const float av = wa[0][e] * (hl ? bfhi(am[e2]) : bflo(am[e2])) + wa[1][e] * (hl ? bfhi(a0[e2]) : bflo(a0[e2])) +
                                 wa[2][e] * (hl ? bfhi(ap[e2]) : bflo(ap[e2])) + ba[e];
                const float gv = wg[0][e] * (hl ? bfhi(gm[e2]) : bflo(gm[e2])) + wg[1][e] * (hl ? bfhi(g0[e2]) : bflo(g0[e2])) +
                                 wg[2][e] * (hl ? bfhi(gp[e2]) : bflo(gp[e2])) + bg[e];
                res[hl] = siluf_(gv) * av;
              }
              ov[e2] = pk2(res[0], res[1]);
            }
            *(u32x4*)((bh*)Cv + (size_t)t * 2816 + ja) = ov;
          }
        }
      }
    }
#pragma unroll
    for (int m = 0; m < MT; ++m)
#pragma unroll
      for (int n = 0; n < 4; ++n) {
        if (OUT_BF16 == 1 || OUT_BF16 == 3) continue;
        int col = nt * 128 + wc * 64 + n * 16 + r;
        const size_t rowb = (size_t)mt * BM + wr * (BM / 2) + m * 16 + g * 4;
        if (OUT_BF16 == 2 && nt >= 20) {
          bh* hyt = (bh*)((char*)Cv + OFF_HYT) + (size_t)(col - 2560) * NT + rowb;
          u32x2 pv;
          pv[0] = pk2(acc[m][n][0], acc[m][n][1]);
          pv[1] = pk2(acc[m][n][2], acc[m][n][3]);
          *(u32x2*)hyt = pv;
        } else if (col < N) {
#pragma unroll
          for (int j = 0; j < 4; ++j) {
            size_t row = rowb + j;
            if (OUT_BF16) ((bh*)Cv)[row * ldc + col] = f2bf(acc[m][n][j]);
            else ((float*)Cv)[row * ldc + col] = acc[m][n][j];
          }
        }
      }
  }
}

__device__ __forceinline__ void convert_tile(const float* __restrict__ W, int K, int N, bh* __restrict__ WT, int tile, char* smem, bool perm = false) {
  float* tl = (float*)smem;
  int tid_l_ = threadIdx.x; asm volatile("" : "+v"(tid_l_)); const int tid = tid_l_;
  const int ntk = K >> 6;
  const int kt = tile % ntk, ntile = tile / ntk;
  __syncthreads();
#pragma unroll
  for (int i = 0; i < 16; ++i) {
    int e = tid + i * 256, kk = e >> 6, nn = e & 63, n = ntile * 64 + nn;
    tl[kk * 65 + nn] = (n < N) ? W[(size_t)(kt * 64 + kk) * N + n] : 0.f;
  }
  __syncthreads();
#pragma unroll
  for (int i = 0; i < 16; ++i) {
    int e = tid + i * 256, nn = e >> 6, kk = e & 63;
    const int orow = perm ? (ntile % 44) * 128 + (ntile / 44) * 64 + nn : ntile * 64 + nn;
    WT[(size_t)orow * K + kt * 64 + kk] = f2bf(tl[kk * 65 + nn]);
  }
}

__device__ __forceinline__ void gemv_job(const Params& p, int job, char* smem) {
  float* sc = (float*)smem;
  float* rd = sc + 768;
  int tid_l_ = threadIdx.x; asm volatile("" : "+v"(tid_l_)); const int tid = tid_l_;
  const int iq = job & 3, jb = (job >> 2) % 96, l = (job >> 2) / 96;
  __syncthreads();
  for (int i = tid; i < 768; i += 256) {
    int r = i >> 8, idx = iq * 256 + (i & 255);
    float v = (r == 0) ? p.c_ctx[idx] : p.c[(r - 1) * 1024 + idx];
    sc[i] = siluf_(v);
  }
  __syncthreads();
  const int jl = tid & 63, ig = tid >> 6, j = jb * 64 + jl;
  const float* W = p.ada_w + (size_t)l * 1024 * 6144 + (size_t)(iq * 256 + ig * 64) * 6144 + j;
  float a0 = 0.f, a1 = 0.f, a2 = 0.f;
#pragma unroll 16
  for (int i = 0; i < 64; ++i) {
    float wv = W[(size_t)i * 6144];
    a0 += sc[ig * 64 + i] * wv;
    a1 += sc[256 + ig * 64 + i] * wv;
    a2 += sc[512 + ig * 64 + i] * wv;
  }
  rd[(ig * 3 + 0) * 64 + jl] = a0;
  rd[(ig * 3 + 1) * 64 + jl] = a1;
  rd[(ig * 3 + 2) * 64 + jl] = a2;
  __syncthreads();
  if (tid < 192) {
    int r = tid >> 6, jl2 = tid & 63, j2 = jb * 64 + jl2;
    float sacc = (iq == 0) ? p.ada_b[l * 6144 + j2] : 0.f;
    for (int q = 0; q < 4; ++q) sacc += rd[(q * 3 + r) * 64 + jl2];
    atomicAdd(p.mod + (size_t)(l * 3 + r) * 6144 + j2, sacc);
  }
}

__device__ __forceinline__ void filter_job(const Params& p, int job, char* smem) {
  float* sh2 = (float*)smem;
  int tid_l_ = threadIdx.x; asm volatile("" : "+v"(tid_l_)); const int tid = tid_l_, lane = tid & 63, w = tid >> 6;
  int L, pos0;
  bh* gt;
  if (job < 64) { L = 256; pos0 = job * 4; gt = p.gt256; }
  else { L = 2048; pos0 = (job - 64) * 4; gt = p.gt2048; }
  __syncthreads();
  {
    const int pos = pos0 + w;
    const float t = (float)pos / (float)(L - 1);
    const float wv = 2.0f * 3.14159265358979323846f * (float)pos / (float)L;
    float zv = 0.f;
    if (lane == 0) zv = t;
    else if (lane <= 16) { float fb = 1e-4f + (float)(lane - 1) * ((15.0f - 1e-4f) / 15.0f); zv = cosf(fb * wv); }
    else if (lane <= 32) { float fb = 1e-4f + (float)(lane - 17) * ((15.0f - 1e-4f) / 15.0f); zv = -sinf(fb * wv); }
    const float fr = p.hy_freq[lane];
    float a = p.hy_b1[lane];
    for (int i = 0; i < 33; ++i) a += __shfl(zv, i) * p.hy_w1[i * 64 + lane];
    const float h1 = sinf(fr * a);
    a = p.hy_b2[lane];
    for (int i = 0; i < 64; ++i) a += __shfl(h1, i) * p.hy_w2[i * 64 + lane];
    sh2[w * 64 + lane] = sinf(fr * a);
  }
  __syncthreads();
  float acc[8][4];
#pragma unroll
  for (int m = 0; m < 8; ++m)
#pragma unroll
    for (int pp = 0; pp < 4; ++pp) acc[m][pp] = 0.f;
#pragma unroll 8
  for (int i = 0; i < 64; ++i) {
    const float h0 = sh2[i], h1 = sh2[64 + i], h2 = sh2[128 + i], h3 = sh2[192 + i];
#pragma unroll
    for (int m = 0; m < 8; ++m) {
      const float wv = p.hy_w3[i * 2048 + tid + 256 * m];
      acc[m][0] += wv * h0; acc[m][1] += wv * h1; acc[m][2] += wv * h2; acc[m][3] += wv * h3;
    }
  }
  const float min_decay = logf(1e-2f) / 1.5f, max_decay = logf(1e-2f) / 0.3f;
#pragma unroll
  for (int m = 0; m < 8; ++m) {
    const int o = tid + 256 * m;
    const int ord = o >> 10, side = (o >> 9) & 1, c = o & 511;
    const float delta = fabsf(min_decay + (float)c * ((max_decay - min_decay) / 511.0f));
    bh* grow = gt + (size_t)(ord * 512 + c) * (2 * L);
#pragma unroll
    for (int pp = 0; pp < 4; ++pp) {
      const int pos = pos0 + pp;
      const float t = (float)pos / (float)(L - 1);
      const bh val = f2bf(acc[m][pp] * expf(-t * delta));
      if (side == 0) grow[L - 1 - pos] = val;
      else if (pos >= 1) grow[L - 1 + pos] = val;
    }
  }
}

__device__ __forceinline__ void rows_job(const Params& p, int job, bool first, const bh* src, const float* gres, int lgate, int gate_idx,
                         const float* gnext, int lnext, int shift_idx) {
  int tid_l_ = threadIdx.x; asm volatile("" : "+v"(tid_l_)); const int tid = tid_l_, lane = tid & 63, w = tid >> 6;
  const int rowb = job * 16 + w * 4;
  const int r = rowb < NTP ? 0 : 1 + ((rowb - NTP) >> 11);
  float4 y[4][4], m[4][4];
#pragma unroll
  for (int rr = 0; rr < 4; ++rr) {
    const int row = rowb + rr;
    const float* xin = first ? (row < NTP ? p.x_prompt + (size_t)row * 1024 : p.x_sample + (size_t)(row - NTP) * 1024)
                             : p.out + (size_t)row * 1024;
#pragma unroll
    for (int i = 0; i < 4; ++i) y[rr][i] = *(const float4*)(xin + i * 256 + lane * 4);
    if (src) {
#pragma unroll
      for (int i = 0; i < 4; ++i) { const u32x2 mv = *(const u32x2*)(src + (size_t)row * 1024 + i * 256 + lane * 4); m[rr][i] = make_float4(bflo(mv[0]), bfhi(mv[0]), bflo(mv[1]), bfhi(mv[1])); }
    }
  }
  if (src) {
    const float* gate = p.mod + (size_t)(lgate * 3 + r) * 6144 + gate_idx * 1024;
    float4 gg[4], gt[4];
#pragma unroll
    for (int i = 0; i < 4; ++i) {
      gg[i] = *(const float4*)(gres + i * 256 + lane * 4);
      gt[i] = *(const float4*)(gate + i * 256 + lane * 4);
    }
#pragma unroll
    for (int rr = 0; rr < 4; ++rr) {
      float ss = 0.f;
#pragma unroll
      for (int i = 0; i < 4; ++i)
        ss += m[rr][i].x * m[rr][i].x + m[rr][i].y * m[rr][i].y + m[rr][i].z * m[rr][i].z + m[rr][i].w * m[rr][i].w;
      ss = wave_sum(ss);
      const float rs = rsqrtf(ss * (1.f / 1024.f) + EPSF);
#pragma unroll
      for (int i = 0; i < 4; ++i) {
        y[rr][i].x += gt[i].x * (m[rr][i].x * rs * gg[i].x);
        y[rr][i].y += gt[i].y * (m[rr][i].y * rs * gg[i].y);
        y[rr][i].z += gt[i].z * (m[rr][i].z * rs * gg[i].z);
        y[rr][i].w += gt[i].w * (m[rr][i].w * rs * gg[i].w);
      }
    }
  }
  if (src) {
#pragma unroll
    for (int rr = 0; rr < 4; ++rr)
#pragma unroll
      for (int i = 0; i < 4; ++i) *(float4*)(p.out + (size_t)(rowb + rr) * 1024 + i * 256 + lane * 4) = y[rr][i];
  }
  if (gnext) {
    const float* sh = p.mod + (size_t)(lnext * 3 + r) * 6144 + shift_idx * 1024;
    const float* scl = sh + 1024;
    float4 gg[4], s4[4], c4[4];
#pragma unroll
    for (int i = 0; i < 4; ++i) {
      gg[i] = *(const float4*)(gnext + i * 256 + lane * 4);
      s4[i] = *(const float4*)(sh + i * 256 + lane * 4);
      c4[i] = *(const float4*)(scl + i * 256 + lane * 4);
    }
#pragma unroll
    for (int rr = 0; rr < 4; ++rr) {
      float ss = 0.f;
#pragma unroll
      for (int i = 0; i < 4; ++i)
        ss += y[rr][i].x * y[rr][i].x + y[rr][i].y * y[rr][i].y + y[rr][i].z * y[rr][i].z + y[rr][i].w * y[rr][i].w;
      ss = wave_sum(ss);
      const float rs = rsqrtf(ss * (1.f / 1024.f) + EPSF);
      bh* arow = p.act + (size_t)(rowb + rr) * 1024;
#pragma unroll
      for (int i = 0; i < 4; ++i) {
        ushort4 o;
        o.x = f2bf(y[rr][i].x * rs * gg[i].x * (1.f + c4[i].x) + s4[i].x);
        o.y = f2bf(y[rr][i].y * rs * gg[i].y * (1.f + c4[i].y) + s4[i].y);
        o.z = f2bf(y[rr][i].z * rs * gg[i].z * (1.f + c4[i].z) + s4[i].z);
        o.w = f2bf(y[rr][i].w * rs * gg[i].w * (1.f + c4[i].w) + s4[i].w);
        *(ushort4*)(arow + i * 256 + lane * 4) = o;
      }
    }
  }
}

template <int CTRL>
__device__ __forceinline__ float dppf(float v) {
  return __int_as_float(__builtin_amdgcn_update_dpp(0, __float_as_int(v), CTRL, 0xF, 0xF, true));
}
__device__ __forceinline__ float sum16(float v) {
  v += dppf<0xB1>(v); v += dppf<0x4E>(v); v += dppf<0x141>(v); v += dppf<0x140>(v);
  return v;
}
__device__ __forceinline__ float max16(float v) {
  v = fmaxf(v, dppf<0xB1>(v)); v = fmaxf(v, dppf<0x4E>(v)); v = fmaxf(v, dppf<0x141>(v)); v = fmaxf(v, dppf<0x140>(v));
  return v;
}

typedef short s16x4 __attribute__((ext_vector_type(4)));

#define OFF_SC_EVEN 188743680ull
#define OFF_SC_ODD 79691776ull
#define SC_SLOC 8388608ull
#define SC_DECT 16777216ull

template <int MODE, int SKIP = 0>
__device__ __forceinline__ void scan2_unit(const Params& p, int unit, char* smem) {
  constexpr int DK = MODE == 0 ? 128 : 64;
  constexpr int LD = MODE == 0 ? 4096 : 3104;
  constexpr int NQ = DK / 32;
  constexpr int NP = 256 / DK;
  constexpr int TPP = 16 / NP;
  constexpr int RS = DK + 8;
  constexpr int TPT = DK / 8;
  float* sq = (float*)smem;
  float* slf = sq + 16 * DK;
  float* skk = slf + 16 * DK;
  bh* QE = (bh*)(skk + 16 * DK);
  bh* KE = QE + 16 * RS;
  bh* KLT = KE + 16 * RS;
  bh* VT = KLT + DK * 24;
  float* dec = (float*)(VT + 128 * 24);
  float* sx = dec + DK;
  int tid_l_ = threadIdx.x; asm volatile("" : "+v"(tid_l_)); const int tid = tid_l_, lane = tid & 63, w = tid >> 6, r = lane & 15, g = lane >> 4;
  const int dir = unit & 1, h = (unit >> 1) & 3, ss = unit >> 3;
  const bool samp = ss >= 32;
  const int sb = (ss - 32) >> 3, seg = (ss - 32) & 7;
  const int rbase = samp ? (NTP + sb * 2048 + (dir ? 2047 - seg * 256 : seg * 256)) : (ss * 256 + (dir ? 255 : 0));
  const int sgn = dir ? -1 : 1;
  const bh* proj = (const bh*)p.R;
  char* scbase = p.R + (MODE == 0 ? OFF_SC_EVEN : OFF_SC_ODD);
  bh* QB = (bh*)scbase;
  float* odir = (float*)(p.R + OFF_ODIR) + (size_t)dir * NT * 512;
  __syncthreads();
  if (MODE == 0) {
    for (int k = tid; k < 128; k += 256) {
      int ci = dir * 512 + h * 128 + k;
      float x0 = p.hgrn_lb[ci], x1 = p.hgrn_lb[1024 + ci], x2 = p.hgrn_lb[2048 + ci];
      float mx = fmaxf(x0, fmaxf(x1, x2));
      float e0 = expf(x0 - mx), e1 = expf(x1 - mx), e2 = expf(x2 - mx);
      sx[k] = e0 / (e0 + e1 + e2);
    }
  } else {
    for (int i = tid; i < 1024; i += 256) {
      int rr = i >> 6, k = i & 63;
      sx[i] = p.gla_aw[(size_t)(dir * 16 + rr) * 256 + h * 64 + k];
    }
    if (tid < 64) sx[1024 + tid] = p.gla_ab[dir * 256 + h * 64 + tid];
  }
  f32x4 S[2 * NQ][2];
#pragma unroll
  for (int a = 0; a < 2 * NQ; ++a) { S[a][0] = (f32x4){0.f, 0.f, 0.f, 0.f}; S[a][1] = (f32x4){0.f, 0.f, 0.f, 0.f}; }
  constexpr int EPT = MODE == 0 ? 8 : 4;
  const int li = tid >> 4, lk8 = (tid & 15) * EPT;
  const int vi = tid >> 4, v8 = (tid & 15) * 8;
  const int pk = tid % DK, ppart = tid / DK;
  float basec = 0.f;
  u32x4 rq = {0, 0, 0, 0}, rf = {0, 0, 0, 0}, rv = {0, 0, 0, 0}, rd0 = {0, 0, 0, 0}, rd1 = {0, 0, 0, 0};
  auto issue = [&](int c) {
    {
      const bh* pr = proj + (size_t)(rbase + sgn * (c * 16 + li)) * LD;
      if (MODE == 0) {
        rq = *(const u32x4*)(pr + h * 128 + lk8);
        rf = *(const u32x4*)(pr + 512 + dir * 512 + h * 128 + lk8);
      } else {
        const u32x2 q2 = *(const u32x2*)(pr + 1536 + h * 64 + lk8);
        const u32x2 k2 = *(const u32x2*)(pr + 1792 + h * 64 + lk8);
        rq[0] = q2[0]; rq[1] = q2[1]; rf[0] = k2[0]; rf[1] = k2[1];
        rd0 = *(const u32x4*)(pr + 3072 + dir * 16);
        rd1 = *(const u32x4*)(pr + 3072 + dir * 16 + 8);
      }
    }
    {
      const bh* pr = proj + (size_t)(rbase + sgn * (c * 16 + vi)) * LD;
      rv = *(const u32x4*)(pr + (MODE == 0 ? 1536 : 2048) + h * 128 + v8);
    }
  };
  issue(0);
#pragma unroll 1
  for (int c = 0; c < 16; ++c) {
    __syncthreads();
    if (SKIP != 3) {
      float oq[EPT], ol[EPT], ok[EPT];
      if (MODE == 0) {
#pragma unroll
        for (int e = 0; e < EPT; ++e) {
          float q = (e & 1) ? bfhi(rq[e >> 1]) : bflo(rq[e >> 1]);
          float ff = (e & 1) ? bfhi(rf[e >> 1]) : bflo(rf[e >> 1]);
          float lb = sx[lk8 + e];
          float f = lb + (1.f - lb) * sigmoidf_(ff);
          oq[e] = siluf_(q) * 0.08838834764831845f;
          ol[e] = __logf(f);
          ok[e] = 1.f - f;
        }
      } else {
        float da[16];
#pragma unroll
        for (int rr = 0; rr < 16; ++rr) {
          unsigned wd = rr < 8 ? rd0[(rr & 7) >> 1] : rd1[(rr & 7) >> 1];
          da[rr] = (rr & 1) ? bfhi(wd) : bflo(wd);
        }
        float xx[4];
        {
          float4 b0_ = *(const float4*)(sx + 1024 + lk8);
          xx[0] = b0_.x; xx[1] = b0_.y; xx[2] = b0_.z; xx[3] = b0_.w;
        }
#pragma unroll
        for (int rr = 0; rr < 16; ++rr) {
          float4 a0_ = *(const float4*)(sx + rr * 64 + lk8);
          xx[0] += da[rr] * a0_.x; xx[1] += da[rr] * a0_.y; xx[2] += da[rr] * a0_.z; xx[3] += da[rr] * a0_.w;
        }
#pragma unroll
        for (int e = 0; e < 4; ++e) {
          float q = (e & 1) ? bfhi(rq[e >> 1]) : bflo(rq[e >> 1]);
          float kk = (e & 1) ? bfhi(rf[e >> 1]) : bflo(rf[e >> 1]);
          float x = xx[e];
          float ls = fminf(x, 0.f) - __logf(1.f + __expf(-fabsf(x)));
          oq[e] = q * 0.125f;
          ol[e] = ls * 0.0625f;
          ok[e] = kk;
        }
      }
      float* dq_ = sq + li * DK + lk8;
      float* dl_ = slf + li * DK + lk8;
      float* dk_ = skk + li * DK + lk8;
#pragma unroll
      for (int e4 = 0; e4 < EPT; e4 += 4) {
        *(float4*)(dq_ + e4) = make_float4(oq[e4], oq[e4 + 1], oq[e4 + 2], oq[e4 + 3]);
        *(float4*)(dl_ + e4) = make_float4(ol[e4], ol[e4 + 1], ol[e4 + 2], ol[e4 + 3]);
        *(float4*)(dk_ + e4) = make_float4(ok[e4], ok[e4 + 1], ok[e4 + 2], ok[e4 + 3]);
      }
    }
#pragma unroll
    for (int e = 0; e < 8; ++e) {
      unsigned wv = rv[e >> 1];
      VT[(v8 + e) * 24 + vi] = (bh)((e & 1) ? (wv >> 16) : (wv & 0xffffu));
    }
    __syncthreads();
    if (c + 1 < 16) issue(c + 1);
    {
      float total = 0.f, pre = 0.f;
#pragma unroll
      for (int i = 0; i < 16; ++i) {
        float l = slf[i * DK + pk];
        if (i < ppart * TPP) pre += l;
        total += l;
      }
      unsigned kw[TPP / 2];
#pragma unroll
      for (int ii = 0; ii < TPP; ii += 2) {
        float klv[2];
#pragma unroll
        for (int u = 0; u < 2; ++u) {
          const int i = ppart * TPP + ii + u;
          pre += slf[i * DK + pk];
          const float qv = sq[i * DK + pk], kv = skk[i * DK + pk];
          QE[i * RS + pk] = f2bf(qv * __expf(pre));
          KE[i * RS + pk] = f2bf(kv * __expf(-pre));
          klv[u] = kv * __expf(total - pre);
          if (samp) {
            const int row = rbase + sgn * (c * 16 + i);
            QB[((size_t)dir * 4096 + (row - NTP)) * (4 * DK) + h * DK + pk] = f2bf(qv * __expf(basec + pre));
          }
        }
        kw[ii >> 1] = pk2(klv[0], klv[1]);
      }
      if (TPP == 8) {
        u32x4 kv4 = {kw[0], kw[1], kw[(TPP / 2) > 2 ? 2 : 0], kw[(TPP / 2) > 3 ? 3 : 0]};
        *(u32x4*)(KLT + pk * 24 + ppart * 8) = kv4;
      } else {
        u32x2 kv2 = {kw[0], kw[1]};
        *(u32x2*)(KLT + pk * 24 + ppart * 4) = kv2;
      }
      if (ppart == 0) dec[pk] = __expf(total);
      basec += total;
    }
    __syncthreads();
    {
      bf16x8 qf[NQ], kf[NQ];
#pragma unroll
      for (int q = 0; q < NQ; ++q) {
        qf[q] = *(const bf16x8*)(QE + r * RS + q * 32 + g * 8);
        kf[q] = *(const bf16x8*)(KE + r * RS + q * 32 + g * 8);
      }
      f32x4 at = (f32x4){0.f, 0.f, 0.f, 0.f};
#pragma unroll
      for (int q = 0; q < NQ; ++q) at = __builtin_amdgcn_mfma_f32_16x16x32_bf16(kf[q], qf[q], at, 0, 0, 0);
      u32x2 paw;
      paw[0] = pk2((g * 4 + 0 <= r) ? at[0] : 0.f, (g * 4 + 1 <= r) ? at[1] : 0.f);
      paw[1] = pk2((g * 4 + 2 <= r) ? at[2] : 0.f, (g * 4 + 3 <= r) ? at[3] : 0.f);
      const s16x4 pa = __builtin_bit_cast(s16x4, paw);
      s16x4 vf[2];
      f32x4 o[2];
#pragma unroll
      for (int nt = 0; nt < 2; ++nt) {
        vf[nt] = *(const s16x4*)(VT + (w * 32 + nt * 16 + r) * 24 + g * 4);
        o[nt] = __builtin_amdgcn_mfma_f32_16x16x16bf16_1k(pa, vf[nt], (f32x4){0.f, 0.f, 0.f, 0.f}, 0, 0, 0);
      }
#pragma unroll
      for (int q = 0; q < NQ; ++q) {
#pragma unroll
        for (int half = 0; half < 2; ++half) {
          const s16x4 qa = half == 0 ? __builtin_shufflevector(qf[q], qf[q], 0, 1, 2, 3)
                                     : __builtin_shufflevector(qf[q], qf[q], 4, 5, 6, 7);
#pragma unroll
          for (int nt = 0; nt < 2; ++nt) {
            const f32x4 sv_ = S[2 * q + half][nt];
            u32x2 sw;
            sw[0] = pk2(sv_[0], sv_[1]);
            sw[1] = pk2(sv_[2], sv_[3]);
            o[nt] = __builtin_amdgcn_mfma_f32_16x16x16bf16_1k(qa, __builtin_bit_cast(s16x4, sw), o[nt], 0, 0, 0);
          }
        }
      }
#pragma unroll
      for (int nt = 0; nt < 2; ++nt)
#pragma unroll
        for (int j = 0; j < 4; ++j) {
          const int row = rbase + sgn * (c * 16 + g * 4 + j);
          odir[(size_t)row * 512 + h * 128 + w * 32 + nt * 16 + r] = o[nt][j];
        }
#pragma unroll
      for (int q = 0; q < NQ; ++q) {
#pragma unroll
        for (int half = 0; half < 2; ++half) {
          const float4 d4 = *(const float4*)(dec + q * 32 + g * 8 + half * 4);
          const int ka = q * 32 + (r >> 2) * 8 + half * 4 + (r & 3);
          const s16x4 ka4 = *(const s16x4*)(KLT + ka * 24 + g * 4);
#pragma unroll
          for (int nt = 0; nt < 2; ++nt) {
            f32x4 sv_ = S[2 * q + half][nt];
            sv_[0] *= d4.x; sv_[1] *= d4.y; sv_[2] *= d4.z; sv_[3] *= d4.w;
            S[2 * q + half][nt] = __builtin_amdgcn_mfma_f32_16x16x16bf16_1k(ka4, vf[nt], sv_, 0, 0, 0);
          }
        }
      }
    }
  }
  {
    float* so;
    if (!samp) so = p.out + (MODE == 0 ? OUT_HGRN : OUT_GLA) + ((size_t)(ss * 2 + dir) * 4 + h) * DK * 128;
    else {
      const int us = ((sb * 4 + h) * 2 + dir) * 8 + seg;
      so = (float*)(scbase + SC_SLOC) + (size_t)us * DK * 128;
      if (ppart == 0) ((float*)(scbase + SC_DECT))[us * DK + pk] = __expf(basec);
    }
#pragma unroll
    for (int q = 0; q < NQ; ++q)
#pragma unroll
      for (int half = 0; half < 2; ++half)
#pragma unroll
        for (int nt = 0; nt < 2; ++nt)
#pragma unroll
          for (int j = 0; j < 4; ++j)
            so[(size_t)(q * 32 + g * 8 + half * 4 + j) * 128 + w * 32 + nt * 16 + r] = S[2 * q + half][nt][j];
  }
}

template <int MODE>
__device__ __forceinline__ void fixup_unit(const Params& p, int unit, char* smem) {
  constexpr int DK = MODE == 0 ? 128 : 64;
  constexpr int NQ = DK / 32;
  constexpr int RS = DK + 8;
  bh* ST = (bh*)smem;
  int tid_l_ = threadIdx.x; asm volatile("" : "+v"(tid_l_)); const int tid = tid_l_, lane = tid & 63, w = tid >> 6, r = lane & 15, g = lane >> 4;
  const int seg = unit & 7, dir = (unit >> 3) & 1, h = (unit >> 4) & 3, sb = unit >> 6;
  const int unit0 = unit & ~7;
  char* scbase = p.R + (MODE == 0 ? OFF_SC_EVEN : OFF_SC_ODD);
  const bh* QB = (const bh*)scbase;
  const float* SLOC = (const float*)(scbase + SC_SLOC);
  const float* DECT = (const float*)(scbase + SC_DECT);
  const float* s0 = (MODE == 0 ? p.state_hgrn : p.state_gla) + ((size_t)(sb * 2 + dir) * 4 + h) * DK * 128;
  float* odir = (float*)(p.R + OFF_ODIR) + (size_t)dir * NT * 512;
  __syncthreads();
  for (int m = 0; m < DK * 128 / 256; ++m) {
    const int e = tid + 256 * m, k = e >> 7, v = e & 127;
    float cur = s0[e];
    for (int jj = 0; jj < seg; ++jj)
      cur = DECT[(unit0 + jj) * DK + k] * cur + SLOC[(size_t)(unit0 + jj) * DK * 128 + e];
    ST[v * RS + k] = f2bf(cur);
  }
  __syncthreads();
  const int rbase = NTP + sb * 2048 + (dir ? 2047 - seg * 256 : seg * 256);
  const int sgn = dir ? -1 : 1;
#pragma unroll 1
  for (int mt = 0; mt < 4; ++mt) {
    f32x4 acc[8];
#pragma unroll
    for (int nt = 0; nt < 8; ++nt) acc[nt] = (f32x4){0.f, 0.f, 0.f, 0.f};
    const int rowa = rbase + sgn * (w * 64 + mt * 16 + r);
    const bh* qrow = QB + ((size_t)dir * 4096 + (rowa - NTP)) * (4 * DK) + h * DK + g * 8;
#pragma unroll
    for (int q = 0; q < NQ; ++q) {
      const bf16x8 a = *(const bf16x8*)(qrow + q * 32);
#pragma unroll
      for (int nt = 0; nt < 8; ++nt) {
        const bf16x8 b = *(const bf16x8*)(ST + (nt * 16 + r) * RS + q * 32 + g * 8);
        acc[nt] = __builtin_amdgcn_mfma_f32_16x16x32_bf16(a, b, acc[nt], 0, 0, 0);
      }
    }
#pragma unroll
    for (int nt = 0; nt < 8; ++nt)
#pragma unroll
      for (int j = 0; j < 4; ++j) {
        const int row = rbase + sgn * (w * 64 + mt * 16 + g * 4 + j);
        float* dst = odir + (size_t)row * 512 + h * 128 + nt * 16 + r;
        *dst += acc[nt][j];
      }
  }
}

__device__ __forceinline__ void scan_final_job(const Params& p, int job, int mode) {
  int tid_l_ = threadIdx.x; asm volatile("" : "+v"(tid_l_)); const int tid = tid_l_, lane = tid & 63, w = tid >> 6;
  const int rowb = job * 8 + w * 2;
  const int ld = mode == 0 ? 4096 : 3104;
  const int gcol = mode == 0 ? 2048 : 2560;
  const float* nrm = mode == 0 ? p.hgrn_norm : p.gla_norm;
  float2 a[2][4], b[2][4];
  unsigned gw[2][4];
#pragma unroll
  for (int rr = 0; rr < 2; ++rr) {
    const int row = rowb + rr;
    const float* o0 = (const float*)(p.R + OFF_ODIR) + (size_t)row * 512;
    const float* o1 = o0 + (size_t)NT * 512;
    const bh* proj = (const bh*)p.R + (size_t)row * ld;
#pragma unroll
    for (int h = 0; h < 4; ++h) {
      const int c = h * 128 + lane * 2;
      a[rr][h] = *(const float2*)(o0 + c);
      b[rr][h] = *(const float2*)(o1 + c);
      gw[rr][h] = *(const unsigned*)(proj + gcol + c);
    }
  }
  float2 nv[4];
#pragma unroll
  for (int h = 0; h < 4; ++h) nv[h] = *(const float2*)(nrm + h * 128 + lane * 2);
#pragma unroll
  for (int rr = 0; rr < 2; ++rr) {
    bh* arow = p.act + (size_t)(rowb + rr) * 1024 + (mode == 0 ? 0 : 512);
#pragma unroll
    for (int h = 0; h < 4; ++h) {
      const int c = h * 128 + lane * 2;
      float v0 = a[rr][h].x + b[rr][h].x, v1 = a[rr][h].y + b[rr][h].y;
      float ss = wave_sum(v0 * v0 + v1 * v1);
      float rs = rsqrtf(ss * (1.f / 128.f) + EPSF);
      float g0 = bflo(gw[rr][h]), g1 = bfhi(gw[rr][h]);
      *(unsigned*)(arow + c) = pk2(v0 * rs * nv[h].x * siluf_(g0), v1 * rs * nv[h].y * siluf_(g1));
    }
  }
}

using f32x16 = __attribute__((ext_vector_type(16))) float;
__device__ __forceinline__ bf16x8 toep_frag(const unsigned* Gd, int m0) {
  const int q = m0 >> 1;
  const unsigned sh = (unsigned)(m0 & 1) * 2u;
  const unsigned D0 = Gd[q], D1 = Gd[q + 1], D2 = Gd[q + 2], D3 = Gd[q + 3], D4 = Gd[q + 4];
  u32x4 f;
  f[0] = __builtin_amdgcn_alignbyte(D1, D0, sh);
  f[1] = __builtin_amdgcn_alignbyte(D2, D1, sh);
  f[2] = __builtin_amdgcn_alignbyte(D3, D2, sh);
  f[3] = __builtin_amdgcn_alignbyte(D4, D3, sh);
  return __builtin_bit_cast(bf16x8, f);
}
__device__ __forceinline__ void conv4(const bh* raw, int t, int L, float w0, float w1, float w2, float bb, float* out) {
  const u32x2 x = *(const u32x2*)(raw + t);
  const float xm = t > 0 ? bf2f(raw[t - 1]) : 0.f;
  const float xp = (t + 4 < L) ? bf2f(raw[t + 4]) : 0.f;
  const float x0 = bflo(x[0]), x1 = bfhi(x[0]), x2 = bflo(x[1]), x3 = bfhi(x[1]);
  out[0] = w0 * xm + w1 * x0 + w2 * x1 + bb;
  out[1] = w0 * x0 + w1 * x1 + w2 * x2 + bb;
  out[2] = w0 * x1 + w1 * x2 + w2 * x3 + bb;
  out[3] = w0 * x2 + w1 * x3 + w2 * xp + bb;
}
__device__ __forceinline__ u32x4 conv8(const bh* raw, int t, int L, float w0, float w1, float w2, float bb) {
  const u32x4 x = *(const u32x4*)(raw + t);
  float v[10];
  v[0] = t > 0 ? bf2f(raw[t - 1]) : 0.f;
  v[9] = (t + 8 < L) ? bf2f(raw[t + 8]) : 0.f;
#pragma unroll
  for (int e = 0; e < 4; ++e) { v[1 + 2 * e] = bflo(x[e]); v[2 + 2 * e] = bfhi(x[e]); }
  u32x4 o;
#pragma unroll
  for (int e = 0; e < 4; ++e)
    o[e] = pk2(w0 * v[2 * e] + w1 * v[2 * e + 1] + w2 * v[2 * e + 2] + bb, w0 * v[2 * e + 1] + w1 * v[2 * e + 2] + w2 * v[2 * e + 3] + bb);
  return o;
}

__device__ __forceinline__ void hyena_sample_job(const Params& p, int job, char* smem) {
  int tid_l_ = threadIdx.x; asm volatile("" : "+v"(tid_l_)); const int tid = tid_l_, lane = tid & 63, w = tid >> 6;
  const int col = lane & 31, kh = lane >> 5;
  const int cc = w >> 1, nh = w & 1;
  const int sb = job & 1, c0 = (job >> 1) * 2, c = c0 + cc;
  bh* G = (bh*)(smem + cc * 12288);
  bh* U = G + 4096;
  const unsigned* Gd = (const unsigned*)G;
  const bh* HYT = (const bh*)(p.R + OFF_HYT);
  const int rowoff = NTP + sb * 2048;
  __syncthreads();
  {
    const float vw0 = p.hy_conv_w[c], vw1 = p.hy_conv_w[1536 + c], vw2 = p.hy_conv_w[3072 + c], vb = p.hy_conv_b[c];
    const bh* raw = HYT + (size_t)c * NT + rowoff;
#pragma unroll
    for (int i = 0; i < 2; ++i) {
      const int t0 = (nh * 128 + lane + 64 * i) * 8;
      *(u32x4*)(U + t0) = conv8(raw, t0, 2048, vw0, vw1, vw2, vb);
    }
  }
#pragma unroll 1
  for (int ord = 0; ord < 2; ++ord) {
    {
      const bh* gsrc = p.gt2048 + (size_t)(ord * 512 + c) * 4096;
#pragma unroll
      for (int i = 0; i < 4; ++i) {
        const int e8 = (nh * 256 + lane + 64 * i) * 8;
        *(u32x4*)(G + e8) = *(const u32x4*)(gsrc + e8);
      }
    }
    __syncthreads();
    f32x16 acc;
#pragma unroll
    for (int i = 0; i < 16; ++i) acc[i] = 0.f;
    const int mbase = 2047 - col + kh * 8;
    const int dlo = nh == 0 ? -63 : -31, dhi = nh == 0 ? 31 : 63;
#pragma unroll 2
    for (int d = dlo; d <= dhi; ++d) {
      const bf16x8 a0 = toep_frag(Gd, mbase - d * 32);
      const bf16x8 a1 = toep_frag(Gd, mbase - d * 32 + 16);
      const int s1 = nh * 32 + col - d;
      const bool ok = (unsigned)s1 < 64u;
      const int s1c = ok ? s1 : 0;
      u32x4 b0 = *(const u32x4*)(U + s1c * 32 + kh * 8);
      u32x4 b1 = *(const u32x4*)(U + s1c * 32 + 16 + kh * 8);
      if (!ok) { b0 = (u32x4){0, 0, 0, 0}; b1 = (u32x4){0, 0, 0, 0}; }
      acc = __builtin_amdgcn_mfma_f32_32x32x16_bf16(a0, __builtin_bit_cast(bf16x8, b0), acc, 0, 0, 0);
      acc = __builtin_amdgcn_mfma_f32_32x32x16_bf16(a1, __builtin_bit_cast(bf16x8, b1), acc, 0, 0, 0);
    }
    __syncthreads();
    const int gi = (ord + 1) * 512 + c;
    const float gw0 = p.hy_conv_w[gi], gw1 = p.hy_conv_w[1536 + gi], gw2 = p.hy_conv_w[3072 + gi], gb = p.hy_conv_b[gi];
    const float dd = p.hy_d[ord * 512 + c];
    const bh* graw = HYT + (size_t)gi * NT + rowoff;
#pragma unroll
    for (int rq = 0; rq < 4; ++rq) {
      const int trun = (nh * 32 + col) * 32 + 8 * rq + 4 * kh;
      float gte[4];
      conv4(graw, trun, 2048, gw0, gw1, gw2, gb, gte);
      const u32x2 uo = *(const u32x2*)(U + trun);
      u32x2 zo;
      zo[0] = pk2(gte[0] * (acc[rq * 4 + 0] + bflo(uo[0]) * dd), gte[1] * (acc[rq * 4 + 1] + bfhi(uo[0]) * dd));
      zo[1] = pk2(gte[2] * (acc[rq * 4 + 2] + bflo(uo[1]) * dd), gte[3] * (acc[rq * 4 + 3] + bfhi(uo[1]) * dd));
      *(u32x2*)(U + trun) = zo;
    }
    __syncthreads();
  }
#pragma unroll
  for (int rr = 0; rr < 8; ++rr) {
    const int t = tid + 256 * rr;
    const unsigned z0 = *(const bh*)(smem + 8192 + t * 2);
    const unsigned z1 = *(const bh*)(smem + 12288 + 8192 + t * 2);
    *(unsigned*)(p.act + (size_t)(rowoff + t) * 1024 + 512 + c0) = z0 | (z1 << 16);
  }
}

__device__ __forceinline__ void hyena_prompt_job(const Params& p, int job, char* smem) {
  int tid_l_ = threadIdx.x; asm volatile("" : "+v"(tid_l_)); const int tid = tid_l_, lane = tid & 63, w = tid >> 6;
  const int col = lane & 31, kh = lane >> 5;
  const int cc = w >> 1, th = w & 1;
  const int c0 = job * 2, c = c0 + cc;
  bh* Uall = (bh*)smem;
  bh* Gall = (bh*)(smem + 2 * 32 * 264 * 2);
  bh* U = Uall + cc * 32 * 264;
  const unsigned* Gd = (const unsigned*)(Gall + cc * 512);
  const bh* HYT = (const bh*)(p.R + OFF_HYT);
  __syncthreads();
#pragma unroll 1
  for (int c2 = 0; c2 < 2; ++c2) {
    const int ch = c0 + c2;
    const float vw0 = p.hy_conv_w[ch], vw1 = p.hy_conv_w[1536 + ch], vw2 = p.hy_conv_w[3072 + ch], vb = p.hy_conv_b[ch];
#pragma unroll
    for (int i = 0; i < 4; ++i) {
      const int tg = (tid + 256 * i) * 8, b = tg >> 8, t = tg & 255;
      *(u32x4*)(Uall + c2 * 32 * 264 + b * 264 + t) = conv8(HYT + (size_t)ch * NT + b * 256, t, 256, vw0, vw1, vw2, vb);
    }
  }
#pragma unroll 1
  for (int ord = 0; ord < 2; ++ord) {
    if (tid < 128) {
      const int c2 = tid >> 6, l2 = tid & 63;
      *(u32x4*)(Gall + c2 * 512 + l2 * 8) = *(const u32x4*)(p.gt256 + (size_t)(ord * 512 + c0 + c2) * 512 + l2 * 8);
    }
    __syncthreads();
    f32x16 acc[4];
#pragma unroll
    for (int q = 0; q < 4; ++q)
#pragma unroll
      for (int i = 0; i < 16; ++i) acc[q][i] = 0.f;
    const int mbase = 255 - col + kh * 8;
#pragma unroll
    for (int q = 0; q < 4; ++q) {
      const int t1 = th * 4 + q;
#pragma unroll 2
      for (int s1 = 0; s1 < 8; ++s1) {
        const int d = t1 - s1;
        const bf16x8 a0 = toep_frag(Gd, mbase - d * 32);
        const bf16x8 a1 = toep_frag(Gd, mbase - d * 32 + 16);
        const bf16x8 b0 = *(const bf16x8*)(U + col * 264 + s1 * 32 + kh * 8);
        const bf16x8 b1 = *(const bf16x8*)(U + col * 264 + s1 * 32 + 16 + kh * 8);
        acc[q] = __builtin_amdgcn_mfma_f32_32x32x16_bf16(a0, b0, acc[q], 0, 0, 0);
        acc[q] = __builtin_amdgcn_mfma_f32_32x32x16_bf16(a1, b1, acc[q], 0, 0, 0);
      }
    }
    __syncthreads();
    const int gi = (ord + 1) * 512 + c;
    const float gw0 = p.hy_conv_w[gi], gw1 = p.hy_conv_w[1536 + gi], gw2 = p.hy_conv_w[3072 + gi], gb = p.hy_conv_b[gi];
    const float dd = p.hy_d[ord * 512 + c];
    const bh* graw = HYT + (size_t)gi * NT + col * 256;
#pragma unroll
    for (int q = 0; q < 4; ++q)
#pragma unroll
      for (int rq = 0; rq < 4; ++rq) {
        const int trun = (th * 4 + q) * 32 + 8 * rq + 4 * kh;
        float gte[4];
        conv4(graw, trun, 256, gw0, gw1, gw2, gb, gte);
        bh* up = U + col * 264 + trun;
        const u32x2 uo = *(const u32x2*)up;
        u32x2 zo;
        zo[0] = pk2(gte[0] * (acc[q][rq * 4 + 0] + bflo(uo[0]) * dd), gte[1] * (acc[q][rq * 4 + 1] + bfhi(uo[0]) * dd));
        zo[1] = pk2(gte[2] * (acc[q][rq * 4 + 2] + bflo(uo[1]) * dd), gte[3] * (acc[q][rq * 4 + 3] + bfhi(uo[1]) * dd));
        *(u32x2*)up = zo;
      }
    __syncthreads();
  }
#pragma unroll 4
  for (int i = 0; i < 32; ++i) {
    const int e = tid + 256 * i, b = e >> 8, t = e & 255;
    const unsigned z0 = Uall[b * 264 + t], z1 = Uall[32 * 264 + b * 264 + t];
    *(unsigned*)(p.act + (size_t)e * 1024 + 512 + c0) = z0 | (z1 << 16);
  }
}

__device__ __forceinline__ void oddrow_job(const Params& p, int job) {
  int tid_l_ = threadIdx.x; asm volatile("" : "+v"(tid_l_)); const int tid = tid_l_, lane = tid & 63, w = tid >> 6;
  const int row = job * 4 + w;
  const bh* pr = (const bh*)p.R + (size_t)row * 3104;
  bh* Q = (bh*)(p.R + OFF_Q) + (size_t)row * 512;
  bh* KB = (bh*)(p.R + OFF_KB);
  if (row < NTP) {
    const int b = row >> 8, t = row & 255;
    const int e0 = lane * 8, h = e0 >> 7, x = e0 & 127;
    const u32x4 qv = *(const u32x4*)(pr + e0);
    const u32x4 kv = *(const u32x4*)(pr + 512 + e0);
    const u32x4 vv = *(const u32x4*)(pr + 1024 + e0);
    const size_t idx = ((size_t)(b * 4 + h) * 256 + t) * 128 + x;
    *(u32x4*)(Q + e0) = qv;
    *(u32x4*)(KB + idx) = kv;
    float4 k0 = make_float4(bflo(kv[0]), bfhi(kv[0]), bflo(kv[1]), bfhi(kv[1]));
    float4 k1 = make_float4(bflo(kv[2]), bfhi(kv[2]), bflo(kv[3]), bfhi(kv[3]));
    float4 v0 = make_float4(bflo(vv[0]), bfhi(vv[0]), bflo(vv[1]), bfhi(vv[1]));
    float4 v1 = make_float4(bflo(vv[2]), bfhi(vv[2]), bflo(vv[3]), bfhi(vv[3]));
    *(float4*)(p.out + OUT_CK + idx) = k0;
    *(float4*)(p.out + OUT_CK + idx + 4) = k1;
    *(float4*)(p.out + OUT_CV + idx) = v0;
    *(float4*)(p.out + OUT_CV + idx + 4) = v1;
  } else {
    const int sb = (row - NTP) >> 11, t = (row - NTP) & 2047;
    const int rpos = t >> 6, cpos = t & 63;
    float q1[4], q2[4], k1[4], k2[4];
#pragma unroll
    for (int m = 0; m < 4; ++m) {
      int pi = lane + 64 * m;
      int h = pi >> 6, rem = pi & 63, pp = rem >> 5, part = (rem >> 4) & 1, i = rem & 15;
      int d1 = h * 128 + pp * 64 + part * 32 + i, d2 = d1 + 16;
      q1[m] = bf2f(pr[d1]); q2[m] = bf2f(pr[d2]);
      k1[m] = bf2f(pr[512 + d1]); k2[m] = bf2f(pr[512 + d2]);
    }
#pragma unroll
    for (int m = 0; m < 4; ++m) {
      int pi = lane + 64 * m;
      int h = pi >> 6, rem = pi & 63, pp = rem >> 5, part = (rem >> 4) & 1, i = rem & 15;
      int d1 = h * 128 + pp * 64 + part * 32 + i, d2 = d1 + 16;
      float pos = (float)(part ? cpos : rpos);
      float inv = expf(-(float)i * (9.210340371976184f / 16.f));
      float ang = pos * inv;
      float cs = cosf(ang), sn = sinf(ang);
      Q[d1] = f2bf(q1[m] * cs - q2[m] * sn);
      Q[d2] = f2bf(q1[m] * sn + q2[m] * cs);
      size_t kb = KV_SAMPLE_BASE + ((size_t)(sb * 4 + h) * 2304 + 256 + t) * 128;
      KB[kb + (d1 - h * 128)] = f2bf(k1[m] * cs - k2[m] * sn);
      KB[kb + (d2 - h * 128)] = f2bf(k1[m] * sn + k2[m] * cs);
    }
  }
}
__device__ __forceinline__ void ctxk_job(const Params& p, int job) {
  bh* KB = (bh*)(p.R + OFF_KB);
  int tidl = threadIdx.x; asm volatile("" : "+v"(tidl));
#pragma unroll
  for (int i = 0; i < 4; ++i) {
    int e = job * 1024 + i * 256 + tidl;
    int x = e & 127, j = (e >> 7) & 255, hh = (e >> 15) & 3, sb = e >> 17;
    KB[KV_SAMPLE_BASE + ((size_t)(sb * 4 + hh) * 2304 + j) * 128 + x] = f2bf(p.cache_k[e]);
  }
}
__device__ __forceinline__ void vt_job(const Params& p, int job, char* smem) {
  bh* tl = (bh*)smem;
  int tid_l_ = threadIdx.x; asm volatile("" : "+v"(tid_l_)); const int tid = tid_l_;
  int seq, h, kt, Lk;
  if (job < 288) { seq = 32 + job / 144; int r = job % 144; h = r / 36; kt = r % 36; Lk = 2304; }
  else { int j = job - 288; seq = j >> 4; h = (j >> 2) & 3; kt = j & 3; Lk = 256; }
  const bh* proj = (const bh*)p.R;
  __syncthreads();
#pragma unroll 16
  for (int i = 0; i < 32; ++i) {
    int e = tid + i * 256, key = e >> 7, dv = e & 127;
    bh val;
    if (seq < 32) val = proj[(size_t)(seq * 256 + kt * 64 + key) * 3104 + 1024 + h * 128 + dv];
    else if (kt < 4) val = f2bf(p.cache_v[((size_t)((seq - 32) * 4 + h) * 256 + kt * 64 + key) * 128 + dv]);
    else val = proj[(size_t)(NTP + (seq - 32) * 2048 + (kt - 4) * 64 + key) * 3104 + 1024 + h * 128 + dv];
    tl[key * 130 + dv] = val;
  }
  __syncthreads();
  bh* VT = (bh*)(p.R + OFF_VT) + (seq < 32 ? (size_t)(seq * 4 + h) * 128 * 256
                                            : (size_t)KV_SAMPLE_BASE + (size_t)((seq - 32) * 4 + h) * 128 * 2304);
#pragma unroll 4
  for (int i = 0; i < 32; ++i) {
    int e = tid + i * 256, dv = e >> 6, key = e & 63;
    VT[(size_t)dv * Lk + kt * 64 + key] = tl[key * 130 + dv];
  }
}

__device__ __forceinline__ void attn_unit(const Params& p, int unit, char* smem) {
  bh* Pl = (bh*)smem;
  float* sred = (float*)(smem + 10240);
  int tid_l_ = threadIdx.x; asm volatile("" : "+v"(tid_l_)); const int tid = tid_l_, lane = tid & 63, w = tid >> 6, r = lane & 15, g = lane >> 4;
  int seq, h, qb, Lk;
  if (unit < 256) { seq = 32 + (unit >> 7); h = (unit >> 5) & 3; qb = unit & 31; Lk = 2304; }
  else { int u = unit - 256; seq = u >> 4; h = (u >> 2) & 3; qb = u & 3; Lk = 256; }
  const int row0 = seq < 32 ? seq * 256 : NTP + (seq - 32) * 2048;
  const bh* Q = (const bh*)(p.R + OFF_Q);
  const bh* KB = (const bh*)(p.R + OFF_KB) + (seq < 32 ? (size_t)(seq * 4 + h) * 256 * 128
                                                       : (size_t)KV_SAMPLE_BASE + (size_t)((seq - 32) * 4 + h) * 2304 * 128);
  const bh* VT = (const bh*)(p.R + OFF_VT) + (seq < 32 ? (size_t)(seq * 4 + h) * 128 * 256
                                                       : (size_t)KV_SAMPLE_BASE + (size_t)((seq - 32) * 4 + h) * 128 * 2304);
  __syncthreads();
  if (tid < 64) {
    float a = p.diff_lambda[tid] * p.diff_lambda[64 + tid];
    float b = p.diff_lambda[128 + tid] * p.diff_lambda[192 + tid];
    a = wave_sum(a); b = wave_sum(b);
    if (tid == 0) sred[0] = expf(a) - expf(b);
  }
  __syncthreads();
  const float lam_init = 0.8f - 0.6f * expf(-0.3f * 1.0f);
  const float lam = sred[0] + lam_init;
  const int qrow = row0 + qb * 64 + w * 16;
  bf16x8 aq[2][2];
#pragma unroll
  for (int pp = 0; pp < 2; ++pp)
#pragma unroll
    for (int kk = 0; kk < 2; ++kk)
      aq[pp][kk] = *(const bf16x8*)(Q + (size_t)(qrow + r) * 512 + h * 128 + pp * 64 + kk * 32 + g * 8);
  float mrun[2][4], lrun[2][4];
  f32x4 O[2][8];
#pragma unroll
  for (int pp = 0; pp < 2; ++pp) {
#pragma unroll
    for (int j = 0; j < 4; ++j) { mrun[pp][j] = -1e30f; lrun[pp][j] = 0.f; }
#pragma unroll
    for (int n = 0; n < 8; ++n) O[pp][n] = (f32x4){0.f, 0.f, 0.f, 0.f};
  }
  bh* Pw = Pl + w * (2 * 16 * 40);
  const float scale = 0.125f;
  bh* Ks = (bh*)(smem + 10752);
  bh* Vs = Ks + 64 * 128;
  u32x4 pk_[4], pv_[4];
  auto tload = [&](int kt) {
#pragma unroll
    for (int i = 0; i < 4; ++i) {
      const int pz = tid + 256 * i;
      pk_[i] = *(const u32x4*)(KB + (size_t)(kt + (pz >> 4)) * 128 + (pz & 15) * 8);
      pv_[i] = *(const u32x4*)(VT + (size_t)(pz >> 3) * Lk + kt + (pz & 7) * 8);
    }
  };
  tload(0);
#pragma unroll 1
  for (int kt = 0; kt < Lk; kt += 64) {
    __syncthreads();
#pragma unroll
    for (int i = 0; i < 4; ++i) {
      const int pz = tid + 256 * i;
      const int key = pz >> 4, ck = pz & 15, dv = pz >> 3, cv = pz & 7;
      *(u32x4*)(Ks + key * 128 + ((ck ^ (key & 15)) << 3)) = pk_[i];
      *(u32x4*)(Vs + dv * 64 + ((cv ^ ((dv >> 1) & 7)) << 3)) = pv_[i];
    }
    __syncthreads();
    if (kt + 64 < Lk) tload(kt + 64);
#pragma unroll
    for (int h2 = 0; h2 < 2; ++h2) {
      f32x4 s[2][2];
#pragma unroll
      for (int sub = 0; sub < 2; ++sub) {
        const int key = h2 * 32 + sub * 16 + r;
#pragma unroll
        for (int pp = 0; pp < 2; ++pp) {
          const bf16x8 b0 = *(const bf16x8*)(Ks + key * 128 + (((pp * 8 + g) ^ (key & 15)) << 3));
          const bf16x8 b1 = *(const bf16x8*)(Ks + key * 128 + (((pp * 8 + 4 + g) ^ (key & 15)) << 3));
          f32x4 z = (f32x4){0.f, 0.f, 0.f, 0.f};
          z = __builtin_amdgcn_mfma_f32_16x16x32_bf16(aq[pp][0], b0, z, 0, 0, 0);
          z = __builtin_amdgcn_mfma_f32_16x16x32_bf16(aq[pp][1], b1, z, 0, 0, 0);
          s[pp][sub] = z;
        }
      }
#pragma unroll
      for (int pp = 0; pp < 2; ++pp) {
#pragma unroll
        for (int j = 0; j < 4; ++j) {
          float s0 = s[pp][0][j] * scale, s1 = s[pp][1][j] * scale;
          float mx = max16(fmaxf(s0, s1));
          float mnew = fmaxf(mrun[pp][j], mx);
          float alpha = __expf(mrun[pp][j] - mnew);
          float p0 = __expf(s0 - mnew), p1 = __expf(s1 - mnew);
          float rs = sum16(p0 + p1);
          lrun[pp][j] = lrun[pp][j] * alpha + rs;
          mrun[pp][j] = mnew;
#pragma unroll
          for (int n = 0; n < 8; ++n) O[pp][n][j] *= alpha;
          Pw[(pp * 16 + g * 4 + j) * 40 + r] = f2bf(p0);
          Pw[(pp * 16 + g * 4 + j) * 40 + 16 + r] = f2bf(p1);
        }
      }
      __builtin_amdgcn_fence(__ATOMIC_RELEASE, "wavefront");
      __builtin_amdgcn_wave_barrier();
      __builtin_amdgcn_fence(__ATOMIC_ACQUIRE, "wavefront");
      bf16x8 pa0 = *(const bf16x8*)(Pw + (0 * 16 + r) * 40 + g * 8);
      bf16x8 pa1 = *(const bf16x8*)(Pw + (1 * 16 + r) * 40 + g * 8);
#pragma unroll
      for (int n = 0; n < 8; ++n) {
        const int dv = n * 16 + r;
        const bf16x8 vb = *(const bf16x8*)(Vs + dv * 64 + (((h2 * 4 + g) ^ ((dv >> 1) & 7)) << 3));
        O[0][n] = __builtin_amdgcn_mfma_f32_16x16x32_bf16(pa0, vb, O[0][n], 0, 0, 0);
        O[1][n] = __builtin_amdgcn_mfma_f32_16x16x32_bf16(pa1, vb, O[1][n], 0, 0, 0);
      }
      __builtin_amdgcn_fence(__ATOMIC_RELEASE, "wavefront");
      __builtin_amdgcn_wave_barrier();
    }
  }
#pragma unroll
  for (int j = 0; j < 4; ++j) {
    float i0 = 1.f / lrun[0][j], i1 = lam / lrun[1][j];
    float o[8];
    float ss = 0.f;
#pragma unroll
    for (int n = 0; n < 8; ++n) { o[n] = O[0][n][j] * i0 - O[1][n][j] * i1; ss += o[n] * o[n]; }
    ss = sum16(ss);
    float rs = rsqrtf(ss * (1.f / 128.f) + EPSF) * (1.f - lam_init);
    bh* arow = p.act + (size_t)(qrow + g * 4 + j) * 1024 + h * 128;
#pragma unroll
    for (int n = 0; n < 8; ++n) arow[n * 16 + r] = f2bf(o[n] * rs * p.diff_norm[h * 128 + n * 16 + r]);
  }
}

__device__ __forceinline__ void ffnact_job(const Params& p, int layer, int job) {
  int tidl = threadIdx.x; asm volatile("" : "+v"(tidl));
  const int item = job * 256 + tidl;
  const int rc = item / 352, j = (item % 352) * 8;
  const int t0 = rc * 8;
  const bh* U = (const bh*)p.R;
  bh* AO = (bh*)(p.R + OFF_ACTF);
  const float* cw = p.ffn_conv_w + (size_t)layer * 3 * 5632;
  const float* cb = p.ffn_conv_b + (size_t)layer * 5632;
  const bool start = (t0 < NTP) ? ((t0 & 255) == 0) : ((t0 & 2047) == 0);
  const bool endd = (t0 < NTP) ? (((t0 + 8) & 255) == 0) : (((t0 + 8) & 2047) == 0);
  u32x4 ua[10], ug[10];
  const u32x4 zz = {0, 0, 0, 0};
#pragma unroll
  for (int i = 0; i < 10; ++i) {
    const int t = t0 - 1 + i;
    const bool ok = (i == 0) ? !start : ((i == 9) ? !endd : true);
    ua[i] = ok ? *(const u32x4*)(U + (size_t)t * 5632 + j) : zz;
    ug[i] = ok ? *(const u32x4*)(U + (size_t)t * 5632 + 2816 + j) : zz;
  }
  float wa[3][8], wg[3][8], ba[8], bg[8];
#pragma unroll
  for (int tp = 0; tp < 3; ++tp) {
    float4 x0 = *(const float4*)(cw + tp * 5632 + j), x1 = *(const float4*)(cw + tp * 5632 + j + 4);
    float4 y0 = *(const float4*)(cw + tp * 5632 + 2816 + j), y1 = *(const float4*)(cw + tp * 5632 + 2816 + j + 4);
    wa[tp][0] = x0.x; wa[tp][1] = x0.y; wa[tp][2] = x0.z; wa[tp][3] = x0.w; wa[tp][4] = x1.x; wa[tp][5] = x1.y; wa[tp][6] = x1.z; wa[tp][7] = x1.w;
    wg[tp][0] = y0.x; wg[tp][1] = y0.y; wg[tp][2] = y0.z; wg[tp][3] = y0.w; wg[tp][4] = y1.x; wg[tp][5] = y1.y; wg[tp][6] = y1.z; wg[tp][7] = y1.w;
  }
  {
    float4 x0 = *(const float4*)(cb + j), x1 = *(const float4*)(cb + j + 4);
    float4 y0 = *(const float4*)(cb + 2816 + j), y1 = *(const float4*)(cb + 2816 + j + 4);
    ba[0] = x0.x; ba[1] = x0.y; ba[2] = x0.z; ba[3] = x0.w; ba[4] = x1.x; ba[5] = x1.y; ba[6] = x1.z; ba[7] = x1.w;
    bg[0] = y0.x; bg[1] = y0.y; bg[2] = y0.z; bg[3] = y0.w; bg[4] = y1.x; bg[5] = y1.y; bg[6] = y1.z; bg[7] = y1.w;
  }
#pragma unroll
  for (int i = 0; i < 8; ++i) {
    u32x4 ov;
#pragma unroll
    for (int e2 = 0; e2 < 4; ++e2) {
      float res[2];
#pragma unroll
      for (int hl = 0; hl < 2; ++hl) {
        const int e = e2 * 2 + hl;
        float am = hl ? bfhi(ua[i][e2]) : bflo(ua[i][e2]);
        float a0 = hl ? bfhi(ua[i + 1][e2]) : bflo(ua[i + 1][e2]);
        float ap = hl ? bfhi(ua[i + 2][e2]) : bflo(ua[i + 2][e2]);
        float gm = hl ? bfhi(ug[i][e2]) : bflo(ug[i][e2]);
        float g0 = hl ? bfhi(ug[i + 1][e2]) : bflo(ug[i + 1][e2]);
        float gp = hl ? bfhi(ug[i + 2][e2]) : bflo(ug[i + 2][e2]);
        float av = wa[0][e] * am + wa[1][e] * a0 + wa[2][e] * ap + ba[e];
        float gv = wg[0][e] * gm + wg[1][e] * g0 + wg[2][e] * gp + bg[e];
        res[hl] = siluf_(gv) * av;
      }
      ov[e2] = pk2(res[0], res[1]);
    }
    *(u32x4*)(AO + (size_t)(t0 + i) * 2816 + j) = ov;
  }
}

#define XB_TMO      128
#define XB_XCNT(j)  (256  + 64 * (j))
#define XB_XSUB(j)  (1280 + 64 * (j))
#define XB_XGEN(j)  (2304 + 64 * (j))
#define XB_TOP      3328
#define XB_TOPGEN   3392
#define XCD_BAR_WORDS 3456
#define XB_SPIN_CAP (1u << 18)
#define LAS __attribute__((address_space(3)))

__device__ __forceinline__ unsigned xb_ld(unsigned* p)              { return __hip_atomic_load(p, __ATOMIC_RELAXED, __HIP_MEMORY_SCOPE_AGENT); }
__device__ __forceinline__ unsigned xb_add(unsigned* p, unsigned v) { return __hip_atomic_fetch_add(p, v, __ATOMIC_RELAXED, __HIP_MEMORY_SCOPE_AGENT); }
__device__ __forceinline__ unsigned xb_xcc_id() { return (unsigned)__builtin_amdgcn_s_getreg((3 << 11) | 20) & 0xFu; }
#define XB_SPIN(cond, bar) do { unsigned _sp = 0; while (cond) { __builtin_amdgcn_s_sleep(1); \
    if ((++_sp & 255u) == 0u) { if (xb_ld(&(bar)[XB_TMO])) break; if (_sp > XB_SPIN_CAP) { atomicAdd(&(bar)[XB_TMO], 1u); break; } } } } while (0)

struct XcdBarrier {
    unsigned* bar; unsigned x;
    volatile LAS unsigned* st;
};

__device__ __forceinline__ XcdBarrier xcd_barrier_post(unsigned* bar, volatile LAS unsigned* st) {
    XcdBarrier b; b.bar = bar; b.x = xb_xcc_id(); b.st = st;
    if (threadIdx.x == 0) (void)xb_add(&bar[XB_XCNT(b.x)], 1u);
    return b;
}
__device__ __forceinline__ void xcd_barrier_complete(unsigned* bar, unsigned x, unsigned& nloc, unsigned& nx) {
    const unsigned G = gridDim.x * gridDim.y * gridDim.z;
    unsigned sum, cnt, mine, sp = 0u;
    for (;;) {
        sum = 0u; cnt = 0u; mine = 0u;
#pragma unroll
        for (unsigned j = 0; j < 16; ++j) { const unsigned c = xb_ld(&bar[XB_XCNT(j)]); sum += c; cnt += (c > 0u) ? 1u : 0u; mine = (j == x) ? c : mine; }
        if (sum == G) break;
        __builtin_amdgcn_s_sleep(1);
        if ((++sp & 255u) == 0u) { if (xb_ld(&bar[XB_TMO])) break; if (sp > XB_SPIN_CAP) { atomicAdd(&bar[XB_TMO], 1u); break; } }
    }
    nloc = mine > 0u ? mine : 1u; nx = cnt > 0u ? cnt : 1u;
}

__device__ __forceinline__ void xcd_barrier(const XcdBarrier& b) {
    asm volatile("s_waitcnt vmcnt(0)" ::: "memory");
    __syncthreads();
    if (threadIdx.x == 0) {
        unsigned* bar = b.bar;
        __builtin_amdgcn_s_waitcnt(0);
        unsigned nloc = b.st[0], nx = b.st[1];
        if (nloc == 0u) { xcd_barrier_complete(bar, b.x, nloc, nx); b.st[0] = nloc; b.st[1] = nx; }
        const unsigned old = xb_add(&bar[XB_XSUB(b.x)], 1u);
        const unsigned gen = old / nloc;
        if (old + 1u == (gen + 1u) * nloc) {
            __builtin_amdgcn_fence(__ATOMIC_RELEASE, "agent");
            asm volatile("s_waitcnt vmcnt(0)" ::: "memory");
            const unsigned og = xb_add(&bar[XB_TOP], 1u);
            const unsigned tg = og / nx;
            if (og + 1u == (tg + 1u) * nx) xb_add(&bar[XB_TOPGEN], 1u);
            else XB_SPIN(xb_ld(&bar[XB_TOPGEN]) == tg, bar);
            __builtin_amdgcn_fence(__ATOMIC_ACQUIRE, "agent");
            xb_add(&bar[XB_XGEN(b.x)], 1u);
            asm volatile("s_waitcnt vmcnt(0)" ::: "memory");
        } else {
            XB_SPIN(xb_ld(&bar[XB_XGEN(b.x)]) == gen, bar);
            __builtin_amdgcn_fence(__ATOMIC_ACQUIRE, "agent");
            asm volatile("s_waitcnt vmcnt(0)" ::: "memory");
        }
    }
    __syncthreads();
}


template <int ph>
__device__ __forceinline__ void run_phase(const Params& p, int bid, int nb, char* smem, bool rep = false) {
  const float* ng = p.norm_g;
  const bh* Rf = (const bh*)p.R;
  if (ph == 0) {
    for (int j = bid + (rep ? 768 : 0); j < 768 + 576 + 1024; j += nb) {
      if (j < 768) gemv_job(p, j, smem);
      else if (j < 1344) filter_job(p, j - 768, smem);
      else convert_tile(p.w_in_even, 1024, 4096, p.wt, j - 1344, smem);
    }
  } else if (ph == 1) {
    for (int j = bid; j < 768; j += nb) rows_job(p, j, true, nullptr, nullptr, 0, 0, ng + 0 * 1024, 0, 0);
  } else if (ph == 2) {
    gemm_phase<2, 192, 3>(p.act, 1024, p.wt, 1024, p.R, 4096, 4096, 32, bid, nb, smem);
  } else if (ph == 3) {
    if (nb == 512 && !rep) {
      hyena_sample_job(p, bid, smem);
      if (bid < 384) scan2_unit<0>(p, bid, smem);
      else {
        const int q = bid - 384;
        hyena_prompt_job(p, q, smem);
        hyena_prompt_job(p, q + 128, smem);
        convert_tile(p.w_out_even, 1024, 1024, p.wt, q, smem);
        convert_tile(p.w_out_even, 1024, 1024, p.wt, q + 128, smem);
      }
    } else {
      for (int j = bid + (rep ? 512 : 0); j < (rep ? 896 : 512 + 384 + 256 + 256); j += nb) {
        if (j < 512) hyena_sample_job(p, j, smem);
        else if (j < 896) scan2_unit<0>(p, j - 512, smem);
        else if (j < 1152) hyena_prompt_job(p, j - 896, smem);
        else convert_tile(p.w_out_even, 1024, 1024, p.wt, j - 1152, smem);
      }
    }
  } else if (ph == 4) {
    for (int j = bid; j < 128 + 1024; j += nb) {
      if (j < 128) fixup_unit<0>(p, j, smem);
      else scan_final_job(p, j - 128, 0);
    }
  } else if (ph == 5) {
    for (int j = bid; j < 512; j += nb) scan_final_job(p, 1024 + j, 0);
  } else if (ph == 6) {
    gemm_phase<1, 192, 3>(p.act, 1024, p.wt, 1024, p.R, 1024, 1024, 8, bid, nb, smem);
  } else if (ph == 7) {
    for (int j = bid; j < 768 + 1408 + 704; j += nb) {
      if (j < 768) rows_job(p, j, true, Rf, ng + 1 * 1024, 0, 2, ng + 2 * 1024, 0, 3);
      else if (j < 2176) convert_tile(p.ffn_up, 1024, 5632, p.wt, j - 768, smem, true);
      else convert_tile(p.ffn_down, 2816, 1024, p.wt2, j - 2176, smem);
    }
  } else if (ph == 8) {
    gemm_phase<3, 192, 3>(p.act, 1024, p.wt, 1024, p.R + OFF_ACTF, 2816, 5632, 44, bid, nb, smem, p.ffn_conv_w, p.ffn_conv_b);
  } else if (ph == 9) {
  } else if (ph == 10) {
    gemm_phase<1, 192, 3>((const bh*)(p.R + OFF_ACTF), 2816, p.wt2, 2816, p.R, 1024, 1024, 8, bid, nb, smem);
  } else if (ph == 11) {
    for (int j = bid; j < 768 + 800; j += nb) {
      if (j < 768) rows_job(p, j, false, Rf, ng + 3 * 1024, 0, 5, ng + 4 * 1024, 1, 0);
      else convert_tile(p.w_in_odd, 1024, 3104, p.wt, j - 768, smem);
    }
  } else if (ph == 12) {
    gemm_phase<1, 128, 3>(p.act, 1024, p.wt, 1024, p.R, 3104, 3104, 25, bid, nb, smem);
  } else if (ph == 13) {
    auto small13 = [&](int sj) {
      if (sj < 800) vt_job(p, sj, smem);
      else if (sj < 3872) oddrow_job(p, sj - 800);
      else if (sj < 4128) ctxk_job(p, sj - 3872);
      else convert_tile(p.w_out_odd, 1024, 1024, p.wt, sj - 4128, smem);
    };
    if (nb == 512 && !rep) {
      if (bid < 384) {
        scan2_unit<1>(p, bid, smem);
        for (int sj = 3072 + bid; sj < 4384; sj += 384) small13(sj);
      } else {
        for (int k = 0; k < 24; ++k) small13((bid - 384) + 128 * k);
      }
    } else {
      for (int j = bid; j < (rep ? 384 : 384 + 4384); j += nb) {
        if (j < 384) scan2_unit<1>(p, j, smem);
        else small13(j - 384);
      }
    }
  } else if (ph == 14) {
    if (nb == 512 && !rep) {
      if (bid < 256) attn_unit(p, bid, smem);
      else {
        const int q = bid - 256;
        attn_unit(p, 256 + q, smem);
        attn_unit(p, 512 + q, smem);
        if (q < 128) fixup_unit<1>(p, q, smem);
        for (int k = 0; k < 4; ++k) scan_final_job(p, q + 256 * k, 1);
      }
    } else {
      for (int j = bid; j < (rep ? 768 : 768 + 128 + 1024); j += nb) {
        if (j < 768) attn_unit(p, j, smem);
        else if (j < 896) fixup_unit<1>(p, j - 768, smem);
        else scan_final_job(p, j - 896, 1);
      }
    }
  } else if (ph == 15) {
    for (int j = bid; j < 512; j += nb) scan_final_job(p, 1024 + j, 1);
  } else if (ph == 16) {
    gemm_phase<1, 192, 3>(p.act, 1024, p.wt, 1024, p.R, 1024, 1024, 8, bid, nb, smem);
  } else if (ph == 17) {
    for (int j = bid; j < 768 + 1408 + 704; j += nb) {
      if (j < 768) rows_job(p, j, false, Rf, ng + 5 * 1024, 1, 2, ng + 6 * 1024, 1, 3);
      else if (j < 2176) convert_tile(p.ffn_up + (size_t)1024 * 5632, 1024, 5632, p.wt, j - 768, smem, true);
      else convert_tile(p.ffn_down + (size_t)2816 * 1024, 2816, 1024, p.wt2, j - 2176, smem);
    }
  } else if (ph == 18) {
    gemm_phase<3, 192, 3>(p.act, 1024, p.wt, 1024, p.R + OFF_ACTF, 2816, 5632, 44, bid, nb, smem, p.ffn_conv_w + 3 * 5632, p.ffn_conv_b + 5632);
  } else if (ph == 19) {
  } else if (ph == 20) {
    gemm_phase<1, 192, 3>((const bh*)(p.R + OFF_ACTF), 2816, p.wt2, 2816, p.R, 1024, 1024, 8, bid, nb, smem);
  } else if (ph == 21) {
    for (int j = bid; j < 768; j += nb) rows_job(p, j, false, Rf, ng + 7 * 1024, 1, 5, nullptr, 0, 0);
  }
}

template <int PH>
__device__ __forceinline__ void phase_step(const Params& p, int ph0, int ph1, char* smem, cg::grid_group& grid, const XcdBarrier& xb) {
  if (PH == 9 || PH == 19) return;
  if (PH >= ph0 && PH < ph1) {
    if (PH == REP_PH) { run_phase<PH>(p, blockIdx.x, gridDim.x, smem, true); xcd_barrier(xb); }
    run_phase<PH>(p, blockIdx.x, gridDim.x, smem);
    if (PH + 1 < ph1) {
      xcd_barrier(xb);
    }
  }
}

__global__ void __launch_bounds__(256, 2) mega_kernel(Params p, int ph0, int ph1) {
  __shared__ __attribute__((aligned(16))) char smem[49152];
  cg::grid_group grid = cg::this_grid();
  __shared__ uint4 xb_words;
  if (threadIdx.x == 0) xb_words = make_uint4(0u, 0u, 0u, 0u);
  __syncthreads();
  XcdBarrier xb = xcd_barrier_post(p.bar, (volatile LAS unsigned*)&xb_words);
#ifdef EXTRA_SYNCS
  for (int i = 0; i < EXTRA_SYNCS; ++i) xcd_barrier(xb);
#endif
  phase_step<0>(p, ph0, ph1, smem, grid, xb);
  phase_step<1>(p, ph0, ph1, smem, grid, xb);
  phase_step<2>(p, ph0, ph1, smem, grid, xb);
  phase_step<3>(p, ph0, ph1, smem, grid, xb);
  phase_step<4>(p, ph0, ph1, smem, grid, xb);
  phase_step<5>(p, ph0, ph1, smem, grid, xb);
  phase_step<6>(p, ph0, ph1, smem, grid, xb);
  phase_step<7>(p, ph0, ph1, smem, grid, xb);
  phase_step<8>(p, ph0, ph1, smem, grid, xb);
  phase_step<9>(p, ph0, ph1, smem, grid, xb);
  phase_step<10>(p, ph0, ph1, smem, grid, xb);
  phase_step<11>(p, ph0, ph1, smem, grid, xb);
  phase_step<12>(p, ph0, ph1, smem, grid, xb);
  phase_step<13>(p, ph0, ph1, smem, grid, xb);
  phase_step<14>(p, ph0, ph1, smem, grid, xb);
  phase_step<15>(p, ph0, ph1, smem, grid, xb);
  phase_step<16>(p, ph0, ph1, smem, grid, xb);
  phase_step<17>(p, ph0, ph1, smem, grid, xb);
  phase_step<18>(p, ph0, ph1, smem, grid, xb);
  phase_step<19>(p, ph0, ph1, smem, grid, xb);
  phase_step<20>(p, ph0, ph1, smem, grid, xb);
  phase_step<21>(p, ph0, ph1, smem, grid, xb);
}

extern "C" void kernel_launch(void* const* d_in, const int* in_sizes, int n_in, void* d_out, int out_size, void* d_ws,
                              size_t ws_size, hipStream_t stream) {
  static int grid_blocks = 0;
  if (!grid_blocks) {
    int dev = 0, cus = 0, per_cu = 0;
    hipGetDevice(&dev);
    hipDeviceGetAttribute(&cus, hipDeviceAttributeMultiprocessorCount, dev);
    hipOccupancyMaxActiveBlocksPerMultiprocessor(&per_cu, mega_kernel, 256, 0);
    if (per_cu > 2) per_cu = 2;
    if (per_cu < 1) per_cu = 1;
    grid_blocks = cus * per_cu;
  }
  Params p{};
  const float** pf = (const float**)&p;
  for (int i = 0; i < 35; ++i) pf[i] = (const float*)d_in[i];
  p.out = (float*)d_out;
  char* ws = (char*)d_ws;
  size_t off = 0;
  p.act = (bh*)(ws + off); off += (size_t)NT * 1024 * 2;
  p.wt = (bh*)(ws + off); off += (size_t)5632 * 1024 * 2;
  p.wt2 = (bh*)(ws + off); off += (size_t)1024 * 2816 * 2;
  p.R = ws + off; off += R_BYTES;
  p.mod = (float*)(ws + off); off += (size_t)2 * 3 * 6144 * 4;
  p.bar = (unsigned*)(ws + off); off += (size_t)XCD_BAR_WORDS * 4;
  p.gt256 = (bh*)(ws + off); off += (size_t)2 * 512 * 512 * 2;
  p.gt2048 = (bh*)(ws + off); off += (size_t)2 * 512 * 4096 * 2;
  if (off > ws_size) { fprintf(stderr, "workspace too small: need %zu have %zu\n", off, ws_size); return; }
  hipMemsetAsync(p.mod, 0, (size_t)2 * 3 * 6144 * 4 + (size_t)XCD_BAR_WORDS * 4, stream);
#if MEGA
  int ph0 = 0, ph1 = NPHASE;
  void* args[] = {&p, &ph0, &ph1};
  hipError_t e = hipLaunchCooperativeKernel((void*)mega_kernel, dim3(grid_blocks), dim3(256), args, 0, stream);
  if (e != hipSuccess) fprintf(stderr, "cooperative launch failed: %s (grid %d)\n", hipGetErrorString(e), grid_blocks);
#else
  for (int ph = 0; ph < NPHASE; ++ph) {
    int ph0 = ph, ph1 = ph + 1;
    void* args[] = {&p, &ph0, &ph1};
    hipError_t e = hipLaunchCooperativeKernel((void*)mega_kernel, dim3(grid_blocks), dim3(256), args, 0, stream);
    if (e != hipSuccess) fprintf(stderr, "launch failed: %s\n", hipGetErrorString(e));
  }
#endif
}
```

```cpp
#include <hip/hip_runtime.h>
#include <hip/hip_cooperative_groups.h>
#include <stdint.h>
#include <cstdio>
namespace cg = cooperative_groups;

#ifndef MEGA
#define MEGA 1
#endif
#ifndef REP_PH
#define REP_PH -1
#endif

typedef unsigned short bh;
using bf16x8 = __attribute__((ext_vector_type(8))) short;
using f32x4 = __attribute__((ext_vector_type(4))) float;
using u32x4 = __attribute__((ext_vector_type(4))) unsigned int;

#define NT 12288
#define NTP 8192
#define EPSF 1e-6f
#define NPHASE 22

#define OUT_HGRN 12582912
#define OUT_CK 16777216
#define OUT_CV 20971520
#define OUT_GLA 25165824

#define OFF_ODIR 100663296ull
#define OFF_Z1 150994944ull
#define OFF_HYT 150994944ull
#define OFF_ACTF 138412032ull
#define OFF_Q 150994944ull
#define OFF_KB 163577856ull
#define OFF_VT 176685056ull
#define R_BYTES 207618048ull
#define KV_SAMPLE_BASE 4194304

struct Params {
  const float *x_prompt, *x_sample, *state_hgrn, *cache_k, *cache_v, *state_gla, *c, *c_ctx;
  const float *ada_w, *ada_b, *norm_g, *ffn_up, *ffn_conv_w, *ffn_conv_b, *ffn_down;
  const float *w_in_even, *w_out_even, *hgrn_lb, *hgrn_norm, *hy_conv_w, *hy_conv_b;
  const float *hy_w1, *hy_b1, *hy_w2, *hy_b2, *hy_w3, *hy_freq, *hy_d;
  const float *w_in_odd, *w_out_odd, *diff_lambda, *diff_norm, *gla_aw, *gla_ab, *gla_norm;
  float* out;
  bh* act;
  bh* wt;
  bh* wt2;
  char* R;
  float* mod;
  bh* gt256;
  bh* gt2048;
  unsigned* bar;
};

typedef __bf16 bf2_t __attribute__((ext_vector_type(2)));
typedef float f2_t __attribute__((ext_vector_type(2)));
typedef unsigned int u32x2 __attribute__((ext_vector_type(2)));
__device__ __forceinline__ unsigned pk2(float a, float b) {
  f2_t v = {a, b};
  return __builtin_bit_cast(unsigned, __builtin_convertvector(v, bf2_t));
}
__device__ __forceinline__ bh f2bf(float x) { return (bh)(pk2(x, x) & 0xffffu); }
__device__ __forceinline__ float bflo(unsigned w) { return __uint_as_float(w << 16); }
__device__ __forceinline__ float bfhi(unsigned w) { return __uint_as_float(w & 0xffff0000u); }
__device__ __forceinline__ float bf2f(bh h) { return __uint_as_float(((uint32_t)h) << 16); }
__device__ __forceinline__ float sigmoidf_(float x) { return __builtin_amdgcn_rcpf(1.f + __expf(-x)); }
__device__ __forceinline__ float siluf_(float x) { return x * __builtin_amdgcn_rcpf(1.f + __expf(-x)); }
template <int CTRL>
__device__ __forceinline__ float dppf0(float v) {
  return __int_as_float(__builtin_amdgcn_update_dpp(0, __float_as_int(v), CTRL, 0xF, 0xF, true));
}
__device__ __forceinline__ float wave_sum(float v) {
  v += dppf0<0xB1>(v); v += dppf0<0x4E>(v); v += dppf0<0x141>(v); v += dppf0<0x140>(v);
  v += __shfl_xor(v, 16);
  v += __shfl_xor(v, 32);
  return v;
}

template <int OUT_BF16, int BM, int DEPTH>
__device__ __forceinline__ void gemm_phase(const bh* __restrict__ A, int lda, const bh* __restrict__ Bt, int K, void* Cv, int ldc,
                           int N, int ntn, int bid, int nb, char* smem, const float* cw = nullptr, const float* cb = nullptr) {
  constexpr int MT = BM / 32;
  constexpr int NPA = BM / 32;
  bh* As = (bh*)smem;
  bh* Bs = As + BM * 64;
  int tid_l_ = threadIdx.x; asm volatile("" : "+v"(tid_l_)); const int tid = tid_l_, lane = tid & 63, w = tid >> 6, wr = w >> 1, wc = w & 1, r = lane & 15, g = lane >> 4;
  constexpr int MB = (NT / BM) / 8;
  const int xcd = bid & 7, nloc = nb >> 3;
  const int qend = OUT_BF16 == 3 ? MB * ntn + (ntn + 7) / 8 : MB * ntn;
  for (int q = bid >> 3; q < qend; q += nloc) {
    int mt = xcd * MB + (q % MB), nt = q / MB;
    if (OUT_BF16 == 3 && q >= MB * ntn) { mt = 64; nt = (q - MB * ntn) * 8 + xcd; if (nt >= ntn) continue; }
    const int trow0 = OUT_BF16 == 3 ? mt * 190 - 1 : mt * BM;
    const bh* Ag = A;
    const bh* Bg = Bt + (size_t)(nt * 128) * K;
    f32x4 acc[MT][4];
#pragma unroll
    for (int m = 0; m < MT; ++m)
#pragma unroll
      for (int n = 0; n < 4; ++n) acc[m][n] = (f32x4){0.f, 0.f, 0.f, 0.f};
    u32x4 pa0[NPA], pb0[4], pa1[NPA], pb1[4];
    auto gload = [&](u32x4* pa, u32x4* pb, int kofs) {
#pragma unroll
      for (int i = 0; i < NPA; ++i) {
        int pz = tid + i * 256, row = pz >> 3, cp = pz & 7;
        int tr = trow0 + row;
        if (OUT_BF16 == 3) tr = min(max(tr, 0), NT - 1);
        pa[i] = *(const u32x4*)(Ag + (size_t)tr * lda + kofs + cp * 8);
      }
#pragma unroll
      for (int i = 0; i < 4; ++i) {
        int pz = tid + i * 256, row = pz >> 3, cp = pz & 7;
        pb[i] = *(const u32x4*)(Bg + (size_t)row * K + kofs + cp * 8);
      }
    };
    auto kstep = [&](u32x4* pa, u32x4* pb, int knext) {
      __syncthreads();
#pragma unroll
      for (int i = 0; i < NPA; ++i) {
        int pz = tid + i * 256, row = pz >> 3, cp = pz & 7;
        *(u32x4*)(As + row * 64 + ((cp ^ ((row >> 1) & 7)) << 3)) = pa[i];
      }
#pragma unroll
      for (int i = 0; i < 4; ++i) {
        int pz = tid + i * 256, row = pz >> 3, cp = pz & 7;
        *(u32x4*)(Bs + row * 64 + ((cp ^ ((row >> 1) & 7)) << 3)) = pb[i];
      }
      __syncthreads();
      if (knext < K) gload(pa, pb, knext);
#pragma unroll
      for (int kk = 0; kk < 2; ++kk) {
        bf16x8 af[MT], bfr[4];
#pragma unroll
        for (int m = 0; m < MT; ++m) { const int row = wr * (BM / 2) + m * 16 + r; af[m] = *(const bf16x8*)(As + row * 64 + (((kk * 4 + g) ^ ((row >> 1) & 7)) << 3)); }
#pragma unroll
        for (int n = 0; n < 4; ++n) { const int row = wc * 64 + n * 16 + r; bfr[n] = *(const bf16x8*)(Bs + row * 64 + (((kk * 4 + g) ^ ((row >> 1) & 7)) << 3)); }
        __builtin_amdgcn_sched_barrier(0);
#pragma unroll
        for (int m = 0; m < MT; ++m)
#pragma unroll
          for (int n = 0; n < 4; ++n)
            acc[m][n] = (OUT_BF16 == 1 || OUT_BF16 == 3) ? __builtin_amdgcn_mfma_f32_16x16x32_bf16(bfr[n], af[m], acc[m][n], 0, 0, 0)
                                        : __builtin_amdgcn_mfma_f32_16x16x32_bf16(af[m], bfr[n], acc[m][n], 0, 0, 0);
        __builtin_amdgcn_sched_barrier(0);
      }
    };
    if (DEPTH == 3) {
      constexpr int NA3 = BM / 64;
      bh* As3 = (bh*)smem;
      bh* Bs3 = As3 + 2 * BM * 32;
      u32x4 ra0[NA3], rb0[2], ra1[NA3], rb1[2];
      auto ld3 = [&](u32x4* ra, u32x4* rb, int kofs) {
#pragma unroll
        for (int i = 0; i < NA3; ++i) {
          int pz = tid + i * 256, row = pz >> 2, c = pz & 3;
          int tr = trow0 + row;
          if (OUT_BF16 == 3) tr = min(max(tr, 0), NT - 1);
          ra[i] = *(const u32x4*)(Ag + (size_t)tr * lda + kofs + c * 8);
        }
#pragma unroll
        for (int i = 0; i < 2; ++i) {
          int pz = tid + i * 256, row = pz >> 2, c = pz & 3;
          rb[i] = *(const u32x4*)(Bg + (size_t)row * K + kofs + c * 8);
        }
      };
      auto st3 = [&](const u32x4* ra, const u32x4* rb, int stg) {
#pragma unroll
        for (int i = 0; i < NA3; ++i) {
          int pz = tid + i * 256, row = pz >> 2, c = pz & 3;
          *(u32x4*)(As3 + stg * BM * 32 + row * 32 + ((c ^ (((row >> 3) & 1) << 1)) << 3)) = ra[i];
        }
#pragma unroll
        for (int i = 0; i < 2; ++i) {
          int pz = tid + i * 256, row = pz >> 2, c = pz & 3;
          *(u32x4*)(Bs3 + stg * 128 * 32 + row * 32 + ((c ^ (((row >> 3) & 1) << 1)) << 3)) = rb[i];
        }
      };
      auto comp3 = [&](int cur) {
        __builtin_amdgcn_s_setprio(1);
        bf16x8 af[MT], bfr[4];
#pragma unroll
        for (int m = 0; m < MT; ++m) {
          const int row = wr * (BM / 2) + m * 16 + r;
          af[m] = *(const bf16x8*)(As3 + cur * BM * 32 + row * 32 + ((g ^ (((row >> 3) & 1) << 1)) << 3));
        }
#pragma unroll
        for (int n = 0; n < 4; ++n) {
          const int row = wc * 64 + n * 16 + r;
          bfr[n] = *(const bf16x8*)(Bs3 + cur * 128 * 32 + row * 32 + ((g ^ (((row >> 3) & 1) << 1)) << 3));
        }
#pragma unroll
        for (int m = 0; m < MT; ++m)
#pragma unroll
          for (int n = 0; n < 4; ++n)
            acc[m][n] = (OUT_BF16 == 1 || OUT_BF16 == 3) ? __builtin_amdgcn_mfma_f32_16x16x32_bf16(bfr[n], af[m], acc[m][n], 0, 0, 0)
                                        : __builtin_amdgcn_mfma_f32_16x16x32_bf16(af[m], bfr[n], acc[m][n], 0, 0, 0);
        __builtin_amdgcn_s_setprio(0);
      };
      const int nk = K >> 5;
      __syncthreads();
      ld3(ra0, rb0, 0);
      ld3(ra1, rb1, 32);
      st3(ra0, rb0, 0);
      ld3(ra0, rb0, 64);
      __syncthreads();
      for (int ks = 0; ks < nk; ks += 2) {
        comp3(0);
        st3(ra1, rb1, 1);
        if (ks + 3 < nk) ld3(ra1, rb1, (ks + 3) << 5);
        __syncthreads();
        comp3(1);
        if (ks + 2 < nk) st3(ra0, rb0, 0);
        if (ks + 4 < nk) ld3(ra0, rb0, (ks + 4) << 5);
        __syncthreads();
      }
    } else {
    gload(pa0, pb0, 0);
    if (DEPTH == 2) {
      gload(pa1, pb1, 64);
      for (int k0 = 0; k0 < K; k0 += 128) {
        kstep(pa0, pb0, k0 + 128);
        kstep(pa1, pb1, k0 + 192);
      }
    } else {
      for (int k0 = 0; k0 < K; k0 += 64) kstep(pa0, pb0, k0 + 64);
    }
    }
    if (OUT_BF16 == 1 || OUT_BF16 == 3) {
      __syncthreads();
      bh* Ct = (bh*)smem;
#pragma unroll
      for (int m = 0; m < MT; ++m)
#pragma unroll
        for (int n = 0; n < 4; ++n) {
          const int row = wr * (BM / 2) + m * 16 + r;
          const int sl = wc * 16 + n * 4 + g;
          u32x2 pv;
          pv[0] = pk2(acc[m][n][0], acc[m][n][1]);
          pv[1] = pk2(acc[m][n][2], acc[m][n][3]);
          *(u32x2*)(Ct + row * 128 + ((sl ^ ((row & 15) << 1)) << 2)) = pv;
        }
      __syncthreads();
      if (OUT_BF16 == 1) {
#pragma unroll 2
        for (int i = 0; i < BM / 16; ++i) {
          const int pz = tid + i * 256, row = pz >> 4, pc = pz & 15;
          const u32x4 v = *(const u32x4*)(Ct + row * 128 + ((pc ^ (row & 15)) << 3));
          const int col = nt * 128 + pc * 8;
          if (col < N) *(u32x4*)((bh*)Cv + ((size_t)mt * BM + row) * ldc + col) = v;
        }
      } else {
        const int c8 = tid & 7, rs = tid >> 3;
        const int ja = nt * 64 + c8 * 8;
        float wa[3][8], wg[3][8], ba[8], bg[8];
#pragma unroll
        for (int tp = 0; tp < 3; ++tp) {
          const float4 x0 = *(const float4*)(cw + tp * 5632 + ja), x1 = *(const float4*)(cw + tp * 5632 + ja + 4);
          const float4 y0 = *(const float4*)(cw + tp * 5632 + 2816 + ja), y1 = *(const float4*)(cw + tp * 5632 + 2816 + ja + 4);
          wa[tp][0] = x0.x; wa[tp][1] = x0.y; wa[tp][2] = x0.z; wa[tp][3] = x0.w; wa[tp][4] = x1.x; wa[tp][5] = x1.y; wa[tp][6] = x1.z; wa[tp][7] = x1.w;
          wg[tp][0] = y0.x; wg[tp][1] = y0.y; wg[tp][2] = y0.z; wg[tp][3] = y0.w; wg[tp][4] = y1.x; wg[tp][5] = y1.y; wg[tp][6] = y1.z; wg[tp][7] = y1.w;
        }
        {
          const float4 x0 = *(const float4*)(cb + ja), x1 = *(const float4*)(cb + ja + 4);
          const float4 y0 = *(const float4*)(cb + 2816 + ja), y1 = *(const float4*)(cb + 2816 + ja + 4);
          ba[0] = x0.x; ba[1] = x0.y; ba[2] = x0.z; ba[3] = x0.w; ba[4] = x1.x; ba[5] = x1.y; ba[6] = x1.z; ba[7] = x1.w;
          bg[0] = y0.x; bg[1] = y0.y; bg[2] = y0.z; bg[3] = y0.w; bg[4] = y1.x; bg[5] = y1.y; bg[6] = y1.z; bg[7] = y1.w;
        }
#pragma unroll 1
        for (int i = 0; i < 6; ++i) {
          const int rr = 1 + rs + 32 * i;
          const int t = trow0 + rr;
          if (rr <= 190 && t < NT) {
            const bool start = (t < NTP) ? ((t & 255) == 0) : ((t & 2047) == 0);
            const bool endd = (t < NTP) ? ((t & 255) == 255) : ((t & 2047) == 2047);
            u32x4 am = *(const u32x4*)(Ct + (rr - 1) * 128 + ((c8 ^ ((rr - 1) & 15)) << 3));
            u32x4 gm = *(const u32x4*)(Ct + (rr - 1) * 128 + (((8 + c8) ^ ((rr - 1) & 15)) << 3));
            const u32x4 a0 = *(const u32x4*)(Ct + rr * 128 + ((c8 ^ (rr & 15)) << 3));
            const u32x4 g0 = *(const u32x4*)(Ct + rr * 128 + (((8 + c8) ^ (rr & 15)) << 3));
            u32x4 ap = *(const u32x4*)(Ct + (rr + 1) * 128 + ((c8 ^ ((rr + 1) & 15)) << 3));
            u32x4 gp = *(const u32x4*)(Ct + (rr + 1) * 128 + (((8 + c8) ^ ((rr + 1) & 15)) << 3));
            if (start) { am = (u32x4){0, 0, 0, 0}; gm = (u32x4){0, 0, 0, 0}; }
            if (endd) { ap = (u32x4){0, 0, 0, 0}; gp = (u32x4){0, 0, 0, 0}; }
            u32x4 ov;
#pragma unroll
            for (int e2 = 0; e2 < 4; ++e2) {
              float res[2];
#pragma unroll
              for (int hl = 0; hl < 2; ++hl) {
                const int e = e2 * 2 + hl;
                const float av = wa[0][e] * (hl ? bfhi(am[e2]) : bflo(am[e2])) + wa[1][e] * (hl ? bfhi(a0[e2]) : bflo(a0[e2])) +
                                 wa[2][e] * (hl ? bfhi(ap[e2]) : bflo(ap[e2])) + ba[e];
                const float gv = wg[0][e] * (hl ? bfhi(gm[e2]) : bflo(gm[e2])) + wg[1][e] * (hl ? bfhi(g0[e2]) : bflo(g0[e2])) +
                                 wg[2][e] * (hl ? bfhi(gp[e2]) : bflo(gp[e2])) + bg[e];
                res[hl] = siluf_(gv) * av;
              }
              ov[e2] = pk2(res[0], res[1]);
            }
            *(u32x4*)((bh*)Cv + (size_t)t * 2816 + ja) = ov;
          }
        }
      }
    }
#pragma unroll
    for (int m = 0; m < MT; ++m)
#pragma unroll
      for (int n = 0; n < 4; ++n) {
        if (OUT_BF16 == 1 || OUT_BF16 == 3) continue;
        int col = nt * 128 + wc * 64 + n * 16 + r;
        const size_t rowb = (size_t)mt * BM + wr * (BM / 2) + m * 16 + g * 4;
        if (OUT_BF16 == 2 && nt >= 20) {
          bh* hyt = (bh*)((char*)Cv + OFF_HYT) + (size_t)(col - 2560) * NT + rowb;
          u32x2 pv;
          pv[0] = pk2(acc[m][n][0], acc[m][n][1]);
          pv[1] = pk2(acc[m][n][2], acc[m][n][3]);
          *(u32x2*)hyt = pv;
        } else if (col < N) {
#pragma unroll
          for (int j = 0; j < 4; ++j) {
            size_t row = rowb + j;
            if (OUT_BF16) ((bh*)Cv)[row * ldc + col] = f2bf(acc[m][n][j]);
            else ((float*)Cv)[row * ldc + col] = acc[m][n][j];
          }
        }
      }
  }
}

__device__ __forceinline__ void convert_tile(const float* __restrict__ W, int K, int N, bh* __restrict__ WT, int tile, char* smem, bool perm = false) {
  float* tl = (float*)smem;
  int tid_l_ = threadIdx.x; asm volatile("" : "+v"(tid_l_)); const int tid = tid_l_;
  const int ntk = K >> 6;
  const int kt = tile % ntk, ntile = tile / ntk;
  __syncthreads();
#pragma unroll
  for (int i = 0; i < 16; ++i) {
    int e = tid + i * 256, kk = e >> 6, nn = e & 63, n = ntile * 64 + nn;
    tl[kk * 65 + nn] = (n < N) ? W[(size_t)(kt * 64 + kk) * N + n] : 0.f;
  }
  __syncthreads();
#pragma unroll
  for (int i = 0; i < 16; ++i) {
    int e = tid + i * 256, nn = e >> 6, kk = e & 63;
    const int orow = perm ? (ntile % 44) * 128 + (ntile / 44) * 64 + nn : ntile * 64 + nn;
    WT[(size_t)orow * K + kt * 64 + kk] = f2bf(tl[kk * 65 + nn]);
  }
}

__device__ __forceinline__ void gemv_job(const Params& p, int job, char* smem) {
  float* sc = (float*)smem;
  float* rd = sc + 768;
  int tid_l_ = threadIdx.x; asm volatile("" : "+v"(tid_l_)); const int tid = tid_l_;
  const int iq = job & 3, jb = (job >> 2) % 96, l = (job >> 2) / 96;
  __syncthreads();
  for (int i = tid; i < 768; i += 256) {
    int r = i >> 8, idx = iq * 256 + (i & 255);
    float v = (r == 0) ? p.c_ctx[idx] : p.c[(r - 1) * 1024 + idx];
    sc[i] = siluf_(v);
  }
  __syncthreads();
  const int jl = tid & 63, ig = tid >> 6, j = jb * 64 + jl;
  const float* W = p.ada_w + (size_t)l * 1024 * 6144 + (size_t)(iq * 256 + ig * 64) * 6144 + j;
  float a0 = 0.f, a1 = 0.f, a2 = 0.f;
#pragma unroll 16
  for (int i = 0; i < 64; ++i) {
    float wv = W[(size_t)i * 6144];
    a0 += sc[ig * 64 + i] * wv;
    a1 += sc[256 + ig * 64 + i] * wv;
    a2 += sc[512 + ig * 64 + i] * wv;
  }
  rd[(ig * 3 + 0) * 64 + jl] = a0;
  rd[(ig * 3 + 1) * 64 + jl] = a1;
  rd[(ig * 3 + 2) * 64 + jl] = a2;
  __syncthreads();
  if (tid < 192) {
    int r = tid >> 6, jl2 = tid & 63, j2 = jb * 64 + jl2;
    float sacc = (iq == 0) ? p.ada_b[l * 6144 + j2] : 0.f;
    for (int q = 0; q < 4; ++q) sacc += rd[(q * 3 + r) * 64 + jl2];
    atomicAdd(p.mod + (size_t)(l * 3 + r) * 6144 + j2, sacc);
  }
}

__device__ __forceinline__ void filter_job(const Params& p, int job, char* smem) {
  float* sh2 = (float*)smem;
  int tid_l_ = threadIdx.x; asm volatile("" : "+v"(tid_l_)); const int tid = tid_l_, lane = tid & 63, w = tid >> 6;
  int L, pos0;
  bh* gt;
  if (job < 64) { L = 256; pos0 = job * 4; gt = p.gt256; }
  else { L = 2048; pos0 = (job - 64) * 4; gt = p.gt2048; }
  __syncthreads();
  {
    const int pos = pos0 + w;
    const float t = (float)pos / (float)(L - 1);
    const float wv = 2.0f * 3.14159265358979323846f * (float)pos / (float)L;
    float zv = 0.f;
    if (lane == 0) zv = t;
    else if (lane <= 16) { float fb = 1e-4f + (float)(lane - 1) * ((15.0f - 1e-4f) / 15.0f); zv = cosf(fb * wv); }
    else if (lane <= 32) { float fb = 1e-4f + (float)(lane - 17) * ((15.0f - 1e-4f) / 15.0f); zv = -sinf(fb * wv); }
    const float fr = p.hy_freq[lane];
    float a = p.hy_b1[lane];
    for (int i = 0; i < 33; ++i) a += __shfl(zv, i) * p.hy_w1[i * 64 + lane];
    const float h1 = sinf(fr * a);
    a = p.hy_b2[lane];
    for (int i = 0; i < 64; ++i) a += __shfl(h1, i) * p.hy_w2[i * 64 + lane];
    sh2[w * 64 + lane] = sinf(fr * a);
  }
  __syncthreads();
  float acc[8][4];
#pragma unroll
  for (int m = 0; m < 8; ++m)
#pragma unroll
    for (int pp = 0; pp < 4; ++pp) acc[m][pp] = 0.f;
#pragma unroll 8
  for (int i = 0; i < 64; ++i) {
    const float h0 = sh2[i], h1 = sh2[64 + i], h2 = sh2[128 + i], h3 = sh2[192 + i];
#pragma unroll
    for (int m = 0; m < 8; ++m) {
      const float wv = p.hy_w3[i * 2048 + tid + 256 * m];
      acc[m][0] += wv * h0; acc[m][1] += wv * h1; acc[m][2] += wv * h2; acc[m][3] += wv * h3;
    }
  }
  const float min_decay = logf(1e-2f) / 1.5f, max_decay = logf(1e-2f) / 0.3f;
#pragma unroll
  for (int m = 0; m < 8; ++m) {
    const int o = tid + 256 * m;
    const int ord = o >> 10, side = (o >> 9) & 1, c = o & 511;
    const float delta = fabsf(min_decay + (float)c * ((max_decay - min_decay) / 511.0f));
    bh* grow = gt + (size_t)(ord * 512 + c) * (2 * L);
#pragma unroll
    for (int pp = 0; pp < 4; ++pp) {
      const int pos = pos0 + pp;
      const float t = (float)pos / (float)(L - 1);
      const bh val = f2bf(acc[m][pp] * expf(-t * delta));
      if (side == 0) grow[L - 1 - pos] = val;
      else if (pos >= 1) grow[L - 1 + pos] = val;
    }
  }
}

__device__ __forceinline__ void rows_job(const Params& p, int job, bool first, const bh* src, const float* gres, int lgate, int gate_idx,
                         const float* gnext, int lnext, int shift_idx) {
  int tid_l_ = threadIdx.x; asm volatile("" : "+v"(tid_l_)); const int tid = tid_l_, lane = tid & 63, w = tid >> 6;
  const int rowb = job * 16 + w * 4;
  const int r = rowb < NTP ? 0 : 1 + ((rowb - NTP) >> 11);
  float4 y[4][4], m[4][4];
#pragma unroll
  for (int rr = 0; rr < 4; ++rr) {
    const int row = rowb + rr;
    const float* xin = first ? (row < NTP ? p.x_prompt + (size_t)row * 1024 : p.x_sample + (size_t)(row - NTP) * 1024)
                             : p.out + (size_t)row * 1024;
#pragma unroll
    for (int i = 0; i < 4; ++i) y[rr][i] = *(const float4*)(xin + i * 256 + lane * 4);
    if (src) {
#pragma unroll
      for (int i = 0; i < 4; ++i) { const u32x2 mv = *(const u32x2*)(src + (size_t)row * 1024 + i * 256 + lane * 4); m[rr][i] = make_float4(bflo(mv[0]), bfhi(mv[0]), bflo(mv[1]), bfhi(mv[1])); }
    }
  }
  if (src) {
    const float* gate = p.mod + (size_t)(lgate * 3 + r) * 6144 + gate_idx * 1024;
    float4 gg[4], gt[4];
#pragma unroll
    for (int i = 0; i < 4; ++i) {
      gg[i] = *(const float4*)(gres + i * 256 + lane * 4);
      gt[i] = *(const float4*)(gate + i * 256 + lane * 4);
    }
#pragma unroll
    for (int rr = 0; rr < 4; ++rr) {
      float ss = 0.f;
#pragma unroll
      for (int i = 0; i < 4; ++i)
        ss += m[rr][i].x * m[rr][i].x + m[rr][i].y * m[rr][i].y + m[rr][i].z * m[rr][i].z + m[rr][i].w * m[rr][i].w;
      ss = wave_sum(ss);
      const float rs = rsqrtf(ss * (1.f / 1024.f) + EPSF);
#pragma unroll
      for (int i = 0; i < 4; ++i) {
        y[rr][i].x += gt[i].x * (m[rr][i].x * rs * gg[i].x);
        y[rr][i].y += gt[i].y * (m[rr][i].y * rs * gg[i].y);
        y[rr][i].z += gt[i].z * (m[rr][i].z * rs * gg[i].z);
        y[rr][i].w += gt[i].w * (m[rr][i].w * rs * gg[i].w);
      }
    }
  }
  if (src) {
#pragma unroll
    for (int rr = 0; rr < 4; ++rr)
#pragma unroll
      for (int i = 0; i < 4; ++i) __builtin_nontemporal_store((f32x4){y[rr][i].x, y[rr][i].y, y[rr][i].z, y[rr][i].w}, (f32x4*)(p.out + (size_t)(rowb + rr) * 1024 + i * 256 + lane * 4));
  }
  if (gnext) {
    const float* sh = p.mod + (size_t)(lnext * 3 + r) * 6144 + shift_idx * 1024;
    const float* scl = sh + 1024;
    float4 gg[4], s4[4], c4[4];
#pragma unroll
    for (int i = 0; i < 4; ++i) {
      gg[i] = *(const float4*)(gnext + i * 256 + lane * 4);
      s4[i] = *(const float4*)(sh + i * 256 + lane * 4);
      c4[i] = *(const float4*)(scl + i * 256 + lane * 4);
    }
#pragma unroll
    for (int rr = 0; rr < 4; ++rr) {
      float ss = 0.f;
#pragma unroll
      for (int i = 0; i < 4; ++i)
        ss += y[rr][i].x * y[rr][i].x + y[rr][i].y * y[rr][i].y + y[rr][i].z * y[rr][i].z + y[rr][i].w * y[rr][i].w;
      ss = wave_sum(ss);
      const float rs = rsqrtf(ss * (1.f / 1024.f) + EPSF);
      bh* arow = p.act + (size_t)(rowb + rr) * 1024;
#pragma unroll
      for (int i = 0; i < 4; ++i) {
        ushort4 o;
        o.x = f2bf(y[rr][i].x * rs * gg[i].x * (1.f + c4[i].x) + s4[i].x);
        o.y = f2bf(y[rr][i].y * rs * gg[i].y * (1.f + c4[i].y) + s4[i].y);
        o.z = f2bf(y[rr][i].z * rs * gg[i].z * (1.f + c4[i].z) + s4[i].z);
        o.w = f2bf(y[rr][i].w * rs * gg[i].w * (1.f + c4[i].w) + s4[i].w);
        *(ushort4*)(arow + i * 256 + lane * 4) = o;
      }
    }
  }
}

template <int CTRL>
__device__ __forceinline__ float dppf(float v) {
  return __int_as_float(__builtin_amdgcn_update_dpp(0, __float_as_int(v), CTRL, 0xF, 0xF, true));
}
__device__ __forceinline__ float sum16(float v) {
  v += dppf<0xB1>(v); v += dppf<0x4E>(v); v += dppf<0x141>(v); v += dppf<0x140>(v);
  return v;
}
__device__ __forceinline__ float max16(float v) {
  v = fmaxf(v, dppf<0xB1>(v)); v = fmaxf(v, dppf<0x4E>(v)); v = fmaxf(v, dppf<0x141>(v)); v = fmaxf(v, dppf<0x140>(v));
  return v;
}

typedef short s16x4 __attribute__((ext_vector_type(4)));

#define OFF_SC_EVEN 188743680ull
#define OFF_SC_ODD 79691776ull
#define SC_SLOC 8388608ull
#define SC_DECT 16777216ull

template <int MODE, int SKIP = 0>
__device__ __forceinline__ void scan2_unit(const Params& p, int unit, char* smem) {
  constexpr int DK = MODE == 0 ? 128 : 64;
  constexpr int LD = MODE == 0 ? 4096 : 3104;
  constexpr int NQ = DK / 32;
  constexpr int NP = 256 / DK;
  constexpr int TPP = 16 / NP;
  constexpr int RS = DK + 8;
  constexpr int TPT = DK / 8;
  float* sq = (float*)smem;
  float* slf = sq + 16 * DK;
  float* skk = slf + 16 * DK;
  bh* QE = (bh*)(skk + 16 * DK);
  bh* KE = QE + 16 * RS;
  bh* KLT = KE + 16 * RS;
  bh* VT = KLT + DK * 24;
  float* dec = (float*)(VT + 128 * 24);
  float* sx = dec + DK;
  int tid_l_ = threadIdx.x; asm volatile("" : "+v"(tid_l_)); const int tid = tid_l_, lane = tid & 63, w = tid >> 6, r = lane & 15, g = lane >> 4;
  const int dir = unit & 1, h = (unit >> 1) & 3, ss = unit >> 3;
  const bool samp = ss >= 32;
  const int sb = (ss - 32) >> 3, seg = (ss - 32) & 7;
  const int rbase = samp ? (NTP + sb * 2048 + (dir ? 2047 - seg * 256 : seg * 256)) : (ss * 256 + (dir ? 255 : 0));
  const int sgn = dir ? -1 : 1;
  const bh* proj = (const bh*)p.R;
  char* scbase = p.R + (MODE == 0 ? OFF_SC_EVEN : OFF_SC_ODD);
  bh* QB = (bh*)scbase;
  float* odir = (float*)(p.R + OFF_ODIR) + (size_t)dir * NT * 512;
  __syncthreads();
  if (MODE == 0) {
    for (int k = tid; k < 128; k += 256) {
      int ci = dir * 512 + h * 128 + k;
      float x0 = p.hgrn_lb[ci], x1 = p.hgrn_lb[1024 + ci], x2 = p.hgrn_lb[2048 + ci];
      float mx = fmaxf(x0, fmaxf(x1, x2));
      float e0 = expf(x0 - mx), e1 = expf(x1 - mx), e2 = expf(x2 - mx);
      sx[k] = e0 / (e0 + e1 + e2);
    }
  } else {
    for (int i = tid; i < 1024; i += 256) {
      int rr = i >> 6, k = i & 63;
      sx[i] = p.gla_aw[(size_t)(dir * 16 + rr) * 256 + h * 64 + k];
    }
    if (tid < 64) sx[1024 + tid] = p.gla_ab[dir * 256 + h * 64 + tid];
  }
  f32x4 S[2 * NQ][2];
#pragma unroll
  for (int a = 0; a < 2 * NQ; ++a) { S[a][0] = (f32x4){0.f, 0.f, 0.f, 0.f}; S[a][1] = (f32x4){0.f, 0.f, 0.f, 0.f}; }
  constexpr int EPT = MODE == 0 ? 8 : 4;
  const int li = tid >> 4, lk8 = (tid & 15) * EPT;
  const int vi = tid >> 4, v8 = (tid & 15) * 8;
  const int pk = tid % DK, ppart = tid / DK;
  float basec = 0.f;
  u32x4 rq = {0, 0, 0, 0}, rf = {0, 0, 0, 0}, rv = {0, 0, 0, 0}, rd0 = {0, 0, 0, 0}, rd1 = {0, 0, 0, 0};
  auto issue = [&](int c) {
    {
      const bh* pr = proj + (size_t)(rbase + sgn * (c * 16 + li)) * LD;
      if (MODE == 0) {
        rq = *(const u32x4*)(pr + h * 128 + lk8);
        rf = *(const u32x4*)(pr + 512 + dir * 512 + h * 128 + lk8);
      } else {
        const u32x2 q2 = *(const u32x2*)(pr + 1536 + h * 64 + lk8);
        const u32x2 k2 = *(const u32x2*)(pr + 1792 + h * 64 + lk8);
        rq[0] = q2[0]; rq[1] = q2[1]; rf[0] = k2[0]; rf[1] = k2[1];
        rd0 = *(const u32x4*)(pr + 3072 + dir * 16);
        rd1 = *(const u32x4*)(pr + 3072 + dir * 16 + 8);
      }
    }
    {
      const bh* pr = proj + (size_t)(rbase + sgn * (c * 16 + vi)) * LD;
      rv = *(const u32x4*)(pr + (MODE == 0 ? 1536 : 2048) + h * 128 + v8);
    }
  };
  issue(0);
#pragma unroll 1
  for (int c = 0; c < 16; ++c) {
    __syncthreads();
    if (SKIP != 3) {
      float oq[EPT], ol[EPT], ok[EPT];
      if (MODE == 0) {
#pragma unroll
        for (int e = 0; e < EPT; ++e) {
          float q = (e & 1) ? bfhi(rq[e >> 1]) : bflo(rq[e >> 1]);
          float ff = (e & 1) ? bfhi(rf[e >> 1]) : bflo(rf[e >> 1]);
          float lb = sx[lk8 + e];
          float f = lb + (1.f - lb) * sigmoidf_(ff);
          oq[e] = siluf_(q) * 0.08838834764831845f;
          ol[e] = __logf(f);
          ok[e] = 1.f - f;
        }
      } else {
        float da[16];
#pragma unroll
        for (int rr = 0; rr < 16; ++rr) {
          unsigned wd = rr < 8 ? rd0[(rr & 7) >> 1] : rd1[(rr & 7) >> 1];
          da[rr] = (rr & 1) ? bfhi(wd) : bflo(wd);
        }
        float xx[4];
        {
          float4 b0_ = *(const float4*)(sx + 1024 + lk8);
          xx[0] = b0_.x; xx[1] = b0_.y; xx[2] = b0_.z; xx[3] = b0_.w;
        }
#pragma unroll
        for (int rr = 0; rr < 16; ++rr) {
          float4 a0_ = *(const float4*)(sx + rr * 64 + lk8);
          xx[0] += da[rr] * a0_.x; xx[1] += da[rr] * a0_.y; xx[2] += da[rr] * a0_.z; xx[3] += da[rr] * a0_.w;
        }
#pragma unroll
        for (int e = 0; e < 4; ++e) {
          float q = (e & 1) ? bfhi(rq[e >> 1]) : bflo(rq[e >> 1]);
          float kk = (e & 1) ? bfhi(rf[e >> 1]) : bflo(rf[e >> 1]);
          float x = xx[e];
          float ls = fminf(x, 0.f) - __logf(1.f + __expf(-fabsf(x)));
          oq[e] = q * 0.125f;
          ol[e] = ls * 0.0625f;
          ok[e] = kk;
        }
      }
      float* dq_ = sq + li * DK + lk8;
      float* dl_ = slf + li * DK + lk8;
      float* dk_ = skk + li * DK + lk8;
#pragma unroll
      for (int e4 = 0; e4 < EPT; e4 += 4) {
        *(float4*)(dq_ + e4) = make_float4(oq[e4], oq[e4 + 1], oq[e4 + 2], oq[e4 + 3]);
        *(float4*)(dl_ + e4) = make_float4(ol[e4], ol[e4 + 1], ol[e4 + 2], ol[e4 + 3]);
        *(float4*)(dk_ + e4) = make_float4(ok[e4], ok[e4 + 1], ok[e4 + 2], ok[e4 + 3]);
      }
    }
#pragma unroll
    for (int e = 0; e < 8; ++e) {
      unsigned wv = rv[e >> 1];
      VT[(v8 + e) * 24 + vi] = (bh)((e & 1) ? (wv >> 16) : (wv & 0xffffu));
    }
    __syncthreads();
    if (c + 1 < 16) issue(c + 1);
    {
      float total = 0.f, pre = 0.f;
#pragma unroll
      for (int i = 0; i < 16; ++i) {
        float l = slf[i * DK + pk];
        if (i < ppart * TPP) pre += l;
        total += l;
      }
      unsigned kw[TPP / 2];
#pragma unroll
      for (int ii = 0; ii < TPP; ii += 2) {
        float klv[2];
#pragma unroll
        for (int u = 0; u < 2; ++u) {
          const int i = ppart * TPP + ii + u;
          pre += slf[i * DK + pk];
          const float qv = sq[i * DK + pk], kv = skk[i * DK + pk];
          QE[i * RS + pk] = f2bf(qv * __expf(pre));
          KE[i * RS + pk] = f2bf(kv * __expf(-pre));
          klv[u] = kv * __expf(total - pre);
          if (samp) {
            const int row = rbase + sgn * (c * 16 + i);
            QB[((size_t)dir * 4096 + (row - NTP)) * (4 * DK) + h * DK + pk] = f2bf(qv * __expf(basec + pre));
          }
        }
        kw[ii >> 1] = pk2(klv[0], klv[1]);
      }
      if (TPP == 8) {
        u32x4 kv4 = {kw[0], kw[1], kw[(TPP / 2) > 2 ? 2 : 0], kw[(TPP / 2) > 3 ? 3 : 0]};
        *(u32x4*)(KLT + pk * 24 + ppart * 8) = kv4;
      } else {
        u32x2 kv2 = {kw[0], kw[1]};
        *(u32x2*)(KLT + pk * 24 + ppart * 4) = kv2;
      }
      if (ppart == 0) dec[pk] = __expf(total);
      basec += total;
    }
    __syncthreads();
    {
      bf16x8 qf[NQ], kf[NQ];
#pragma unroll
      for (int q = 0; q < NQ; ++q) {
        qf[q] = *(const bf16x8*)(QE + r * RS + q * 32 + g * 8);
        kf[q] = *(const bf16x8*)(KE + r * RS + q * 32 + g * 8);
      }
      f32x4 at = (f32x4){0.f, 0.f, 0.f, 0.f};
#pragma unroll
      for (int q = 0; q < NQ; ++q) at = __builtin_amdgcn_mfma_f32_16x16x32_bf16(kf[q], qf[q], at, 0, 0, 0);
      u32x2 paw;
      paw[0] = pk2((g * 4 + 0 <= r) ? at[0] : 0.f, (g * 4 + 1 <= r) ? at[1] : 0.f);
      paw[1] = pk2((g * 4 + 2 <= r) ? at[2] : 0.f, (g * 4 + 3 <= r) ? at[3] : 0.f);
      const s16x4 pa = __builtin_bit_cast(s16x4, paw);
      s16x4 vf[2];
      f32x4 o[2];
#pragma unroll
      for (int nt = 0; nt < 2; ++nt) {
        vf[nt] = *(const s16x4*)(VT + (w * 32 + nt * 16 + r) * 24 + g * 4);
        o[nt] = __builtin_amdgcn_mfma_f32_16x16x16bf16_1k(pa, vf[nt], (f32x4){0.f, 0.f, 0.f, 0.f}, 0, 0, 0);
      }
#pragma unroll
      for (int q = 0; q < NQ; ++q) {
#pragma unroll
        for (int half = 0; half < 2; ++half) {
          const s16x4 qa = half == 0 ? __builtin_shufflevector(qf[q], qf[q], 0, 1, 2, 3)
                                     : __builtin_shufflevector(qf[q], qf[q], 4, 5, 6, 7);
#pragma unroll
          for (int nt = 0; nt < 2; ++nt) {
            const f32x4 sv_ = S[2 * q + half][nt];
            u32x2 sw;
            sw[0] = pk2(sv_[0], sv_[1]);
            sw[1] = pk2(sv_[2], sv_[3]);
            o[nt] = __builtin_amdgcn_mfma_f32_16x16x16bf16_1k(qa, __builtin_bit_cast(s16x4, sw), o[nt], 0, 0, 0);
          }
        }
      }
#pragma unroll
      for (int nt = 0; nt < 2; ++nt)
#pragma unroll
        for (int j = 0; j < 4; ++j) {
          const int row = rbase + sgn * (c * 16 + g * 4 + j);
          odir[(size_t)row * 512 + h * 128 + w * 32 + nt * 16 + r] = o[nt][j];
        }
#pragma unroll
      for (int q = 0; q < NQ; ++q) {
#pragma unroll
        for (int half = 0; half < 2; ++half) {
          const float4 d4 = *(const float4*)(dec + q * 32 + g * 8 + half * 4);
          const int ka = q * 32 + (r >> 2) * 8 + half * 4 + (r & 3);
          const s16x4 ka4 = *(const s16x4*)(KLT + ka * 24 + g * 4);
#pragma unroll
          for (int nt = 0; nt < 2; ++nt) {
            f32x4 sv_ = S[2 * q + half][nt];
            sv_[0] *= d4.x; sv_[1] *= d4.y; sv_[2] *= d4.z; sv_[3] *= d4.w;
            S[2 * q + half][nt] = __builtin_amdgcn_mfma_f32_16x16x16bf16_1k(ka4, vf[nt], sv_, 0, 0, 0);
          }
        }
      }
    }
  }
  {
    float* so;
    if (!samp) so = p.out + (MODE == 0 ? OUT_HGRN : OUT_GLA) + ((size_t)(ss * 2 + dir) * 4 + h) * DK * 128;
    else {
      const int us = ((sb * 4 + h) * 2 + dir) * 8 + seg;
      so = (float*)(scbase + SC_SLOC) + (size_t)us * DK * 128;
      if (ppart == 0) ((float*)(scbase + SC_DECT))[us * DK + pk] = __expf(basec);
    }
#pragma unroll
    for (int q = 0; q < NQ; ++q)
#pragma unroll
      for (int half = 0; half < 2; ++half)
#pragma unroll
        for (int nt = 0; nt < 2; ++nt)
#pragma unroll
          for (int j = 0; j < 4; ++j)
            so[(size_t)(q * 32 + g * 8 + half * 4 + j) * 128 + w * 32 + nt * 16 + r] = S[2 * q + half][nt][j];
  }
}

template <int MODE>
__device__ __forceinline__ void fixup_unit(const Params& p, int unit, char* smem) {
  constexpr int DK = MODE == 0 ? 128 : 64;
  constexpr int NQ = DK / 32;
  constexpr int RS = DK + 8;
  bh* ST = (bh*)smem;
  int tid_l_ = threadIdx.x; asm volatile("" : "+v"(tid_l_)); const int tid = tid_l_, lane = tid & 63, w = tid >> 6, r = lane & 15, g = lane >> 4;
  const int seg = unit & 7, dir = (unit >> 3) & 1, h = (unit >> 4) & 3, sb = unit >> 6;
  const int unit0 = unit & ~7;
  char* scbase = p.R + (MODE == 0 ? OFF_SC_EVEN : OFF_SC_ODD);
  const bh* QB = (const bh*)scbase;
  const float* SLOC = (const float*)(scbase + SC_SLOC);
  const float* DECT = (const float*)(scbase + SC_DECT);
  const float* s0 = (MODE == 0 ? p.state_hgrn : p.state_gla) + ((size_t)(sb * 2 + dir) * 4 + h) * DK * 128;
  float* odir = (float*)(p.R + OFF_ODIR) + (size_t)dir * NT * 512;
  __syncthreads();
  for (int m = 0; m < DK * 128 / 256; ++m) {
    const int e = tid + 256 * m, k = e >> 7, v = e & 127;
    float cur = s0[e];
    for (int jj = 0; jj < seg; ++jj)
      cur = DECT[(unit0 + jj) * DK + k] * cur + SLOC[(size_t)(unit0 + jj) * DK * 128 + e];
    ST[v * RS + k] = f2bf(cur);
  }
  __syncthreads();
  const int rbase = NTP + sb * 2048 + (dir ? 2047 - seg * 256 : seg * 256);
  const int sgn = dir ? -1 : 1;
#pragma unroll 1
  for (int mt = 0; mt < 4; ++mt) {
    f32x4 acc[8];
#pragma unroll
    for (int nt = 0; nt < 8; ++nt) acc[nt] = (f32x4){0.f, 0.f, 0.f, 0.f};
    const int rowa = rbase + sgn * (w * 64 + mt * 16 + r);
    const bh* qrow = QB + ((size_t)dir * 4096 + (rowa - NTP)) * (4 * DK) + h * DK + g * 8;
#pragma unroll
    for (int q = 0; q < NQ; ++q) {
      const bf16x8 a = *(const bf16x8*)(qrow + q * 32);
#pragma unroll
      for (int nt = 0; nt < 8; ++nt) {
        const bf16x8 b = *(const bf16x8*)(ST + (nt * 16 + r) * RS + q * 32 + g * 8);
        acc[nt] = __builtin_amdgcn_mfma_f32_16x16x32_bf16(a, b, acc[nt], 0, 0, 0);
      }
    }
#pragma unroll
    for (int nt = 0; nt < 8; ++nt)
#pragma unroll
      for (int j = 0; j < 4; ++j) {
        const int row = rbase + sgn * (w * 64 + mt * 16 + g * 4 + j);
        float* dst = odir + (size_t)row * 512 + h * 128 + nt * 16 + r;
        *dst += acc[nt][j];
      }
  }
}

__device__ __forceinline__ void scan_final_job(const Params& p, int job, int mode) {
  int tid_l_ = threadIdx.x; asm volatile("" : "+v"(tid_l_)); const int tid = tid_l_, lane = tid & 63, w = tid >> 6;
  const int rowb = job * 8 + w * 2;
  const int ld = mode == 0 ? 4096 : 3104;
  const int gcol = mode == 0 ? 2048 : 2560;
  const float* nrm = mode == 0 ? p.hgrn_norm : p.gla_norm;
  float2 a[2][4], b[2][4];
  unsigned gw[2][4];
#pragma unroll
  for (int rr = 0; rr < 2; ++rr) {
    const int row = rowb + rr;
    const float* o0 = (const float*)(p.R + OFF_ODIR) + (size_t)row * 512;
    const float* o1 = o0 + (size_t)NT * 512;
    const bh* proj = (const bh*)p.R + (size_t)row * ld;
#pragma unroll
    for (int h = 0; h < 4; ++h) {
      const int c = h * 128 + lane * 2;
      a[rr][h] = *(const float2*)(o0 + c);
      b[rr][h] = *(const float2*)(o1 + c);
      gw[rr][h] = *(const unsigned*)(proj + gcol + c);
    }
  }
  float2 nv[4];
#pragma unroll
  for (int h = 0; h < 4; ++h) nv[h] = *(const float2*)(nrm + h * 128 + lane * 2);
#pragma unroll
  for (int rr = 0; rr < 2; ++rr) {
    bh* arow = p.act + (size_t)(rowb + rr) * 1024 + (mode == 0 ? 0 : 512);
#pragma unroll
    for (int h = 0; h < 4; ++h) {
      const int c = h * 128 + lane * 2;
      float v0 = a[rr][h].x + b[rr][h].x, v1 = a[rr][h].y + b[rr][h].y;
      float ss = wave_sum(v0 * v0 + v1 * v1);
      float rs = rsqrtf(ss * (1.f / 128.f) + EPSF);
      float g0 = bflo(gw[rr][h]), g1 = bfhi(gw[rr][h]);
      *(unsigned*)(arow + c) = pk2(v0 * rs * nv[h].x * siluf_(g0), v1 * rs * nv[h].y * siluf_(g1));
    }
  }
}

using f32x16 = __attribute__((ext_vector_type(16))) float;
__device__ __forceinline__ bf16x8 toep_frag(const unsigned* Gd, int m0) {
  const int q = m0 >> 1;
  const unsigned sh = (unsigned)(m0 & 1) * 2u;
  const unsigned D0 = Gd[q], D1 = Gd[q + 1], D2 = Gd[q + 2], D3 = Gd[q + 3], D4 = Gd[q + 4];
  u32x4 f;
  f[0] = __builtin_amdgcn_alignbyte(D1, D0, sh);
  f[1] = __builtin_amdgcn_alignbyte(D2, D1, sh);
  f[2] = __builtin_amdgcn_alignbyte(D3, D2, sh);
  f[3] = __builtin_amdgcn_alignbyte(D4, D3, sh);
  return __builtin_bit_cast(bf16x8, f);
}
__device__ __forceinline__ void conv4(const bh* raw, int t, int L, float w0, float w1, float w2, float bb, float* out) {
  const u32x2 x = *(const u32x2*)(raw + t);
  const float xm = t > 0 ? bf2f(raw[t - 1]) : 0.f;
  const float xp = (t + 4 < L) ? bf2f(raw[t + 4]) : 0.f;
  const float x0 = bflo(x[0]), x1 = bfhi(x[0]), x2 = bflo(x[1]), x3 = bfhi(x[1]);
  out[0] = w0 * xm + w1 * x0 + w2 * x1 + bb;
  out[1] = w0 * x0 + w1 * x1 + w2 * x2 + bb;
  out[2] = w0 * x1 + w1 * x2 + w2 * x3 + bb;
  out[3] = w0 * x2 + w1 * x3 + w2 * xp + bb;
}
__device__ __forceinline__ u32x4 conv8(const bh* raw, int t, int L, float w0, float w1, float w2, float bb) {
  const u32x4 x = *(const u32x4*)(raw + t);
  float v[10];
  v[0] = t > 0 ? bf2f(raw[t - 1]) : 0.f;
  v[9] = (t + 8 < L) ? bf2f(raw[t + 8]) : 0.f;
#pragma unroll
  for (int e = 0; e < 4; ++e) { v[1 + 2 * e] = bflo(x[e]); v[2 + 2 * e] = bfhi(x[e]); }
  u32x4 o;
#pragma unroll
  for (int e = 0; e < 4; ++e)
    o[e] = pk2(w0 * v[2 * e] + w1 * v[2 * e + 1] + w2 * v[2 * e + 2] + bb, w0 * v[2 * e + 1] + w1 * v[2 * e + 2] + w2 * v[2 * e + 3] + bb);
  return o;
}

__device__ __forceinline__ void hyena_sample_job(const Params& p, int job, char* smem) {
  int tid_l_ = threadIdx.x; asm volatile("" : "+v"(tid_l_)); const int tid = tid_l_, lane = tid & 63, w = tid >> 6;
  const int col = lane & 31, kh = lane >> 5;
  const int cc = w >> 1, nh = w & 1;
  const int sb = job & 1, c0 = (job >> 1) * 2, c = c0 + cc;
  bh* G = (bh*)(smem + cc * 12288);
  bh* U = G + 4096;
  const unsigned* Gd = (const unsigned*)G;
  const bh* HYT = (const bh*)(p.R + OFF_HYT);
  const int rowoff = NTP + sb * 2048;
  __syncthreads();
  {
    const float vw0 = p.hy_conv_w[c], vw1 = p.hy_conv_w[1536 + c], vw2 = p.hy_conv_w[3072 + c], vb = p.hy_conv_b[c];
    const bh* raw = HYT + (size_t)c * NT + rowoff;
#pragma unroll
    for (int i = 0; i < 2; ++i) {
      const int t0 = (nh * 128 + lane + 64 * i) * 8;
      *(u32x4*)(U + t0) = conv8(raw, t0, 2048, vw0, vw1, vw2, vb);
    }
  }
#pragma unroll 1
  for (int ord = 0; ord < 2; ++ord) {
    {
      const bh* gsrc = p.gt2048 + (size_t)(ord * 512 + c) * 4096;
#pragma unroll
      for (int i = 0; i < 4; ++i) {
        const int e8 = (nh * 256 + lane + 64 * i) * 8;
        *(u32x4*)(G + e8) = *(const u32x4*)(gsrc + e8);
      }
    }
    __syncthreads();
    f32x16 acc;
#pragma unroll
    for (int i = 0; i < 16; ++i) acc[i] = 0.f;
    const int mbase = 2047 - col + kh * 8;
    const int dlo = nh == 0 ? -63 : -31, dhi = nh == 0 ? 31 : 63;
#pragma unroll 2
    for (int d = dlo; d <= dhi; ++d) {
      const bf16x8 a0 = toep_frag(Gd, mbase - d * 32);
      const bf16x8 a1 = toep_frag(Gd, mbase - d * 32 + 16);
      const int s1 = nh * 32 + col - d;
      const bool ok = (unsigned)s1 < 64u;
      const int s1c = ok ? s1 : 0;
      u32x4 b0 = *(const u32x4*)(U + s1c * 32 + kh * 8);
      u32x4 b1 = *(const u32x4*)(U + s1c * 32 + 16 + kh * 8);
      if (!ok) { b0 = (u32x4){0, 0, 0, 0}; b1 = (u32x4){0, 0, 0, 0}; }
      acc = __builtin_amdgcn_mfma_f32_32x32x16_bf16(a0, __builtin_bit_cast(bf16x8, b0), acc, 0, 0, 0);
      acc = __builtin_amdgcn_mfma_f32_32x32x16_bf16(a1, __builtin_bit_cast(bf16x8, b1), acc, 0, 0, 0);
    }
    __syncthreads();
    const int gi = (ord + 1) * 512 + c;
    const float gw0 = p.hy_conv_w[gi], gw1 = p.hy_conv_w[1536 + gi], gw2 = p.hy_conv_w[3072 + gi], gb = p.hy_conv_b[gi];
    const float dd = p.hy_d[ord * 512 + c];
    const bh* graw = HYT + (size_t)gi * NT + rowoff;
#pragma unroll
    for (int rq = 0; rq < 4; ++rq) {
      const int trun = (nh * 32 + col) * 32 + 8 * rq + 4 * kh;
      float gte[4];
      conv4(graw, trun, 2048, gw0, gw1, gw2, gb, gte);
      const u32x2 uo = *(const u32x2*)(U + trun);
      u32x2 zo;
      zo[0] = pk2(gte[0] * (acc[rq * 4 + 0] + bflo(uo[0]) * dd), gte[1] * (acc[rq * 4 + 1] + bfhi(uo[0]) * dd));
      zo[1] = pk2(gte[2] * (acc[rq * 4 + 2] + bflo(uo[1]) * dd), gte[3] * (acc[rq * 4 + 3] + bfhi(uo[1]) * dd));
      *(u32x2*)(U + trun) = zo;
    }
    __syncthreads();
  }
#pragma unroll
  for (int rr = 0; rr < 8; ++rr) {
    const int t = tid + 256 * rr;
    const unsigned z0 = *(const bh*)(smem + 8192 + t * 2);
    const unsigned z1 = *(const bh*)(smem + 12288 + 8192 + t * 2);
    *(unsigned*)(p.act + (size_t)(rowoff + t) * 1024 + 512 + c0) = z0 | (z1 << 16);
  }
}

__device__ __forceinline__ void hyena_prompt_job(const Params& p, int job, char* smem) {
  int tid_l_ = threadIdx.x; asm volatile("" : "+v"(tid_l_)); const int tid = tid_l_, lane = tid & 63, w = tid >> 6;
  const int col = lane & 31, kh = lane >> 5;
  const int cc = w >> 1, th = w & 1;
  const int c0 = job * 2, c = c0 + cc;
  bh* Uall = (bh*)smem;
  bh* Gall = (bh*)(smem + 2 * 32 * 264 * 2);
  bh* U = Uall + cc * 32 * 264;
  const unsigned* Gd = (const unsigned*)(Gall + cc * 512);
  const bh* HYT = (const bh*)(p.R + OFF_HYT);
  __syncthreads();
#pragma unroll 1
  for (int c2 = 0; c2 < 2; ++c2) {
    const int ch = c0 + c2;
    const float vw0 = p.hy_conv_w[ch], vw1 = p.hy_conv_w[1536 + ch], vw2 = p.hy_conv_w[3072 + ch], vb = p.hy_conv_b[ch];
#pragma unroll
    for (int i = 0; i < 4; ++i) {
      const int tg = (tid + 256 * i) * 8, b = tg >> 8, t = tg & 255;
      *(u32x4*)(Uall + c2 * 32 * 264 + b * 264 + t) = conv8(HYT + (size_t)ch * NT + b * 256, t, 256, vw0, vw1, vw2, vb);
    }
  }
#pragma unroll 1
  for (int ord = 0; ord < 2; ++ord) {
    if (tid < 128) {
      const int c2 = tid >> 6, l2 = tid & 63;
      *(u32x4*)(Gall + c2 * 512 + l2 * 8) = *(const u32x4*)(p.gt256 + (size_t)(ord * 512 + c0 + c2) * 512 + l2 * 8);
    }
    __syncthreads();
    f32x16 acc[4];
#pragma unroll
    for (int q = 0; q < 4; ++q)
#pragma unroll
      for (int i = 0; i < 16; ++i) acc[q][i] = 0.f;
    const int mbase = 255 - col + kh * 8;
#pragma unroll
    for (int q = 0; q < 4; ++q) {
      const int t1 = th * 4 + q;
#pragma unroll 2
      for (int s1 = 0; s1 < 8; ++s1) {
        const int d = t1 - s1;
        const bf16x8 a0 = toep_frag(Gd, mbase - d * 32);
        const bf16x8 a1 = toep_frag(Gd, mbase - d * 32 + 16);
        const bf16x8 b0 = *(const bf16x8*)(U + col * 264 + s1 * 32 + kh * 8);
        const bf16x8 b1 = *(const bf16x8*)(U + col * 264 + s1 * 32 + 16 + kh * 8);
        acc[q] = __builtin_amdgcn_mfma_f32_32x32x16_bf16(a0, b0, acc[q], 0, 0, 0);
        acc[q] = __builtin_amdgcn_mfma_f32_32x32x16_bf16(a1, b1, acc[q], 0, 0, 0);
      }
    }
    __syncthreads();
    const int gi = (ord + 1) * 512 + c;
    const float gw0 = p.hy_conv_w[gi], gw1 = p.hy_conv_w[1536 + gi], gw2 = p.hy_conv_w[3072 + gi], gb = p.hy_conv_b[gi];
    const float dd = p.hy_d[ord * 512 + c];
    const bh* graw = HYT + (size_t)gi * NT + col * 256;
#pragma unroll
    for (int q = 0; q < 4; ++q)
#pragma unroll
      for (int rq = 0; rq < 4; ++rq) {
        const int trun = (th * 4 + q) * 32 + 8 * rq + 4 * kh;
        float gte[4];
        conv4(graw, trun, 256, gw0, gw1, gw2, gb, gte);
        bh* up = U + col * 264 + trun;
        const u32x2 uo = *(const u32x2*)up;
        u32x2 zo;
        zo[0] = pk2(gte[0] * (acc[q][rq * 4 + 0] + bflo(uo[0]) * dd), gte[1] * (acc[q][rq * 4 + 1] + bfhi(uo[0]) * dd));
        zo[1] = pk2(gte[2] * (acc[q][rq * 4 + 2] + bflo(uo[1]) * dd), gte[3] * (acc[q][rq * 4 + 3] + bfhi(uo[1]) * dd));
        *(u32x2*)up = zo;
      }
    __syncthreads();
  }
#pragma unroll 4
  for (int i = 0; i < 32; ++i) {
    const int e = tid + 256 * i, b = e >> 8, t = e & 255;
    const unsigned z0 = Uall[b * 264 + t], z1 = Uall[32 * 264 + b * 264 + t];
    *(unsigned*)(p.act + (size_t)e * 1024 + 512 + c0) = z0 | (z1 << 16);
  }
}

__device__ __forceinline__ void oddrow_job(const Params& p, int job) {
  int tid_l_ = threadIdx.x; asm volatile("" : "+v"(tid_l_)); const int tid = tid_l_, lane = tid & 63, w = tid >> 6;
  const int row = job * 4 + w;
  const bh* pr = (const bh*)p.R + (size_t)row * 3104;
  bh* Q = (bh*)(p.R + OFF_Q) + (size_t)row * 512;
  bh* KB = (bh*)(p.R + OFF_KB);
  if (row < NTP) {
    const int b = row >> 8, t = row & 255;
    const int e0 = lane * 8, h = e0 >> 7, x = e0 & 127;
    const u32x4 qv = *(const u32x4*)(pr + e0);
    const u32x4 kv = *(const u32x4*)(pr + 512 + e0);
    const u32x4 vv = *(const u32x4*)(pr + 1024 + e0);
    const size_t idx = ((size_t)(b * 4 + h) * 256 + t) * 128 + x;
    *(u32x4*)(Q + e0) = qv;
    *(u32x4*)(KB + idx) = kv;
    float4 k0 = make_float4(bflo(kv[0]), bfhi(kv[0]), bflo(kv[1]), bfhi(kv[1]));
    float4 k1 = make_float4(bflo(kv[2]), bfhi(kv[2]), bflo(kv[3]), bfhi(kv[3]));
    float4 v0 = make_float4(bflo(vv[0]), bfhi(vv[0]), bflo(vv[1]), bfhi(vv[1]));
    float4 v1 = make_float4(bflo(vv[2]), bfhi(vv[2]), bflo(vv[3]), bfhi(vv[3]));
    __builtin_nontemporal_store((f32x4){k0.x, k0.y, k0.z, k0.w}, (f32x4*)(p.out + OUT_CK + idx));
    __builtin_nontemporal_store((f32x4){k1.x, k1.y, k1.z, k1.w}, (f32x4*)(p.out + OUT_CK + idx + 4));
    __builtin_nontemporal_store((f32x4){v0.x, v0.y, v0.z, v0.w}, (f32x4*)(p.out + OUT_CV + idx));
    __builtin_nontemporal_store((f32x4){v1.x, v1.y, v1.z, v1.w}, (f32x4*)(p.out + OUT_CV + idx + 4));
  } else {
    const int sb = (row - NTP) >> 11, t = (row - NTP) & 2047;
    const int rpos = t >> 6, cpos = t & 63;
    float q1[4], q2[4], k1[4], k2[4];
#pragma unroll
    for (int m = 0; m < 4; ++m) {
      int pi = lane + 64 * m;
      int h = pi >> 6, rem = pi & 63, pp = rem >> 5, part = (rem >> 4) & 1, i = rem & 15;
      int d1 = h * 128 + pp * 64 + part * 32 + i, d2 = d1 + 16;
      q1[m] = bf2f(pr[d1]); q2[m] = bf2f(pr[d2]);
      k1[m] = bf2f(pr[512 + d1]); k2[m] = bf2f(pr[512 + d2]);
    }
#pragma unroll
    for (int m = 0; m < 4; ++m) {
      int pi = lane + 64 * m;
      int h = pi >> 6, rem = pi & 63, pp = rem >> 5, part = (rem >> 4) & 1, i = rem & 15;
      int d1 = h * 128 + pp * 64 + part * 32 + i, d2 = d1 + 16;
      float pos = (float)(part ? cpos : rpos);
      float inv = expf(-(float)i * (9.210340371976184f / 16.f));
      float ang = pos * inv;
      float cs = cosf(ang), sn = sinf(ang);
      Q[d1] = f2bf(q1[m] * cs - q2[m] * sn);
      Q[d2] = f2bf(q1[m] * sn + q2[m] * cs);
      size_t kb = KV_SAMPLE_BASE + ((size_t)(sb * 4 + h) * 2304 + 256 + t) * 128;
      KB[kb + (d1 - h * 128)] = f2bf(k1[m] * cs - k2[m] * sn);
      KB[kb + (d2 - h * 128)] = f2bf(k1[m] * sn + k2[m] * cs);
    }
  }
}
__device__ __forceinline__ void ctxk_job(const Params& p, int job) {
  bh* KB = (bh*)(p.R + OFF_KB);
  int tidl = threadIdx.x; asm volatile("" : "+v"(tidl));
#pragma unroll
  for (int i = 0; i < 4; ++i) {
    int e = job * 1024 + i * 256 + tidl;
    int x = e & 127, j = (e >> 7) & 255, hh = (e >> 15) & 3, sb = e >> 17;
    KB[KV_SAMPLE_BASE + ((size_t)(sb * 4 + hh) * 2304 + j) * 128 + x] = f2bf(p.cache_k[e]);
  }
}
__device__ __forceinline__ void vt_job(const Params& p, int job, char* smem) {
  bh* tl = (bh*)smem;
  int tid_l_ = threadIdx.x; asm volatile("" : "+v"(tid_l_)); const int tid = tid_l_;
  int seq, h, kt, Lk;
  if (job < 288) { seq = 32 + job / 144; int r = job % 144; h = r / 36; kt = r % 36; Lk = 2304; }
  else { int j = job - 288; seq = j >> 4; h = (j >> 2) & 3; kt = j & 3; Lk = 256; }
  const bh* proj = (const bh*)p.R;
  __syncthreads();
#pragma unroll 16
  for (int i = 0; i < 32; ++i) {
    int e = tid + i * 256, key = e >> 7, dv = e & 127;
    bh val;
    if (seq < 32) val = proj[(size_t)(seq * 256 + kt * 64 + key) * 3104 + 1024 + h * 128 + dv];
    else if (kt < 4) val = f2bf(p.cache_v[((size_t)((seq - 32) * 4 + h) * 256 + kt * 64 + key) * 128 + dv]);
    else val = proj[(size_t)(NTP + (seq - 32) * 2048 + (kt - 4) * 64 + key) * 3104 + 1024 + h * 128 + dv];
    tl[key * 130 + dv] = val;
  }
  __syncthreads();
  bh* VT = (bh*)(p.R + OFF_VT) + (seq < 32 ? (size_t)(seq * 4 + h) * 128 * 256
                                            : (size_t)KV_SAMPLE_BASE + (size_t)((seq - 32) * 4 + h) * 128 * 2304);
#pragma unroll 4
  for (int i = 0; i < 32; ++i) {
    int e = tid + i * 256, dv = e >> 6, key = e & 63;
    VT[(size_t)dv * Lk + kt * 64 + key] = tl[key * 130 + dv];
  }
}

__device__ __forceinline__ void attn_unit(const Params& p, int unit, char* smem) {
  bh* Pl = (bh*)smem;
  float* sred = (float*)(smem + 10240);
  int tid_l_ = threadIdx.x; asm volatile("" : "+v"(tid_l_)); const int tid = tid_l_, lane = tid & 63, w = tid >> 6, r = lane & 15, g = lane >> 4;
  int seq, h, qb, Lk;
  if (unit < 256) { seq = 32 + (unit >> 7); h = (unit >> 5) & 3; qb = unit & 31; Lk = 2304; }
  else { int u = unit - 256; seq = u >> 4; h = (u >> 2) & 3; qb = u & 3; Lk = 256; }
  const int row0 = seq < 32 ? seq * 256 : NTP + (seq - 32) * 2048;
  const bh* Q = (const bh*)(p.R + OFF_Q);
  const bh* KB = (const bh*)(p.R + OFF_KB) + (seq < 32 ? (size_t)(seq * 4 + h) * 256 * 128
                                                       : (size_t)KV_SAMPLE_BASE + (size_t)((seq - 32) * 4 + h) * 2304 * 128);
  const bh* VT = (const bh*)(p.R + OFF_VT) + (seq < 32 ? (size_t)(seq * 4 + h) * 128 * 256
                                                       : (size_t)KV_SAMPLE_BASE + (size_t)((seq - 32) * 4 + h) * 128 * 2304);
  __syncthreads();
  if (tid < 64) {
    float a = p.diff_lambda[tid] * p.diff_lambda[64 + tid];
    float b = p.diff_lambda[128 + tid] * p.diff_lambda[192 + tid];
    a = wave_sum(a); b = wave_sum(b);
    if (tid == 0) sred[0] = expf(a) - expf(b);
  }
  __syncthreads();
  const float lam_init = 0.8f - 0.6f * expf(-0.3f * 1.0f);
  const float lam = sred[0] + lam_init;
  const int qrow = row0 + qb * 64 + w * 16;
  bf16x8 aq[2][2];
#pragma unroll
  for (int pp = 0; pp < 2; ++pp)
#pragma unroll
    for (int kk = 0; kk < 2; ++kk)
      aq[pp][kk] = *(const bf16x8*)(Q + (size_t)(qrow + r) * 512 + h * 128 + pp * 64 + kk * 32 + g * 8);
  float mrun[2][4], lrun[2][4];
  f32x4 O[2][8];
#pragma unroll
  for (int pp = 0; pp < 2; ++pp) {
#pragma unroll
    for (int j = 0; j < 4; ++j) { mrun[pp][j] = -1e30f; lrun[pp][j] = 0.f; }
#pragma unroll
    for (int n = 0; n < 8; ++n) O[pp][n] = (f32x4){0.f, 0.f, 0.f, 0.f};
  }
  bh* Pw = Pl + w * (2 * 16 * 40);
  const float scale = 0.125f;
  bh* Ks = (bh*)(smem + 10752);
  bh* Vs = Ks + 64 * 128;
  u32x4 pk_[4], pv_[4];
  auto tload = [&](int kt) {
#pragma unroll
    for (int i = 0; i < 4; ++i) {
      const int pz = tid + 256 * i;
      pk_[i] = *(const u32x4*)(KB + (size_t)(kt + (pz >> 4)) * 128 + (pz & 15) * 8);
      pv_[i] = *(const u32x4*)(VT + (size_t)(pz >> 3) * Lk + kt + (pz & 7) * 8);
    }
  };
  tload(0);
#pragma unroll 1
  for (int kt = 0; kt < Lk; kt += 64) {
    __syncthreads();
#pragma unroll
    for (int i = 0; i < 4; ++i) {
      const int pz = tid + 256 * i;
      const int key = pz >> 4, ck = pz & 15, dv = pz >> 3, cv = pz & 7;
      *(u32x4*)(Ks + key * 128 + ((ck ^ (key & 15)) << 3)) = pk_[i];
      *(u32x4*)(Vs + dv * 64 + ((cv ^ ((dv >> 1) & 7)) << 3)) = pv_[i];
    }
    __syncthreads();
    if (kt + 64 < Lk) tload(kt + 64);
#pragma unroll
    for (int h2 = 0; h2 < 2; ++h2) {
      f32x4 s[2][2];
#pragma unroll
      for (int sub = 0; sub < 2; ++sub) {
        const int key = h2 * 32 + sub * 16 + r;
#pragma unroll
        for (int pp = 0; pp < 2; ++pp) {
          const bf16x8 b0 = *(const bf16x8*)(Ks + key * 128 + (((pp * 8 + g) ^ (key & 15)) << 3));
          const bf16x8 b1 = *(const bf16x8*)(Ks + key * 128 + (((pp * 8 + 4 + g) ^ (key & 15)) << 3));
          f32x4 z = (f32x4){0.f, 0.f, 0.f, 0.f};
          z = __builtin_amdgcn_mfma_f32_16x16x32_bf16(aq[pp][0], b0, z, 0, 0, 0);
          z = __builtin_amdgcn_mfma_f32_16x16x32_bf16(aq[pp][1], b1, z, 0, 0, 0);
          s[pp][sub] = z;
        }
      }
#pragma unroll
      for (int pp = 0; pp < 2; ++pp) {
#pragma unroll
        for (int j = 0; j < 4; ++j) {
          float s0 = s[pp][0][j] * scale, s1 = s[pp][1][j] * scale;
          float mx = max16(fmaxf(s0, s1));
          float mnew = fmaxf(mrun[pp][j], mx);
          float alpha = __expf(mrun[pp][j] - mnew);
          float p0 = __expf(s0 - mnew), p1 = __expf(s1 - mnew);
          float rs = sum16(p0 + p1);
          lrun[pp][j] = lrun[pp][j] * alpha + rs;
          mrun[pp][j] = mnew;
#pragma unroll
          for (int n = 0; n < 8; ++n) O[pp][n][j] *= alpha;
          Pw[(pp * 16 + g * 4 + j) * 40 + r] = f2bf(p0);
          Pw[(pp * 16 + g * 4 + j) * 40 + 16 + r] = f2bf(p1);
        }
      }
      __builtin_amdgcn_fence(__ATOMIC_RELEASE, "wavefront");
      __builtin_amdgcn_wave_barrier();
      __builtin_amdgcn_fence(__ATOMIC_ACQUIRE, "wavefront");
      bf16x8 pa0 = *(const bf16x8*)(Pw + (0 * 16 + r) * 40 + g * 8);
      bf16x8 pa1 = *(const bf16x8*)(Pw + (1 * 16 + r) * 40 + g * 8);
#pragma unroll
      for (int n = 0; n < 8; ++n) {
        const int dv = n * 16 + r;
        const bf16x8 vb = *(const bf16x8*)(Vs + dv * 64 + (((h2 * 4 + g) ^ ((dv >> 1) & 7)) << 3));
        O[0][n] = __builtin_amdgcn_mfma_f32_16x16x32_bf16(pa0, vb, O[0][n], 0, 0, 0);
        O[1][n] = __builtin_amdgcn_mfma_f32_16x16x32_bf16(pa1, vb, O[1][n], 0, 0, 0);
      }
      __builtin_amdgcn_fence(__ATOMIC_RELEASE, "wavefront");
      __builtin_amdgcn_wave_barrier();
    }
  }
#pragma unroll
  for (int j = 0; j < 4; ++j) {
    float i0 = 1.f / lrun[0][j], i1 = lam / lrun[1][j];
    float o[8];
    float ss = 0.f;
#pragma unroll
    for (int n = 0; n < 8; ++n) { o[n] = O[0][n][j] * i0 - O[1][n][j] * i1; ss += o[n] * o[n]; }
    ss = sum16(ss);
    float rs = rsqrtf(ss * (1.f / 128.f) + EPSF) * (1.f - lam_init);
    bh* arow = p.act + (size_t)(qrow + g * 4 + j) * 1024 + h * 128;
#pragma unroll
    for (int n = 0; n < 8; ++n) arow[n * 16 + r] = f2bf(o[n] * rs * p.diff_norm[h * 128 + n * 16 + r]);
  }
}

__device__ __forceinline__ void ffnact_job(const Params& p, int layer, int job) {
  int tidl = threadIdx.x; asm volatile("" : "+v"(tidl));
  const int item = job * 256 + tidl;
  const int rc = item / 352, j = (item % 352) * 8;
  const int t0 = rc * 8;
  const bh* U = (const bh*)p.R;
  bh* AO = (bh*)(p.R + OFF_ACTF);
  const float* cw = p.ffn_conv_w + (size_t)layer * 3 * 5632;
  const float* cb = p.ffn_conv_b + (size_t)layer * 5632;
  const bool start = (t0 < NTP) ? ((t0 & 255) == 0) : ((t0 & 2047) == 0);
  const bool endd = (t0 < NTP) ? (((t0 + 8) & 255) == 0) : (((t0 + 8) & 2047) == 0);
  u32x4 ua[10], ug[10];
  const u32x4 zz = {0, 0, 0, 0};
#pragma unroll
  for (int i = 0; i < 10; ++i) {
    const int t = t0 - 1 + i;
    const bool ok = (i == 0) ? !start : ((i == 9) ? !endd : true);
    ua[i] = ok ? *(const u32x4*)(U + (size_t)t * 5632 + j) : zz;
    ug[i] = ok ? *(const u32x4*)(U + (size_t)t * 5632 + 2816 + j) : zz;
  }
  float wa[3][8], wg[3][8], ba[8], bg[8];
#pragma unroll
  for (int tp = 0; tp < 3; ++tp) {
    float4 x0 = *(const float4*)(cw + tp * 5632 + j), x1 = *(const float4*)(cw + tp * 5632 + j + 4);
    float4 y0 = *(const float4*)(cw + tp * 5632 + 2816 + j), y1 = *(const float4*)(cw + tp * 5632 + 2816 + j + 4);
    wa[tp][0] = x0.x; wa[tp][1] = x0.y; wa[tp][2] = x0.z; wa[tp][3] = x0.w; wa[tp][4] = x1.x; wa[tp][5] = x1.y; wa[tp][6] = x1.z; wa[tp][7] = x1.w;
    wg[tp][0] = y0.x; wg[tp][1] = y0.y; wg[tp][2] = y0.z; wg[tp][3] = y0.w; wg[tp][4] = y1.x; wg[tp][5] = y1.y; wg[tp][6] = y1.z; wg[tp][7] = y1.w;
  }
  {
    float4 x0 = *(const float4*)(cb + j), x1 = *(const float4*)(cb + j + 4);
    float4 y0 = *(const float4*)(cb + 2816 + j), y1 = *(const float4*)(cb + 2816 + j + 4);
    ba[0] = x0.x; ba[1] = x0.y; ba[2] = x0.z; ba[3] = x0.w; ba[4] = x1.x; ba[5] = x1.y; ba[6] = x1.z; ba[7] = x1.w;
    bg[0] = y0.x; bg[1] = y0.y; bg[2] = y0.z; bg[3] = y0.w; bg[4] = y1.x; bg[5] = y1.y; bg[6] = y1.z; bg[7] = y1.w;
  }
#pragma unroll
  for (int i = 0; i < 8; ++i) {
    u32x4 ov;
#pragma unroll
    for (int e2 = 0; e2 < 4; ++e2) {
      float res[2];
#pragma unroll
      for (int hl = 0; hl < 2; ++hl) {
        const int e = e2 * 2 + hl;
        float am = hl ? bfhi(ua[i][e2]) : bflo(ua[i][e2]);
        float a0 = hl ? bfhi(ua[i + 1][e2]) : bflo(ua[i + 1][e2]);
        float ap = hl ? bfhi(ua[i + 2][e2]) : bflo(ua[i + 2][e2]);
        float gm = hl ? bfhi(ug[i][e2]) : bflo(ug[i][e2]);
        float g0 = hl ? bfhi(ug[i + 1][e2]) : bflo(ug[i + 1][e2]);
        float gp = hl ? bfhi(ug[i + 2][e2]) : bflo(ug[i + 2][e2]);
        float av = wa[0][e] * am + wa[1][e] * a0 + wa[2][e] * ap + ba[e];
        float gv = wg[0][e] * gm + wg[1][e] * g0 + wg[2][e] * gp + bg[e];
        res[hl] = siluf_(gv) * av;
      }
      ov[e2] = pk2(res[0], res[1]);
    }
    *(u32x4*)(AO + (size_t)(t0 + i) * 2816 + j) = ov;
  }
}

#define XB_TMO      128
#define XB_XCNT(j)  (256  + 64 * (j))
#define XB_XSUB(j)  (1280 + 64 * (j))
#define XB_XGEN(j)  (2304 + 64 * (j))
#define XB_TOP      3328
#define XB_TOPGEN   3392
#define XCD_BAR_WORDS 3456
#define XB_SPIN_CAP (1u << 18)
#define LAS __attribute__((address_space(3)))

__device__ __forceinline__ unsigned xb_ld(unsigned* p)              { return __hip_atomic_load(p, __ATOMIC_RELAXED, __HIP_MEMORY_SCOPE_AGENT); }
__device__ __forceinline__ unsigned xb_add(unsigned* p, unsigned v) { return __hip_atomic_fetch_add(p, v, __ATOMIC_RELAXED, __HIP_MEMORY_SCOPE_AGENT); }
__device__ __forceinline__ unsigned xb_xcc_id() { return (unsigned)__builtin_amdgcn_s_getreg((3 << 11) | 20) & 0xFu; }
#define XB_SPIN(cond, bar) do { unsigned _sp = 0; while (cond) { __builtin_amdgcn_s_sleep(1); \
    if ((++_sp & 255u) == 0u) { if (xb_ld(&(bar)[XB_TMO])) break; if (_sp > XB_SPIN_CAP) { atomicAdd(&(bar)[XB_TMO], 1u); break; } } } } while (0)

struct XcdBarrier {
    unsigned* bar; unsigned x;
    volatile LAS unsigned* st;
};

__device__ __forceinline__ XcdBarrier xcd_barrier_post(unsigned* bar, volatile LAS unsigned* st) {
    XcdBarrier b; b.bar = bar; b.x = xb_xcc_id(); b.st = st;
    if (threadIdx.x == 0) (void)xb_add(&bar[XB_XCNT(b.x)], 1u);
    return b;
}
__device__ __forceinline__ void xcd_barrier_complete(unsigned* bar, unsigned x, unsigned& nloc, unsigned& nx) {
    const unsigned G = gridDim.x * gridDim.y * gridDim.z;
    unsigned sum, cnt, mine, sp = 0u;
    for (;;) {
        sum = 0u; cnt = 0u; mine = 0u;
#pragma unroll
        for (unsigned j = 0; j < 16; ++j) { const unsigned c = xb_ld(&bar[XB_XCNT(j)]); sum += c; cnt += (c > 0u) ? 1u : 0u; mine = (j == x) ? c : mine; }
        if (sum == G) break;
        __builtin_amdgcn_s_sleep(1);
        if ((++sp & 255u) == 0u) { if (xb_ld(&bar[XB_TMO])) break; if (sp > XB_SPIN_CAP) { atomicAdd(&bar[XB_TMO], 1u); break; } }
    }
    nloc = mine > 0u ? mine : 1u; nx = cnt > 0u ? cnt : 1u;
}

__device__ __forceinline__ void xcd_barrier(const XcdBarrier& b) {
    asm volatile("s_waitcnt vmcnt(0)" ::: "memory");
    __syncthreads();
    if (threadIdx.x == 0) {
        unsigned* bar = b.bar;
        __builtin_amdgcn_s_waitcnt(0);
        unsigned nloc = b.st[0], nx = b.st[1];
        if (nloc == 0u) { xcd_barrier_complete(bar, b.x, nloc, nx); b.st[0] = nloc; b.st[1] = nx; }
        const unsigned old = xb_add(&bar[XB_XSUB(b.x)], 1u);
        const unsigned gen = old / nloc;
        if (old + 1u == (gen + 1u) * nloc) {
            __builtin_amdgcn_fence(__ATOMIC_RELEASE, "agent");
            asm volatile("s_waitcnt vmcnt(0)" ::: "memory");
            const unsigned og = xb_add(&bar[XB_TOP], 1u);
            const unsigned tg = og / nx;
            if (og + 1u == (tg + 1u) * nx) xb_add(&bar[XB_TOPGEN], 1u);
            else XB_SPIN(xb_ld(&bar[XB_TOPGEN]) == tg, bar);
            __builtin_amdgcn_fence(__ATOMIC_ACQUIRE, "agent");
            xb_add(&bar[XB_XGEN(b.x)], 1u);
            asm volatile("s_waitcnt vmcnt(0)" ::: "memory");
        } else {
            XB_SPIN(xb_ld(&bar[XB_XGEN(b.x)]) == gen, bar);
            __builtin_amdgcn_fence(__ATOMIC_ACQUIRE, "agent");
            asm volatile("s_waitcnt vmcnt(0)" ::: "memory");
        }
    }
    __syncthreads();
}


template <int ph>
__device__ __forceinline__ void run_phase(const Params& p, int bid, int nb, char* smem, bool rep = false) {
  const float* ng = p.norm_g;
  const bh* Rf = (const bh*)p.R;
  if (ph == 0) {
    for (int j = bid + (rep ? 768 : 0); j < 768 + 576 + 1024; j += nb) {
      if (j < 768) gemv_job(p, j, smem);
      else if (j < 1344) filter_job(p, j - 768, smem);
      else convert_tile(p.w_in_even, 1024, 4096, p.wt, j - 1344, smem);
    }
  } else if (ph == 1) {
    for (int j = bid; j < 768; j += nb) rows_job(p, j, true, nullptr, nullptr, 0, 0, ng + 0 * 1024, 0, 0);
  } else if (ph == 2) {
    gemm_phase<2, 192, 3>(p.act, 1024, p.wt, 1024, p.R, 4096, 4096, 32, bid, nb, smem);
  } else if (ph == 3) {
    if (nb == 512 && !rep) {
      hyena_sample_job(p, bid, smem);
      if (bid < 384) scan2_unit<0>(p, bid, smem);
      else {
        const int q = bid - 384;
        hyena_prompt_job(p, q, smem);
        hyena_prompt_job(p, q + 128, smem);
        convert_tile(p.w_out_even, 1024, 1024, p.wt, q, smem);
        convert_tile(p.w_out_even, 1024, 1024, p.wt, q + 128, smem);
      }
    } else {
      for (int j = bid + (rep ? 512 : 0); j < (rep ? 896 : 512 + 384 + 256 + 256); j += nb) {
        if (j < 512) hyena_sample_job(p, j, smem);
        else if (j < 896) scan2_unit<0>(p, j - 512, smem);
        else if (j < 1152) hyena_prompt_job(p, j - 896, smem);
        else convert_tile(p.w_out_even, 1024, 1024, p.wt, j - 1152, smem);
      }
    }
  } else if (ph == 4) {
    for (int j = bid; j < 128 + 1024; j += nb) {
      if (j < 128) fixup_unit<0>(p, j, smem);
      else scan_final_job(p, j - 128, 0);
    }
  } else if (ph == 5) {
    for (int j = bid; j < 512; j += nb) scan_final_job(p, 1024 + j, 0);
  } else if (ph == 6) {
    gemm_phase<1, 192, 3>(p.act, 1024, p.wt, 1024, p.R, 1024, 1024, 8, bid, nb, smem);
  } else if (ph == 7) {
    for (int j = bid; j < 768 + 1408 + 704; j += nb) {
      if (j < 768) rows_job(p, j, true, Rf, ng + 1 * 1024, 0, 2, ng + 2 * 1024, 0, 3);
      else if (j < 2176) convert_tile(p.ffn_up, 1024, 5632, p.wt, j - 768, smem, true);
      else convert_tile(p.ffn_down, 2816, 1024, p.wt2, j - 2176, smem);
    }
  } else if (ph == 8) {
    gemm_phase<3, 192, 3>(p.act, 1024, p.wt, 1024, p.R + OFF_ACTF, 2816, 5632, 44, bid, nb, smem, p.ffn_conv_w, p.ffn_conv_b);
  } else if (ph == 9) {
  } else if (ph == 10) {
    gemm_phase<1, 192, 3>((const bh*)(p.R + OFF_ACTF), 2816, p.wt2, 2816, p.R, 1024, 1024, 8, bid, nb, smem);
  } else if (ph == 11) {
    for (int j = bid; j < 768 + 800; j += nb) {
      if (j < 768) rows_job(p, j, false, Rf, ng + 3 * 1024, 0, 5, ng + 4 * 1024, 1, 0);
      else convert_tile(p.w_in_odd, 1024, 3104, p.wt, j - 768, smem);
    }
  } else if (ph == 12) {
    gemm_phase<1, 128, 3>(p.act, 1024, p.wt, 1024, p.R, 3104, 3104, 25, bid, nb, smem);
  } else if (ph == 13) {
    auto small13 = [&](int sj) {
      if (sj < 800) vt_job(p, sj, smem);
      else if (sj < 3872) oddrow_job(p, sj - 800);
      else if (sj < 4128) ctxk_job(p, sj - 3872);
      else convert_tile(p.w_out_odd, 1024, 1024, p.wt, sj - 4128, smem);
    };
    if (nb == 512 && !rep) {
      if (bid < 384) {
        scan2_unit<1>(p, bid, smem);
        for (int sj = 3072 + bid; sj < 4384; sj += 384) small13(sj);
      } else {
        for (int k = 0; k < 24; ++k) small13((bid - 384) + 128 * k);
      }
    } else {
      for (int j = bid; j < (rep ? 384 : 384 + 4384); j += nb) {
        if (j < 384) scan2_unit<1>(p, j, smem);
        else small13(j - 384);
      }
    }
  } else if (ph == 14) {
    if (nb == 512 && !rep) {
      if (bid < 256) attn_unit(p, bid, smem);
      else {
        const int q = bid - 256;
        attn_unit(p, 256 + q, smem);
        attn_unit(p, 512 + q, smem);
        if (q < 128) fixup_unit<1>(p, q, smem);
        for (int k = 0; k < 4; ++k) scan_final_job(p, q + 256 * k, 1);
      }
    } else {
      for (int j = bid; j < (rep ? 768 : 768 + 128 + 1024); j += nb) {
        if (j < 768) attn_unit(p, j, smem);
        else if (j < 896) fixup_unit<1>(p, j - 768, smem);
        else scan_final_job(p, j - 896, 1);
      }
    }
  } else if (ph == 15) {
    for (int j = bid; j < 512; j += nb) scan_final_job(p, 1024 + j, 1);
  } else if (ph == 16) {
    gemm_phase<1, 192, 3>(p.act, 1024, p.wt, 1024, p.R, 1024, 1024, 8, bid, nb, smem);
  } else if (ph == 17) {
    for (int j = bid; j < 768 + 1408 + 704; j += nb) {
      if (j < 768) rows_job(p, j, false, Rf, ng + 5 * 1024, 1, 2, ng + 6 * 1024, 1, 3);
      else if (j < 2176) convert_tile(p.ffn_up + (size_t)1024 * 5632, 1024, 5632, p.wt, j - 768, smem, true);
      else convert_tile(p.ffn_down + (size_t)2816 * 1024, 2816, 1024, p.wt2, j - 2176, smem);
    }
  } else if (ph == 18) {
    gemm_phase<3, 192, 3>(p.act, 1024, p.wt, 1024, p.R + OFF_ACTF, 2816, 5632, 44, bid, nb, smem, p.ffn_conv_w + 3 * 5632, p.ffn_conv_b + 5632);
  } else if (ph == 19) {
  } else if (ph == 20) {
    gemm_phase<1, 192, 3>((const bh*)(p.R + OFF_ACTF), 2816, p.wt2, 2816, p.R, 1024, 1024, 8, bid, nb, smem);
  } else if (ph == 21) {
    for (int j = bid; j < 768; j += nb) rows_job(p, j, false, Rf, ng + 7 * 1024, 1, 5, nullptr, 0, 0);
  }
}

template <int PH>
__device__ __forceinline__ void phase_step(const Params& p, int ph0, int ph1, char* smem, cg::grid_group& grid, const XcdBarrier& xb) {
  if (PH == 9 || PH == 19) return;
  if (PH >= ph0 && PH < ph1) {
    if (PH == REP_PH) { run_phase<PH>(p, blockIdx.x, gridDim.x, smem, true); xcd_barrier(xb); }
    run_phase<PH>(p, blockIdx.x, gridDim.x, smem);
    if (PH + 1 < ph1) {
      xcd_barrier(xb);
    }
  }
}

__global__ void __launch_bounds__(256, 2) mega_kernel(Params p, int ph0, int ph1) {
  __shared__ __attribute__((aligned(16))) char smem[49152];
  cg::grid_group grid = cg::this_grid();
  __shared__ uint4 xb_words;
  if (threadIdx.x == 0) xb_words = make_uint4(0u, 0u, 0u, 0u);
  __syncthreads();
  XcdBarrier xb = xcd_barrier_post(p.bar, (volatile LAS unsigned*)&xb_words);
#ifdef EXTRA_SYNCS
  for (int i = 0; i < EXTRA_SYNCS; ++i) xcd_barrier(xb);
#endif
  phase_step<0>(p, ph0, ph1, smem, grid, xb);
  phase_step<1>(p, ph0, ph1, smem, grid, xb);
  phase_step<2>(p, ph0, ph1, smem, grid, xb);
  phase_step<3>(p, ph0, ph1, smem, grid, xb);
  phase_step<4>(p, ph0, ph1, smem, grid, xb);
  phase_step<5>(p, ph0, ph1, smem, grid, xb);
  phase_step<6>(p, ph0, ph1, smem, grid, xb);
  phase_step<7>(p, ph0, ph1, smem, grid, xb);
  phase_step<8>(p, ph0, ph1, smem, grid, xb);
  phase_step<9>(p, ph0, ph1, smem, grid, xb);
  phase_step<10>(p, ph0, ph1, smem, grid, xb);
  phase_step<11>(p, ph0, ph1, smem, grid, xb);
  phase_step<12>(p, ph0, ph1, smem, grid, xb);
  phase_step<13>(p, ph0, ph1, smem, grid, xb);
  phase_step<14>(p, ph0, ph1, smem, grid, xb);
  phase_step<15>(p, ph0, ph1, smem, grid, xb);
  phase_step<16>(p, ph0, ph1, smem, grid, xb);
  phase_step<17>(p, ph0, ph1, smem, grid, xb);
  phase_step<18>(p, ph0, ph1, smem, grid, xb);
  phase_step<19>(p, ph0, ph1, smem, grid, xb);
  phase_step<20>(p, ph0, ph1, smem, grid, xb);
  phase_step<21>(p, ph0, ph1, smem, grid, xb);
}

extern "C" void kernel_launch(void* const* d_in, const int* in_sizes, int n_in, void* d_out, int out_size, void* d_ws,
                              size_t ws_size, hipStream_t stream) {
  static int grid_blocks = 0;
  if (!grid_blocks) {
    int dev = 0, cus = 0, per_cu = 0;
    hipGetDevice(&dev);
    hipDeviceGetAttribute(&cus, hipDeviceAttributeMultiprocessorCount, dev);
    hipOccupancyMaxActiveBlocksPerMultiprocessor(&per_cu, mega_kernel, 256, 0);
    if (per_cu > 2) per_cu = 2;
    if (per_cu < 1) per_cu = 1;
    grid_blocks = cus * per_cu;
  }
  Params p{};
  const float** pf = (const float**)&p;
  for (int i = 0; i < 35; ++i) pf[i] = (const float*)d_in[i];
  p.out = (float*)d_out;
  char* ws = (char*)d_ws;
  size_t off = 0;
  p.act = (bh*)(ws + off); off += (size_t)NT * 1024 * 2;
  p.wt = (bh*)(ws + off); off += (size_t)5632 * 1024 * 2;
  p.wt2 = (bh*)(ws + off); off += (size_t)1024 * 2816 * 2;
  p.R = ws + off; off += R_BYTES;
  p.mod = (float*)(ws + off); off += (size_t)2 * 3 * 6144 * 4;
  p.bar = (unsigned*)(ws + off); off += (size_t)XCD_BAR_WORDS * 4;
  p.gt256 = (bh*)(ws + off); off += (size_t)2 * 512 * 512 * 2;
  p.gt2048 = (bh*)(ws + off); off += (size_t)2 * 512 * 4096 * 2;
  if (off > ws_size) { fprintf(stderr, "workspace too small: need %zu have %zu\n", off, ws_size); return; }
  hipMemsetAsync(p.mod, 0, (size_t)2 * 3 * 6144 * 4 + (size_t)XCD_BAR_WORDS * 4, stream);
#if MEGA
  int ph0 = 0, ph1 = NPHASE;
  void* args[] = {&p, &ph0, &ph1};
  hipError_t e = hipLaunchCooperativeKernel((void*)mega_kernel, dim3(grid_blocks), dim3(256), args, 0, stream);
  if (e != hipSuccess) fprintf(stderr, "cooperative launch failed: %s (grid %d)\n", hipGetErrorString(e), grid_blocks);
#else
  for (int ph = 0; ph < NPHASE; ++ph) {
    int ph0 = ph, ph1 = ph + 1;
    void* args[] = {&p, &ph0, &ph1};
    hipError_t e = hipLaunchCooperativeKernel((void*)mega_kernel, dim3(grid_blocks), dim3(256), args, 0, stream);
    if (e != hipSuccess) fprintf(stderr, "launch failed: %s\n", hipGetErrorString(e));
  }
#endif
}
```

```cpp
#include <hip/hip_runtime.h>
#include <hip/hip_cooperative_groups.h>
#include <stdint.h>
#include <cstdio>
namespace cg = cooperative_groups;

#ifndef MEGA
#define MEGA 1
#endif
#ifndef REP_PH
#define REP_PH -1
#endif

typedef unsigned short bh;
using bf16x8 = __attribute__((ext_vector_type(8))) short;
using f32x4 = __attribute__((ext_vector_type(4))) float;
using u32x4 = __attribute__((ext_vector_type(4))) unsigned int;

#define NT 12288
#define NTP 8192
#define EPSF 1e-6f
#define NPHASE 22

#define OUT_HGRN 12582912
#define OUT_CK 16777216
#define OUT_CV 20971520
#define OUT_GLA 25165824

#define OFF_ODIR 100663296ull
#define OFF_Z1 150994944ull
#define OFF_HYT 150994944ull
#define OFF_ACTF 138412032ull
#define OFF_Q 150994944ull
#define OFF_KB 163577856ull
#define OFF_VT 176685056ull
#define R_BYTES 207618048ull
#define KV_SAMPLE_BASE 4194304

struct Params {
  const float *x_prompt, *x_sample, *state_hgrn, *cache_k, *cache_v, *state_gla, *c, *c_ctx;
  const float *ada_w, *ada_b, *norm_g, *ffn_up, *ffn_conv_w, *ffn_conv_b, *ffn_down;
  const float *w_in_even, *w_out_even, *hgrn_lb, *hgrn_norm, *hy_conv_w, *hy_conv_b;
  const float *hy_w1, *hy_b1, *hy_w2, *hy_b2, *hy_w3, *hy_freq, *hy_d;
  const float *w_in_odd, *w_out_odd, *diff_lambda, *diff_norm, *gla_aw, *gla_ab, *gla_norm;
  float* out;
  bh* act;
  bh* wt;
  bh* wt2;
  char* R;
  float* mod;
  bh* gt256;
  bh* gt2048;
  unsigned* bar;
};

typedef __bf16 bf2_t __attribute__((ext_vector_type(2)));
typedef float f2_t __attribute__((ext_vector_type(2)));
typedef unsigned int u32x2 __attribute__((ext_vector_type(2)));
__device__ __forceinline__ unsigned pk2(float a, float b) {
  f2_t v = {a, b};
  return __builtin_bit_cast(unsigned, __builtin_convertvector(v, bf2_t));
}
__device__ __forceinline__ bh f2bf(float x) { return (bh)(pk2(x, x) & 0xffffu); }
__device__ __forceinline__ float bflo(unsigned w) { return __uint_as_float(w << 16); }
__device__ __forceinline__ float bfhi(unsigned w) { return __uint_as_float(w & 0xffff0000u); }
__device__ __forceinline__ float bf2f(bh h) { return __uint_as_float(((uint32_t)h) << 16); }
__device__ __forceinline__ float sigmoidf_(float x) { return __builtin_amdgcn_rcpf(1.f + __expf(-x)); }
__device__ __forceinline__ float siluf_(float x) { return x * __builtin_amdgcn_rcpf(1.f + __expf(-x)); }
template <int CTRL>
__device__ __forceinline__ float dppf0(float v) {
  return __int_as_float(__builtin_amdgcn_update_dpp(0, __float_as_int(v), CTRL, 0xF, 0xF, true));
}
__device__ __forceinline__ float wave_sum(float v) {
  v += dppf0<0xB1>(v); v += dppf0<0x4E>(v); v += dppf0<0x141>(v); v += dppf0<0x140>(v);
  v += __shfl_xor(v, 16);
  v += __shfl_xor(v, 32);
  return v;
}

template <int OUT_BF16, int BM, int DEPTH>
__device__ __forceinline__ void gemm_phase(const bh* __restrict__ A, int lda, const bh* __restrict__ Bt, int K, void* Cv, int ldc,
                           int N, int ntn, int bid, int nb, char* smem, const float* cw = nullptr, const float* cb = nullptr) {
  constexpr int MT = BM / 32;
  constexpr int NPA = BM / 32;
  bh* As = (bh*)smem;
  bh* Bs = As + BM * 64;
  int tid_l_ = threadIdx.x; asm volatile("" : "+v"(tid_l_)); const int tid = tid_l_, lane = tid & 63, w = tid >> 6, wr = w >> 1, wc = w & 1, r = lane & 15, g = lane >> 4;
  constexpr int MB = (NT / BM) / 8;
  const int xcd = bid & 7, nloc = nb >> 3;
  const int qend = OUT_BF16 == 3 ? MB * ntn + (ntn + 7) / 8 : MB * ntn;
  for (int q = bid >> 3; q < qend; q += nloc) {
    int mt = xcd * MB + (q % MB), nt = q / MB;
    if (OUT_BF16 == 3 && q >= MB * ntn) { mt = 64; nt = (q - MB * ntn) * 8 + xcd; if (nt >= ntn) continue; }
    const int trow0 = OUT_BF16 == 3 ? mt * 190 - 1 : mt * BM;
    const bh* Ag = A;
    const bh* Bg = Bt + (size_t)(nt * 128) * K;
    f32x4 acc[MT][4];
#pragma unroll
    for (int m = 0; m < MT; ++m)
#pragma unroll
      for (int n = 0; n < 4; ++n) acc[m][n] = (f32x4){0.f, 0.f, 0.f, 0.f};
    u32x4 pa0[NPA], pb0[4], pa1[NPA], pb1[4];
    auto gload = [&](u32x4* pa, u32x4* pb, int kofs) {
#pragma unroll
      for (int i = 0; i < NPA; ++i) {
        int pz = tid + i * 256, row = pz >> 3, cp = pz & 7;
        int tr = trow0 + row;
        if (OUT_BF16 == 3) tr = min(max(tr, 0), NT - 1);
        pa[i] = *(const u32x4*)(Ag + (size_t)tr * lda + kofs + cp * 8);
      }
#pragma unroll
      for (int i = 0; i < 4; ++i) {
        int pz = tid + i * 256, row = pz >> 3, cp = pz & 7;
        pb[i] = *(const u32x4*)(Bg + (size_t)row * K + kofs + cp * 8);
      }
    };
    auto kstep = [&](u32x4* pa, u32x4* pb, int knext) {
      __syncthreads();
#pragma unroll
      for (int i = 0; i < NPA; ++i) {
        int pz = tid + i * 256, row = pz >> 3, cp = pz & 7;
        *(u32x4*)(As + row * 64 + ((cp ^ ((row >> 1) & 7)) << 3)) = pa[i];
      }
#pragma unroll
      for (int i = 0; i < 4; ++i) {
        int pz = tid + i * 256, row = pz >> 3, cp = pz & 7;
        *(u32x4*)(Bs + row * 64 + ((cp ^ ((row >> 1) & 7)) << 3)) = pb[i];
      }
      __syncthreads();
      if (knext < K) gload(pa, pb, knext);
#pragma unroll
      for (int kk = 0; kk < 2; ++kk) {
        bf16x8 af[MT], bfr[4];
#pragma unroll
        for (int m = 0; m < MT; ++m) { const int row = wr * (BM / 2) + m * 16 + r; af[m] = *(const bf16x8*)(As + row * 64 + (((kk * 4 + g) ^ ((row >> 1) & 7)) << 3)); }
#pragma unroll
        for (int n = 0; n < 4; ++n) { const int row = wc * 64 + n * 16 + r; bfr[n] = *(const bf16x8*)(Bs + row * 64 + (((kk * 4 + g) ^ ((row >> 1) & 7)) << 3)); }
        __builtin_amdgcn_sched_barrier(0);
#pragma unroll
        for (int m = 0; m < MT; ++m)
#pragma unroll
          for (int n = 0; n < 4; ++n)
            acc[m][n] = (OUT_BF16 == 1 || OUT_BF16 == 3) ? __builtin_amdgcn_mfma_f32_16x16x32_bf16(bfr[n], af[m], acc[m][n], 0, 0, 0)
                                        : __builtin_amdgcn_mfma_f32_16x16x32_bf16(af[m], bfr[n], acc[m][n], 0, 0, 0);
        __builtin_amdgcn_sched_barrier(0);
      }
    };
    if (DEPTH == 3) {
      constexpr int NA3 = BM / 64;
      bh* As3 = (bh*)smem;
      bh* Bs3 = As3 + 2 * BM * 32;
      u32x4 ra0[NA3], rb0[2], ra1[NA3], rb1[2];
      auto ld3 = [&](u32x4* ra, u32x4* rb, int kofs) {
#pragma unroll
        for (int i = 0; i < NA3; ++i) {
          int pz = tid + i * 256, row = pz >> 2, c = pz & 3;
          int tr = trow0 + row;
          if (OUT_BF16 == 3) tr = min(max(tr, 0), NT - 1);
          ra[i] = *(const u32x4*)(Ag + (size_t)tr * lda + kofs + c * 8);
        }
#pragma unroll
        for (int i = 0; i < 2; ++i) {
          int pz = tid + i * 256, row = pz >> 2, c = pz & 3;
          rb[i] = *(const u32x4*)(Bg + (size_t)row * K + kofs + c * 8);
        }
      };
      auto st3 = [&](const u32x4* ra, const u32x4* rb, int stg) {
#pragma unroll
        for (int i = 0; i < NA3; ++i) {
          int pz = tid + i * 256, row = pz >> 2, c = pz & 3;
          *(u32x4*)(As3 + stg * BM * 32 + row * 32 + ((c ^ (((row >> 3) & 1) << 1)) << 3)) = ra[i];
        }
#pragma unroll
        for (int i = 0; i < 2; ++i) {
          int pz = tid + i * 256, row = pz >> 2, c = pz & 3;
          *(u32x4*)(Bs3 + stg * 128 * 32 + row * 32 + ((c ^ (((row >> 3) & 1) << 1)) << 3)) = rb[i];
        }
      };
      auto comp3 = [&](int cur) {
        __builtin_amdgcn_s_setprio(1);
        bf16x8 af[MT], bfr[4];
#pragma unroll
        for (int m = 0; m < MT; ++m) {
          const int row = wr * (BM / 2) + m * 16 + r;
          af[m] = *(const bf16x8*)(As3 + cur * BM * 32 + row * 32 + ((g ^ (((row >> 3) & 1) << 1)) << 3));
        }
#pragma unroll
        for (int n = 0; n < 4; ++n) {
          const int row = wc * 64 + n * 16 + r;
          bfr[n] = *(const bf16x8*)(Bs3 + cur * 128 * 32 + row * 32 + ((g ^ (((row >> 3) & 1) << 1)) << 3));
        }
#pragma unroll
        for (int m = 0; m < MT; ++m)
#pragma unroll
          for (int n = 0; n < 4; ++n)
            acc[m][n] = (OUT_BF16 == 1 || OUT_BF16 == 3) ? __builtin_amdgcn_mfma_f32_16x16x32_bf16(bfr[n], af[m], acc[m][n], 0, 0, 0)
                                        : __builtin_amdgcn_mfma_f32_16x16x32_bf16(af[m], bfr[n], acc[m][n], 0, 0, 0);
        __builtin_amdgcn_s_setprio(0);
      };
      const int nk = K >> 5;
      __syncthreads();
      ld3(ra0, rb0, 0);
      ld3(ra1, rb1, 32);
      st3(ra0, rb0, 0);
      ld3(ra0, rb0, 64);
      __syncthreads();
      for (int ks = 0; ks < nk; ks += 2) {
        comp3(0);
        st3(ra1, rb1, 1);
        if (ks + 3 < nk) ld3(ra1, rb1, (ks + 3) << 5);
        __syncthreads();
        comp3(1);
        if (ks + 2 < nk) st3(ra0, rb0, 0);
        if (ks + 4 < nk) ld3(ra0, rb0, (ks + 4) << 5);
        __syncthreads();
      }
    } else {
    gload(pa0, pb0, 0);
    if (DEPTH == 2) {
      gload(pa1, pb1, 64);
      for (int k0 = 0; k0 < K; k0 += 128) {
        kstep(pa0, pb0, k0 + 128);
        kstep(pa1, pb1, k0 + 192);
      }
    } else {
      for (int k0 = 0; k0 < K; k0 += 64) kstep(pa0, pb0, k0 + 64);
    }
    }
    if (OUT_BF16 == 1 || OUT_BF16 == 3) {
      __syncthreads();
      bh* Ct = (bh*)smem;
#pragma unroll
      for (int m = 0; m < MT; ++m)
#pragma unroll
        for (int n = 0; n < 4; ++n) {
          const int row = wr * (BM / 2) + m * 16 + r;
          const int sl = wc * 16 + n * 4 + g;
          u32x2 pv;
          pv[0] = pk2(acc[m][n][0], acc[m][n][1]);
          pv[1] = pk2(acc[m][n][2], acc[m][n][3]);
          *(u32x2*)(Ct + row * 128 + ((sl ^ ((row & 15) << 1)) << 2)) = pv;
        }
      __syncthreads();
      if (OUT_BF16 == 1) {
#pragma unroll 2
        for (int i = 0; i < BM / 16; ++i) {
          const int pz = tid + i * 256, row = pz >> 4, pc = pz & 15;
          const u32x4 v = *(const u32x4*)(Ct + row * 128 + ((pc ^ (row & 15)) << 3));
          const int col = nt * 128 + pc * 8;
          if (col < N) *(u32x4*)((bh*)Cv + ((size_t)mt * BM + row) * ldc + col) = v;
        }
      } else {
        const int c8 = tid & 7, rs = tid >> 3;
        const int ja = nt * 64 + c8 * 8;
        float wa[3][8], wg[3][8], ba[8], bg[8];
#pragma unroll
        for (int tp = 0; tp < 3; ++tp) {
          const float4 x0 = *(const float4*)(cw + tp * 5632 + ja), x1 = *(const float4*)(cw + tp * 5632 + ja + 4);
          const float4 y0 = *(const float4*)(cw + tp * 5632 + 2816 + ja), y1 = *(const float4*)(cw + tp * 5632 + 2816 + ja + 4);
          wa[tp][0] = x0.x; wa[tp][1] = x0.y; wa[tp][2] = x0.z; wa[tp][3] = x0.w; wa[tp][4] = x1.x; wa[tp][5] = x1.y; wa[tp][6] = x1.z; wa[tp][7] = x1.w;
          wg[tp][0] = y0.x; wg[tp][1] = y0.y; wg[tp][2] = y0.z; wg[tp][3] = y0.w; wg[tp][4] = y1.x; wg[tp][5] = y1.y; wg[tp][6] = y1.z; wg[tp][7] = y1.w;
        }
        {
          const float4 x0 = *(const float4*)(cb + ja), x1 = *(const float4*)(cb + ja + 4);
          const float4 y0 = *(const float4*)(cb + 2816 + ja), y1 = *(const float4*)(cb + 2816 + ja + 4);
          ba[0] = x0.x; ba[1] = x0.y; ba[2] = x0.z; ba[3] = x0.w; ba[4] = x1.x; ba[5] = x1.y; ba[6] = x1.z; ba[7] = x1.w;
          bg[0] = y0.x; bg[1] = y0.y; bg[2] = y0.z; bg[3] = y0.w; bg[4] = y1.x; bg[5] = y1.y; bg[6] = y1.z; bg[7] = y1.w;
        }
#pragma unroll 1
        for (int i = 0; i < 6; ++i) {
          const int rr = 1 + rs + 32 * i;
          const int t = trow0 + rr;
          if (rr <= 190 && t < NT) {
            const bool start = (t < NTP) ? ((t & 255) == 0) : ((t & 2047) == 0);
            const bool endd = (t < NTP) ? ((t & 255) == 255) : ((t & 2047) == 2047);
            u32x4 am = *(const u32x4*)(Ct + (rr - 1) * 128 + ((c8 ^ ((rr - 1) & 15)) << 3));
            u32x4 gm = *(const u32x4*)(Ct + (rr - 1) * 128 + (((8 + c8) ^ ((rr - 1) & 15)) << 3));
            const u32x4 a0 = *(const u32x4*)(Ct + rr * 128 + ((c8 ^ (rr & 15)) << 3));
            const u32x4 g0 = *(const u32x4*)(Ct + rr * 128 + (((8 + c8) ^ (rr & 15)) << 3));
            u32x4 ap = *(const u32x4*)(Ct + (rr + 1) * 128 + ((c8 ^ ((rr + 1) & 15)) << 3));
            u32x4 gp = *(const u32x4*)(Ct + (rr + 1) * 128 + (((8 + c8) ^ ((rr + 1) & 15)) << 3));
            if (start) { am = (u32x4){0, 0, 0, 0}; gm = (u32x4){0, 0, 0, 0}; }
            if (endd) { ap = (u32x4){0, 0, 0, 0}; gp = (u32x4){0, 0, 0, 0}; }
            u32x4 ov;
#pragma unroll
            for (int e2 = 0; e2 < 4; ++e2) {
              float res[2];
#pragma unroll
              for (int hl = 0; hl < 2; ++hl) {
                const int e = e2 * 2 + hl;
                const float av = wa[0][e] * (hl ? bfhi(am[e2]) : bflo(am[e2])) + wa[1][e] * (hl ? bfhi(a0[e2]) : bflo(a0[e2])) +
                                 wa[2][e] * (hl ? bfhi(ap[e2]) : bflo(ap[e2])) + ba[e];
                const float gv = wg[0][e] * (hl ? bfhi(gm[e2]) : bflo(gm[e2])) + wg[1][e] * (hl ? bfhi(g0[e2]) : bflo(g0[e2])) +
                                 wg[2][e] * (hl ? bfhi(gp[e2]) : bflo(gp[e2])) + bg[e];
                res[hl] = siluf_(gv) * av;
              }
              ov[e2] = pk2(res[0], res[1]);
            }
            *(u32x4*)((bh*)Cv + (size_t)t * 2816 + ja) = ov;
          }
        }
      }
    }
#pragma unroll
    for (int m = 0; m < MT; ++m)
#pragma unroll
      for (int n = 0; n < 4; ++n) {
        if (OUT_BF16 == 1 || OUT_BF16 == 3) continue;
        int col = nt * 128 + wc * 64 + n * 16 + r;
        const size_t rowb = (size_t)mt * BM + wr * (BM / 2) + m * 16 + g * 4;
        if (OUT_BF16 == 2 && nt >= 20) {
          bh* hyt = (bh*)((char*)Cv + OFF_HYT) + (size_t)(col - 2560) * NT + rowb;
          u32x2 pv;
          pv[0] = pk2(acc[m][n][0], acc[m][n][1]);
          pv[1] = pk2(acc[m][n][2], acc[m][n][3]);
          *(u32x2*)hyt = pv;
        } else if (col < N) {
#pragma unroll
          for (int j = 0; j < 4; ++j) {
            size_t row = rowb + j;
            if (OUT_BF16) ((bh*)Cv)[row * ldc + col] = f2bf(acc[m][n][j]);
            else ((float*)Cv)[row * ldc + col] = acc[m][n][j];
          }
        }
      }
  }
}

__device__ __forceinline__ void convert_tile(const float* __restrict__ W, int K, int N, bh* __restrict__ WT, int tile, char* smem, bool perm = false) {
  float* tl = (float*)smem;
  int tid_l_ = threadIdx.x; asm volatile("" : "+v"(tid_l_)); const int tid = tid_l_;
  const int ntk = K >> 6;
  const int kt = tile % ntk, ntile = tile / ntk;
  __syncthreads();
#pragma unroll
  for (int i = 0; i < 16; ++i) {
    int e = tid + i * 256, kk = e >> 6, nn = e & 63, n = ntile * 64 + nn;
    tl[kk * 65 + nn] = (n < N) ? __builtin_nontemporal_load(W + (size_t)(kt * 64 + kk) * N + n) : 0.f;
  }
  __syncthreads();
#pragma unroll
  for (int i = 0; i < 16; ++i) {
    int e = tid + i * 256, nn = e >> 6, kk = e & 63;
    const int orow = perm ? (ntile % 44) * 128 + (ntile / 44) * 64 + nn : ntile * 64 + nn;
    WT[(size_t)orow * K + kt * 64 + kk] = f2bf(tl[kk * 65 + nn]);
  }
}

__device__ __forceinline__ void gemv_job(const Params& p, int job, char* smem) {
  float* sc = (float*)smem;
  float* rd = sc + 768;
  int tid_l_ = threadIdx.x; asm volatile("" : "+v"(tid_l_)); const int tid = tid_l_;
  const int iq = job & 3, jb = (job >> 2) % 96, l = (job >> 2) / 96;
  __syncthreads();
  for (int i = tid; i < 768; i += 256) {
    int r = i >> 8, idx = iq * 256 + (i & 255);
    float v = (r == 0) ? p.c_ctx[idx] : p.c[(r - 1) * 1024 + idx];
    sc[i] = siluf_(v);
  }
  __syncthreads();
  const int jl = tid & 63, ig = tid >> 6, j = jb * 64 + jl;
  const float* W = p.ada_w + (size_t)l * 1024 * 6144 + (size_t)(iq * 256 + ig * 64) * 6144 + j;
  float a0 = 0.f, a1 = 0.f, a2 = 0.f;
#pragma unroll 16
  for (int i = 0; i < 64; ++i) {
    float wv = __builtin_nontemporal_load(W + (size_t)i * 6144);
    a0 += sc[ig * 64 + i] * wv;
    a1 += sc[256 + ig * 64 + i] * wv;
    a2 += sc[512 + ig * 64 + i] * wv;
  }
  rd[(ig * 3 + 0) * 64 + jl] = a0;
  rd[(ig * 3 + 1) * 64 + jl] = a1;
  rd[(ig * 3 + 2) * 64 + jl] = a2;
  __syncthreads();
  if (tid < 192) {
    int r = tid >> 6, jl2 = tid & 63, j2 = jb * 64 + jl2;
    float sacc = (iq == 0) ? p.ada_b[l * 6144 + j2] : 0.f;
    for (int q = 0; q < 4; ++q) sacc += rd[(q * 3 + r) * 64 + jl2];
    atomicAdd(p.mod + (size_t)(l * 3 + r) * 6144 + j2, sacc);
  }
}

__device__ __forceinline__ void filter_job(const Params& p, int job, char* smem) {
  float* sh2 = (float*)smem;
  int tid_l_ = threadIdx.x; asm volatile("" : "+v"(tid_l_)); const int tid = tid_l_, lane = tid & 63, w = tid >> 6;
  int L, pos0;
  bh* gt;
  if (job < 64) { L = 256; pos0 = job * 4; gt = p.gt256; }
  else { L = 2048; pos0 = (job - 64) * 4; gt = p.gt2048; }
  __syncthreads();
  {
    const int pos = pos0 + w;
    const float t = (float)pos / (float)(L - 1);
    const float wv = 2.0f * 3.14159265358979323846f * (float)pos / (float)L;
    float zv = 0.f;
    if (lane == 0) zv = t;
    else if (lane <= 16) { float fb = 1e-4f + (float)(lane - 1) * ((15.0f - 1e-4f) / 15.0f); zv = cosf(fb * wv); }
    else if (lane <= 32) { float fb = 1e-4f + (float)(lane - 17) * ((15.0f - 1e-4f) / 15.0f); zv = -sinf(fb * wv); }
    const float fr = p.hy_freq[lane];
    float a = p.hy_b1[lane];
    for (int i = 0; i < 33; ++i) a += __shfl(zv, i) * p.hy_w1[i * 64 + lane];
    const float h1 = sinf(fr * a);
    a = p.hy_b2[lane];
    for (int i = 0; i < 64; ++i) a += __shfl(h1, i) * p.hy_w2[i * 64 + lane];
    sh2[w * 64 + lane] = sinf(fr * a);
  }
  __syncthreads();
  float acc[8][4];
#pragma unroll
  for (int m = 0; m < 8; ++m)
#pragma unroll
    for (int pp = 0; pp < 4; ++pp) acc[m][pp] = 0.f;
#pragma unroll 8
  for (int i = 0; i < 64; ++i) {
    const float h0 = sh2[i], h1 = sh2[64 + i], h2 = sh2[128 + i], h3 = sh2[192 + i];
#pragma unroll
    for (int m = 0; m < 8; ++m) {
      const float wv = p.hy_w3[i * 2048 + tid + 256 * m];
      acc[m][0] += wv * h0; acc[m][1] += wv * h1; acc[m][2] += wv * h2; acc[m][3] += wv * h3;
    }
  }
  const float min_decay = logf(1e-2f) / 1.5f, max_decay = logf(1e-2f) / 0.3f;
#pragma unroll
  for (int m = 0; m < 8; ++m) {
    const int o = tid + 256 * m;
    const int ord = o >> 10, side = (o >> 9) & 1, c = o & 511;
    const float delta = fabsf(min_decay + (float)c * ((max_decay - min_decay) / 511.0f));
    bh* grow = gt + (size_t)(ord * 512 + c) * (2 * L);
#pragma unroll
    for (int pp = 0; pp < 4; ++pp) {
      const int pos = pos0 + pp;
      const float t = (float)pos / (float)(L - 1);
      const bh val = f2bf(acc[m][pp] * expf(-t * delta));
      if (side == 0) grow[L - 1 - pos] = val;
      else if (pos >= 1) grow[L - 1 + pos] = val;
    }
  }
}

__device__ __forceinline__ void rows_job(const Params& p, int job, bool first, const bh* src, const float* gres, int lgate, int gate_idx,
                         const float* gnext, int lnext, int shift_idx) {
  int tid_l_ = threadIdx.x; asm volatile("" : "+v"(tid_l_)); const int tid = tid_l_, lane = tid & 63, w = tid >> 6;
  const int rowb = job * 16 + w * 4;
  const int r = rowb < NTP ? 0 : 1 + ((rowb - NTP) >> 11);
  float4 y[4][4], m[4][4];
#pragma unroll
  for (int rr = 0; rr < 4; ++rr) {
    const int row = rowb + rr;
    const float* xin = first ? (row < NTP ? p.x_prompt + (size_t)row * 1024 : p.x_sample + (size_t)(row - NTP) * 1024)
                             : p.out + (size_t)row * 1024;
#pragma unroll
    for (int i = 0; i < 4; ++i) y[rr][i] = *(const float4*)(xin + i * 256 + lane * 4);
    if (src) {
#pragma unroll
      for (int i = 0; i < 4; ++i) { const u32x2 mv = *(const u32x2*)(src + (size_t)row * 1024 + i * 256 + lane * 4); m[rr][i] = make_float4(bflo(mv[0]), bfhi(mv[0]), bflo(mv[1]), bfhi(mv[1])); }
    }
  }
  if (src) {
    const float* gate = p.mod + (size_t)(lgate * 3 + r) * 6144 + gate_idx * 1024;
    float4 gg[4], gt[4];
#pragma unroll
    for (int i = 0; i < 4; ++i) {
      gg[i] = *(const float4*)(gres + i * 256 + lane * 4);
      gt[i] = *(const float4*)(gate + i * 256 + lane * 4);
    }
#pragma unroll
    for (int rr = 0; rr < 4; ++rr) {
      float ss = 0.f;
#pragma unroll
      for (int i = 0; i < 4; ++i)
        ss += m[rr][i].x * m[rr][i].x + m[rr][i].y * m[rr][i].y + m[rr][i].z * m[rr][i].z + m[rr][i].w * m[rr][i].w;
      ss = wave_sum(ss);
      const float rs = rsqrtf(ss * (1.f / 1024.f) + EPSF);
#pragma unroll
      for (int i = 0; i < 4; ++i) {
        y[rr][i].x += gt[i].x * (m[rr][i].x * rs * gg[i].x);
        y[rr][i].y += gt[i].y * (m[rr][i].y * rs * gg[i].y);
        y[rr][i].z += gt[i].z * (m[rr][i].z * rs * gg[i].z);
        y[rr][i].w += gt[i].w * (m[rr][i].w * rs * gg[i].w);
      }
    }
  }
  if (src) {
#pragma unroll
    for (int rr = 0; rr < 4; ++rr)
#pragma unroll
      for (int i = 0; i < 4; ++i) __builtin_nontemporal_store((f32x4){y[rr][i].x, y[rr][i].y, y[rr][i].z, y[rr][i].w}, (f32x4*)(p.out + (size_t)(rowb + rr) * 1024 + i * 256 + lane * 4));
  }
  if (gnext) {
    const float* sh = p.mod + (size_t)(lnext * 3 + r) * 6144 + shift_idx * 1024;
    const float* scl = sh + 1024;
    float4 gg[4], s4[4], c4[4];
#pragma unroll
    for (int i = 0; i < 4; ++i) {
      gg[i] = *(const float4*)(gnext + i * 256 + lane * 4);
      s4[i] = *(const float4*)(sh + i * 256 + lane * 4);
      c4[i] = *(const float4*)(scl + i * 256 + lane * 4);
    }
#pragma unroll
    for (int rr = 0; rr < 4; ++rr) {
      float ss = 0.f;
#pragma unroll
      for (int i = 0; i < 4; ++i)
        ss += y[rr][i].x * y[rr][i].x + y[rr][i].y * y[rr][i].y + y[rr][i].z * y[rr][i].z + y[rr][i].w * y[rr][i].w;
      ss = wave_sum(ss);
      const float rs = rsqrtf(ss * (1.f / 1024.f) + EPSF);
      bh* arow = p.act + (size_t)(rowb + rr) * 1024;
#pragma unroll
      for (int i = 0; i < 4; ++i) {
        ushort4 o;
        o.x = f2bf(y[rr][i].x * rs * gg[i].x * (1.f + c4[i].x) + s4[i].x);
        o.y = f2bf(y[rr][i].y * rs * gg[i].y * (1.f + c4[i].y) + s4[i].y);
        o.z = f2bf(y[rr][i].z * rs * gg[i].z * (1.f + c4[i].z) + s4[i].z);
        o.w = f2bf(y[rr][i].w * rs * gg[i].w * (1.f + c4[i].w) + s4[i].w);
        *(ushort4*)(arow + i * 256 + lane * 4) = o;
      }
    }
  }
}

template <int CTRL>
__device__ __forceinline__ float dppf(float v) {
  return __int_as_float(__builtin_amdgcn_update_dpp(0, __float_as_int(v), CTRL, 0xF, 0xF, true));
}
__device__ __forceinline__ float sum16(float v) {
  v += dppf<0xB1>(v); v += dppf<0x4E>(v); v += dppf<0x141>(v); v += dppf<0x140>(v);
  return v;
}
__device__ __forceinline__ float max16(float v) {
  v = fmaxf(v, dppf<0xB1>(v)); v = fmaxf(v, dppf<0x4E>(v)); v = fmaxf(v, dppf<0x141>(v)); v = fmaxf(v, dppf<0x140>(v));
  return v;
}

typedef short s16x4 __attribute__((ext_vector_type(4)));

#define OFF_SC_EVEN 188743680ull
#define OFF_SC_ODD 79691776ull
#define SC_SLOC 8388608ull
#define SC_DECT 16777216ull

template <int MODE, int SKIP = 0>
__device__ __forceinline__ void scan2_unit(const Params& p, int unit, char* smem) {
  constexpr int DK = MODE == 0 ? 128 : 64;
  constexpr int LD = MODE == 0 ? 4096 : 3104;
  constexpr int NQ = DK / 32;
  constexpr int NP = 256 / DK;
  constexpr int TPP = 16 / NP;
  constexpr int RS = DK + 8;
  constexpr int TPT = DK / 8;
  float* sq = (float*)smem;
  float* slf = sq + 16 * DK;
  float* skk = slf + 16 * DK;
  bh* QE = (bh*)(skk + 16 * DK);
  bh* KE = QE + 16 * RS;
  bh* KLT = KE + 16 * RS;
  bh* VT = KLT + DK * 24;
  float* dec = (float*)(VT + 128 * 24);
  float* sx = dec + DK;
  int tid_l_ = threadIdx.x; asm volatile("" : "+v"(tid_l_)); const int tid = tid_l_, lane = tid & 63, w = tid >> 6, r = lane & 15, g = lane >> 4;
  const int dir = unit & 1, h = (unit >> 1) & 3, ss = unit >> 3;
  const bool samp = ss >= 32;
  const int sb = (ss - 32) >> 3, seg = (ss - 32) & 7;
  const int rbase = samp ? (NTP + sb * 2048 + (dir ? 2047 - seg * 256 : seg * 256)) : (ss * 256 + (dir ? 255 : 0));
  const int sgn = dir ? -1 : 1;
  const bh* proj = (const bh*)p.R;
  char* scbase = p.R + (MODE == 0 ? OFF_SC_EVEN : OFF_SC_ODD);
  bh* QB = (bh*)scbase;
  float* odir = (float*)(p.R + OFF_ODIR) + (size_t)dir * NT * 512;
  __syncthreads();
  if (MODE == 0) {
    for (int k = tid; k < 128; k += 256) {
      int ci = dir * 512 + h * 128 + k;
      float x0 = p.hgrn_lb[ci], x1 = p.hgrn_lb[1024 + ci], x2 = p.hgrn_lb[2048 + ci];
      float mx = fmaxf(x0, fmaxf(x1, x2));
      float e0 = expf(x0 - mx), e1 = expf(x1 - mx), e2 = expf(x2 - mx);
      sx[k] = e0 / (e0 + e1 + e2);
    }
  } else {
    for (int i = tid; i < 1024; i += 256) {
      int rr = i >> 6, k = i & 63;
      sx[i] = p.gla_aw[(size_t)(dir * 16 + rr) * 256 + h * 64 + k];
    }
    if (tid < 64) sx[1024 + tid] = p.gla_ab[dir * 256 + h * 64 + tid];
  }
  f32x4 S[2 * NQ][2];
#pragma unroll
  for (int a = 0; a < 2 * NQ; ++a) { S[a][0] = (f32x4){0.f, 0.f, 0.f, 0.f}; S[a][1] = (f32x4){0.f, 0.f, 0.f, 0.f}; }
  constexpr int EPT = MODE == 0 ? 8 : 4;
  const int li = tid >> 4, lk8 = (tid & 15) * EPT;
  const int vi = tid >> 4, v8 = (tid & 15) * 8;
  const int pk = tid % DK, ppart = tid / DK;
  float basec = 0.f;
  u32x4 rq = {0, 0, 0, 0}, rf = {0, 0, 0, 0}, rv = {0, 0, 0, 0}, rd0 = {0, 0, 0, 0}, rd1 = {0, 0, 0, 0};
  auto issue = [&](int c) {
    {
      const bh* pr = proj + (size_t)(rbase + sgn * (c * 16 + li)) * LD;
      if (MODE == 0) {
        rq = *(const u32x4*)(pr + h * 128 + lk8);
        rf = *(const u32x4*)(pr + 512 + dir * 512 + h * 128 + lk8);
      } else {
        const u32x2 q2 = *(const u32x2*)(pr + 1536 + h * 64 + lk8);
        const u32x2 k2 = *(const u32x2*)(pr + 1792 + h * 64 + lk8);
        rq[0] = q2[0]; rq[1] = q2[1]; rf[0] = k2[0]; rf[1] = k2[1];
        rd0 = *(const u32x4*)(pr + 3072 + dir * 16);
        rd1 = *(const u32x4*)(pr + 3072 + dir * 16 + 8);
      }
    }
    {
      const bh* pr = proj + (size_t)(rbase + sgn * (c * 16 + vi)) * LD;
      rv = *(const u32x4*)(pr + (MODE == 0 ? 1536 : 2048) + h * 128 + v8);
    }
  };
  issue(0);
#pragma unroll 1
  for (int c = 0; c < 16; ++c) {
    __syncthreads();
    if (SKIP != 3) {
      float oq[EPT], ol[EPT], ok[EPT];
      if (MODE == 0) {
#pragma unroll
        for (int e = 0; e < EPT; ++e) {
          float q = (e & 1) ? bfhi(rq[e >> 1]) : bflo(rq[e >> 1]);
          float ff = (e & 1) ? bfhi(rf[e >> 1]) : bflo(rf[e >> 1]);
          float lb = sx[lk8 + e];
          float f = lb + (1.f - lb) * sigmoidf_(ff);
          oq[e] = siluf_(q) * 0.08838834764831845f;
          ol[e] = __logf(f);
          ok[e] = 1.f - f;
        }
      } else {
        float da[16];
#pragma unroll
        for (int rr = 0; rr < 16; ++rr) {
          unsigned wd = rr < 8 ? rd0[(rr & 7) >> 1] : rd1[(rr & 7) >> 1];
          da[rr] = (rr & 1) ? bfhi(wd) : bflo(wd);
        }
        float xx[4];
        {
          float4 b0_ = *(const float4*)(sx + 1024 + lk8);
          xx[0] = b0_.x; xx[1] = b0_.y; xx[2] = b0_.z; xx[3] = b0_.w;
        }
#pragma unroll
        for (int rr = 0; rr < 16; ++rr) {
          float4 a0_ = *(const float4*)(sx + rr * 64 + lk8);
          xx[0] += da[rr] * a0_.x; xx[1] += da[rr] * a0_.y; xx[2] += da[rr] * a0_.z; xx[3] += da[rr] * a0_.w;
        }
#pragma unroll
        for (int e = 0; e < 4; ++e) {
          float q = (e & 1) ? bfhi(rq[e >> 1]) : bflo(rq[e >> 1]);
          float kk = (e & 1) ? bfhi(rf[e >> 1]) : bflo(rf[e >> 1]);
          float x = xx[e];
          float ls = fminf(x, 0.f) - __logf(1.f + __expf(-fabsf(x)));
          oq[e] = q * 0.125f;
          ol[e] = ls * 0.0625f;
          ok[e] = kk;
        }
      }
      float* dq_ = sq + li * DK + lk8;
      float* dl_ = slf + li * DK + lk8;
      float* dk_ = skk + li * DK + lk8;
#pragma unroll
      for (int e4 = 0; e4 < EPT; e4 += 4) {
        *(float4*)(dq_ + e4) = make_float4(oq[e4], oq[e4 + 1], oq[e4 + 2], oq[e4 + 3]);
        *(float4*)(dl_ + e4) = make_float4(ol[e4], ol[e4 + 1], ol[e4 + 2], ol[e4 + 3]);
        *(float4*)(dk_ + e4) = make_float4(ok[e4], ok[e4 + 1], ok[e4 + 2], ok[e4 + 3]);
      }
    }
#pragma unroll
    for (int e = 0; e < 8; ++e) {
      unsigned wv = rv[e >> 1];
      VT[(v8 + e) * 24 + vi] = (bh)((e & 1) ? (wv >> 16) : (wv & 0xffffu));
    }
    __syncthreads();
    if (c + 1 < 16) issue(c + 1);
    {
      float total = 0.f, pre = 0.f;
#pragma unroll
      for (int i = 0; i < 16; ++i) {
        float l = slf[i * DK + pk];
        if (i < ppart * TPP) pre += l;
        total += l;
      }
      unsigned kw[TPP / 2];
#pragma unroll
      for (int ii = 0; ii < TPP; ii += 2) {
        float klv[2];
#pragma unroll
        for (int u = 0; u < 2; ++u) {
          const int i = ppart * TPP + ii + u;
          pre += slf[i * DK + pk];
          const float qv = sq[i * DK + pk], kv = skk[i * DK + pk];
          QE[i * RS + pk] = f2bf(qv * __expf(pre));
          KE[i * RS + pk] = f2bf(kv * __expf(-pre));
          klv[u] = kv * __expf(total - pre);
          if (samp) {
            const int row = rbase + sgn * (c * 16 + i);
            QB[((size_t)dir * 4096 + (row - NTP)) * (4 * DK) + h * DK + pk] = f2bf(qv * __expf(basec + pre));
          }
        }
        kw[ii >> 1] = pk2(klv[0], klv[1]);
      }
      if (TPP == 8) {
        u32x4 kv4 = {kw[0], kw[1], kw[(TPP / 2) > 2 ? 2 : 0], kw[(TPP / 2) > 3 ? 3 : 0]};
        *(u32x4*)(KLT + pk * 24 + ppart * 8) = kv4;
      } else {
        u32x2 kv2 = {kw[0], kw[1]};
        *(u32x2*)(KLT + pk * 24 + ppart * 4) = kv2;
      }
      if (ppart == 0) dec[pk] = __expf(total);
      basec += total;
    }
    __syncthreads();
    {
      bf16x8 qf[NQ], kf[NQ];
#pragma unroll
      for (int q = 0; q < NQ; ++q) {
        qf[q] = *(const bf16x8*)(QE + r * RS + q * 32 + g * 8);
        kf[q] = *(const bf16x8*)(KE + r * RS + q * 32 + g * 8);
      }
      f32x4 at = (f32x4){0.f, 0.f, 0.f, 0.f};
#pragma unroll
      for (int q = 0; q < NQ; ++q) at = __builtin_amdgcn_mfma_f32_16x16x32_bf16(kf[q], qf[q], at, 0, 0, 0);
      u32x2 paw;
      paw[0] = pk2((g * 4 + 0 <= r) ? at[0] : 0.f, (g * 4 + 1 <= r) ? at[1] : 0.f);
      paw[1] = pk2((g * 4 + 2 <= r) ? at[2] : 0.f, (g * 4 + 3 <= r) ? at[3] : 0.f);
      const s16x4 pa = __builtin_bit_cast(s16x4, paw);
      s16x4 vf[2];
      f32x4 o[2];
#pragma unroll
      for (int nt = 0; nt < 2; ++nt) {
        vf[nt] = *(const s16x4*)(VT + (w * 32 + nt * 16 + r) * 24 + g * 4);
        o[nt] = __builtin_amdgcn_mfma_f32_16x16x16bf16_1k(pa, vf[nt], (f32x4){0.f, 0.f, 0.f, 0.f}, 0, 0, 0);
      }
#pragma unroll
      for (int q = 0; q < NQ; ++q) {
#pragma unroll
        for (int half = 0; half < 2; ++half) {
          const s16x4 qa = half == 0 ? __builtin_shufflevector(qf[q], qf[q], 0, 1, 2, 3)
                                     : __builtin_shufflevector(qf[q], qf[q], 4, 5, 6, 7);
#pragma unroll
          for (int nt = 0; nt < 2; ++nt) {
            const f32x4 sv_ = S[2 * q + half][nt];
            u32x2 sw;
            sw[0] = pk2(sv_[0], sv_[1]);
            sw[1] = pk2(sv_[2], sv_[3]);
            o[nt] = __builtin_amdgcn_mfma_f32_16x16x16bf16_1k(qa, __builtin_bit_cast(s16x4, sw), o[nt], 0, 0, 0);
          }
        }
      }
#pragma unroll
      for (int nt = 0; nt < 2; ++nt)
#pragma unroll
        for (int j = 0; j < 4; ++j) {
          const int row = rbase + sgn * (c * 16 + g * 4 + j);
          odir[(size_t)row * 512 + h * 128 + w * 32 + nt * 16 + r] = o[nt][j];
        }
#pragma unroll
      for (int q = 0; q < NQ; ++q) {
#pragma unroll
        for (int half = 0; half < 2; ++half) {
          const float4 d4 = *(const float4*)(dec + q * 32 + g * 8 + half * 4);
          const int ka = q * 32 + (r >> 2) * 8 + half * 4 + (r & 3);
          const s16x4 ka4 = *(const s16x4*)(KLT + ka * 24 + g * 4);
#pragma unroll
          for (int nt = 0; nt < 2; ++nt) {
            f32x4 sv_ = S[2 * q + half][nt];
            sv_[0] *= d4.x; sv_[1] *= d4.y; sv_[2] *= d4.z; sv_[3] *= d4.w;
            S[2 * q + half][nt] = __builtin_amdgcn_mfma_f32_16x16x16bf16_1k(ka4, vf[nt], sv_, 0, 0, 0);
          }
        }
      }
    }
  }
  {
    float* so;
    if (!samp) so = p.out + (MODE == 0 ? OUT_HGRN : OUT_GLA) + ((size_t)(ss * 2 + dir) * 4 + h) * DK * 128;
    else {
      const int us = ((sb * 4 + h) * 2 + dir) * 8 + seg;
      so = (float*)(scbase + SC_SLOC) + (size_t)us * DK * 128;
      if (ppart == 0) ((float*)(scbase + SC_DECT))[us * DK + pk] = __expf(basec);
    }
#pragma unroll
    for (int q = 0; q < NQ; ++q)
#pragma unroll
      for (int half = 0; half < 2; ++half)
#pragma unroll
        for (int nt = 0; nt < 2; ++nt)
#pragma unroll
          for (int j = 0; j < 4; ++j)
            so[(size_t)(q * 32 + g * 8 + half * 4 + j) * 128 + w * 32 + nt * 16 + r] = S[2 * q + half][nt][j];
  }
}

template <int MODE>
__device__ __forceinline__ void fixup_unit(const Params& p, int unit, char* smem) {
  constexpr int DK = MODE == 0 ? 128 : 64;
  constexpr int NQ = DK / 32;
  constexpr int RS = DK + 8;
  bh* ST = (bh*)smem;
  int tid_l_ = threadIdx.x; asm volatile("" : "+v"(tid_l_)); const int tid = tid_l_, lane = tid & 63, w = tid >> 6, r = lane & 15, g = lane >> 4;
  const int seg = unit & 7, dir = (unit >> 3) & 1, h = (unit >> 4) & 3, sb = unit >> 6;
  const int unit0 = unit & ~7;
  char* scbase = p.R + (MODE == 0 ? OFF_SC_EVEN : OFF_SC_ODD);
  const bh* QB = (const bh*)scbase;
  const float* SLOC = (const float*)(scbase + SC_SLOC);
  const float* DECT = (const float*)(scbase + SC_DECT);
  const float* s0 = (MODE == 0 ? p.state_hgrn : p.state_gla) + ((size_t)(sb * 2 + dir) * 4 + h) * DK * 128;
  float* odir = (float*)(p.R + OFF_ODIR) + (size_t)dir * NT * 512;
  __syncthreads();
  for (int m = 0; m < DK * 128 / 256; ++m) {
    const int e = tid + 256 * m, k = e >> 7, v = e & 127;
    float cur = s0[e];
    for (int jj = 0; jj < seg; ++jj)
      cur = DECT[(unit0 + jj) * DK + k] * cur + SLOC[(size_t)(unit0 + jj) * DK * 128 + e];
    ST[v * RS + k] = f2bf(cur);
  }
  __syncthreads();
  const int rbase = NTP + sb * 2048 + (dir ? 2047 - seg * 256 : seg * 256);
  const int sgn = dir ? -1 : 1;
#pragma unroll 1
  for (int mt = 0; mt < 4; ++mt) {
    f32x4 acc[8];
#pragma unroll
    for (int nt = 0; nt < 8; ++nt) acc[nt] = (f32x4){0.f, 0.f, 0.f, 0.f};
    const int rowa = rbase + sgn * (w * 64 + mt * 16 + r);
    const bh* qrow = QB + ((size_t)dir * 4096 + (rowa - NTP)) * (4 * DK) + h * DK + g * 8;
#pragma unroll
    for (int q = 0; q < NQ; ++q) {
      const bf16x8 a = *(const bf16x8*)(qrow + q * 32);
#pragma unroll
      for (int nt = 0; nt < 8; ++nt) {
        const bf16x8 b = *(const bf16x8*)(ST + (nt * 16 + r) * RS + q * 32 + g * 8);
        acc[nt] = __builtin_amdgcn_mfma_f32_16x16x32_bf16(a, b, acc[nt], 0, 0, 0);
      }
    }
#pragma unroll
    for (int nt = 0; nt < 8; ++nt)
#pragma unroll
      for (int j = 0; j < 4; ++j) {
        const int row = rbase + sgn * (w * 64 + mt * 16 + g * 4 + j);
        float* dst = odir + (size_t)row * 512 + h * 128 + nt * 16 + r;
        *dst += acc[nt][j];
      }
  }
}

__device__ __forceinline__ void scan_final_job(const Params& p, int job, int mode) {
  int tid_l_ = threadIdx.x; asm volatile("" : "+v"(tid_l_)); const int tid = tid_l_, lane = tid & 63, w = tid >> 6;
  const int rowb = job * 8 + w * 2;
  const int ld = mode == 0 ? 4096 : 3104;
  const int gcol = mode == 0 ? 2048 : 2560;
  const float* nrm = mode == 0 ? p.hgrn_norm : p.gla_norm;
  float2 a[2][4], b[2][4];
  unsigned gw[2][4];
#pragma unroll
  for (int rr = 0; rr < 2; ++rr) {
    const int row = rowb + rr;
    const float* o0 = (const float*)(p.R + OFF_ODIR) + (size_t)row * 512;
    const float* o1 = o0 + (size_t)NT * 512;
    const bh* proj = (const bh*)p.R + (size_t)row * ld;
#pragma unroll
    for (int h = 0; h < 4; ++h) {
      const int c = h * 128 + lane * 2;
      a[rr][h] = *(const float2*)(o0 + c);
      b[rr][h] = *(const float2*)(o1 + c);
      gw[rr][h] = *(const unsigned*)(proj + gcol + c);
    }
  }
  float2 nv[4];
#pragma unroll
  for (int h = 0; h < 4; ++h) nv[h] = *(const float2*)(nrm + h * 128 + lane * 2);
#pragma unroll
  for (int rr = 0; rr < 2; ++rr) {
    bh* arow = p.act + (size_t)(rowb + rr) * 1024 + (mode == 0 ? 0 : 512);
#pragma unroll
    for (int h = 0; h < 4; ++h) {
      const int c = h * 128 + lane * 2;
      float v0 = a[rr][h].x + b[rr][h].x, v1 = a[rr][h].y + b[rr][h].y;
      float ss = wave_sum(v0 * v0 + v1 * v1);
      float rs = rsqrtf(ss * (1.f / 128.f) + EPSF);
      float g0 = bflo(gw[rr][h]), g1 = bfhi(gw[rr][h]);
      *(unsigned*)(arow + c) = pk2(v0 * rs * nv[h].x * siluf_(g0), v1 * rs * nv[h].y * siluf_(g1));
    }
  }
}

using f32x16 = __attribute__((ext_vector_type(16))) float;
__device__ __forceinline__ bf16x8 toep_frag(const unsigned* Gd, int m0) {
  const int q = m0 >> 1;
  const unsigned sh = (unsigned)(m0 & 1) * 2u;
  const unsigned D0 = Gd[q], D1 = Gd[q + 1], D2 = Gd[q + 2], D3 = Gd[q + 3], D4 = Gd[q + 4];
  u32x4 f;
  f[0] = __builtin_amdgcn_alignbyte(D1, D0, sh);
  f[1] = __builtin_amdgcn_alignbyte(D2, D1, sh);
  f[2] = __builtin_amdgcn_alignbyte(D3, D2, sh);
  f[3] = __builtin_amdgcn_alignbyte(D4, D3, sh);
  return __builtin_bit_cast(bf16x8, f);
}
__device__ __forceinline__ void conv4(const bh* raw, int t, int L, float w0, float w1, float w2, float bb, float* out) {
  const u32x2 x = *(const u32x2*)(raw + t);
  const float xm = t > 0 ? bf2f(raw[t - 1]) : 0.f;
  const float xp = (t + 4 < L) ? bf2f(raw[t + 4]) : 0.f;
  const float x0 = bflo(x[0]), x1 = bfhi(x[0]), x2 = bflo(x[1]), x3 = bfhi(x[1]);
  out[0] = w0 * xm + w1 * x0 + w2 * x1 + bb;
  out[1] = w0 * x0 + w1 * x1 + w2 * x2 + bb;
  out[2] = w0 * x1 + w1 * x2 + w2 * x3 + bb;
  out[3] = w0 * x2 + w1 * x3 + w2 * xp + bb;
}
__device__ __forceinline__ u32x4 conv8(const bh* raw, int t, int L, float w0, float w1, float w2, float bb) {
  const u32x4 x = *(const u32x4*)(raw + t);
  float v[10];
  v[0] = t > 0 ? bf2f(raw[t - 1]) : 0.f;
  v[9] = (t + 8 < L) ? bf2f(raw[t + 8]) : 0.f;
#pragma unroll
  for (int e = 0; e < 4; ++e) { v[1 + 2 * e] = bflo(x[e]); v[2 + 2 * e] = bfhi(x[e]); }
  u32x4 o;
#pragma unroll
  for (int e = 0; e < 4; ++e)
    o[e] = pk2(w0 * v[2 * e] + w1 * v[2 * e + 1] + w2 * v[2 * e + 2] + bb, w0 * v[2 * e + 1] + w1 * v[2 * e + 2] + w2 * v[2 * e + 3] + bb);
  return o;
}

__device__ __forceinline__ void hyena_sample_job(const Params& p, int job, char* smem) {
  int tid_l_ = threadIdx.x; asm volatile("" : "+v"(tid_l_)); const int tid = tid_l_, lane = tid & 63, w = tid >> 6;
  const int col = lane & 31, kh = lane >> 5;
  const int cc = w >> 1, nh = w & 1;
  const int sb = job & 1, c0 = (job >> 1) * 2, c = c0 + cc;
  bh* G = (bh*)(smem + cc * 12288);
  bh* U = G + 4096;
  const unsigned* Gd = (const unsigned*)G;
  const bh* HYT = (const bh*)(p.R + OFF_HYT);
  const int rowoff = NTP + sb * 2048;
  __syncthreads();
  {
    const float vw0 = p.hy_conv_w[c], vw1 = p.hy_conv_w[1536 + c], vw2 = p.hy_conv_w[3072 + c], vb = p.hy_conv_b[c];
    const bh* raw = HYT + (size_t)c * NT + rowoff;
#pragma unroll
    for (int i = 0; i < 2; ++i) {
      const int t0 = (nh * 128 + lane + 64 * i) * 8;
      *(u32x4*)(U + t0) = conv8(raw, t0, 2048, vw0, vw1, vw2, vb);
    }
  }
#pragma unroll 1
  for (int ord = 0; ord < 2; ++ord) {
    {
      const bh* gsrc = p.gt2048 + (size_t)(ord * 512 + c) * 4096;
#pragma unroll
      for (int i = 0; i < 4; ++i) {
        const int e8 = (nh * 256 + lane + 64 * i) * 8;
        *(u32x4*)(G + e8) = *(const u32x4*)(gsrc + e8);
      }
    }
    __syncthreads();
    f32x16 acc;
#pragma unroll
    for (int i = 0; i < 16; ++i) acc[i] = 0.f;
    const int mbase = 2047 - col + kh * 8;
    const int dlo = nh == 0 ? -63 : -31, dhi = nh == 0 ? 31 : 63;
#pragma unroll 2
    for (int d = dlo; d <= dhi; ++d) {
      const bf16x8 a0 = toep_frag(Gd, mbase - d * 32);
      const bf16x8 a1 = toep_frag(Gd, mbase - d * 32 + 16);
      const int s1 = nh * 32 + col - d;
      const bool ok = (unsigned)s1 < 64u;
      const int s1c = ok ? s1 : 0;
      u32x4 b0 = *(const u32x4*)(U + s1c * 32 + kh * 8);
      u32x4 b1 = *(const u32x4*)(U + s1c * 32 + 16 + kh * 8);
      if (!ok) { b0 = (u32x4){0, 0, 0, 0}; b1 = (u32x4){0, 0, 0, 0}; }
      acc = __builtin_amdgcn_mfma_f32_32x32x16_bf16(a0, __builtin_bit_cast(bf16x8, b0), acc, 0, 0, 0);
      acc = __builtin_amdgcn_mfma_f32_32x32x16_bf16(a1, __builtin_bit_cast(bf16x8, b1), acc, 0, 0, 0);
    }
    __syncthreads();
    const int gi = (ord + 1) * 512 + c;
    const float gw0 = p.hy_conv_w[gi], gw1 = p.hy_conv_w[1536 + gi], gw2 = p.hy_conv_w[3072 + gi], gb = p.hy_conv_b[gi];
    const float dd = p.hy_d[ord * 512 + c];
    const bh* graw = HYT + (size_t)gi * NT + rowoff;
#pragma unroll
    for (int rq = 0; rq < 4; ++rq) {
      const int trun = (nh * 32 + col) * 32 + 8 * rq + 4 * kh;
      float gte[4];
      conv4(graw, trun, 2048, gw0, gw1, gw2, gb, gte);
      const u32x2 uo = *(const u32x2*)(U + trun);
      u32x2 zo;
      zo[0] = pk2(gte[0] * (acc[rq * 4 + 0] + bflo(uo[0]) * dd), gte[1] * (acc[rq * 4 + 1] + bfhi(uo[0]) * dd));
      zo[1] = pk2(gte[2] * (acc[rq * 4 + 2] + bflo(uo[1]) * dd), gte[3] * (acc[rq * 4 + 3] + bfhi(uo[1]) * dd));
      *(u32x2*)(U + trun) = zo;
    }
    __syncthreads();
  }
#pragma unroll
  for (int rr = 0; rr < 8; ++rr) {
    const int t = tid + 256 * rr;
    const unsigned z0 = *(const bh*)(smem + 8192 + t * 2);
    const unsigned z1 = *(const bh*)(smem + 12288 + 8192 + t * 2);
    *(unsigned*)(p.act + (size_t)(rowoff + t) * 1024 + 512 + c0) = z0 | (z1 << 16);
  }
}

__device__ __forceinline__ void hyena_prompt_job(const Params& p, int job, char* smem) {
  int tid_l_ = threadIdx.x; asm volatile("" : "+v"(tid_l_)); const int tid = tid_l_, lane = tid & 63, w = tid >> 6;
  const int col = lane & 31, kh = lane >> 5;
  const int cc = w >> 1, th = w & 1;
  const int c0 = job * 2, c = c0 + cc;
  bh* Uall = (bh*)smem;
  bh* Gall = (bh*)(smem + 2 * 32 * 264 * 2);
  bh* U = Uall + cc * 32 * 264;
  const unsigned* Gd = (const unsigned*)(Gall + cc * 512);
  const bh* HYT = (const bh*)(p.R + OFF_HYT);
  __syncthreads();
#pragma unroll 1
  for (int c2 = 0; c2 < 2; ++c2) {
    const int ch = c0 + c2;
    const float vw0 = p.hy_conv_w[ch], vw1 = p.hy_conv_w[1536 + ch], vw2 = p.hy_conv_w[3072 + ch], vb = p.hy_conv_b[ch];
#pragma unroll
    for (int i = 0; i < 4; ++i) {
      const int tg = (tid + 256 * i) * 8, b = tg >> 8, t = tg & 255;
      *(u32x4*)(Uall + c2 * 32 * 264 + b * 264 + t) = conv8(HYT + (size_t)ch * NT + b * 256, t, 256, vw0, vw1, vw2, vb);
    }
  }
#pragma unroll 1
  for (int ord = 0; ord < 2; ++ord) {
    if (tid < 128) {
      const int c2 = tid >> 6, l2 = tid & 63;
      *(u32x4*)(Gall + c2 * 512 + l2 * 8) = *(const u32x4*)(p.gt256 + (size_t)(ord * 512 + c0 + c2) * 512 + l2 * 8);
    }
    __syncthreads();
    f32x16 acc[4];
#pragma unroll
    for (int q = 0; q < 4; ++q)
#pragma unroll
      for (int i = 0; i < 16; ++i) acc[q][i] = 0.f;
    const int mbase = 255 - col + kh * 8;
#pragma unroll
    for (int q = 0; q < 4; ++q) {
      const int t1 = th * 4 + q;
#pragma unroll 2
      for (int s1 = 0; s1 < 8; ++s1) {
        const int d = t1 - s1;
        const bf16x8 a0 = toep_frag(Gd, mbase - d * 32);
        const bf16x8 a1 = toep_frag(Gd, mbase - d * 32 + 16);
        const bf16x8 b0 = *(const bf16x8*)(U + col * 264 + s1 * 32 + kh * 8);
        const bf16x8 b1 = *(const bf16x8*)(U + col * 264 + s1 * 32 + 16 + kh * 8);
        acc[q] = __builtin_amdgcn_mfma_f32_32x32x16_bf16(a0, b0, acc[q], 0, 0, 0);
        acc[q] = __builtin_amdgcn_mfma_f32_32x32x16_bf16(a1, b1, acc[q], 0, 0, 0);
      }
    }
    __syncthreads();
    const int gi = (ord + 1) * 512 + c;
    const float gw0 = p.hy_conv_w[gi], gw1 = p.hy_conv_w[1536 + gi], gw2 = p.hy_conv_w[3072 + gi], gb = p.hy_conv_b[gi];
    const float dd = p.hy_d[ord * 512 + c];
    const bh* graw = HYT + (size_t)gi * NT + col * 256;
#pragma unroll
    for (int q = 0; q < 4; ++q)
#pragma unroll
      for (int rq = 0; rq < 4; ++rq) {
        const int trun = (th * 4 + q) * 32 + 8 * rq + 4 * kh;
        float gte[4];
        conv4(graw, trun, 256, gw0, gw1, gw2, gb, gte);
        bh* up = U + col * 264 + trun;
        const u32x2 uo = *(const u32x2*)up;
        u32x2 zo;
        zo[0] = pk2(gte[0] * (acc[q][rq * 4 + 0] + bflo(uo[0]) * dd), gte[1] * (acc[q][rq * 4 + 1] + bfhi(uo[0]) * dd));
        zo[1] = pk2(gte[2] * (acc[q][rq * 4 + 2] + bflo(uo[1]) * dd), gte[3] * (acc[q][rq * 4 + 3] + bfhi(uo[1]) * dd));
        *(u32x2*)up = zo;
      }
    __syncthreads();
  }
#pragma unroll 4
  for (int i = 0; i < 32; ++i) {
    const int e = tid + 256 * i, b = e >> 8, t = e & 255;
    const unsigned z0 = Uall[b * 264 + t], z1 = Uall[32 * 264 + b * 264 + t];
    *(unsigned*)(p.act + (size_t)e * 1024 + 512 + c0) = z0 | (z1 << 16);
  }
}

__device__ __forceinline__ void oddrow_job(const Params& p, int job) {
  int tid_l_ = threadIdx.x; asm volatile("" : "+v"(tid_l_)); const int tid = tid_l_, lane = tid & 63, w = tid >> 6;
  const int row = job * 4 + w;
  const bh* pr = (const bh*)p.R + (size_t)row * 3104;
  bh* Q = (bh*)(p.R + OFF_Q) + (size_t)row * 512;
  bh* KB = (bh*)(p.R + OFF_KB);
  if (row < NTP) {
    const int b = row >> 8, t = row & 255;
    const int e0 = lane * 8, h = e0 >> 7, x = e0 & 127;
    const u32x4 qv = *(const u32x4*)(pr + e0);
    const u32x4 kv = *(const u32x4*)(pr + 512 + e0);
    const u32x4 vv = *(const u32x4*)(pr + 1024 + e0);
    const size_t idx = ((size_t)(b * 4 + h) * 256 + t) * 128 + x;
    *(u32x4*)(Q + e0) = qv;
    *(u32x4*)(KB + idx) = kv;
    float4 k0 = make_float4(bflo(kv[0]), bfhi(kv[0]), bflo(kv[1]), bfhi(kv[1]));
    float4 k1 = make_float4(bflo(kv[2]), bfhi(kv[2]), bflo(kv[3]), bfhi(kv[3]));
    float4 v0 = make_float4(bflo(vv[0]), bfhi(vv[0]), bflo(vv[1]), bfhi(vv[1]));
    float4 v1 = make_float4(bflo(vv[2]), bfhi(vv[2]), bflo(vv[3]), bfhi(vv[3]));
    __builtin_nontemporal_store((f32x4){k0.x, k0.y, k0.z, k0.w}, (f32x4*)(p.out + OUT_CK + idx));
    __builtin_nontemporal_store((f32x4){k1.x, k1.y, k1.z, k1.w}, (f32x4*)(p.out + OUT_CK + idx + 4));
    __builtin_nontemporal_store((f32x4){v0.x, v0.y, v0.z, v0.w}, (f32x4*)(p.out + OUT_CV + idx));
    __builtin_nontemporal_store((f32x4){v1.x, v1.y, v1.z, v1.w}, (f32x4*)(p.out + OUT_CV + idx + 4));
  } else {
    const int sb = (row - NTP) >> 11, t = (row - NTP) & 2047;
    const int rpos = t >> 6, cpos = t & 63;
    float q1[4], q2[4], k1[4], k2[4];
#pragma unroll
    for (int m = 0; m < 4; ++m) {
      int pi = lane + 64 * m;
      int h = pi >> 6, rem = pi & 63, pp = rem >> 5, part = (rem >> 4) & 1, i = rem & 15;
      int d1 = h * 128 + pp * 64 + part * 32 + i, d2 = d1 + 16;
      q1[m] = bf2f(pr[d1]); q2[m] = bf2f(pr[d2]);
      k1[m] = bf2f(pr[512 + d1]); k2[m] = bf2f(pr[512 + d2]);
    }
#pragma unroll
    for (int m = 0; m < 4; ++m) {
      int pi = lane + 64 * m;
      int h = pi >> 6, rem = pi & 63, pp = rem >> 5, part = (rem >> 4) & 1, i = rem & 15;
      int d1 = h * 128 + pp * 64 + part * 32 + i, d2 = d1 + 16;
      float pos = (float)(part ? cpos : rpos);
      float inv = expf(-(float)i * (9.210340371976184f / 16.f));
      float ang = pos * inv;
      float cs = cosf(ang), sn = sinf(ang);
      Q[d1] = f2bf(q1[m] * cs - q2[m] * sn);
      Q[d2] = f2bf(q1[m] * sn + q2[m] * cs);
      size_t kb = KV_SAMPLE_BASE + ((size_t)(sb * 4 + h) * 2304 + 256 + t) * 128;
      KB[kb + (d1 - h * 128)] = f2bf(k1[m] * cs - k2[m] * sn);
      KB[kb + (d2 - h * 128)] = f2bf(k1[m] * sn + k2[m] * cs);
    }
  }
}
__device__ __forceinline__ void ctxk_job(const Params& p, int job) {
  bh* KB = (bh*)(p.R + OFF_KB);
  int tidl = threadIdx.x; asm volatile("" : "+v"(tidl));
#pragma unroll
  for (int i = 0; i < 4; ++i) {
    int e = job * 1024 + i * 256 + tidl;
    int x = e & 127, j = (e >> 7) & 255, hh = (e >> 15) & 3, sb = e >> 17;
    KB[KV_SAMPLE_BASE + ((size_t)(sb * 4 + hh) * 2304 + j) * 128 + x] = f2bf(p.cache_k[e]);
  }
}
__device__ __forceinline__ void vt_job(const Params& p, int job, char* smem) {
  bh* tl = (bh*)smem;
  int tid_l_ = threadIdx.x; asm volatile("" : "+v"(tid_l_)); const int tid = tid_l_;
  int seq, h, kt, Lk;
  if (job < 288) { seq = 32 + job / 144; int r = job % 144; h = r / 36; kt = r % 36; Lk = 2304; }
  else { int j = job - 288; seq = j >> 4; h = (j >> 2) & 3; kt = j & 3; Lk = 256; }
  const bh* proj = (const bh*)p.R;
  __syncthreads();
#pragma unroll 16
  for (int i = 0; i < 32; ++i) {
    int e = tid + i * 256, key = e >> 7, dv = e & 127;
    bh val;
    if (seq < 32) val = proj[(size_t)(seq * 256 + kt * 64 + key) * 3104 + 1024 + h * 128 + dv];
    else if (kt < 4) val = f2bf(p.cache_v[((size_t)((seq - 32) * 4 + h) * 256 + kt * 64 + key) * 128 + dv]);
    else val = proj[(size_t)(NTP + (seq - 32) * 2048 + (kt - 4) * 64 + key) * 3104 + 1024 + h * 128 + dv];
    tl[key * 130 + dv] = val;
  }
  __syncthreads();
  bh* VT = (bh*)(p.R + OFF_VT) + (seq < 32 ? (size_t)(seq * 4 + h) * 128 * 256
                                            : (size_t)KV_SAMPLE_BASE + (size_t)((seq - 32) * 4 + h) * 128 * 2304);
#pragma unroll 4
  for (int i = 0; i < 32; ++i) {
    int e = tid + i * 256, dv = e >> 6, key = e & 63;
    VT[(size_t)dv * Lk + kt * 64 + key] = tl[key * 130 + dv];
  }
}

__device__ __forceinline__ void attn_unit(const Params& p, int unit, char* smem) {
  bh* Pl = (bh*)smem;
  float* sred = (float*)(smem + 10240);
  int tid_l_ = threadIdx.x; asm volatile("" : "+v"(tid_l_)); const int tid = tid_l_, lane = tid & 63, w = tid >> 6, r = lane & 15, g = lane >> 4;
  int seq, h, qb, Lk;
  if (unit < 256) { seq = 32 + (unit >> 7); h = (unit >> 5) & 3; qb = unit & 31; Lk = 2304; }
  else { int u = unit - 256; seq = u >> 4; h = (u >> 2) & 3; qb = u & 3; Lk = 256; }
  const int row0 = seq < 32 ? seq * 256 : NTP + (seq - 32) * 2048;
  const bh* Q = (const bh*)(p.R + OFF_Q);
  const bh* KB = (const bh*)(p.R + OFF_KB) + (seq < 32 ? (size_t)(seq * 4 + h) * 256 * 128
                                                       : (size_t)KV_SAMPLE_BASE + (size_t)((seq - 32) * 4 + h) * 2304 * 128);
  const bh* VT = (const bh*)(p.R + OFF_VT) + (seq < 32 ? (size_t)(seq * 4 + h) * 128 * 256
                                                       : (size_t)KV_SAMPLE_BASE + (size_t)((seq - 32) * 4 + h) * 128 * 2304);
  __syncthreads();
  if (tid < 64) {
    float a = p.diff_lambda[tid] * p.diff_lambda[64 + tid];
    float b = p.diff_lambda[128 + tid] * p.diff_lambda[192 + tid];
    a = wave_sum(a); b = wave_sum(b);
    if (tid == 0) sred[0] = expf(a) - expf(b);
  }
  __syncthreads();
  const float lam_init = 0.8f - 0.6f * expf(-0.3f * 1.0f);
  const float lam = sred[0] + lam_init;
  const int qrow = row0 + qb * 64 + w * 16;
  bf16x8 aq[2][2];
#pragma unroll
  for (int pp = 0; pp < 2; ++pp)
#pragma unroll
    for (int kk = 0; kk < 2; ++kk)
      aq[pp][kk] = *(const bf16x8*)(Q + (size_t)(qrow + r) * 512 + h * 128 + pp * 64 + kk * 32 + g * 8);
  float mrun[2][4], lrun[2][4];
  f32x4 O[2][8];
#pragma unroll
  for (int pp = 0; pp < 2; ++pp) {
#pragma unroll
    for (int j = 0; j < 4; ++j) { mrun[pp][j] = -1e30f; lrun[pp][j] = 0.f; }
#pragma unroll
    for (int n = 0; n < 8; ++n) O[pp][n] = (f32x4){0.f, 0.f, 0.f, 0.f};
  }
  bh* Pw = Pl + w * (2 * 16 * 40);
  const float scale = 0.125f;
  bh* Ks = (bh*)(smem + 10752);
  bh* Vs = Ks + 64 * 128;
  u32x4 pk_[4], pv_[4];
  auto tload = [&](int kt) {
#pragma unroll
    for (int i = 0; i < 4; ++i) {
      const int pz = tid + 256 * i;
      pk_[i] = *(const u32x4*)(KB + (size_t)(kt + (pz >> 4)) * 128 + (pz & 15) * 8);
      pv_[i] = *(const u32x4*)(VT + (size_t)(pz >> 3) * Lk + kt + (pz & 7) * 8);
    }
  };
  tload(0);
#pragma unroll 1
  for (int kt = 0; kt < Lk; kt += 64) {
    __syncthreads();
#pragma unroll
    for (int i = 0; i < 4; ++i) {
      const int pz = tid + 256 * i;
      const int key = pz >> 4, ck = pz & 15, dv = pz >> 3, cv = pz & 7;
      *(u32x4*)(Ks + key * 128 + ((ck ^ (key & 15)) << 3)) = pk_[i];
      *(u32x4*)(Vs + dv * 64 + ((cv ^ ((dv >> 1) & 7)) << 3)) = pv_[i];
    }
    __syncthreads();
    if (kt + 64 < Lk) tload(kt + 64);
#pragma unroll
    for (int h2 = 0; h2 < 2; ++h2) {
      f32x4 s[2][2];
#pragma unroll
      for (int sub = 0; sub < 2; ++sub) {
        const int key = h2 * 32 + sub * 16 + r;
#pragma unroll
        for (int pp = 0; pp < 2; ++pp) {
          const bf16x8 b0 = *(const bf16x8*)(Ks + key * 128 + (((pp * 8 + g) ^ (key & 15)) << 3));
          const bf16x8 b1 = *(const bf16x8*)(Ks + key * 128 + (((pp * 8 + 4 + g) ^ (key & 15)) << 3));
          f32x4 z = (f32x4){0.f, 0.f, 0.f, 0.f};
          z = __builtin_amdgcn_mfma_f32_16x16x32_bf16(aq[pp][0], b0, z, 0, 0, 0);
          z = __builtin_amdgcn_mfma_f32_16x16x32_bf16(aq[pp][1], b1, z, 0, 0, 0);
          s[pp][sub] = z;
        }
      }
#pragma unroll
      for (int pp = 0; pp < 2; ++pp) {
#pragma unroll
        for (int j = 0; j < 4; ++j) {
          float s0 = s[pp][0][j] * scale, s1 = s[pp][1][j] * scale;
          float mx = max16(fmaxf(s0, s1));
          float mnew = fmaxf(mrun[pp][j], mx);
          float alpha = __expf(mrun[pp][j] - mnew);
          float p0 = __expf(s0 - mnew), p1 = __expf(s1 - mnew);
          float rs = sum16(p0 + p1);
          lrun[pp][j] = lrun[pp][j] * alpha + rs;
          mrun[pp][j] = mnew;
#pragma unroll
          for (int n = 0; n < 8; ++n) O[pp][n][j] *= alpha;
          Pw[(pp * 16 + g * 4 + j) * 40 + r] = f2bf(p0);
          Pw[(pp * 16 + g * 4 + j) * 40 + 16 + r] = f2bf(p1);
        }
      }
      __builtin_amdgcn_fence(__ATOMIC_RELEASE, "wavefront");
      __builtin_amdgcn_wave_barrier();
      __builtin_amdgcn_fence(__ATOMIC_ACQUIRE, "wavefront");
      bf16x8 pa0 = *(const bf16x8*)(Pw + (0 * 16 + r) * 40 + g * 8);
      bf16x8 pa1 = *(const bf16x8*)(Pw + (1 * 16 + r) * 40 + g * 8);
#pragma unroll
      for (int n = 0; n < 8; ++n) {
        const int dv = n * 16 + r;
        const bf16x8 vb = *(const bf16x8*)(Vs + dv * 64 + (((h2 * 4 + g) ^ ((dv >> 1) & 7)) << 3));
        O[0][n] = __builtin_amdgcn_mfma_f32_16x16x32_bf16(pa0, vb, O[0][n], 0, 0, 0);
        O[1][n] = __builtin_amdgcn_mfma_f32_16x16x32_bf16(pa1, vb, O[1][n], 0, 0, 0);
      }
      __builtin_amdgcn_fence(__ATOMIC_RELEASE, "wavefront");
      __builtin_amdgcn_wave_barrier();
    }
  }
#pragma unroll
  for (int j = 0; j < 4; ++j) {
    float i0 = 1.f / lrun[0][j], i1 = lam / lrun[1][j];
    float o[8];
    float ss = 0.f;
#pragma unroll
    for (int n = 0; n < 8; ++n) { o[n] = O[0][n][j] * i0 - O[1][n][j] * i1; ss += o[n] * o[n]; }
    ss = sum16(ss);
    float rs = rsqrtf(ss * (1.f / 128.f) + EPSF) * (1.f - lam_init);
    bh* arow = p.act + (size_t)(qrow + g * 4 + j) * 1024 + h * 128;
#pragma unroll
    for (int n = 0; n < 8; ++n) arow[n * 16 + r] = f2bf(o[n] * rs * p.diff_norm[h * 128 + n * 16 + r]);
  }
}

__device__ __forceinline__ void ffnact_job(const Params& p, int layer, int job) {
  int tidl = threadIdx.x; asm volatile("" : "+v"(tidl));
  const int item = job * 256 + tidl;
  const int rc = item / 352, j = (item % 352) * 8;
  const int t0 = rc * 8;
  const bh* U = (const bh*)p.R;
  bh* AO = (bh*)(p.R + OFF_ACTF);
  const float* cw = p.ffn_conv_w + (size_t)layer * 3 * 5632;
  const float* cb = p.ffn_conv_b + (size_t)layer * 5632;
  const bool start = (t0 < NTP) ? ((t0 & 255) == 0) : ((t0 & 2047) == 0);
  const bool endd = (t0 < NTP) ? (((t0 + 8) & 255) == 0) : (((t0 + 8) & 2047) == 0);
  u32x4 ua[10], ug[10];
  const u32x4 zz = {0, 0, 0, 0};
#pragma unroll
  for (int i = 0; i < 10; ++i) {
    const int t = t0 - 1 + i;
    const bool ok = (i == 0) ? !start : ((i == 9) ? !endd : true);
    ua[i] = ok ? *(const u32x4*)(U + (size_t)t * 5632 + j) : zz;
    ug[i] = ok ? *(const u32x4*)(U + (size_t)t * 5632 + 2816 + j) : zz;
  }
  float wa[3][8], wg[3][8], ba[8], bg[8];
#pragma unroll
  for (int tp = 0; tp < 3; ++tp) {
    float4 x0 = *(const float4*)(cw + tp * 5632 + j), x1 = *(const float4*)(cw + tp * 5632 + j + 4);
    float4 y0 = *(const float4*)(cw + tp * 5632 + 2816 + j), y1 = *(const float4*)(cw + tp * 5632 + 2816 + j + 4);
    wa[tp][0] = x0.x; wa[tp][1] = x0.y; wa[tp][2] = x0.z; wa[tp][3] = x0.w; wa[tp][4] = x1.x; wa[tp][5] = x1.y; wa[tp][6] = x1.z; wa[tp][7] = x1.w;
    wg[tp][0] = y0.x; wg[tp][1] = y0.y; wg[tp][2] = y0.z; wg[tp][3] = y0.w; wg[tp][4] = y1.x; wg[tp][5] = y1.y; wg[tp][6] = y1.z; wg[tp][7] = y1.w;
  }
  {
    float4 x0 = *(const float4*)(cb + j), x1 = *(const float4*)(cb + j + 4);
    float4 y0 = *(const float4*)(cb + 2816 + j), y1 = *(const float4*)(cb + 2816 + j + 4);
    ba[0] = x0.x; ba[1] = x0.y; ba[2] = x0.z; ba[3] = x0.w; ba[4] = x1.x; ba[5] = x1.y; ba[6] = x1.z; ba[7] = x1.w;
    bg[0] = y0.x; bg[1] = y0.y; bg[2] = y0.z; bg[3] = y0.w; bg[4] = y1.x; bg[5] = y1.y; bg[6] = y1.z; bg[7] = y1.w;
  }
#pragma unroll
  for (int i = 0; i < 8; ++i) {
    u32x4 ov;
#pragma unroll
    for (int e2 = 0; e2 < 4; ++e2) {
      float res[2];
#pragma unroll
      for (int hl = 0; hl < 2; ++hl) {
        const int e = e2 * 2 + hl;
        float am = hl ? bfhi(ua[i][e2]) : bflo(ua[i][e2]);
        float a0 = hl ? bfhi(ua[i + 1][e2]) : bflo(ua[i + 1][e2]);
        float ap = hl ? bfhi(ua[i + 2][e2]) : bflo(ua[i + 2][e2]);
        float gm = hl ? bfhi(ug[i][e2]) : bflo(ug[i][e2]);
        float g0 = hl ? bfhi(ug[i + 1][e2]) : bflo(ug[i + 1][e2]);
        float gp = hl ? bfhi(ug[i + 2][e2]) : bflo(ug[i + 2][e2]);
        float av = wa[0][e] * am + wa[1][e] * a0 + wa[2][e] * ap + ba[e];
        float gv = wg[0][e] * gm + wg[1][e] * g0 + wg[2][e] * gp + bg[e];
        res[hl] = siluf_(gv) * av;
      }
      ov[e2] = pk2(res[0], res[1]);
    }
    *(u32x4*)(AO + (size_t)(t0 + i) * 2816 + j) = ov;
  }
}

#define XB_TMO      128
#define XB_XCNT(j)  (256  + 64 * (j))
#define XB_XSUB(j)  (1280 + 64 * (j))
#define XB_XGEN(j)  (2304 + 64 * (j))
#define XB_TOP      3328
#define XB_TOPGEN   3392
#define XCD_BAR_WORDS 3456
#define XB_SPIN_CAP (1u << 18)
#define LAS __attribute__((address_space(3)))

__device__ __forceinline__ unsigned xb_ld(unsigned* p)              { return __hip_atomic_load(p, __ATOMIC_RELAXED, __HIP_MEMORY_SCOPE_AGENT); }
__device__ __forceinline__ unsigned xb_add(unsigned* p, unsigned v) { return __hip_atomic_fetch_add(p, v, __ATOMIC_RELAXED, __HIP_MEMORY_SCOPE_AGENT); }
__device__ __forceinline__ unsigned xb_xcc_id() { return (unsigned)__builtin_amdgcn_s_getreg((3 << 11) | 20) & 0xFu; }
#define XB_SPIN(cond, bar) do { unsigned _sp = 0; while (cond) { __builtin_amdgcn_s_sleep(1); \
    if ((++_sp & 255u) == 0u) { if (xb_ld(&(bar)[XB_TMO])) break; if (_sp > XB_SPIN_CAP) { atomicAdd(&(bar)[XB_TMO], 1u); break; } } } } while (0)

struct XcdBarrier {
    unsigned* bar; unsigned x;
    volatile LAS unsigned* st;
};

__device__ __forceinline__ XcdBarrier xcd_barrier_post(unsigned* bar, volatile LAS unsigned* st) {
    XcdBarrier b; b.bar = bar; b.x = xb_xcc_id(); b.st = st;
    if (threadIdx.x == 0) (void)xb_add(&bar[XB_XCNT(b.x)], 1u);
    return b;
}
__device__ __forceinline__ void xcd_barrier_complete(unsigned* bar, unsigned x, unsigned& nloc, unsigned& nx) {
    const unsigned G = gridDim.x * gridDim.y * gridDim.z;
    unsigned sum, cnt, mine, sp = 0u;
    for (;;) {
        sum = 0u; cnt = 0u; mine = 0u;
#pragma unroll
        for (unsigned j = 0; j < 16; ++j) { const unsigned c = xb_ld(&bar[XB_XCNT(j)]); sum += c; cnt += (c > 0u) ? 1u : 0u; mine = (j == x) ? c : mine; }
        if (sum == G) break;
        __builtin_amdgcn_s_sleep(1);
        if ((++sp & 255u) == 0u) { if (xb_ld(&bar[XB_TMO])) break; if (sp > XB_SPIN_CAP) { atomicAdd(&bar[XB_TMO], 1u); break; } }
    }
    nloc = mine > 0u ? mine : 1u; nx = cnt > 0u ? cnt : 1u;
}

__device__ __forceinline__ void xcd_barrier(const XcdBarrier& b) {
    asm volatile("s_waitcnt vmcnt(0)" ::: "memory");
    __syncthreads();
    if (threadIdx.x == 0) {
        unsigned* bar = b.bar;
        __builtin_amdgcn_s_waitcnt(0);
        unsigned nloc = b.st[0], nx = b.st[1];
        if (nloc == 0u) { xcd_barrier_complete(bar, b.x, nloc, nx); b.st[0] = nloc; b.st[1] = nx; }
        const unsigned old = xb_add(&bar[XB_XSUB(b.x)], 1u);
        const unsigned gen = old / nloc;
        if (old + 1u == (gen + 1u) * nloc) {
            __builtin_amdgcn_fence(__ATOMIC_RELEASE, "agent");
            asm volatile("s_waitcnt vmcnt(0)" ::: "memory");
            const unsigned og = xb_add(&bar[XB_TOP], 1u);
            const unsigned tg = og / nx;
            if (og + 1u == (tg + 1u) * nx) xb_add(&bar[XB_TOPGEN], 1u);
            else XB_SPIN(xb_ld(&bar[XB_TOPGEN]) == tg, bar);
            __builtin_amdgcn_fence(__ATOMIC_ACQUIRE, "agent");
            xb_add(&bar[XB_XGEN(b.x)], 1u);
            asm volatile("s_waitcnt vmcnt(0)" ::: "memory");
        } else {
            XB_SPIN(xb_ld(&bar[XB_XGEN(b.x)]) == gen, bar);
            __builtin_amdgcn_fence(__ATOMIC_ACQUIRE, "agent");
            asm volatile("s_waitcnt vmcnt(0)" ::: "memory");
        }
    }
    __syncthreads();
}


template <int ph>
__device__ __forceinline__ void run_phase(const Params& p, int bid, int nb, char* smem, bool rep = false) {
  const float* ng = p.norm_g;
  const bh* Rf = (const bh*)p.R;
  if (ph == 0) {
    for (int j = bid + (rep ? 768 : 0); j < 768 + 576 + 1024; j += nb) {
      if (j < 768) gemv_job(p, j, smem);
      else if (j < 1344) filter_job(p, j - 768, smem);
      else convert_tile(p.w_in_even, 1024, 4096, p.wt, j - 1344, smem);
    }
  } else if (ph == 1) {
    for (int j = bid; j < 768; j += nb) rows_job(p, j, true, nullptr, nullptr, 0, 0, ng + 0 * 1024, 0, 0);
  } else if (ph == 2) {
    gemm_phase<2, 192, 3>(p.act, 1024, p.wt, 1024, p.R, 4096, 4096, 32, bid, nb, smem);
  } else if (ph == 3) {
    if (nb == 512 && !rep) {
      hyena_sample_job(p, bid, smem);
      if (bid < 384) scan2_unit<0>(p, bid, smem);
      else {
        const int q = bid - 384;
        hyena_prompt_job(p, q, smem);
        hyena_prompt_job(p, q + 128, smem);
        convert_tile(p.w_out_even, 1024, 1024, p.wt, q, smem);
        convert_tile(p.w_out_even, 1024, 1024, p.wt, q + 128, smem);
      }
    } else {
      for (int j = bid + (rep ? 512 : 0); j < (rep ? 896 : 512 + 384 + 256 + 256); j += nb) {
        if (j < 512) hyena_sample_job(p, j, smem);
        else if (j < 896) scan2_unit<0>(p, j - 512, smem);
        else if (j < 1152) hyena_prompt_job(p, j - 896, smem);
        else convert_tile(p.w_out_even, 1024, 1024, p.wt, j - 1152, smem);
      }
    }
  } else if (ph == 4) {
    for (int j = bid; j < 128 + 1024; j += nb) {
      if (j < 128) fixup_unit<0>(p, j, smem);
      else scan_final_job(p, j - 128, 0);
    }
  } else if (ph == 5) {
    for (int j = bid; j < 512; j += nb) scan_final_job(p, 1024 + j, 0);
  } else if (ph == 6) {
    gemm_phase<1, 192, 3>(p.act, 1024, p.wt, 1024, p.R, 1024, 1024, 8, bid, nb, smem);
  } else if (ph == 7) {
    for (int j = bid; j < 768 + 1408 + 704; j += nb) {
      if (j < 768) rows_job(p, j, true, Rf, ng + 1 * 1024, 0, 2, ng + 2 * 1024, 0, 3);
      else if (j < 2176) convert_tile(p.ffn_up, 1024, 5632, p.wt, j - 768, smem, true);
      else convert_tile(p.ffn_down, 2816, 1024, p.wt2, j - 2176, smem);
    }
  } else if (ph == 8) {
    gemm_phase<3, 192, 3>(p.act, 1024, p.wt, 1024, p.R + OFF_ACTF, 2816, 5632, 44, bid, nb, smem, p.ffn_conv_w, p.ffn_conv_b);
  } else if (ph == 9) {
  } else if (ph == 10) {
    gemm_phase<1, 192, 3>((const bh*)(p.R + OFF_ACTF), 2816, p.wt2, 2816, p.R, 1024, 1024, 8, bid, nb, smem);
  } else if (ph == 11) {
    for (int j = bid; j < 768 + 800; j += nb) {
      if (j < 768) rows_job(p, j, false, Rf, ng + 3 * 1024, 0, 5, ng + 4 * 1024, 1, 0);
      else convert_tile(p.w_in_odd, 1024, 3104, p.wt, j - 768, smem);
    }
  } else if (ph == 12) {
    gemm_phase<1, 128, 3>(p.act, 1024, p.wt, 1024, p.R, 3104, 3104, 25, bid, nb, smem);
  } else if (ph == 13) {
    auto small13 = [&](int sj) {
      if (sj < 800) vt_job(p, sj, smem);
      else if (sj < 3872) oddrow_job(p, sj - 800);
      else if (sj < 4128) ctxk_job(p, sj - 3872);
      else convert_tile(p.w_out_odd, 1024, 1024, p.wt, sj - 4128, smem);
    };
    if (nb == 512 && !rep) {
      if (bid < 384) {
        scan2_unit<1>(p, bid, smem);
        for (int sj = 3072 + bid; sj < 4384; sj += 384) small13(sj);
      } else {
        for (int k = 0; k < 24; ++k) small13((bid - 384) + 128 * k);
      }
    } else {
      for (int j = bid; j < (rep ? 384 : 384 + 4384); j += nb) {
        if (j < 384) scan2_unit<1>(p, j, smem);
        else small13(j - 384);
      }
    }
  } else if (ph == 14) {
    if (nb == 512 && !rep) {
      if (bid < 256) attn_unit(p, bid, smem);
      else {
        const int q = bid - 256;
        attn_unit(p, 256 + q, smem);
        attn_unit(p, 512 + q, smem);
        if (q < 128) fixup_unit<1>(p, q, smem);
        for (int k = 0; k < 4; ++k) scan_final_job(p, q + 256 * k, 1);
      }
    } else {
      for (int j = bid; j < (rep ? 768 : 768 + 128 + 1024); j += nb) {
        if (j < 768) attn_unit(p, j, smem);
        else if (j < 896) fixup_unit<1>(p, j - 768, smem);
        else scan_final_job(p, j - 896, 1);
      }
    }
  } else if (ph == 15) {
    for (int j = bid; j < 512; j += nb) scan_final_job(p, 1024 + j, 1);
  } else if (ph == 16) {
    gemm_phase<1, 192, 3>(p.act, 1024, p.wt, 1024, p.R, 1024, 1024, 8, bid, nb, smem);
  } else if (ph == 17) {
    for (int j = bid; j < 768 + 1408 + 704; j += nb) {
      if (j < 768) rows_job(p, j, false, Rf, ng + 5 * 1024, 1, 2, ng + 6 * 1024, 1, 3);
      else if (j < 2176) convert_tile(p.ffn_up + (size_t)1024 * 5632, 1024, 5632, p.wt, j - 768, smem, true);
      else convert_tile(p.ffn_down + (size_t)2816 * 1024, 2816, 1024, p.wt2, j - 2176, smem);
    }
  } else if (ph == 18) {
    gemm_phase<3, 192, 3>(p.act, 1024, p.wt, 1024, p.R + OFF_ACTF, 2816, 5632, 44, bid, nb, smem, p.ffn_conv_w + 3 * 5632, p.ffn_conv_b + 5632);
  } else if (ph == 19) {
  } else if (ph == 20) {
    gemm_phase<1, 192, 3>((const bh*)(p.R + OFF_ACTF), 2816, p.wt2, 2816, p.R, 1024, 1024, 8, bid, nb, smem);
  } else if (ph == 21) {
    for (int j = bid; j < 768; j += nb) rows_job(p, j, false, Rf, ng + 7 * 1024, 1, 5, nullptr, 0, 0);
  }
}

template <int PH>
__device__ __forceinline__ void phase_step(const Params& p, int ph0, int ph1, char* smem, cg::grid_group& grid, const XcdBarrier& xb) {
  if (PH == 9 || PH == 19) return;
  if (PH >= ph0 && PH < ph1) {
    if (PH == REP_PH) { run_phase<PH>(p, blockIdx.x, gridDim.x, smem, true); xcd_barrier(xb); }
    run_phase<PH>(p, blockIdx.x, gridDim.x, smem);
    if (PH + 1 < ph1) {
      xcd_barrier(xb);
    }
  }
}

__global__ void __launch_bounds__(256, 2) mega_kernel(Params p, int ph0, int ph1) {
  __shared__ __attribute__((aligned(16))) char smem[49152];
  cg::grid_group grid = cg::this_grid();
  __shared__ uint4 xb_words;
  if (threadIdx.x == 0) xb_words = make_uint4(0u, 0u, 0u, 0u);
  __syncthreads();
  XcdBarrier xb = xcd_barrier_post(p.bar, (volatile LAS unsigned*)&xb_words);
#ifdef EXTRA_SYNCS
  for (int i = 0; i < EXTRA_SYNCS; ++i) xcd_barrier(xb);
#endif
  phase_step<0>(p, ph0, ph1, smem, grid, xb);
  phase_step<1>(p, ph0, ph1, smem, grid, xb);
  phase_step<2>(p, ph0, ph1, smem, grid, xb);
  phase_step<3>(p, ph0, ph1, smem, grid, xb);
  phase_step<4>(p, ph0, ph1, smem, grid, xb);
  phase_step<5>(p, ph0, ph1, smem, grid, xb);
  phase_step<6>(p, ph0, ph1, smem, grid, xb);
  phase_step<7>(p, ph0, ph1, smem, grid, xb);
  phase_step<8>(p, ph0, ph1, smem, grid, xb);
  phase_step<9>(p, ph0, ph1, smem, grid, xb);
  phase_step<10>(p, ph0, ph1, smem, grid, xb);
  phase_step<11>(p, ph0, ph1, smem, grid, xb);
  phase_step<12>(p, ph0, ph1, smem, grid, xb);
  phase_step<13>(p, ph0, ph1, smem, grid, xb);
  phase_step<14>(p, ph0, ph1, smem, grid, xb);
  phase_step<15>(p, ph0, ph1, smem, grid, xb);
  phase_step<16>(p, ph0, ph1, smem, grid, xb);
  phase_step<17>(p, ph0, ph1, smem, grid, xb);
  phase_step<18>(p, ph0, ph1, smem, grid, xb);
  phase_step<19>(p, ph0, ph1, smem, grid, xb);
  phase_step<20>(p, ph0, ph1, smem, grid, xb);
  phase_step<21>(p, ph0, ph1, smem, grid, xb);
}

extern "C" void kernel_launch(void* const* d_in, const int* in_sizes, int n_in, void* d_out, int out_size, void* d_ws,
                              size_t ws_size, hipStream_t stream) {
  static int grid_blocks = 0;
  if (!grid_blocks) {
    int dev = 0, cus = 0, per_cu = 0;
    hipGetDevice(&dev);
    hipDeviceGetAttribute(&cus, hipDeviceAttributeMultiprocessorCount, dev);
    hipOccupancyMaxActiveBlocksPerMultiprocessor(&per_cu, mega_kernel, 256, 0);
    if (per_cu > 2) per_cu = 2;
    if (per_cu < 1) per_cu = 1;
    grid_blocks = cus * per_cu;
  }
  Params p{};
  const float** pf = (const float**)&p;
  for (int i = 0; i < 35; ++i) pf[i] = (const float*)d_in[i];
  p.out = (float*)d_out;
  char* ws = (char*)d_ws;
  size_t off = 0;
  p.act = (bh*)(ws + off); off += (size_t)NT * 1024 * 2;
  p.wt = (bh*)(ws + off); off += (size_t)5632 * 1024 * 2;
  p.wt2 = (bh*)(ws + off); off += (size_t)1024 * 2816 * 2;
  p.R = ws + off; off += R_BYTES;
  p.mod = (float*)(ws + off); off += (size_t)2 * 3 * 6144 * 4;
  p.bar = (unsigned*)(ws + off); off += (size_t)XCD_BAR_WORDS * 4;
  p.gt256 = (bh*)(ws + off); off += (size_t)2 * 512 * 512 * 2;
  p.gt2048 = (bh*)(ws + off); off += (size_t)2 * 512 * 4096 * 2;
  if (off > ws_size) { fprintf(stderr, "workspace too small: need %zu have %zu\n", off, ws_size); return; }
  hipMemsetAsync(p.mod, 0, (size_t)2 * 3 * 6144 * 4 + (size_t)XCD_BAR_WORDS * 4, stream);
#if MEGA
  int ph0 = 0, ph1 = NPHASE;
  void* args[] = {&p, &ph0, &ph1};
  hipError_t e = hipLaunchCooperativeKernel((void*)mega_kernel, dim3(grid_blocks), dim3(256), args, 0, stream);
  if (e != hipSuccess) fprintf(stderr, "cooperative launch failed: %s (grid %d)\n", hipGetErrorString(e), grid_blocks);
#else
  for (int ph = 0; ph < NPHASE; ++ph) {
    int ph0 = ph, ph1 = ph + 1;
    void* args[] = {&p, &ph0, &ph1};
    hipError_t e = hipLaunchCooperativeKernel((void*)mega_kernel, dim3(grid_blocks), dim3(256), args, 0, stream);
    if (e != hipSuccess) fprintf(stderr, "launch failed: %s\n", hipGetErrorString(e));
  }
#endif
}
```
